# Optimizing an MI355X kernel written in HIP

```python
import math
import jax, jax.numpy as jnp
from jax import lax
import numpy as np


D_MODEL = 1024
BATCH = 2
SEQ = 16384
DEPTH = 2

N_MIXERS = 2
ROPE_THETA = 500000.0
ROT_DIM = 16
Q_BLOCK = 128
NORM_EPS = 1e-6
NEG_INF = -1e30

DA_HEAD_DIM = 64
DA_V_DIM = 2 * DA_HEAD_DIM
DA_HEADS = D_MODEL // DA_V_DIM

NSA_HEAD_DIM = 64
NSA_HEADS = D_MODEL // NSA_HEAD_DIM
NSA_KV_GROUPS = 2
NSA_HEADS_PER_GROUP = NSA_HEADS // NSA_KV_GROUPS
NSA_CMP_BLOCK = 32
NSA_CMP_STRIDE = 16
NSA_CMP_HIDDEN = 4 * NSA_HEAD_DIM
NSA_SEL_BLOCK = 64
NSA_TOP_N = 16
NSA_WINDOW = 512
NSA_FORCE = 1e4
NSA_IN_DIM = NSA_HEADS * NSA_HEAD_DIM + 6 * NSA_KV_GROUPS * NSA_HEAD_DIM + 3 * NSA_HEADS

MOE_GROUPS = 4
MOE_EXPERTS_PER_GROUP = 8
MOE_EXPERTS = MOE_GROUPS * MOE_EXPERTS_PER_GROUP
MOE_TOP_K = 2
MOE_HIDDEN = D_MODEL // 4

kernel_name = 'hybrid_diffattn_nsa_hiermoe_adaln'


def _rmsnorm(x, g):
    xf = x.astype(jnp.float32)
    y = xf * lax.rsqrt(jnp.mean(xf * xf, axis=-1, keepdims=True) + NORM_EPS)
    return (y * g.astype(jnp.float32)).astype(x.dtype)


def _rope_tables(positions):
    inv_freq = ROPE_THETA ** (-jnp.arange(0, ROT_DIM, 2, dtype=jnp.float32) / ROT_DIM)
    ang = positions.astype(jnp.float32)[..., None] * inv_freq
    return jnp.cos(ang)[:, :, None, :], jnp.sin(ang)[:, :, None, :]


def _rotary(x, cos, sin):
    half = ROT_DIM // 2
    xr = x[..., :ROT_DIM].astype(jnp.float32)
    x1, x2 = xr[..., :half], xr[..., half:]
    rot = jnp.concatenate([x1 * cos - x2 * sin, x2 * cos + x1 * sin], axis=-1).astype(x.dtype)
    return jnp.concatenate([rot, x[..., ROT_DIM:]], axis=-1)


def _masked_softmax(s, mask):
    s = jnp.where(mask, s.astype(jnp.float32), NEG_INF)
    p = jnp.where(mask, jnp.exp(s - jnp.max(s, axis=-1, keepdims=True)), 0.0)
    return p / jnp.maximum(jnp.sum(p, axis=-1, keepdims=True), 1e-30)


def diff_attention(h, cos, sin, w_in, w_out, lam, subln_g, lambda_init):
    B, S, D = h.shape
    H, d = DA_HEADS, DA_HEAD_DIM
    q, k, v = jnp.split(h @ w_in, 3, axis=-1)
    q = _rotary(q.reshape(B, S, 2 * H, d), cos, sin).reshape(B, S, H, 2, d).transpose(3, 0, 2, 1, 4)
    k = _rotary(k.reshape(B, S, 2 * H, d), cos, sin).reshape(B, S, H, 2, d).transpose(3, 0, 2, 1, 4)
    v = v.reshape(B, S, H, DA_V_DIM).transpose(0, 2, 1, 3)
    lam = lam.astype(jnp.float32)
    lam_full = jnp.exp(jnp.sum(lam[0] * lam[1])) - jnp.exp(jnp.sum(lam[2] * lam[3])) + lambda_init
    scale = d ** -0.5
    k_pos = jnp.arange(S)

    def block(i):
        q0 = i * Q_BLOCK
        qb = lax.dynamic_slice_in_dim(q, q0, Q_BLOCK, axis=3)
        s = jnp.einsum('cbhqd,cbhkd->cbhqk', qb, k) * scale
        mask = k_pos[None, :] <= (q0 + jnp.arange(Q_BLOCK))[:, None]
        p = _masked_softmax(s, mask)
        a = p[0] - lam_full * p[1]
        return jnp.einsum('bhqk,bhkv->bhqv', a.astype(v.dtype), v)

    o = lax.map(block, jnp.arange(S // Q_BLOCK))
    o = o.transpose(1, 0, 3, 2, 4).reshape(B, S, H, DA_V_DIM)
    o = _rmsnorm(o, subln_g) * (1.0 - lambda_init)
    return o.reshape(B, S, D) @ w_out


def _nsa_compress(t, pos_emb, w1, b1, w2):
    B, G, S, d = t.shape
    ch = t.reshape(B, G, S // NSA_CMP_STRIDE, NSA_CMP_STRIDE, d)
    blk = jnp.concatenate([ch[:, :, :-1], ch[:, :, 1:]], axis=3) + pos_emb
    blk = blk.reshape(B, G, blk.shape[2], NSA_CMP_BLOCK * d)
    return jax.nn.gelu(blk @ w1 + b1) @ w2


def nsa_attention(h, cos, sin, w_in, w_out, cmp_pos, cmp_w1, cmp_b1, cmp_w2):
    B, S, D = h.shape
    H, G, Hg, d = NSA_HEADS, NSA_KV_GROUPS, NSA_HEADS_PER_GROUP, NSA_HEAD_DIM
    kvw = G * d
    proj = h @ w_in
    bounds = [H * d + j * kvw for j in range(7)]
    q, k_c, v_c, k_s, v_s, k_w, v_w, g_raw = jnp.split(proj, bounds, axis=-1)
    q = _rotary(q.reshape(B, S, H, d), cos, sin).reshape(B, S, G, Hg, d).transpose(0, 2, 3, 1, 4)

    def kv(t, rope):
        t = t.reshape(B, S, G, d)
        if rope:
            t = _rotary(t, cos, sin)
        return t.transpose(0, 2, 1, 3)

    k_c, v_c = kv(k_c, False), kv(v_c, False)
    k_s, v_s = kv(k_s, True), kv(v_s, True)
    k_w, v_w = kv(k_w, True), kv(v_w, True)
    gates = jax.nn.sigmoid(g_raw.astype(jnp.float32)).reshape(B, S, G, Hg, 3).transpose(0, 2, 3, 1, 4)

    k_cmp = _nsa_compress(k_c, cmp_pos[0], cmp_w1[0], cmp_b1[0], cmp_w2[0])
    v_cmp = _nsa_compress(v_c, cmp_pos[1], cmp_w1[1], cmp_b1[1], cmp_w2[1])
    n_cmp = k_cmp.shape[2]
    n_sel = S // NSA_SEL_BLOCK
    n_top = min(NSA_TOP_N, n_sel)
    cmp_start = jnp.arange(n_cmp) * NSA_CMP_STRIDE
    cmp_end = cmp_start + NSA_CMP_BLOCK - 1
    sel_start = jnp.arange(n_sel) * NSA_SEL_BLOCK
    cmp_to_sel = ((cmp_start[:, None] < sel_start[None, :] + NSA_SEL_BLOCK)
                  & (cmp_start[:, None] + NSA_CMP_BLOCK > sel_start[None, :])).astype(jnp.float32)
    k_blocks = k_s.reshape(B, G, n_sel, NSA_SEL_BLOCK, d)
    v_blocks = v_s.reshape(B, G, n_sel, NSA_SEL_BLOCK, d)
    pad = ((0, 0), (0, 0), (NSA_WINDOW, 0), (0, 0))
    k_w_pad, v_w_pad = jnp.pad(k_w, pad), jnp.pad(v_w, pad)
    b_ix = jnp.arange(B)[:, None, None, None]
    g_ix = jnp.arange(G)[None, :, None, None]
    blk_off = jnp.arange(NSA_SEL_BLOCK)
    sel_ids = jnp.arange(n_sel)
    scale = d ** -0.5

    def block(i):
        q0 = i * Q_BLOCK
        tq = q0 + jnp.arange(Q_BLOCK)
        qb = lax.dynamic_slice_in_dim(q, q0, Q_BLOCK, axis=3)
        s_c = jnp.einsum('bghqd,bgnd->bghqn', qb, k_cmp) * scale
        p_c = _masked_softmax(s_c, cmp_end[None, :] <= tq[:, None])
        o_c = jnp.einsum('bghqn,bgnd->bghqd', p_c.astype(v_cmp.dtype), v_cmp)
        imp = jnp.einsum('bgqn,ns->bgqs', p_c.sum(axis=2), cmp_to_sel)
        q_blk = tq // NSA_SEL_BLOCK
        forced = ((sel_ids[None, :] == 0) | (sel_ids[None, :] == q_blk[:, None])
                  | (sel_ids[None, :] == q_blk[:, None] - 1))
        causal = sel_ids[None, :] <= q_blk[:, None]
        imp = jnp.where(forced, NSA_FORCE, jnp.where(causal, imp, -NSA_FORCE))
        _, sel = lax.top_k(imp, n_top)
        k_sel = k_blocks[b_ix, g_ix, sel].reshape(B, G, Q_BLOCK, n_top * NSA_SEL_BLOCK, d)
        v_sel = v_blocks[b_ix, g_ix, sel].reshape(B, G, Q_BLOCK, n_top * NSA_SEL_BLOCK, d)
        tok = (sel[..., None] * NSA_SEL_BLOCK + blk_off).reshape(B, G, Q_BLOCK, n_top * NSA_SEL_BLOCK)
        s_s = jnp.einsum('bghqd,bgqkd->bghqk', qb, k_sel) * scale
        p_s = _masked_softmax(s_s, tok[:, :, None] <= tq[:, None])
        o_s = jnp.einsum('bghqk,bgqkd->bghqd', p_s.astype(v_sel.dtype), v_sel)
        k_win = lax.dynamic_slice_in_dim(k_w_pad, q0, Q_BLOCK + NSA_WINDOW, axis=2)
        v_win = lax.dynamic_slice_in_dim(v_w_pad, q0, Q_BLOCK + NSA_WINDOW, axis=2)
        tk = q0 - NSA_WINDOW + jnp.arange(Q_BLOCK + NSA_WINDOW)
        dist = tq[:, None] - tk[None, :]
        mask_w = (tk[None, :] >= 0) & (dist >= 0) & (dist < NSA_WINDOW)
        s_w = jnp.einsum('bghqd,bgkd->bghqk', qb, k_win) * scale
        p_w = _masked_softmax(s_w, mask_w)
        o_w = jnp.einsum('bghqk,bgkd->bghqd', p_w.astype(v_win.dtype), v_win)
        gb = lax.dynamic_slice_in_dim(gates, q0, Q_BLOCK, axis=3)
        o = gb[..., 0:1] * o_c + gb[..., 1:2] * o_s + gb[..., 2:3] * o_w
        return o.astype(h.dtype)

    o = lax.map(block, jnp.arange(S // Q_BLOCK))
    o = o.transpose(1, 0, 4, 2, 3, 5).reshape(B, S, D)
    return o @ w_out


def hier_moe(h, w_grp, b_grp, w_exp, b_exp, w_gate, w_up, w_down):
    B, S, D = h.shape
    t = h.reshape(B * S, D)
    T = t.shape[0]
    pg = jax.nn.softmax((t @ w_grp).astype(jnp.float32) + b_grp, axis=-1)
    p_top, grp = lax.top_k(pg, 1)
    le = jnp.einsum('td,gde->tge', t, w_exp).astype(jnp.float32) + b_exp
    le_sel = le[jnp.arange(T), grp[:, 0]]
    val, idx = lax.top_k(le_sel, MOE_TOP_K)
    wts = jax.nn.softmax(val, axis=-1) * p_top
    eid = grp * MOE_EXPERTS_PER_GROUP + idx
    combine = jnp.sum(jax.nn.one_hot(eid, MOE_EXPERTS, dtype=jnp.float32) * wts[..., None], axis=1)
    y = jnp.zeros_like(t)
    for gi in range(MOE_GROUPS):
        sl = slice(gi * MOE_EXPERTS_PER_GROUP, (gi + 1) * MOE_EXPERTS_PER_GROUP)
        a = jax.nn.silu(jnp.einsum('td,edh->teh', t, w_gate[sl])) * jnp.einsum('td,edh->teh', t, w_up[sl])
        a = a * combine[:, sl, None].astype(a.dtype)
        y = y + jnp.einsum('teh,ehd->td', a, w_down[sl]).astype(t.dtype)
    return y.reshape(B, S, D)


def setup_inputs(seed: int = 0) -> dict:
    key = jax.random.key(seed)
    ks = iter(jax.random.split(key, 32))
    D = D_MODEL
    n_a = (DEPTH + N_MIXERS - 1) // N_MIXERS
    n_b = DEPTH // N_MIXERS

    def nrm(shape, scale):
        return jax.random.normal(next(ks), shape, jnp.float32) * scale

    return {
        'x': nrm((BATCH, SEQ, D), 1.0),
        'c': nrm((BATCH, D), 1.0),
        'positions': (jax.random.randint(next(ks), (BATCH, 1), 0, 4096) + jnp.arange(SEQ)[None, :]).astype(jnp.int32),
        'ada_w': nrm((DEPTH, D, 6 * D), 0.5 * D ** -0.5),
        'ada_b': nrm((DEPTH, 6 * D), 0.02),
        'norm_g': 1.0 + nrm((DEPTH, 2, D), 0.02),
        'final_g': 1.0 + nrm((D,), 0.02),
        'diff_w_in': nrm((n_a, D, 3 * D), D ** -0.5),
        'diff_w_out': nrm((n_a, D, D), D ** -0.5),
        'diff_lambda': nrm((n_a, 4, DA_HEAD_DIM), 0.1),
        'diff_subln_g': 1.0 + nrm((n_a, DA_V_DIM), 0.02),
        'nsa_w_in': nrm((n_b, D, NSA_IN_DIM), D ** -0.5),
        'nsa_w_out': nrm((n_b, D, D), D ** -0.5),
        'nsa_cmp_pos': nrm((n_b, 2, NSA_CMP_BLOCK, NSA_HEAD_DIM), 0.02),
        'nsa_cmp_w1': nrm((n_b, 2, NSA_CMP_BLOCK * NSA_HEAD_DIM, NSA_CMP_HIDDEN), (NSA_CMP_BLOCK * NSA_HEAD_DIM) ** -0.5),
        'nsa_cmp_b1': nrm((n_b, 2, NSA_CMP_HIDDEN), 0.02),
        'nsa_cmp_w2': nrm((n_b, 2, NSA_CMP_HIDDEN, NSA_HEAD_DIM), NSA_CMP_HIDDEN ** -0.5),
        'moe_w_group': nrm((DEPTH, D, MOE_GROUPS), D ** -0.5),
        'moe_b_group': nrm((DEPTH, MOE_GROUPS), 0.01),
        'moe_w_expert': nrm((DEPTH, MOE_GROUPS, D, MOE_EXPERTS_PER_GROUP), D ** -0.5),
        'moe_b_expert': nrm((DEPTH, MOE_GROUPS, MOE_EXPERTS_PER_GROUP), 0.01),
        'moe_w_gate': nrm((DEPTH, MOE_EXPERTS, D, MOE_HIDDEN), D ** -0.5),
        'moe_w_up': nrm((DEPTH, MOE_EXPERTS, D, MOE_HIDDEN), D ** -0.5),
        'moe_w_down': nrm((DEPTH, MOE_EXPERTS, MOE_HIDDEN, D), MOE_HIDDEN ** -0.5),
    }


def reference(x, c, positions, ada_w, ada_b, norm_g, final_g,
              diff_w_in, diff_w_out, diff_lambda, diff_subln_g,
              nsa_w_in, nsa_w_out, nsa_cmp_pos, nsa_cmp_w1, nsa_cmp_b1, nsa_cmp_w2,
              moe_w_group, moe_b_group, moe_w_expert, moe_b_expert,
              moe_w_gate, moe_w_up, moe_w_down):
    cos, sin = _rope_tables(positions)
    c_act = jax.nn.silu(c)
    for i in range(DEPTH):
        mod = c_act @ ada_w[i] + ada_b[i]
        sh1, sc1, g1, sh2, sc2, g2 = jnp.split(mod[:, None, :], 6, axis=-1)
        h = _rmsnorm(x, norm_g[i, 0]) * (1.0 + sc1) + sh1
        j = i // N_MIXERS
        if i % N_MIXERS == 0:
            lambda_init = 0.8 - 0.6 * math.exp(-0.3 * i)
            mix = diff_attention(h, cos, sin, diff_w_in[j], diff_w_out[j], diff_lambda[j],
                                 diff_subln_g[j], lambda_init)
        else:
            mix = nsa_attention(h, cos, sin, nsa_w_in[j], nsa_w_out[j], nsa_cmp_pos[j],
                                nsa_cmp_w1[j], nsa_cmp_b1[j], nsa_cmp_w2[j])
        x = x + g1 * mix
        h = _rmsnorm(x, norm_g[i, 1]) * (1.0 + sc2) + sh2
        x = x + g2 * hier_moe(h, moe_w_group[i], moe_b_group[i], moe_w_expert[i], moe_b_expert[i],
                              moe_w_gate[i], moe_w_up[i], moe_w_down[i])
    return _rmsnorm(x, final_g)
```

```cpp
#define REP_MASK ((1u<<5))
#include <hip/hip_runtime.h>
#include <cstdio>
#include <cstdint>
namespace pg8 {
#define PG8_LAS __attribute__((address_space(3)))
typedef unsigned short bf16_t;
typedef short bf16x8 __attribute__((ext_vector_type(8)));
typedef float f32x4 __attribute__((ext_vector_type(4)));
typedef unsigned u32x4 __attribute__((ext_vector_type(4)));
constexpr int BM = 256, BK = 64, HALF = 128, HTB = HALF * BK * 2  , STAGE_BYTES = 8 * HTB, NXCD = 8, WGM = 8;

__host__ __device__ __forceinline__ int lds_byte(int r, int c) { const int st = (r >> 4) * 2 + (c >> 5), rr = r & 15, cc = c & 31, ob = rr * 64 + cc * 2; return st * 1024 + (ob ^ (((ob >> 9) & 1) << 5)); }
__host__ __device__ __forceinline__ void stage_rc(int b, int& R, int& C) { const int st = b / 1024, sb = b % 1024, swz = sb ^ (((sb >> 9) & 1) << 5); R = (st >> 1) * 16 + swz / 64; C = (st & 1) * 32 + (swz % 64) / 2; }
__host__ __device__ __forceinline__ int perm32(int rho) { const int n = rho >> 4, i = rho & 15; return 8 * (i >> 2) + 4 * n + (i & 3); }

struct Unit { int pm, pn, e, ti, cnt, half = 0; };
struct Gemm { const bf16_t* A; const bf16_t* Bt; int M, N, K, lda; };

struct StaticOrder {
    int nM, nN, nwg, G, c;
    __host__ __device__ void init(int M, int N, int G_, int c_) { nM = M / BM; nN = N / BM; nwg = nM * nN; G = G_; c = c_; }
    __host__ __device__ bool next(int i, Unit& u) const {
        const long L = (long)i * G + c; if (L >= nwg) return false;
        int wgid = (int)L; { const int q = nwg / NXCD, r = nwg % NXCD, xcd = wgid % NXCD, off = wgid / NXCD; wgid = (xcd < r ? xcd * (q + 1) : r * (q + 1) + (xcd - r) * q) + off; }
        const int nig = WGM * nN, gid = wgid / nig, fm = gid * WGM, gsz = (nM - fm) < WGM ? (nM - fm) : WGM;
        u.pm = fm + ((wgid % nig) % gsz); u.pn = (wgid % nig) / gsz; return true;
    }
    __device__ __forceinline__ void a_ready(const Unit&) const {}
    __device__ __forceinline__ void done(const Unit&) const {}
};

__device__ __forceinline__ unsigned cvt_pk_bf16(float lo, float hi) { unsigned r; asm volatile("v_cvt_pk_bf16_f32 %0, %1, %2" : "=v"(r) : "v"(lo), "v"(hi)); return r; }
typedef float f32x2 __attribute__((ext_vector_type(2)));

constexpr int kSeq = 16384, kTok = 32768;
struct RopeCtx { const float* rope; unsigned ropemask; };
__device__ __forceinline__ void rope8p(f32x4& v0, f32x4& v1, const RopeCtx& R, int ch, int wc, int fq, int bp, const f32x4 (&t)[4]) {
    if (((R.ropemask >> ch) & 1u) && ((wc & 1) == 0)) {
        f32x4 o0, o1;
#pragma unroll
        for (int i = 0; i < 4; ++i) { o0[i] = __int_as_float(__builtin_amdgcn_ds_bpermute(bp, __float_as_int(v0[i]))); o1[i] = __int_as_float(__builtin_amdgcn_ds_bpermute(bp, __float_as_int(v1[i]))); }
        if (fq < 2) { v0 = v0 * t[0] + o0 * t[2]; v1 = v1 * t[1] + o1 * t[3]; }
    }
}
__device__ __forceinline__ u32x4 pack8(const f32x4& v0, const f32x4& v1) { u32x4 w; w.x = cvt_pk_bf16(v0[0], v0[1]); w.y = cvt_pk_bf16(v0[2], v0[3]); w.z = cvt_pk_bf16(v1[0], v1[1]); w.w = cvt_pk_bf16(v1[2], v1[3]); return w; }

struct EpiQKV {
    static constexpr bool PERM = true, AFTER_DRAIN = false;
    bf16_t* O; size_t tstride; RopeCtx R;
    __device__ __forceinline__ void operator()(const f32x4 (&acc)[2][2][4][2], const Unit& u, int wr, int wc, int fr, int fq) const {
        const int row0 = u.pm * BM + wr * 64 + fr, bp = (((fq ^ 1) & 3) * 16 + fr) * 4;
#pragma unroll
        for (int ai = 0; ai < 2; ++ai)
        { f32x4 rt[4][4];
            if (((R.ropemask >> (2 * u.pn)) & 3u) && ((wc & 1) == 0) && fq < 2) { const float sg = (fq == 0) ? -1.f : 1.f;
#pragma unroll
                for (int m = 0; m < 4; ++m) { const f32x4* rp = (const f32x4*)(R.rope + (size_t)(row0 + ai * HALF + m * 16) * 16); rt[m][0] = rp[0]; rt[m][1] = rp[1]; rt[m][2] = rp[2] * sg; rt[m][3] = rp[3] * sg; } }
#pragma unroll
            for (int m = 0; m < 4; ++m) { const int row = row0 + ai * HALF + m * 16;
#pragma unroll
                for (int bj = 0; bj < 2; ++bj) { const int ch = 2 * u.pn + bj, t = ch >> 3, col = (ch & 7) * 128 + wc * 32 + 8 * fq;
                    f32x4 v0 = acc[ai][bj][m][0], v1 = acc[ai][bj][m][1]; rope8p(v0, v1, R, ch, wc, fq, bp, rt[m]);
                    *(u32x4*)(O + (size_t)t * tstride + (size_t)row * 1024 + col) = pack8(v0, v1); } } }
    }
};
struct EpiNsaProj {
    static constexpr bool PERM = true, AFTER_DRAIN = false;
    bf16_t* P; bf16_t* KC; RopeCtx R;
    __device__ __forceinline__ void operator()(const f32x4 (&acc)[2][2][4][2], const Unit& u, int wr, int wc, int fr, int fq) const {
        const int row0 = u.pm * BM + wr * 64 + fr, bp = (((fq ^ 1) & 3) * 16 + fr) * 4;
#pragma unroll
        for (int ai = 0; ai < 2; ++ai) { f32x4 rt[4][4];
            if (((R.ropemask >> (2 * u.pn)) & 3u) && ((wc & 1) == 0) && fq < 2) { const float sg = (fq == 0) ? -1.f : 1.f;
#pragma unroll
                for (int m = 0; m < 4; ++m) { const f32x4* rp = (const f32x4*)(R.rope + (size_t)(row0 + ai * HALF + m * 16) * 16); rt[m][0] = rp[0]; rt[m][1] = rp[1]; rt[m][2] = rp[2] * sg; rt[m][3] = rp[3] * sg; } }
#pragma unroll
            for (int m = 0; m < 4; ++m) { const int row = row0 + ai * HALF + m * 16;
#pragma unroll
                for (int bj = 0; bj < 2; ++bj) { const int ch = 2 * u.pn + bj;
                    f32x4 v0 = acc[ai][bj][m][0], v1 = acc[ai][bj][m][1]; rope8p(v0, v1, R, ch, wc, fq, bp, rt[m]);
                    bf16_t* dst;
                    if (ch == 8 || ch == 9) { const int kv = ch - 8, b = row >= kSeq ? 1 : 0, t = row - b * kSeq, gi = wc >> 1;
                        dst = KC + ((size_t)((kv * 2 + b) * 2 + gi) * kSeq + t) * 64 + (wc & 1) * 32 + 8 * fq; }
                    else dst = P + (size_t)row * 2048 + ch * 128 + wc * 32 + 8 * fq;
                    *(u32x4*)dst = pack8(v0, v1); } } }
    }
};
struct EpiResid {
    static constexpr bool PERM = false, AFTER_DRAIN = false;
    const float* base; float* out; const float* gate;
    __device__ __forceinline__ void operator()(const f32x4 (&acc)[2][2][4][2], const Unit& u, int wr, int wc, int fr, int fq) const {
        const int row0 = u.pm * BM + wr * 64 + fr, col0 = u.pn * BM + wc * 32 + 4 * fq;
        const float* gp = gate + ((u.pm * BM) >= kSeq ? 6144 : 0);
        f32x4 gv[2][2];
#pragma unroll
        for (int bj = 0; bj < 2; ++bj)
#pragma unroll
            for (int n = 0; n < 2; ++n) gv[bj][n] = *(const f32x4*)(gp + col0 + bj * HALF + n * 16);
#pragma unroll
        for (int ai = 0; ai < 2; ++ai)
#pragma unroll
            for (int m = 0; m < 4; ++m) { const size_t off = (size_t)(row0 + ai * HALF + m * 16) * 1024 + col0;
#pragma unroll
                for (int bj = 0; bj < 2; ++bj)
#pragma unroll
                    for (int n = 0; n < 2; ++n) { const f32x4 bs = *(const f32x4*)(base + off + bj * HALF + n * 16);
                        *(f32x4*)(out + off + bj * HALF + n * 16) = bs + gv[bj][n] * acc[ai][bj][m][n]; } }
    }
};
struct EpiResidB {
    static constexpr bool PERM = true, AFTER_DRAIN = false;
    const float* basef; const bf16_t* baseh; bf16_t* out; const float* gate;
    __device__ __forceinline__ void operator()(const f32x4 (&acc)[2][2][4][2], const Unit& u, int wr, int wc, int fr, int fq) const {
        const int row0 = u.pm * BM + wr * 64 + fr, col0 = u.pn * BM + wc * 32 + 8 * fq;
        const float* gp = gate + ((u.pm * BM) >= kSeq ? 6144 : 0);
        f32x4 gv[2][2];
#pragma unroll
        for (int bj = 0; bj < 2; ++bj) { gv[bj][0] = *(const f32x4*)(gp + col0 + bj * HALF); gv[bj][1] = *(const f32x4*)(gp + col0 + bj * HALF + 4); }
        if (basef) {
#pragma unroll
            for (int am = 0; am < 4; ++am) { const int ai = am >> 1, m0 = (am & 1) * 2; f32x4 bb[2][2][2];
#pragma unroll
                for (int m = 0; m < 2; ++m) { const size_t off = (size_t)(row0 + ai * HALF + (m0 + m) * 16) * 1024 + col0;
#pragma unroll
                    for (int bj = 0; bj < 2; ++bj) { bb[m][bj][0] = *(const f32x4*)(basef + off + bj * HALF); bb[m][bj][1] = *(const f32x4*)(basef + off + bj * HALF + 4); } }
#pragma unroll
                for (int m = 0; m < 2; ++m) { const size_t off = (size_t)(row0 + ai * HALF + (m0 + m) * 16) * 1024 + col0;
#pragma unroll
                    for (int bj = 0; bj < 2; ++bj) *(u32x4*)(out + off + bj * HALF) = pack8(bb[m][bj][0] + gv[bj][0] * acc[ai][bj][m0 + m][0], bb[m][bj][1] + gv[bj][1] * acc[ai][bj][m0 + m][1]); } }
        } else {
            u32x4 hb[2][4][2];
#pragma unroll
            for (int ai = 0; ai < 2; ++ai)
#pragma unroll
                for (int m = 0; m < 4; ++m) { const size_t off = (size_t)(row0 + ai * HALF + m * 16) * 1024 + col0;
#pragma unroll
                    for (int bj = 0; bj < 2; ++bj) hb[ai][m][bj] = *(const u32x4*)(baseh + off + bj * HALF); }
#pragma unroll
            for (int ai = 0; ai < 2; ++ai)
#pragma unroll
                for (int m = 0; m < 4; ++m) { const size_t off = (size_t)(row0 + ai * HALF + m * 16) * 1024 + col0;
#pragma unroll
                    for (int bj = 0; bj < 2; ++bj) { const u32x4 h = hb[ai][m][bj];
                        const f32x4 b0 = (f32x4){__uint_as_float(h.x << 16), __uint_as_float(h.x & 0xffff0000u), __uint_as_float(h.y << 16), __uint_as_float(h.y & 0xffff0000u)};
                        const f32x4 b1 = (f32x4){__uint_as_float(h.z << 16), __uint_as_float(h.z & 0xffff0000u), __uint_as_float(h.w << 16), __uint_as_float(h.w & 0xffff0000u)};
                        *(u32x4*)(out + off + bj * HALF) = pack8(b0 + gv[bj][0] * acc[ai][bj][m][0], b1 + gv[bj][1] * acc[ai][bj][m][1]); } }
        }
    }
};
struct EpiGateUp {
    static constexpr bool PERM = true, AFTER_DRAIN = false;
    bf16_t* ACT; const float* RW;
    __device__ __forceinline__ void operator()(const f32x4 (&acc)[2][2][4][2], const Unit& u, int wr, int wc, int fr, int fq) const {
        const int rl0 = wr * 64 + fr, col = (u.pn & 1) * 128 + wc * 32 + 8 * fq; const float* rwp = RW + u.e * 32768 + u.ti * 256; const int lim = u.cnt - u.ti * 256;
        float wtw[2];
#pragma unroll
        for (int ai = 0; ai < 2; ++ai) { const int rl = wr * 64 + ai * HALF + fq * 16 + fr; const float wv = rwp[rl < lim ? rl : 0]; wtw[ai] = rl < lim ? wv : 0.f; }
#pragma unroll
        for (int ai = 0; ai < 2; ++ai) { if (ai == 1 && u.half) break;
#pragma unroll
            for (int m = 0; m < 4; ++m) { const int rl = rl0 + ai * HALF + m * 16; const float wt = __int_as_float(__builtin_amdgcn_ds_bpermute((m * 16 + fr) * 4, __float_as_int(wtw[ai])));
                f32x4 a[2];
#pragma unroll
                for (int n = 0; n < 2; ++n)
#pragma unroll
                    for (int i = 0; i < 4; ++i) { const float g = acc[ai][0][m][n][i], up = acc[ai][1][m][n][i];
                        const float sg = g * __builtin_amdgcn_rcpf(1.0f + __builtin_amdgcn_exp2f(-1.4426950408889634f * g)); a[n][i] = sg * up * wt; }
                *(u32x4*)(ACT + (size_t)(u.pm * BM + rl) * 256 + col) = pack8(a[0], a[1]); } }
    }
};
struct EpiScatter {
    static constexpr bool PERM = true, AFTER_DRAIN = false;
    unsigned char* B; unsigned yoff, doff; const int* RT;
    __device__ __forceinline__ void operator()(const f32x4 (&acc)[2][2][4][2], const Unit& u, int wr, int wc, int fr, int fq) const {
        asm volatile("" : "+v"(fr), "+v"(fq));
        const int rl0 = wr * 64 + fr, col0 = (u.pn & 3) * BM + wc * 32 + 8 * fq; const int* rtp = RT + u.e * 32768 + u.ti * 256; const int lim = u.cnt - u.ti * 256;
        int tkw[2];
#pragma unroll
        for (int ai = 0; ai < 2; ++ai) { const int rl = wr * 64 + ai * HALF + fq * 16 + fr; const int tv = rtp[rl < lim ? rl : 0]; tkw[ai] = rl < lim ? tv : -1; }
#pragma unroll
        for (int ai = 0; ai < 2; ++ai) { if (ai == 1 && u.half) break;
#pragma unroll
            for (int m = 0; m < 4; ++m) { const int tk = __builtin_amdgcn_ds_bpermute((m * 16 + fr) * 4, tkw[ai]);
                const unsigned yo = (tk >= 0 ? yoff + ((unsigned)(tk & 1) * (unsigned)kTok + (unsigned)(tk >> 1)) * 2048u : doff) + (unsigned)col0 * 2u;
#pragma unroll
                for (int bj = 0; bj < 2; ++bj) *(u32x4*)(B + (size_t)(yo + (unsigned)(bj * HALF * 2))) = pack8(acc[ai][bj][m][0], acc[ai][bj][m][1]);
                asm volatile("" ::: "memory"); } }
    }
};
__device__ __forceinline__ float gelu_tanh(float x) {
    const float z = 0.7978845608028654f * (x + 0.044715f * x * x * x);
    return x * __builtin_amdgcn_rcpf(1.0f + __builtin_amdgcn_exp2f(-2.0f * 1.4426950408889634f * z));
}
struct EpiCmp1 {
    static constexpr bool PERM = true, AFTER_DRAIN = false;
    bf16_t* HID; const float* biasF;
    __device__ __forceinline__ void operator()(const f32x4 (&acc)[2][2][4][2], const Unit& u, int wr, int wc, int fr, int fq) const {
        const int row0 = u.pm * BM + wr * 64 + fr;
#pragma unroll
        for (int bj = 0; bj < 2; ++bj) { const int col = bj * HALF + wc * 32 + 8 * fq;
            const f32x4 b0 = *(const f32x4*)(biasF + u.pn * 256 + col), b1 = *(const f32x4*)(biasF + u.pn * 256 + col + 4);
#pragma unroll
            for (int ai = 0; ai < 2; ++ai)
#pragma unroll
                for (int m = 0; m < 4; ++m) { const int row = row0 + ai * HALF + m * 16; f32x4 v0 = acc[ai][bj][m][0] + b0, v1 = acc[ai][bj][m][1] + b1;
#pragma unroll
                    for (int i = 0; i < 4; ++i) { v0[i] = gelu_tanh(v0[i]); v1[i] = gelu_tanh(v1[i]); }
                    *(u32x4*)(HID + (size_t)row * 256 + col) = pack8(v0, v1); } }
    }
};
struct EpiCmp2 {
    static constexpr bool PERM = true, AFTER_DRAIN = false;
    unsigned char* KC8; unsigned char* VC8;
    __device__ __forceinline__ void operator()(const f32x4 (&acc)[2][2][4][2], const Unit& u, int wr, int wc, int fr, int fq) const {
        if (wc >= 2) return;
        const int row0 = u.pm * BM + wr * 64 + fr, kv = u.pn;
#pragma unroll
        for (int ai = 0; ai < 2; ++ai)
#pragma unroll
            for (int m = 0; m < 4; ++m) { const int row = row0 + ai * HALF + m * 16, r2 = row - kv * 4096, bg = r2 >> 10, n = r2 & 1023, G = n >> 5, k32 = n & 31;
                const f32x4 a0 = acc[ai][0][m][0], a1 = acc[ai][0][m][1];
                int w0 = __builtin_amdgcn_cvt_pk_fp8_f32(a0[0], a0[1], 0, false); w0 = __builtin_amdgcn_cvt_pk_fp8_f32(a0[2], a0[3], w0, true);
                int w1 = __builtin_amdgcn_cvt_pk_fp8_f32(a1[0], a1[1], 0, false); w1 = __builtin_amdgcn_cvt_pk_fp8_f32(a1[2], a1[3], w1, true);
                if (kv == 0) { const int T = (k32 >> 2) & 1, mrow = ((k32 >> 3) << 2) | (k32 & 3);
                    typedef unsigned u32x2 __attribute__((ext_vector_type(2))); u32x2 w; w.x = (unsigned)w0; w.y = (unsigned)w1;
                    *(u32x2*)(KC8 + ((size_t)(bg * 32 + G) * 2 + T) * 1024 + (fq * 16 + mrow) * 16 + wc * 8) = w; }
                else { const int qq = k32 >> 3, j = k32 & 7;
                    unsigned char* vp = VC8 + ((size_t)(bg * 32 + G) * 2 + wc) * 1024 + (qq * 16 + 8 * (fq & 1)) * 16 + (fq >> 1) * 8 + j;
#pragma unroll
                    for (int i = 0; i < 8; ++i) { const unsigned x = (i < 4) ? (unsigned)w0 : (unsigned)w1; vp[i * 16] = (unsigned char)((x >> (8 * (i & 3))) & 0xffu); } } }
    }
};
struct CmpOrder {
    int G, c;
    __device__ __forceinline__ bool next(int i, Unit& u) const { const int L = i * G + c; if (L >= 32) return false; u.pm = L; u.pn = L >> 4; return true; }
    __device__ __forceinline__ void a_ready(const Unit&) const {}
    __device__ __forceinline__ void done(const Unit&) const {}
};
struct MoeOrder {
    const PG8_LAS int* tpre; int npn, G, c;
    __device__ __forceinline__ bool next(int i, Unit& u) const {
        const int L = i * G + c, nbig = __builtin_amdgcn_readfirstlane(tpre[112]) * npn, total = nbig + __builtin_amdgcn_readfirstlane(tpre[152]) * npn; if (L >= total) return false;
        int e, ti, pl, half;
        if (L < nbig) { const int rt = L / npn; pl = L - rt * npn; e = 0; half = 0;
#pragma unroll
            for (int st = 16; st >= 1; st >>= 1) { const int v = __builtin_amdgcn_readfirstlane(tpre[80 + e + st]); e += (rt >= v) ? st : 0; }
            ti = rt - __builtin_amdgcn_readfirstlane(tpre[80 + e]); }
        else { const int Ls = L - nbig, j = Ls / npn; pl = Ls - j * npn; e = __builtin_amdgcn_readfirstlane(tpre[120 + j]); ti = __builtin_amdgcn_readfirstlane(tpre[e + 1] - tpre[e]) - 1; half = 1; }
        u.pm = __builtin_amdgcn_readfirstlane(tpre[e] + ti); u.pn = __builtin_amdgcn_readfirstlane(e * npn + pl); u.e = __builtin_amdgcn_readfirstlane(e); u.ti = __builtin_amdgcn_readfirstlane(ti); u.cnt = __builtin_amdgcn_readfirstlane(tpre[40 + e]); u.half = half; return true;
    }
    __device__ __forceinline__ void a_ready(const Unit&) const {}
    __device__ __forceinline__ void done(const Unit&) const {}
};

template <class Epi, class Sched, bool ALIGN_EPI = false, bool SP2 = false>
__device__ __forceinline__ void gemm_phase(PG8_LAS unsigned char* lds, const Gemm g, const Sched& S, const Epi& E) {
    const int tid = threadIdx.x, wid = __builtin_amdgcn_readfirstlane(tid >> 6), lane = tid & 63, wr = wid >> 2, wc = wid & 3, fr = lane & 15, fq = lane >> 4;
    const int K = g.K, nt = K / BK;
    unsigned voffA[2], voffB[2];
#pragma unroll
    for (int i = 0; i < 2; ++i) { int R, C; stage_rc(tid * 16 + i * 8192, R, C); const int Rb = Epi::PERM ? ((R & ~31) + perm32(R & 31)) : R;
        voffA[i] = (unsigned)(R * g.lda + C) * 2u; voffB[i] = (unsigned)(Rb * K + C) * 2u; }
    const size_t kstep = (size_t)(BK * 2);
    const size_t hstep = (size_t)HALF * K * 2;
    const size_t tstep = 2 * hstep; const size_t hstepA = (size_t)HALF * g.lda * 2, tstepA = 2 * hstepA;
    const unsigned ldsw = (unsigned)wid * 1024u;
    const int aoff = lds_byte(wr * 64 + fr, fq * 8), boff = lds_byte(wc * 32 + fr, fq * 8);
#define PG8_SA(b, h) (((b) * 2 + (h)) * HTB)
#define PG8_SB(b, h) ((4 + (b) * 2 + (h)) * HTB)
#define PG8_STAGE(bufoff, gbase, voff) do { _Pragma("unroll") for (int _i = 0; _i < 2; ++_i) \
        __builtin_amdgcn_global_load_lds((const unsigned*)((const char*)(gbase) + (voff)[_i]), (PG8_LAS unsigned*)(lds + (bufoff) + ldsw + _i * 8192), 16, 0, 0); } while (0)
#define PG8_LDA(dst, b, h) do { _Pragma("unroll") for (int m = 0; m < 4; ++m) _Pragma("unroll") for (int k = 0; k < 2; ++k) dst[m][k] = *(const PG8_LAS bf16x8*)(lds + PG8_SA(b, h) + aoff + m * 2048 + k * 1024); } while (0)
#define PG8_LDB(dst, b, h) do { _Pragma("unroll") for (int n = 0; n < 2; ++n) _Pragma("unroll") for (int k = 0; k < 2; ++k) dst[n][k] = *(const PG8_LAS bf16x8*)(lds + PG8_SB(b, h) + boff + n * 2048 + k * 1024); } while (0)
#define PG8_MMA(ai, bj, At, Bt) do { __builtin_amdgcn_s_setprio(1); _Pragma("unroll") for (int m = 0; m < 4; ++m) _Pragma("unroll") for (int n = 0; n < 2; ++n) _Pragma("unroll") for (int k = 0; k < 2; ++k) \
        acc[ai][bj][m][n] = __builtin_amdgcn_mfma_f32_16x16x32_bf16(Bt[n][k], At[m][k], acc[ai][bj][m][n], 0, 0, 0); __builtin_amdgcn_s_setprio(0); } while (0)
#define PG8_WAIT_V(n) asm volatile("s_waitcnt vmcnt(" #n ")" ::: "memory")
#define PG8_WAIT_L(n) asm volatile("s_waitcnt lgkmcnt(" #n ")" ::: "memory")
#define PG8_BAR __builtin_amdgcn_s_barrier()
#define PG8_SCHED __builtin_amdgcn_sched_barrier(0)
    Unit cur, nxt; int ui = 0;
    if (!S.next(0, cur)) return;
    f32x4 acc[2][2][4][2];
#pragma unroll
    for (int a = 0; a < 2; ++a)
#pragma unroll
        for (int b = 0; b < 2; ++b)
#pragma unroll
            for (int m = 0; m < 4; ++m)
#pragma unroll
                for (int n = 0; n < 2; ++n) acc[a][b][m][n] = (f32x4){0.f, 0.f, 0.f, 0.f};
    bf16x8 At[4][2], B0[2][2], B1[2][2];
    const char* cA = (const char*)g.A + (size_t)cur.pm * tstepA; const char* cB = (const char*)g.Bt + (size_t)cur.pn * tstep;
    S.a_ready(cur);
    if constexpr (SP2) {
        PG8_STAGE(PG8_SB(0, 0), cB, voffB); PG8_STAGE(PG8_SB(0, 1), cB + hstep, voffB); PG8_STAGE(PG8_SA(0, 0), cA, voffA); PG8_STAGE(PG8_SA(0, 1), cA + hstepA, voffA);
        if (wr == 1) PG8_BAR;
        PG8_WAIT_V(2); PG8_BAR;
        PG8_STAGE(PG8_SB(1, 0), cB + kstep, voffB); PG8_STAGE(PG8_SA(1, 0), cA + kstep, voffA); PG8_STAGE(PG8_SB(1, 1), cB + hstep + kstep, voffB);
        PG8_WAIT_V(6); PG8_BAR;
    } else {
        PG8_STAGE(PG8_SB(0, 0), cB, voffB); PG8_STAGE(PG8_SA(0, 0), cA, voffA); PG8_STAGE(PG8_SB(0, 1), cB + hstep, voffB); PG8_STAGE(PG8_SA(0, 1), cA + hstepA, voffA);
        if (wr == 1) PG8_BAR;
        PG8_WAIT_V(4); PG8_BAR;
        PG8_STAGE(PG8_SB(1, 0), cB + kstep, voffB); PG8_STAGE(PG8_SA(1, 0), cA + kstep, voffA); PG8_STAGE(PG8_SB(1, 1), cB + hstep + kstep, voffB);
        PG8_WAIT_V(6); PG8_BAR;
    }
    for (;;) {
        const bool has_next = S.next(ui + 1, nxt);
        const char* nA = has_next ? (const char*)g.A + (size_t)nxt.pm * tstepA : cA; const char* nB = has_next ? (const char*)g.Bt + (size_t)nxt.pn * tstep : cB;
        for (int t = 0; t < nt; t += 2) {
            const bool last = (t == nt - 2);
            const char* a1 = cA + (size_t)(t + 1) * kstep;
            const char* a2 = last ? nA : cA + (size_t)(t + 2) * kstep; const char* b2 = last ? nB : cB + (size_t)(t + 2) * kstep;
            const char* a3 = a2 + kstep; const char* b3 = b2 + kstep;
            if (last && has_next) S.a_ready(nxt);
            if constexpr (SP2) {
            PG8_LDB(B0, 0, 0); PG8_LDB(B1, 0, 1); PG8_SCHED; PG8_LDA(At, 0, 0); PG8_STAGE(PG8_SA(1, 1), a1 + hstepA, voffA);
            PG8_WAIT_V(8); PG8_WAIT_L(0); PG8_BAR; PG8_MMA(0, 0, At, B0); PG8_MMA(0, 1, At, B1); PG8_BAR; PG8_SCHED;
            PG8_LDA(At, 0, 1); PG8_STAGE(PG8_SB(0, 0), b2, voffB); PG8_STAGE(PG8_SB(0, 1), b2 + hstep, voffB); PG8_STAGE(PG8_SA(0, 0), a2, voffA);
            PG8_WAIT_V(8); PG8_WAIT_L(0); PG8_BAR; if (!cur.half) { PG8_MMA(1, 0, At, B0); PG8_MMA(1, 1, At, B1); } PG8_BAR; PG8_SCHED;
            PG8_LDB(B0, 1, 0); PG8_LDB(B1, 1, 1); PG8_SCHED; PG8_LDA(At, 1, 0); PG8_STAGE(PG8_SA(0, 1), a2 + hstepA, voffA);
            PG8_WAIT_V(8); PG8_WAIT_L(0); PG8_BAR; PG8_MMA(0, 0, At, B0); PG8_MMA(0, 1, At, B1); PG8_BAR; PG8_SCHED;
            PG8_LDA(At, 1, 1); PG8_STAGE(PG8_SB(1, 0), b3, voffB); PG8_STAGE(PG8_SB(1, 1), b3 + hstep, voffB); PG8_STAGE(PG8_SA(1, 0), a3, voffA);
            PG8_WAIT_V(8); PG8_WAIT_L(0); PG8_BAR; if (!cur.half) { PG8_MMA(1, 0, At, B0); PG8_MMA(1, 1, At, B1); } PG8_BAR; PG8_SCHED;
            } else {
            PG8_LDB(B0, 0, 0); PG8_SCHED; PG8_LDA(At, 0, 0); PG8_STAGE(PG8_SA(1, 1), a1 + hstepA, voffA);
            PG8_WAIT_L(8); PG8_BAR; PG8_WAIT_L(0); PG8_MMA(0, 0, At, B0); PG8_BAR; PG8_SCHED;
            PG8_LDB(B1, 0, 1); PG8_STAGE(PG8_SB(0, 0), b2, voffB);
            PG8_BAR; PG8_WAIT_L(0); PG8_MMA(0, 1, At, B1); PG8_BAR;
            PG8_LDA(At, 0, 1); PG8_STAGE(PG8_SA(0, 0), a2, voffA);
            PG8_BAR; PG8_WAIT_L(0); PG8_MMA(1, 0, At, B0); PG8_BAR; PG8_SCHED;
            PG8_STAGE(PG8_SB(0, 1), b2 + hstep, voffB);
            PG8_WAIT_V(6); PG8_BAR; PG8_MMA(1, 1, At, B1); PG8_BAR;
            PG8_LDB(B0, 1, 0); PG8_SCHED; PG8_LDA(At, 1, 0); PG8_STAGE(PG8_SA(0, 1), a2 + hstepA, voffA);
            PG8_WAIT_L(8); PG8_BAR; PG8_WAIT_L(0); PG8_MMA(0, 0, At, B0); PG8_BAR; PG8_SCHED;
            PG8_LDB(B1, 1, 1); PG8_STAGE(PG8_SB(1, 0), b3, voffB);
            PG8_BAR; PG8_WAIT_L(0); PG8_MMA(0, 1, At, B1); PG8_BAR;
            PG8_LDA(At, 1, 1); PG8_STAGE(PG8_SA(1, 0), a3, voffA);
            PG8_BAR; PG8_WAIT_L(0); PG8_MMA(1, 0, At, B0); PG8_BAR; PG8_SCHED;
            PG8_STAGE(PG8_SB(1, 1), b3 + hstep, voffB);
            PG8_WAIT_V(6); PG8_BAR; PG8_MMA(1, 1, At, B1); PG8_BAR;
            }
        }
        if constexpr (ALIGN_EPI) { if (wr == 0) PG8_BAR; }
        if constexpr (!Epi::AFTER_DRAIN) { E(acc, cur, wr, wc, fr, fq); S.done(cur); }
        if (!has_next) break;
#pragma unroll
        for (int a = 0; a < 2; ++a)
#pragma unroll
            for (int b = 0; b < 2; ++b)
#pragma unroll
                for (int m = 0; m < 4; ++m)
#pragma unroll
                    for (int n = 0; n < 2; ++n) acc[a][b][m][n] = (f32x4){0.f, 0.f, 0.f, 0.f};
        cur = nxt; cA = nA; cB = nB; ++ui;
        if constexpr (ALIGN_EPI) { if (wr == 1) PG8_BAR; }
    }
    PG8_WAIT_V(0);
    if constexpr (!ALIGN_EPI) { if (wr == 0) PG8_BAR; }
    PG8_BAR;
    if constexpr (Epi::AFTER_DRAIN) { E.fused(acc, cur, wr, wc, fr, fq, lds, wid, lane); S.done(cur); }
#undef PG8_SA
#undef PG8_SB
#undef PG8_STAGE
#undef PG8_LDA
#undef PG8_LDB
#undef PG8_MMA
#undef PG8_WAIT_V
#undef PG8_WAIT_L
#undef PG8_BAR
#undef PG8_SCHED
}
template <class Epi, class Sched, bool ALIGN_EPI = false>
__device__ __forceinline__ void gemm_phase_g(PG8_LAS unsigned char* lds, const Gemm g, const Sched& S, const Epi& E, const PG8_LAS unsigned* gtab) {
    constexpr bool SP2 = true;
    const int tid = threadIdx.x, wid = __builtin_amdgcn_readfirstlane(tid >> 6), lane = tid & 63, wr = wid >> 2, wc = wid & 3, fr = lane & 15, fq = lane >> 4;
    const int K = g.K, nt = K / BK;
    unsigned voffB[2], cofsA[2]; int rowA[2];
#pragma unroll
    for (int i = 0; i < 2; ++i) { int R, C; stage_rc(tid * 16 + i * 8192, R, C); const int Rb = Epi::PERM ? ((R & ~31) + perm32(R & 31)) : R;
        rowA[i] = R; cofsA[i] = (unsigned)C * 2u; voffB[i] = (unsigned)(Rb * K + C) * 2u; }
    unsigned vC0[2], vC1[2], vN0[2], vN1[2];
#define PG8_GV(dst0, dst1, u_) do { _Pragma("unroll") for (int _i = 0; _i < 2; ++_i) { dst0[_i] = gtab[(u_) * 256 + rowA[_i]] + cofsA[_i]; dst1[_i] = gtab[(u_) * 256 + 128 + rowA[_i]] + cofsA[_i]; } } while (0)
    const size_t kstep = (size_t)(BK * 2);
    const size_t hstep = (size_t)HALF * K * 2;
    const size_t tstep = 2 * hstep; const size_t hstepA = (size_t)HALF * g.lda * 2, tstepA = 2 * hstepA;
    const unsigned ldsw = (unsigned)wid * 1024u;
    const int aoff = lds_byte(wr * 64 + fr, fq * 8), boff = lds_byte(wc * 32 + fr, fq * 8);
#define PG8_SA(b, h) (((b) * 2 + (h)) * HTB)
#define PG8_SB(b, h) ((4 + (b) * 2 + (h)) * HTB)
#define PG8_STAGE(bufoff, gbase, voff) do { _Pragma("unroll") for (int _i = 0; _i < 2; ++_i) \
        __builtin_amdgcn_global_load_lds((const unsigned*)((const char*)(gbase) + (voff)[_i]), (PG8_LAS unsigned*)(lds + (bufoff) + ldsw + _i * 8192), 16, 0, 0); } while (0)
#define PG8_LDA(dst, b, h) do { _Pragma("unroll") for (int m = 0; m < 4; ++m) _Pragma("unroll") for (int k = 0; k < 2; ++k) dst[m][k] = *(const PG8_LAS bf16x8*)(lds + PG8_SA(b, h) + aoff + m * 2048 + k * 1024); } while (0)
#define PG8_LDB(dst, b, h) do { _Pragma("unroll") for (int n = 0; n < 2; ++n) _Pragma("unroll") for (int k = 0; k < 2; ++k) dst[n][k] = *(const PG8_LAS bf16x8*)(lds + PG8_SB(b, h) + boff + n * 2048 + k * 1024); } while (0)
#define PG8_MMA(ai, bj, At, Bt) do { __builtin_amdgcn_s_setprio(1); _Pragma("unroll") for (int m = 0; m < 4; ++m) _Pragma("unroll") for (int n = 0; n < 2; ++n) _Pragma("unroll") for (int k = 0; k < 2; ++k) \
        acc[ai][bj][m][n] = __builtin_amdgcn_mfma_f32_16x16x32_bf16(Bt[n][k], At[m][k], acc[ai][bj][m][n], 0, 0, 0); __builtin_amdgcn_s_setprio(0); } while (0)
#define PG8_WAIT_V(n) asm volatile("s_waitcnt vmcnt(" #n ")" ::: "memory")
#define PG8_WAIT_L(n) asm volatile("s_waitcnt lgkmcnt(" #n ")" ::: "memory")
#define PG8_BAR __builtin_amdgcn_s_barrier()
#define PG8_SCHED __builtin_amdgcn_sched_barrier(0)
    Unit cur, nxt; int ui = 0;
    if (!S.next(0, cur)) return;
    f32x4 acc[2][2][4][2];
#pragma unroll
    for (int a = 0; a < 2; ++a)
#pragma unroll
        for (int b = 0; b < 2; ++b)
#pragma unroll
            for (int m = 0; m < 4; ++m)
#pragma unroll
                for (int n = 0; n < 2; ++n) acc[a][b][m][n] = (f32x4){0.f, 0.f, 0.f, 0.f};
    bf16x8 At[4][2], B0[2][2], B1[2][2];
    const char* cA = (const char*)g.A; const char* cB = (const char*)g.Bt + (size_t)cur.pn * tstep;
    PG8_GV(vC0, vC1, 0);
    S.a_ready(cur);
    if constexpr (SP2) {
        PG8_STAGE(PG8_SB(0, 0), cB, voffB); PG8_STAGE(PG8_SB(0, 1), cB + hstep, voffB); PG8_STAGE(PG8_SA(0, 0), cA, vC0); PG8_STAGE(PG8_SA(0, 1), cA, vC1);
        if (wr == 1) PG8_BAR;
        PG8_WAIT_V(2); PG8_BAR;
        PG8_STAGE(PG8_SB(1, 0), cB + kstep, voffB); PG8_STAGE(PG8_SA(1, 0), cA + kstep, vC0); PG8_STAGE(PG8_SB(1, 1), cB + hstep + kstep, voffB);
        PG8_WAIT_V(6); PG8_BAR;
    } else {
        PG8_STAGE(PG8_SB(0, 0), cB, voffB); PG8_STAGE(PG8_SA(0, 0), cA, vC0); PG8_STAGE(PG8_SB(0, 1), cB + hstep, voffB); PG8_STAGE(PG8_SA(0, 1), cA, vC1);
        if (wr == 1) PG8_BAR;
        PG8_WAIT_V(4); PG8_BAR;
        PG8_STAGE(PG8_SB(1, 0), cB + kstep, voffB); PG8_STAGE(PG8_SA(1, 0), cA + kstep, vC0); PG8_STAGE(PG8_SB(1, 1), cB + hstep + kstep, voffB);
        PG8_WAIT_V(6); PG8_BAR;
    }
    for (;;) {
        const bool has_next = S.next(ui + 1, nxt);
        const char* nA = cA; const char* nB = has_next ? (const char*)g.Bt + (size_t)nxt.pn * tstep : cB;
        if (has_next) PG8_GV(vN0, vN1, ui + 1); else { _Pragma("unroll") for (int _i = 0; _i < 2; ++_i) { vN0[_i] = vC0[_i]; vN1[_i] = vC1[_i]; } }
        for (int t = 0; t < nt; t += 2) {
            const bool last = (t == nt - 2);
            const char* a1 = cA + (size_t)(t + 1) * kstep;
            const unsigned va0[2] = {last ? vN0[0] : vC0[0], last ? vN0[1] : vC0[1]}, va1[2] = {last ? vN1[0] : vC1[0], last ? vN1[1] : vC1[1]};
            const char* a2 = last ? nA : cA + (size_t)(t + 2) * kstep; const char* b2 = last ? nB : cB + (size_t)(t + 2) * kstep;
            const char* a3 = a2 + kstep; const char* b3 = b2 + kstep;
            if (last && has_next) S.a_ready(nxt);
            if constexpr (SP2) {
            PG8_LDB(B0, 0, 0); PG8_LDB(B1, 0, 1); PG8_SCHED; PG8_LDA(At, 0, 0); PG8_STAGE(PG8_SA(1, 1), a1, vC1);
            PG8_WAIT_V(8); PG8_WAIT_L(0); PG8_BAR; PG8_MMA(0, 0, At, B0); PG8_MMA(0, 1, At, B1); PG8_BAR; PG8_SCHED;
            PG8_LDA(At, 0, 1); PG8_STAGE(PG8_SB(0, 0), b2, voffB); PG8_STAGE(PG8_SB(0, 1), b2 + hstep, voffB); PG8_STAGE(PG8_SA(0, 0), a2, va0);
            PG8_WAIT_V(8); PG8_WAIT_L(0); PG8_BAR; if (!cur.half) { PG8_MMA(1, 0, At, B0); PG8_MMA(1, 1, At, B1); } PG8_BAR; PG8_SCHED;
            PG8_LDB(B0, 1, 0); PG8_LDB(B1, 1, 1); PG8_SCHED; PG8_LDA(At, 1, 0); PG8_STAGE(PG8_SA(0, 1), a2, va1);
            PG8_WAIT_V(8); PG8_WAIT_L(0); PG8_BAR; PG8_MMA(0, 0, At, B0); PG8_MMA(0, 1, At, B1); PG8_BAR; PG8_SCHED;
            PG8_LDA(At, 1, 1); PG8_STAGE(PG8_SB(1, 0), b3, voffB); PG8_STAGE(PG8_SB(1, 1), b3 + hstep, voffB); PG8_STAGE(PG8_SA(1, 0), a3, va0);
            PG8_WAIT_V(8); PG8_WAIT_L(0); PG8_BAR; if (!cur.half) { PG8_MMA(1, 0, At, B0); PG8_MMA(1, 1, At, B1); } PG8_BAR; PG8_SCHED;
            } else {
            PG8_LDB(B0, 0, 0); PG8_SCHED; PG8_LDA(At, 0, 0); PG8_STAGE(PG8_SA(1, 1), a1, vC1);
            PG8_WAIT_L(8); PG8_BAR; PG8_WAIT_L(0); PG8_MMA(0, 0, At, B0); PG8_BAR; PG8_SCHED;
            PG8_LDB(B1, 0, 1); PG8_STAGE(PG8_SB(0, 0), b2, voffB);
            PG8_BAR; PG8_WAIT_L(0); PG8_MMA(0, 1, At, B1); PG8_BAR;
            PG8_LDA(At, 0, 1); PG8_STAGE(PG8_SA(0, 0), a2, va0);
            PG8_BAR; PG8_WAIT_L(0); PG8_MMA(1, 0, At, B0); PG8_BAR; PG8_SCHED;
            PG8_STAGE(PG8_SB(0, 1), b2 + hstep, voffB);
            PG8_WAIT_V(6); PG8_BAR; PG8_MMA(1, 1, At, B1); PG8_BAR;
            PG8_LDB(B0, 1, 0); PG8_SCHED; PG8_LDA(At, 1, 0); PG8_STAGE(PG8_SA(0, 1), a2, va1);
            PG8_WAIT_L(8); PG8_BAR; PG8_WAIT_L(0); PG8_MMA(0, 0, At, B0); PG8_BAR; PG8_SCHED;
            PG8_LDB(B1, 1, 1); PG8_STAGE(PG8_SB(1, 0), b3, voffB);
            PG8_BAR; PG8_WAIT_L(0); PG8_MMA(0, 1, At, B1); PG8_BAR;
            PG8_LDA(At, 1, 1); PG8_STAGE(PG8_SA(1, 0), a3, va0);
            PG8_BAR; PG8_WAIT_L(0); PG8_MMA(1, 0, At, B0); PG8_BAR; PG8_SCHED;
            PG8_STAGE(PG8_SB(1, 1), b3 + hstep, voffB);
            PG8_WAIT_V(6); PG8_BAR; PG8_MMA(1, 1, At, B1); PG8_BAR;
            }
        }
        if constexpr (ALIGN_EPI) { if (wr == 0) PG8_BAR; }
        if constexpr (!Epi::AFTER_DRAIN) { E(acc, cur, wr, wc, fr, fq); S.done(cur); }
        if (!has_next) break;
#pragma unroll
        for (int a = 0; a < 2; ++a)
#pragma unroll
            for (int b = 0; b < 2; ++b)
#pragma unroll
                for (int m = 0; m < 4; ++m)
#pragma unroll
                    for (int n = 0; n < 2; ++n) acc[a][b][m][n] = (f32x4){0.f, 0.f, 0.f, 0.f};
        cur = nxt; cA = nA; cB = nB; ++ui;
        { _Pragma("unroll") for (int _i = 0; _i < 2; ++_i) { vC0[_i] = vN0[_i]; vC1[_i] = vN1[_i]; } }
        if constexpr (ALIGN_EPI) { if (wr == 1) PG8_BAR; }
    }
    PG8_WAIT_V(0);
    if constexpr (!ALIGN_EPI) { if (wr == 0) PG8_BAR; }
    PG8_BAR;
    if constexpr (Epi::AFTER_DRAIN) { E.fused(acc, cur, wr, wc, fr, fq, lds, wid, lane); S.done(cur); }
#undef PG8_SA
#undef PG8_SB
#undef PG8_STAGE
#undef PG8_LDA
#undef PG8_LDB
#undef PG8_MMA
#undef PG8_WAIT_V
#undef PG8_WAIT_L
#undef PG8_BAR
#undef PG8_SCHED
#undef PG8_GV
}

}

#include <hip/hip_bf16.h>
#include <cmath>
namespace attn_body {
using bf16=__hip_bfloat16;
using bf16x8=__attribute__((ext_vector_type(8)))short;
using s16x4=__attribute__((ext_vector_type(4)))short;
using f32x16=__attribute__((ext_vector_type(16)))float;
using u32x4=__attribute__((ext_vector_type(4)))unsigned;
constexpr int BATCH=2,NHEAD=16,SEQ=16384,D=64,DM=NHEAD*D;
constexpr int NW=8,QBLK=32,QB=QBLK*NW,KVBLK=64,NQB=SEQ/QB;
constexpr int ATTN_PITCH=DM, ATTN_UNIT_ROWS=QB;
__device__ __forceinline__ int crow(int r,int hi){return (r&3)+8*(r>>2)+4*hi;}
#define SBAR() __builtin_amdgcn_sched_barrier(0)
__device__ __forceinline__ void cmask(f32x16&p0,f32x16&p1,int jb,int qrel,int hi){
  const float NEG=-INFINITY; int kb=64*jb+4*hi;
  #pragma unroll
  for(int r=0;r<16;++r){int kv=kb+(r&3)+8*(r>>2); if(kv>qrel)p0[r]=NEG; if(kv+32>qrel)p1[r]=NEG;}
}

constexpr int NSLOT=3, SLOTB=8192;
constexpr int LDS_K=0, LDS_V=NSLOT*SLOTB, LDS_WS=2*NSLOT*SLOTB, LDS_OST=LDS_WS+NW*64*4, LDS_BYTES=LDS_OST+NW*4096;
constexpr float C2=0.125f*1.4426950408889634f;
__device__ __forceinline__ void glds16(const void*gsrc,unsigned lds_dst){unsigned keep;
  asm volatile("s_mov_b32 %0, m0\n\ts_mov_b32 m0, %2\n\ts_nop 0\n\tglobal_load_lds_dwordx4 %1, off\n\ts_mov_b32 m0, %0":"=&s"(keep):"v"(gsrc),"s"(lds_dst):"memory");}
__device__ __forceinline__ float max3f(float a,float b,float c){float r;asm("v_max3_f32 %0, %1, %2, %3":"=v"(r):"v"(a),"v"(b),"v"(c));return r;}
__device__ __forceinline__ float max2f(float a,float b){float r;asm("v_max_f32_e32 %0, %1, %2":"=v"(r):"v"(a),"v"(b));return r;}
__device__ __forceinline__ float fadd_s(float a,float b){float r;asm("v_add_f32_e32 %0, %1, %2":"=v"(r):"v"(a),"v"(b));return r;}
__device__ __forceinline__ float fsub_s(float a,float b){float r;asm("v_sub_f32_e32 %0, %1, %2":"=v"(r):"v"(a),"v"(b));return r;}
typedef float f32x2_t __attribute__((ext_vector_type(2))); typedef __bf16 bf16x2_t __attribute__((ext_vector_type(2)));
__device__ __forceinline__ unsigned cvtpk_s(float lo,float hi){f32x2_t v={lo,hi};bf16x2_t b=__builtin_convertvector(v,bf16x2_t);return __builtin_bit_cast(unsigned,b);}
#define WAIT_BAR(N) asm volatile("s_waitcnt vmcnt(" #N ") lgkmcnt(0)\n\ts_barrier":::"memory")

__device__ __forceinline__ void qkt(f32x16&p0,f32x16&p1,const char*Kslot,const bf16x8*qr,const f32x16&negm,int r32,int hi){
  const char*kb=Kslot+hi*1024+r32*16;
  #pragma unroll
  for(int d0=0;d0<4;++d0){
    const bf16x8 b0=*reinterpret_cast<const bf16x8*>(kb+d0*2048);
    const bf16x8 b1=*reinterpret_cast<const bf16x8*>(kb+d0*2048+512);
    if(d0==0){p0=__builtin_amdgcn_mfma_f32_32x32x16_bf16(b0,qr[0],negm,0,0,0);p1=__builtin_amdgcn_mfma_f32_32x32x16_bf16(b1,qr[0],negm,0,0,0);}
    else{p0=__builtin_amdgcn_mfma_f32_32x32x16_bf16(b0,qr[d0],p0,0,0,0);p1=__builtin_amdgcn_mfma_f32_32x32x16_bf16(b1,qr[d0],p1,0,0,0);}}
}
typedef __attribute__((address_space(3))) const char* lds_cptr;
typedef short v4i16_t __attribute__((ext_vector_type(4)));
__device__ __forceinline__ void kload8(bf16x8*kf,lds_cptr kp){
  kf[0]=*(const __attribute__((address_space(3))) bf16x8*)(kp);      kf[1]=*(const __attribute__((address_space(3))) bf16x8*)(kp+512);
  kf[2]=*(const __attribute__((address_space(3))) bf16x8*)(kp+2048); kf[3]=*(const __attribute__((address_space(3))) bf16x8*)(kp+2560);
  kf[4]=*(const __attribute__((address_space(3))) bf16x8*)(kp+4096); kf[5]=*(const __attribute__((address_space(3))) bf16x8*)(kp+4608);
  kf[6]=*(const __attribute__((address_space(3))) bf16x8*)(kp+6144); kf[7]=*(const __attribute__((address_space(3))) bf16x8*)(kp+6656);
}
__device__ __forceinline__ void kload2(bf16x8*kf,lds_cptr kp,int j){ kf[2*j]=*(const __attribute__((address_space(3))) bf16x8*)(kp+j*2048); kf[2*j+1]=*(const __attribute__((address_space(3))) bf16x8*)(kp+j*2048+512); }
__device__ __forceinline__ s16x4 vtr(lds_cptr p){ return __builtin_bit_cast(s16x4,__builtin_amdgcn_ds_read_tr16_b64_v4i16((__attribute__((address_space(3))) v4i16_t*)p)); }
__device__ __forceinline__ float rowmax(const f32x16&p0,const f32x16&p1){
  float a=max3f(p0[0],p0[1],p1[0]),b=max3f(p0[2],p0[3],p1[1]);a=max3f(a,p1[2],p1[3]);
  #pragma unroll
  for(int r=4;r<16;r+=4){a=max3f(a,p0[r],p0[r+1]);b=max3f(b,p0[r+2],p0[r+3]);a=max3f(a,p1[r],p1[r+1]);b=max3f(b,p1[r+2],p1[r+3]);}
  const float m=max2f(a,b);
  auto rr=__builtin_amdgcn_permlane32_swap(__float_as_uint(m),__float_as_uint(m),false,false);
  return max2f(__uint_as_float(rr[0]),__uint_as_float(rr[1]));
}
__device__ __forceinline__ void pv(f32x16*o,int vb,bf16x8 pa0,bf16x8 pa1,bf16x8 pa2,bf16x8 pa3){
  #pragma unroll
  for(int d0=0;d0<2;++d0){s16x4 lo[4],hi[4];
    #pragma unroll
    for(int ks=0;ks<4;++ks){
      asm volatile("ds_read_b64_tr_b16 %0,%1 offset:%c2":"=&v"(lo[ks]):"v"(vb),"i"(d0*4096+ks*1024):"memory");
      asm volatile("ds_read_b64_tr_b16 %0,%1 offset:%c2":"=&v"(hi[ks]):"v"(vb),"i"(d0*4096+ks*1024+512):"memory");}
    asm volatile("s_waitcnt lgkmcnt(0)":::"memory");SBAR();
    #define PK(k) (bf16x8){lo[k][0],lo[k][1],lo[k][2],lo[k][3],hi[k][0],hi[k][1],hi[k][2],hi[k][3]}
    o[d0]=__builtin_amdgcn_mfma_f32_32x32x16_bf16(pa0,PK(0),o[d0],0,0,0);
    o[d0]=__builtin_amdgcn_mfma_f32_32x32x16_bf16(pa1,PK(1),o[d0],0,0,0);
    o[d0]=__builtin_amdgcn_mfma_f32_32x32x16_bf16(pa2,PK(2),o[d0],0,0,0);
    o[d0]=__builtin_amdgcn_mfma_f32_32x32x16_bf16(pa3,PK(3),o[d0],0,0,0);
    #undef PK
  }
}

#ifndef ATTN_STORE16
#define ATTN_STORE16(p,v) (*(u32x4*)(p)=(v))
#endif
template<int THRL> __device__ __forceinline__ void attn_unit(int b,int h,int qb,const bf16*Q,const bf16*__restrict__ K,const bf16*__restrict__ V,bf16*O,char*shm){
  int tid_=threadIdx.x; asm volatile("":"+v"(tid_)); const int tid=tid_,lane=tid&63,r32=lane&31,hi=lane>>5; const int wid=__builtin_amdgcn_readfirstlane(tid>>6);
  const long rowbase=(long)b*SEQ; const int q0=qb*QB;
  const bf16*Qw=Q+(rowbase+q0+wid*QBLK)*DM+h*D;
  const bf16*Kh=K+rowbase*DM+h*D,*Vh=V+rowbase*DM+h*D;
  const unsigned lds0=(unsigned)(uintptr_t)shm;
  float*wsf=(float*)(shm+LDS_WS)+wid*64;
  const bf16*ksrc=Kh+(long)lane*DM+wid*8;
  const bf16*vsrc=Vh+(long)(16*(wid&3)+(lane>>2))*DM+(wid>>2)*32+(lane&3)*8;
  const unsigned kdst=lds0+LDS_K+wid*1024, vdst=lds0+LDS_V+wid*1024;
  #define DMA_K(t,slot) glds16(ksrc+(long)(t)*KVBLK*DM,(unsigned)__builtin_amdgcn_readfirstlane(kdst+(slot)))
  #define DMA_V(t,slot) glds16(vsrc+(long)(t)*KVBLK*DM,(unsigned)__builtin_amdgcn_readfirstlane(vdst+(slot)))
  const int vb0=(int)(lds0+LDS_V)+((lane>>4)&1)*32+(lane&3)*8+(4*hi+((lane&15)>>2))*64;
  const char*Kbase=shm+LDS_K; bf16x8 kf[8];
  const lds_cptr shm3=(lds_cptr)shm; const lds_cptr kp0=shm3+LDS_K+hi*1024+r32*16; const lds_cptr vp0=shm3+LDS_V+((lane>>4)&1)*32+(lane&3)*8+(4*hi+((lane&15)>>2))*64;
  const int NT=(q0+QB)/KVBLK;
  DMA_K(0,0);DMA_V(0,0);DMA_K(1,SLOTB);
  bf16x8 qr[4];
  #pragma unroll
  for(int d0=0;d0<4;++d0)qr[d0]=*reinterpret_cast<const bf16x8*>(&Qw[(long)r32*DM+d0*16+hi*8]);
  float mhat=0.f,l_reg=0.f;f32x16 o[2];o[0]=f32x16{};o[1]=f32x16{};f32x16 negm=f32x16{};asm volatile("":"+v"(negm));
  const int qrel=wid*QBLK+r32;
  #define CMASK(P0,P1,t) do{int jb_=(t)-(NT-4); if(jb_>=0)cmask(P0,P1,jb_,qrel,hi);}while(0)
  bool resc=false;
  #define START(P0,P1) do{ const float rm=rowmax(P0,P1); resc=false; \
    { const float dl=rm; mhat=fadd_s(mhat,dl); \
      _Pragma("unroll") for(int r=0;r<16;++r){P0[r]=fsub_s(P0[r],dl);P1[r]=fsub_s(P1[r],dl);} \
      _Pragma("unroll") for(int r=0;r<16;++r)negm[r]=-mhat; asm volatile("":"+v"(negm)); } \
    _Pragma("unroll") for(int r=0;r<16;++r)P0[r]=__builtin_amdgcn_exp2f(P0[r]); }while(0)
  #define RESC() do{ if(resc){ asm volatile("s_waitcnt lgkmcnt(0)":::"memory"); \
      _Pragma("unroll") for(int d_=0;d_<2;++d_) _Pragma("unroll") for(int r=0;r<16;++r)o[d_][r]*=wsf[crow(r,hi)]; } }while(0)
  f32x16 pA0,pA1,pB0,pB1;
  int sl_prev=0,sl_cur=0,sl_next=SLOTB;
  #define ROT() do{sl_prev=sl_cur;sl_cur=sl_next;sl_next=(sl_next==(NSLOT-1)*SLOTB)?0:sl_next+SLOTB;}while(0)
  DMA_K(2,2*SLOTB);
  WAIT_BAR(3);
  qkt(pA0,pA1,Kbase,qr,negm,r32,hi);asm volatile("s_nop 15\n\ts_nop 7":"+v"(pA0),"+v"(pA1));CMASK(pA0,pA1,0);
  START(pA0,pA1);
  _Pragma("unroll") for(int r=0;r<16;++r)pA1[r]=__builtin_amdgcn_exp2f(pA1[r]);
  WAIT_BAR(0);
  DMA_K(3,0);DMA_V(1,SLOTB);
  ROT();
  kload8(kf,kp0+sl_cur);
  WAIT_BAR(2);
  s16x4 vlo[8],vhi[8]; u32x4 pw0,pw1,pw2,pw3;
  #define PKW(P,B) cvtpk_s(P[B],P[B+1])
  #define PAF(k) __builtin_bit_cast(bf16x8,pw##k)
  #define VFR(i) (bf16x8){vlo[i][0],vlo[i][1],vlo[i][2],vlo[i][3],vhi[i][0],vhi[i][1],vhi[i][2],vhi[i][3]}
  #define PIN(x) asm volatile("":"+v"(x))
  #define MX3(a,b,c) __builtin_fmaxf(__builtin_fmaxf((a),(b)),(c))
  #define GAPA(MF,A0,A1,A2,A3,W0,W1,PW) do{ MF; sacc+=A0; sacc+=A1; sacc+=A2; sacc+=A3; PIN(sacc); W0; W1; PIN(PW); SBAR(); }while(0)
  #define EX(v) __builtin_amdgcn_exp2f(v)
  #define GAPB(MF,X,B) do{ MF; X[B]=EX(X[B]); X[B+1]=EX(X[B+1]); X[B+2]=EX(X[B+2]); X[B+3]=EX(X[B+3]); PIN(X); SBAR(); }while(0)
  #define VRD(i) do{ vlo[i]=vtr(vp_+(((i)>>2)*4096+((i)&3)*1024)); vhi[i]=vtr(vp_+(((i)>>2)*4096+((i)&3)*1024+512)); }while(0)
  #define KRD(G,j) do{ if(G){ kload2(kf,kp0+sl_next,j); SBAR(); } }while(0)
  #define STEP(C0,C1,P0,P1,t,GK,GV,GL) do{ SBAR(); \
    const lds_cptr vp_=vp0+sl_prev; \
    VRD(0); SBAR(); float sacc=(P0[0]+P0[1]); \
    GAPA(C0=__builtin_amdgcn_mfma_f32_32x32x16_bf16(kf[0],qr[0],negm,0,0,0), P0[2],P0[3],P0[4],P0[5],     pw0[0]=PKW(P0,0), pw0[1]=PKW(P0,2), pw0); \
    VRD(4); SBAR(); GAPA(C1=__builtin_amdgcn_mfma_f32_32x32x16_bf16(kf[1],qr[0],negm,0,0,0), P0[6],P0[7],P0[8],P0[9],     pw0[2]=PKW(P0,4), pw0[3]=PKW(P0,6), pw0); \
    VRD(1); SBAR(); GAPA(C0=__builtin_amdgcn_mfma_f32_32x32x16_bf16(kf[2],qr[1],C0,0,0,0),   P0[10],P0[11],P0[12],P0[13], pw1[0]=PKW(P0,8), pw1[1]=PKW(P0,10), pw1); \
    VRD(5); SBAR(); GAPA(C1=__builtin_amdgcn_mfma_f32_32x32x16_bf16(kf[3],qr[1],C1,0,0,0),   P0[14],P0[15],P1[0],P1[1],   pw1[2]=PKW(P0,12),pw1[3]=PKW(P0,14), pw1); \
    VRD(2); SBAR(); GAPA(C0=__builtin_amdgcn_mfma_f32_32x32x16_bf16(kf[4],qr[2],C0,0,0,0),   P1[2],P1[3],P1[4],P1[5],     pw2[0]=PKW(P1,0), pw2[1]=PKW(P1,2), pw2); \
    VRD(6); SBAR(); GAPA(C1=__builtin_amdgcn_mfma_f32_32x32x16_bf16(kf[5],qr[2],C1,0,0,0),   P1[6],P1[7],P1[8],P1[9],     pw2[2]=PKW(P1,4), pw2[3]=PKW(P1,6), pw2); \
    VRD(3); SBAR(); GAPA(C0=__builtin_amdgcn_mfma_f32_32x32x16_bf16(kf[6],qr[3],C0,0,0,0),   P1[10],P1[11],P1[12],P1[13], pw3[0]=PKW(P1,8), pw3[1]=PKW(P1,10), pw3); \
    VRD(7); SBAR(); GAPA(C1=__builtin_amdgcn_mfma_f32_32x32x16_bf16(kf[7],qr[3],C1,0,0,0),   P1[14],P1[15],0.f,0.f,       pw3[2]=PKW(P1,12),pw3[3]=PKW(P1,14), pw3); \
    l_reg+=sacc; \
    if(GK){DMA_K((t)+3,sl_cur);} if(GV){DMA_V((t)+1,sl_next);} \
    CMASK(C0,C1,t); \
    { float a=MX3(C0[0],C0[1],C1[0]),b=MX3(C0[2],C0[3],C1[1]); a=MX3(a,C1[2],C1[3]); \
      _Pragma("unroll") for(int r=4;r<16;r+=4){a=MX3(a,C0[r],C0[r+1]);b=MX3(b,C0[r+2],C0[r+3]);a=MX3(a,C1[r],C1[r+1]);b=MX3(b,C1[r+2],C1[r+3]);} \
      float rm=__builtin_fmaxf(a,b); { auto rr=__builtin_amdgcn_permlane32_swap(__float_as_uint(rm),__float_as_uint(rm),false,false); rm=__builtin_fmaxf(__uint_as_float(rr[0]),__uint_as_float(rr[1])); } \
      resc=false; \
      if(__builtin_expect(__any(rm>(float)THRL),0)){ const float dl=__builtin_fmaxf(rm,0.f); mhat+=dl; \
        _Pragma("unroll") for(int r=0;r<16;++r){C0[r]-=dl;C1[r]-=dl;} \
        _Pragma("unroll") for(int r=0;r<16;++r)negm[r]=-mhat; asm volatile("":"+v"(negm)); \
        const float f=__builtin_amdgcn_exp2f(-dl); l_reg*=f; if(hi==0)wsf[r32]=f; resc=true; } } \
    SBAR(); \
    GAPB(o[0]=__builtin_amdgcn_mfma_f32_32x32x16_bf16(PAF(0),VFR(0),o[0],0,0,0), C0,0); \
    GAPB(o[1]=__builtin_amdgcn_mfma_f32_32x32x16_bf16(PAF(0),VFR(4),o[1],0,0,0), C0,4); \
    KRD(GL,0); GAPB(o[0]=__builtin_amdgcn_mfma_f32_32x32x16_bf16(PAF(1),VFR(1),o[0],0,0,0), C0,8); \
    KRD(GL,1); GAPB(o[1]=__builtin_amdgcn_mfma_f32_32x32x16_bf16(PAF(1),VFR(5),o[1],0,0,0), C0,12); \
    KRD(GL,2); GAPB(o[0]=__builtin_amdgcn_mfma_f32_32x32x16_bf16(PAF(2),VFR(2),o[0],0,0,0), C1,0); \
    KRD(GL,3); GAPB(o[1]=__builtin_amdgcn_mfma_f32_32x32x16_bf16(PAF(2),VFR(6),o[1],0,0,0), C1,4); \
    GAPB(o[0]=__builtin_amdgcn_mfma_f32_32x32x16_bf16(PAF(3),VFR(3),o[0],0,0,0), C1,8); \
    GAPB(o[1]=__builtin_amdgcn_mfma_f32_32x32x16_bf16(PAF(3),VFR(7),o[1],0,0,0), C1,12); \
    }while(0)
  int t=1;
  #undef CMASK
  #define CMASK(P0,P1,t) do{}while(0)
  for(;t+5<NT;t+=2){
    STEP(pB0,pB1,pA0,pA1,t,true,true,true);     WAIT_BAR(2); RESC(); ROT();
    STEP(pA0,pA1,pB0,pB1,t+1,true,true,true);   WAIT_BAR(2); RESC(); ROT();
  }
  #undef CMASK
  #define CMASK(P0,P1,t) do{int jb_=(t)-(NT-4); if(jb_>=0)cmask(P0,P1,jb_,qrel,hi);}while(0)
  #define ENDW(tt) do{ if((tt)+3<NT){WAIT_BAR(2);} else if((tt)+2<NT){WAIT_BAR(1);} else {WAIT_BAR(0);} }while(0)
  for(;t+1<NT;t+=2){
    STEP(pB0,pB1,pA0,pA1,t,(t+3<NT),(t+1<NT),(t+1<NT));       ENDW(t);   RESC(); ROT();
    STEP(pA0,pA1,pB0,pB1,t+1,(t+4<NT),(t+2<NT),(t+2<NT));     ENDW(t+1); RESC(); ROT();
  }
  STEP(pB0,pB1,pA0,pA1,NT-1,false,false,false); RESC();
  { float sacc=pB0[0]+pB0[1]; _Pragma("unroll") for(int r=2;r<16;++r)sacc+=pB0[r]; _Pragma("unroll") for(int r=0;r<16;++r)sacc+=pB1[r]; l_reg+=sacc;
    pw0=(u32x4){PKW(pB0,0),PKW(pB0,2),PKW(pB0,4),PKW(pB0,6)};pw1=(u32x4){PKW(pB0,8),PKW(pB0,10),PKW(pB0,12),PKW(pB0,14)};pw2=(u32x4){PKW(pB1,0),PKW(pB1,2),PKW(pB1,4),PKW(pB1,6)};pw3=(u32x4){PKW(pB1,8),PKW(pB1,10),PKW(pB1,12),PKW(pB1,14)};
    SBAR(); pv(o,vb0+sl_cur,PAF(0),PAF(1),PAF(2),PAF(3)); }
  #undef PKW
  #undef PAF
  #undef VFR
  #undef PIN
  #undef MX3
  #undef GAPA
  #undef GAPB
  #undef EX
  #undef VRD
  #undef KRD
  #undef STEP
  #undef ENDW
  {auto rr=__builtin_amdgcn_permlane32_swap(__float_as_uint(l_reg),__float_as_uint(l_reg),false,false);l_reg=__uint_as_float(rr[0])+__uint_as_float(rr[1]);}
  if(hi==0)wsf[32+r32]=l_reg;asm volatile("s_waitcnt lgkmcnt(0)":::"memory");
  float rli[16];
  #pragma unroll
  for(int r=0;r<16;++r)rli[r]=__builtin_amdgcn_rcpf(wsf[32+crow(r,hi)]);
  bf16*Ow=O+(rowbase+q0+wid*QBLK)*DM+h*D;
  { bf16*stg=(bf16*)(shm+LDS_OST)+wid*2048;
    #pragma unroll
    for(int r=0;r<16;++r){const int orow=crow(r,hi);
      #pragma unroll
      for(int d0=0;d0<2;++d0)stg[orow*64+d0*32+r32]=__float2bfloat16(o[d0][r]*rli[r]);}
    asm volatile("s_waitcnt lgkmcnt(0)":::"memory");
    #pragma unroll
    for(int i=0;i<4;++i){const int row=i*8+(lane>>3),ch=lane&7; const u32x4 v=*(const u32x4*)(stg+row*64+ch*8); ATTN_STORE16(Ow+(long)row*DM+ch*8,v);} }
  asm volatile("s_waitcnt lgkmcnt(0)\n\ts_barrier":::"memory");
  #undef DMA_K
  #undef DMA_V
  #undef CMASK
  #undef START
  #undef RESC
  #undef ROT
}
constexpr int V2SLOT=16384;
constexpr int L2_K=0, L2_V=NSLOT*SLOTB, L2_WS=L2_V+NSLOT*V2SLOT, L2_OST=L2_WS+NW*64*4, L2_BYTES=L2_OST+NW*4096;
__device__ __forceinline__ void pv4(f32x16*o,int vb,bf16x8 pa0,bf16x8 pa1,bf16x8 pa2,bf16x8 pa3){
  #pragma unroll
  for(int d0=0;d0<4;++d0){s16x4 lo[4],hi[4];
    #pragma unroll
    for(int ks=0;ks<4;++ks){
      asm volatile("ds_read_b64_tr_b16 %0,%1 offset:%c2":"=&v"(lo[ks]):"v"(vb),"i"(d0*4096+ks*1024):"memory");
      asm volatile("ds_read_b64_tr_b16 %0,%1 offset:%c2":"=&v"(hi[ks]):"v"(vb),"i"(d0*4096+ks*1024+512):"memory");}
    asm volatile("s_waitcnt lgkmcnt(0)":::"memory");SBAR();
    #define PK(k) (bf16x8){lo[k][0],lo[k][1],lo[k][2],lo[k][3],hi[k][0],hi[k][1],hi[k][2],hi[k][3]}
    o[d0]=__builtin_amdgcn_mfma_f32_32x32x16_bf16(pa0,PK(0),o[d0],0,0,0);
    o[d0]=__builtin_amdgcn_mfma_f32_32x32x16_bf16(pa1,PK(1),o[d0],0,0,0);
    o[d0]=__builtin_amdgcn_mfma_f32_32x32x16_bf16(pa2,PK(2),o[d0],0,0,0);
    o[d0]=__builtin_amdgcn_mfma_f32_32x32x16_bf16(pa3,PK(3),o[d0],0,0,0);
    #undef PK
  }
}
template<int THRL> __device__ __forceinline__ void attn_unit2(int b,int qb,const bf16*Q,const bf16*__restrict__ K,const bf16*__restrict__ V,bf16*O,char*shm){
  int tid_=threadIdx.x; asm volatile("":"+v"(tid_)); const int tid=tid_,lane=tid&63,r32=lane&31,hi=lane>>5; const int wid=__builtin_amdgcn_readfirstlane(tid>>6);
  const long rowbase=(long)b*SEQ; const int q0=qb*QB;
  if(wid>=4)__builtin_amdgcn_s_setprio(1);
  const bf16*Qw=Q+(rowbase+q0+wid*QBLK)*DM;
  const bf16*Kh=K+rowbase*DM,*Vh=V+rowbase*DM;
  const unsigned lds0=(unsigned)(uintptr_t)shm;
  float*wsf=(float*)(shm+L2_WS)+wid*64;
  const bf16*ksrc=Kh+(long)lane*DM+wid*8;
  const bf16*vsrc=Vh+(long)(16*(wid&3)+(lane>>2))*DM+(wid>>2)*32+(lane&3)*8;
  const unsigned kdst=lds0+L2_K+wid*1024, vdst=lds0+L2_V+wid*1024;
  #define DMA_K(t,slot) glds16(ksrc+(long)(t)*KVBLK*DM,(unsigned)__builtin_amdgcn_readfirstlane(kdst+(slot)))
  #define DMA_V(t,slot) do{ glds16(vsrc+(long)(t)*KVBLK*DM,(unsigned)__builtin_amdgcn_readfirstlane(vdst+2*(slot))); glds16(vsrc+64+(long)(t)*KVBLK*DM,(unsigned)__builtin_amdgcn_readfirstlane(vdst+2*(slot)+8192)); }while(0)
  const int vb0=(int)(lds0+L2_V)+((lane>>4)&1)*32+(lane&3)*8+(4*hi+((lane&15)>>2))*64;
  const char*Kbase=shm+L2_K; bf16x8 kf[8];
  const lds_cptr shm3=(lds_cptr)shm; const lds_cptr kp0=shm3+L2_K+hi*1024+r32*16; const lds_cptr vp0=shm3+L2_V+((lane>>4)&1)*32+(lane&3)*8+(4*hi+((lane&15)>>2))*64;
  const int NT=(q0+QB)/KVBLK;
  DMA_K(0,0);DMA_V(0,0);DMA_K(1,SLOTB);
  bf16x8 qr[4];
  #pragma unroll
  for(int d0=0;d0<4;++d0)qr[d0]=*reinterpret_cast<const bf16x8*>(&Qw[(long)r32*DM+d0*16+hi*8]);
  float mhat=0.f,l_reg=0.f;f32x16 o[4];o[0]=f32x16{};o[1]=f32x16{};o[2]=f32x16{};o[3]=f32x16{};f32x16 negm=f32x16{};asm volatile("":"+v"(negm));
  const int qrel=wid*QBLK+r32;
  #define CMASK(P0,P1,t) do{int jb_=(t)-(NT-4); if(jb_>=0)cmask(P0,P1,jb_,qrel,hi);}while(0)
  bool resc=false;
  #define START(P0,P1) do{ const float rm=rowmax(P0,P1); resc=false; \
    { const float dl=rm; mhat=fadd_s(mhat,dl); \
      _Pragma("unroll") for(int r=0;r<16;++r){P0[r]=fsub_s(P0[r],dl);P1[r]=fsub_s(P1[r],dl);} \
      _Pragma("unroll") for(int r=0;r<16;++r)negm[r]=-mhat; asm volatile("":"+v"(negm)); } \
    _Pragma("unroll") for(int r=0;r<16;++r)P0[r]=__builtin_amdgcn_exp2f(P0[r]); }while(0)
  #define RESC() do{ if(resc){ asm volatile("s_waitcnt lgkmcnt(0)":::"memory"); \
      _Pragma("unroll") for(int d_=0;d_<4;++d_) _Pragma("unroll") for(int r=0;r<16;++r)o[d_][r]*=wsf[crow(r,hi)]; } }while(0)
  f32x16 pA0,pA1,pB0,pB1;
  int sl_prev=0,sl_cur=0,sl_next=SLOTB;
  #define ROT() do{sl_prev=sl_cur;sl_cur=sl_next;sl_next=(sl_next==(NSLOT-1)*SLOTB)?0:sl_next+SLOTB;}while(0)
  DMA_K(2,2*SLOTB);
  WAIT_BAR(4);
  qkt(pA0,pA1,Kbase,qr,negm,r32,hi);asm volatile("s_nop 15\n\ts_nop 7":"+v"(pA0),"+v"(pA1));CMASK(pA0,pA1,0);
  START(pA0,pA1);
  _Pragma("unroll") for(int r=0;r<16;++r)pA1[r]=__builtin_amdgcn_exp2f(pA1[r]);
  WAIT_BAR(0);
  DMA_K(3,0);DMA_V(1,SLOTB);
  ROT();
  kload8(kf,kp0+sl_cur);
  WAIT_BAR(3);
  s16x4 vlo[8],vhi[8]; u32x4 pw0,pw1,pw2,pw3;
  #define VRD2(rg,i) do{ vlo[rg]=vtr(vp_+(((i)>>2)*4096+((i)&3)*1024)); vhi[rg]=vtr(vp_+(((i)>>2)*4096+((i)&3)*1024+512)); }while(0)
  #define GAPB2(MF,X,B) do{ MF; X[B]=EX(X[B]); X[B+1]=EX(X[B+1]); PIN(X); SBAR(); }while(0)
  #define PKW(P,B) cvtpk_s(P[B],P[B+1])
  #define PAF(k) __builtin_bit_cast(bf16x8,pw##k)
  #define VFR(i) (bf16x8){vlo[i][0],vlo[i][1],vlo[i][2],vlo[i][3],vhi[i][0],vhi[i][1],vhi[i][2],vhi[i][3]}
  #define PIN(x) asm volatile("":"+v"(x))
  #define MX3(a,b,c) __builtin_fmaxf(__builtin_fmaxf((a),(b)),(c))
  #define GAPA(MF,A0,A1,A2,A3,W0,W1,PW) do{ MF; sacc+=A0; sacc+=A1; sacc+=A2; sacc+=A3; PIN(sacc); W0; W1; PIN(PW); SBAR(); }while(0)
  #define EX(v) __builtin_amdgcn_exp2f(v)
  #define GAPB(MF,X,B) do{ MF; X[B]=EX(X[B]); X[B+1]=EX(X[B+1]); X[B+2]=EX(X[B+2]); X[B+3]=EX(X[B+3]); PIN(X); SBAR(); }while(0)
  #define VRD(i) do{ vlo[i]=vtr(vp_+(((i)>>2)*4096+((i)&3)*1024)); vhi[i]=vtr(vp_+(((i)>>2)*4096+((i)&3)*1024+512)); }while(0)
  #define KRD(G,j) do{ if(G){ kload2(kf,kp0+sl_next,j); SBAR(); } }while(0)
  #define STEP(C0,C1,P0,P1,t,GK,GV,GL) do{ SBAR(); \
    const lds_cptr vp_=vp0+2*sl_prev; \
    VRD2(0,0); SBAR(); float sacc=(P0[0]+P0[1]); \
    GAPA(C0=__builtin_amdgcn_mfma_f32_32x32x16_bf16(kf[0],qr[0],negm,0,0,0), P0[2],P0[3],P0[4],P0[5],     pw0[0]=PKW(P0,0), pw0[1]=PKW(P0,2), pw0); \
    VRD2(1,4); SBAR(); GAPA(C1=__builtin_amdgcn_mfma_f32_32x32x16_bf16(kf[1],qr[0],negm,0,0,0), P0[6],P0[7],P0[8],P0[9],     pw0[2]=PKW(P0,4), pw0[3]=PKW(P0,6), pw0); \
    VRD2(2,8); SBAR(); GAPA(C0=__builtin_amdgcn_mfma_f32_32x32x16_bf16(kf[2],qr[1],C0,0,0,0),   P0[10],P0[11],P0[12],P0[13], pw1[0]=PKW(P0,8), pw1[1]=PKW(P0,10), pw1); \
    VRD2(3,12); SBAR(); GAPA(C1=__builtin_amdgcn_mfma_f32_32x32x16_bf16(kf[3],qr[1],C1,0,0,0),   P0[14],P0[15],P1[0],P1[1],   pw1[2]=PKW(P0,12),pw1[3]=PKW(P0,14), pw1); \
    VRD2(4,1); SBAR(); GAPA(C0=__builtin_amdgcn_mfma_f32_32x32x16_bf16(kf[4],qr[2],C0,0,0,0),   P1[2],P1[3],P1[4],P1[5],     pw2[0]=PKW(P1,0), pw2[1]=PKW(P1,2), pw2); \
    VRD2(5,5); SBAR(); GAPA(C1=__builtin_amdgcn_mfma_f32_32x32x16_bf16(kf[5],qr[2],C1,0,0,0),   P1[6],P1[7],P1[8],P1[9],     pw2[2]=PKW(P1,4), pw2[3]=PKW(P1,6), pw2); \
    VRD2(6,9); SBAR(); GAPA(C0=__builtin_amdgcn_mfma_f32_32x32x16_bf16(kf[6],qr[3],C0,0,0,0),   P1[10],P1[11],P1[12],P1[13], pw3[0]=PKW(P1,8), pw3[1]=PKW(P1,10), pw3); \
    VRD2(7,13); SBAR(); GAPA(C1=__builtin_amdgcn_mfma_f32_32x32x16_bf16(kf[7],qr[3],C1,0,0,0),   P1[14],P1[15],0.f,0.f,       pw3[2]=PKW(P1,12),pw3[3]=PKW(P1,14), pw3); \
    l_reg+=sacc; \
    if(GK){DMA_K((t)+3,sl_cur);} if(GV){DMA_V((t)+1,sl_next);} \
    CMASK(C0,C1,t); \
    { float a=MX3(C0[0],C0[1],C1[0]),b=MX3(C0[2],C0[3],C1[1]); a=MX3(a,C1[2],C1[3]); \
      _Pragma("unroll") for(int r=4;r<16;r+=4){a=MX3(a,C0[r],C0[r+1]);b=MX3(b,C0[r+2],C0[r+3]);a=MX3(a,C1[r],C1[r+1]);b=MX3(b,C1[r+2],C1[r+3]);} \
      float rm=__builtin_fmaxf(a,b); { auto rr=__builtin_amdgcn_permlane32_swap(__float_as_uint(rm),__float_as_uint(rm),false,false); rm=__builtin_fmaxf(__uint_as_float(rr[0]),__uint_as_float(rr[1])); } \
      resc=false; \
      if(__builtin_expect(__any(rm>(float)THRL),0)){ const float dl=__builtin_fmaxf(rm,0.f); mhat+=dl; \
        _Pragma("unroll") for(int r=0;r<16;++r){C0[r]-=dl;C1[r]-=dl;} \
        _Pragma("unroll") for(int r=0;r<16;++r)negm[r]=-mhat; asm volatile("":"+v"(negm)); \
        const float f=__builtin_amdgcn_exp2f(-dl); l_reg*=f; if(hi==0)wsf[r32]=f; resc=true; } } \
    SBAR(); \
    GAPB2(o[0]=__builtin_amdgcn_mfma_f32_32x32x16_bf16(PAF(0),VFR(0),o[0],0,0,0), C0,0); VRD2(0,2); SBAR(); \
    GAPB2(o[1]=__builtin_amdgcn_mfma_f32_32x32x16_bf16(PAF(0),VFR(1),o[1],0,0,0), C0,2); VRD2(1,6); SBAR(); \
    GAPB2(o[2]=__builtin_amdgcn_mfma_f32_32x32x16_bf16(PAF(0),VFR(2),o[2],0,0,0), C0,4); VRD2(2,10); SBAR(); \
    GAPB2(o[3]=__builtin_amdgcn_mfma_f32_32x32x16_bf16(PAF(0),VFR(3),o[3],0,0,0), C0,6); VRD2(3,14); SBAR(); \
    GAPB2(o[0]=__builtin_amdgcn_mfma_f32_32x32x16_bf16(PAF(1),VFR(4),o[0],0,0,0), C0,8); VRD2(4,3); SBAR(); \
    GAPB2(o[1]=__builtin_amdgcn_mfma_f32_32x32x16_bf16(PAF(1),VFR(5),o[1],0,0,0), C0,10); VRD2(5,7); SBAR(); \
    GAPB2(o[2]=__builtin_amdgcn_mfma_f32_32x32x16_bf16(PAF(1),VFR(6),o[2],0,0,0), C0,12); VRD2(6,11); SBAR(); \
    GAPB2(o[3]=__builtin_amdgcn_mfma_f32_32x32x16_bf16(PAF(1),VFR(7),o[3],0,0,0), C0,14); VRD2(7,15); SBAR(); \
    KRD(GL,0); GAPB2(o[0]=__builtin_amdgcn_mfma_f32_32x32x16_bf16(PAF(2),VFR(0),o[0],0,0,0), C1,0); \
    KRD(GL,1); GAPB2(o[1]=__builtin_amdgcn_mfma_f32_32x32x16_bf16(PAF(2),VFR(1),o[1],0,0,0), C1,2); \
    KRD(GL,2); GAPB2(o[2]=__builtin_amdgcn_mfma_f32_32x32x16_bf16(PAF(2),VFR(2),o[2],0,0,0), C1,4); \
    KRD(GL,3); GAPB2(o[3]=__builtin_amdgcn_mfma_f32_32x32x16_bf16(PAF(2),VFR(3),o[3],0,0,0), C1,6); \
    GAPB2(o[0]=__builtin_amdgcn_mfma_f32_32x32x16_bf16(PAF(3),VFR(4),o[0],0,0,0), C1,8); \
    GAPB2(o[1]=__builtin_amdgcn_mfma_f32_32x32x16_bf16(PAF(3),VFR(5),o[1],0,0,0), C1,10); \
    GAPB2(o[2]=__builtin_amdgcn_mfma_f32_32x32x16_bf16(PAF(3),VFR(6),o[2],0,0,0), C1,12); \
    GAPB2(o[3]=__builtin_amdgcn_mfma_f32_32x32x16_bf16(PAF(3),VFR(7),o[3],0,0,0), C1,14); \
    }while(0)
  int t=1;
  #undef CMASK
  #define CMASK(P0,P1,t) do{}while(0)
  for(;t+5<NT;t+=2){
    STEP(pB0,pB1,pA0,pA1,t,true,true,true);     WAIT_BAR(3); RESC(); ROT();
    STEP(pA0,pA1,pB0,pB1,t+1,true,true,true);   WAIT_BAR(3); RESC(); ROT();
  }
  #undef CMASK
  #define CMASK(P0,P1,t) do{int jb_=(t)-(NT-4); if(jb_>=0)cmask(P0,P1,jb_,qrel,hi);}while(0)
  #define ENDW(tt) do{ if((tt)+3<NT){WAIT_BAR(3);} else if((tt)+2<NT){WAIT_BAR(2);} else {WAIT_BAR(0);} }while(0)
  for(;t+1<NT;t+=2){
    STEP(pB0,pB1,pA0,pA1,t,(t+3<NT),(t+1<NT),(t+1<NT));       ENDW(t);   RESC(); ROT();
    STEP(pA0,pA1,pB0,pB1,t+1,(t+4<NT),(t+2<NT),(t+2<NT));     ENDW(t+1); RESC(); ROT();
  }
  STEP(pB0,pB1,pA0,pA1,NT-1,false,false,false); RESC();
  { float sacc=pB0[0]+pB0[1]; _Pragma("unroll") for(int r=2;r<16;++r)sacc+=pB0[r]; _Pragma("unroll") for(int r=0;r<16;++r)sacc+=pB1[r]; l_reg+=sacc;
    pw0=(u32x4){PKW(pB0,0),PKW(pB0,2),PKW(pB0,4),PKW(pB0,6)};pw1=(u32x4){PKW(pB0,8),PKW(pB0,10),PKW(pB0,12),PKW(pB0,14)};pw2=(u32x4){PKW(pB1,0),PKW(pB1,2),PKW(pB1,4),PKW(pB1,6)};pw3=(u32x4){PKW(pB1,8),PKW(pB1,10),PKW(pB1,12),PKW(pB1,14)};
    SBAR(); pv4(o,vb0+2*sl_cur,PAF(0),PAF(1),PAF(2),PAF(3)); }
  #undef PKW
  #undef PAF
  #undef VFR
  #undef PIN
  #undef MX3
  #undef GAPA
  #undef GAPB
  #undef EX
  #undef VRD
  #undef VRD2
  #undef GAPB2
  #undef KRD
  #undef STEP
  #undef ENDW
  {auto rr=__builtin_amdgcn_permlane32_swap(__float_as_uint(l_reg),__float_as_uint(l_reg),false,false);l_reg=__uint_as_float(rr[0])+__uint_as_float(rr[1]);}
  if(hi==0)wsf[32+r32]=l_reg;asm volatile("s_waitcnt lgkmcnt(0)":::"memory");
  float rli[16];
  #pragma unroll
  for(int r=0;r<16;++r)rli[r]=__builtin_amdgcn_rcpf(wsf[32+crow(r,hi)]);
  bf16*Ow=O+(rowbase+q0+wid*QBLK)*DM;
  { bf16*stg=(bf16*)(shm+L2_OST)+wid*2048;
    #pragma unroll
    for(int hf=0;hf<2;++hf){
      #pragma unroll
      for(int r=0;r<16;++r){const int orow=crow(r,hi);
        #pragma unroll
        for(int d0=0;d0<2;++d0)stg[orow*64+d0*32+r32]=__float2bfloat16(o[2*hf+d0][r]*rli[r]);}
      asm volatile("s_waitcnt lgkmcnt(0)":::"memory");
      #pragma unroll
      for(int i=0;i<4;++i){const int row=i*8+(lane>>3),ch=lane&7; const u32x4 v=*(const u32x4*)(stg+row*64+ch*8); ATTN_STORE16(Ow+(long)row*DM+hf*64+ch*8,v);}
      asm volatile("s_waitcnt lgkmcnt(0)":::"memory"); } }
  asm volatile("s_waitcnt lgkmcnt(0)\n\ts_barrier":::"memory");
  __builtin_amdgcn_s_setprio(0);
  #undef DMA_K
  #undef DMA_V
  #undef CMASK
  #undef START
  #undef RESC
  #undef ROT
}

__device__ __forceinline__ void wmask(f32x16&p0,f32x16&p1,int thr,int hi){
  const float NEG=-INFINITY; const int kb=4*hi;
  #pragma unroll
  for(int r=0;r<16;++r){const int kv=kb+(r&3)+8*(r>>2); if(kv<thr)p0[r]=NEG; if(kv+32<thr)p1[r]=NEG;}
}
__device__ __forceinline__ void cmask2(f32x16&p0,f32x16&p1,int nb,int lim,int hi){
  const float NEG=-INFINITY; const int kb=nb+4*hi;
  #pragma unroll
  for(int r=0;r<16;++r){const int kv=kb+(r&3)+8*(r>>2); if(kv>lim)p0[r]=NEG; if(kv+32>lim)p1[r]=NEG;}
}
template<int THRL,int MODE,int PQ,int PKV,int PO> __device__ __forceinline__ void attn_unitN(int q0,int NT,const bf16*Qw0,const bf16*__restrict__ Kh,const bf16*__restrict__ Vh,bf16*Ow0,char*shm){
  int tid_=threadIdx.x; asm volatile("":"+v"(tid_)); const int tid=tid_,lane=tid&63,r32=lane&31,hi=lane>>5; const int wid=__builtin_amdgcn_readfirstlane(tid>>6);
  const bf16*Qw=Qw0+(long)(wid*QBLK)*PQ;
  const unsigned lds0=(unsigned)(uintptr_t)shm;
  float*wsf=(float*)(shm+LDS_WS)+wid*64;
  const bf16*ksrc=Kh+(long)lane*PKV+wid*8;
  const bf16*vsrc=Vh+(long)(16*(wid&3)+(lane>>2))*PKV+(wid>>2)*32+(lane&3)*8;
  const unsigned kdst=lds0+LDS_K+wid*1024, vdst=lds0+LDS_V+wid*1024;
  #define DMA_K(t,slot) glds16(ksrc+(long)(t)*KVBLK*PKV,(unsigned)__builtin_amdgcn_readfirstlane(kdst+(slot)))
  #define DMA_V(t,slot) glds16(vsrc+(long)(t)*KVBLK*PKV,(unsigned)__builtin_amdgcn_readfirstlane(vdst+(slot)))
  const int vb0=(int)(lds0+LDS_V)+((lane>>4)&1)*32+(lane&3)*8+(4*hi+((lane&15)>>2))*64;
  const char*Kbase=shm+LDS_K; bf16x8 kf[8];
  const lds_cptr shm3=(lds_cptr)shm; const lds_cptr kp0=shm3+LDS_K+hi*1024+r32*16; const lds_cptr vp0=shm3+LDS_V+((lane>>4)&1)*32+(lane&3)*8+(4*hi+((lane&15)>>2))*64;
  DMA_K(0,0);DMA_V(0,0);DMA_K(1,SLOTB);
  bf16x8 qr[4];
  #pragma unroll
  for(int d0=0;d0<4;++d0)qr[d0]=*reinterpret_cast<const bf16x8*>(&Qw[(long)r32*PQ+d0*16+hi*8]);
  float mhat=0.f,l_reg=0.f;f32x16 o[2];o[0]=f32x16{};o[1]=f32x16{};const f32x16 negm=f32x16{};
  const int qrel=wid*QBLK+r32; const int clim=(q0+qrel-31)>>4; (void)clim;
  #define CMASK(P0,P1,t) do{int jb_=(t)-(NT-4); if(jb_>=0){ if(MODE==2)cmask2(P0,P1,64*(t),clim,hi); else cmask(P0,P1,jb_,qrel,hi);} else if(MODE==1&&(t)<NT-8)wmask(P0,P1,qrel-511-64*jb_,hi);}while(0)
  bool resc=false;
  #define START(P0,P1) do{ const float rm=__builtin_fmaxf(rowmax(P0,P1),-32.f); resc=false; \
    { const float dl=rm; mhat=fadd_s(mhat,dl); \
      _Pragma("unroll") for(int r=0;r<16;++r){P0[r]=fsub_s(P0[r],dl);P1[r]=fsub_s(P1[r],dl);} \
      } \
    _Pragma("unroll") for(int r=0;r<16;++r)P0[r]=__builtin_amdgcn_exp2f(P0[r]); }while(0)
  #define RESC() do{ if(resc){ asm volatile("s_waitcnt lgkmcnt(0)":::"memory"); \
      _Pragma("unroll") for(int d_=0;d_<2;++d_) _Pragma("unroll") for(int r=0;r<16;++r)o[d_][r]*=wsf[crow(r,hi)]; } }while(0)
  f32x16 pA0,pA1,pB0,pB1;
  int sl_prev=0,sl_cur=0,sl_next=SLOTB;
  #define ROT() do{sl_prev=sl_cur;sl_cur=sl_next;sl_next=(sl_next==(NSLOT-1)*SLOTB)?0:sl_next+SLOTB;}while(0)
  DMA_K(2,2*SLOTB);
  WAIT_BAR(3);
  qkt(pA0,pA1,Kbase,qr,negm,r32,hi);asm volatile("s_nop 15\n\ts_nop 7":"+v"(pA0),"+v"(pA1));CMASK(pA0,pA1,0);
  START(pA0,pA1);
  _Pragma("unroll") for(int r=0;r<16;++r)pA1[r]=__builtin_amdgcn_exp2f(pA1[r]);
  WAIT_BAR(0);
  DMA_K(3,0);DMA_V(1,SLOTB);
  ROT();
  kload8(kf,kp0+sl_cur);
  WAIT_BAR(2);
  s16x4 vlo[8],vhi[8]; u32x4 pw0,pw1,pw2,pw3;
  #define PKW(P,B) cvtpk_s(P[B],P[B+1])
  #define PAF(k) __builtin_bit_cast(bf16x8,pw##k)
  #define VFR(i) (bf16x8){vlo[i][0],vlo[i][1],vlo[i][2],vlo[i][3],vhi[i][0],vhi[i][1],vhi[i][2],vhi[i][3]}
  #define PIN(x) asm volatile("":"+v"(x))
  #define MX3(a,b,c) __builtin_fmaxf(__builtin_fmaxf((a),(b)),(c))
  #define GAPA(MF,A0,A1,A2,A3,W0,W1,PW) do{ MF; sacc+=A0; sacc+=A1; sacc+=A2; sacc+=A3; PIN(sacc); W0; W1; PIN(PW); SBAR(); }while(0)
  #define EX(v) __builtin_amdgcn_exp2f(v)
  #define GAPB(MF,X,B) do{ MF; X[B]=EX(X[B]); X[B+1]=EX(X[B+1]); X[B+2]=EX(X[B+2]); X[B+3]=EX(X[B+3]); PIN(X); SBAR(); }while(0)
  #define VRD(i) do{ vlo[i]=vtr(vp_+(((i)>>2)*4096+((i)&3)*1024)); vhi[i]=vtr(vp_+(((i)>>2)*4096+((i)&3)*1024+512)); }while(0)
  #define KRD(G,j) do{ if(G){ kload2(kf,kp0+sl_next,j); SBAR(); } }while(0)
  #define STEP(C0,C1,P0,P1,t,GK,GV,GL) do{ SBAR(); \
    const lds_cptr vp_=vp0+sl_prev; \
    VRD(0); SBAR(); float sacc=(P0[0]+P0[1]); \
    GAPA(C0=__builtin_amdgcn_mfma_f32_32x32x16_bf16(kf[0],qr[0],negm,0,0,0), P0[2],P0[3],P0[4],P0[5],     pw0[0]=PKW(P0,0), pw0[1]=PKW(P0,2), pw0); \
    VRD(4); SBAR(); GAPA(C1=__builtin_amdgcn_mfma_f32_32x32x16_bf16(kf[1],qr[0],negm,0,0,0), P0[6],P0[7],P0[8],P0[9],     pw0[2]=PKW(P0,4), pw0[3]=PKW(P0,6), pw0); \
    VRD(1); SBAR(); GAPA(C0=__builtin_amdgcn_mfma_f32_32x32x16_bf16(kf[2],qr[1],C0,0,0,0),   P0[10],P0[11],P0[12],P0[13], pw1[0]=PKW(P0,8), pw1[1]=PKW(P0,10), pw1); \
    VRD(5); SBAR(); GAPA(C1=__builtin_amdgcn_mfma_f32_32x32x16_bf16(kf[3],qr[1],C1,0,0,0),   P0[14],P0[15],P1[0],P1[1],   pw1[2]=PKW(P0,12),pw1[3]=PKW(P0,14), pw1); \
    VRD(2); SBAR(); GAPA(C0=__builtin_amdgcn_mfma_f32_32x32x16_bf16(kf[4],qr[2],C0,0,0,0),   P1[2],P1[3],P1[4],P1[5],     pw2[0]=PKW(P1,0), pw2[1]=PKW(P1,2), pw2); \
    VRD(6); SBAR(); GAPA(C1=__builtin_amdgcn_mfma_f32_32x32x16_bf16(kf[5],qr[2],C1,0,0,0),   P1[6],P1[7],P1[8],P1[9],     pw2[2]=PKW(P1,4), pw2[3]=PKW(P1,6), pw2); \
    VRD(3); SBAR(); GAPA(C0=__builtin_amdgcn_mfma_f32_32x32x16_bf16(kf[6],qr[3],C0,0,0,0),   P1[10],P1[11],P1[12],P1[13], pw3[0]=PKW(P1,8), pw3[1]=PKW(P1,10), pw3); \
    VRD(7); SBAR(); GAPA(C1=__builtin_amdgcn_mfma_f32_32x32x16_bf16(kf[7],qr[3],C1,0,0,0),   P1[14],P1[15],0.f,0.f,       pw3[2]=PKW(P1,12),pw3[3]=PKW(P1,14), pw3); \
    l_reg+=sacc; \
    if(GK){DMA_K((t)+3,sl_cur);} if(GV){DMA_V((t)+1,sl_next);} \
    C0=C0-mhat; C1=C1-mhat; \
    CMASK(C0,C1,t); \
    { float a=MX3(C0[0],C0[1],C1[0]),b=MX3(C0[2],C0[3],C1[1]); a=MX3(a,C1[2],C1[3]); \
      _Pragma("unroll") for(int r=4;r<16;r+=4){a=MX3(a,C0[r],C0[r+1]);b=MX3(b,C0[r+2],C0[r+3]);a=MX3(a,C1[r],C1[r+1]);b=MX3(b,C1[r+2],C1[r+3]);} \
      float rm=__builtin_fmaxf(a,b); { auto rr=__builtin_amdgcn_permlane32_swap(__float_as_uint(rm),__float_as_uint(rm),false,false); rm=__builtin_fmaxf(__uint_as_float(rr[0]),__uint_as_float(rr[1])); } \
      resc=false; \
      if(__builtin_expect(__any(rm>(float)THRL),0)){ const float dl=__builtin_fmaxf(rm,0.f); mhat+=dl; \
        _Pragma("unroll") for(int r=0;r<16;++r){C0[r]-=dl;C1[r]-=dl;} \
        const float f=__builtin_amdgcn_exp2f(-dl); l_reg*=f; if(hi==0)wsf[r32]=f; resc=true; } } \
    SBAR(); \
    GAPB(o[0]=__builtin_amdgcn_mfma_f32_32x32x16_bf16(PAF(0),VFR(0),o[0],0,0,0), C0,0); \
    GAPB(o[1]=__builtin_amdgcn_mfma_f32_32x32x16_bf16(PAF(0),VFR(4),o[1],0,0,0), C0,4); \
    KRD(GL,0); GAPB(o[0]=__builtin_amdgcn_mfma_f32_32x32x16_bf16(PAF(1),VFR(1),o[0],0,0,0), C0,8); \
    KRD(GL,1); GAPB(o[1]=__builtin_amdgcn_mfma_f32_32x32x16_bf16(PAF(1),VFR(5),o[1],0,0,0), C0,12); \
    KRD(GL,2); GAPB(o[0]=__builtin_amdgcn_mfma_f32_32x32x16_bf16(PAF(2),VFR(2),o[0],0,0,0), C1,0); \
    KRD(GL,3); GAPB(o[1]=__builtin_amdgcn_mfma_f32_32x32x16_bf16(PAF(2),VFR(6),o[1],0,0,0), C1,4); \
    GAPB(o[0]=__builtin_amdgcn_mfma_f32_32x32x16_bf16(PAF(3),VFR(3),o[0],0,0,0), C1,8); \
    GAPB(o[1]=__builtin_amdgcn_mfma_f32_32x32x16_bf16(PAF(3),VFR(7),o[1],0,0,0), C1,12); \
    }while(0)
  int t=1;
  #undef CMASK
  #define CMASK(P0,P1,t) do{ if(MODE==1&&(t)<NT-8)wmask(P0,P1,qrel-511-64*((t)-(NT-4)),hi); }while(0)
  for(;t+5<NT;t+=2){
    STEP(pB0,pB1,pA0,pA1,t,true,true,true);     WAIT_BAR(2); RESC(); ROT();
    STEP(pA0,pA1,pB0,pB1,t+1,true,true,true);   WAIT_BAR(2); RESC(); ROT();
  }
  #undef CMASK
  #define CMASK(P0,P1,t) do{int jb_=(t)-(NT-4); if(jb_>=0){ if(MODE==2)cmask2(P0,P1,64*(t),clim,hi); else cmask(P0,P1,jb_,qrel,hi);} else if(MODE==1&&(t)<NT-8)wmask(P0,P1,qrel-511-64*jb_,hi);}while(0)
  #define ENDW(tt) do{ if((tt)+3<NT){WAIT_BAR(2);} else if((tt)+2<NT){WAIT_BAR(1);} else {WAIT_BAR(0);} }while(0)
  for(;t+1<NT;t+=2){
    STEP(pB0,pB1,pA0,pA1,t,(t+3<NT),(t+1<NT),(t+1<NT));       ENDW(t);   RESC(); ROT();
    STEP(pA0,pA1,pB0,pB1,t+1,(t+4<NT),(t+2<NT),(t+2<NT));     ENDW(t+1); RESC(); ROT();
  }
  STEP(pB0,pB1,pA0,pA1,NT-1,false,false,false); RESC();
  { float sacc=pB0[0]+pB0[1]; _Pragma("unroll") for(int r=2;r<16;++r)sacc+=pB0[r]; _Pragma("unroll") for(int r=0;r<16;++r)sacc+=pB1[r]; l_reg+=sacc;
    pw0=(u32x4){PKW(pB0,0),PKW(pB0,2),PKW(pB0,4),PKW(pB0,6)};pw1=(u32x4){PKW(pB0,8),PKW(pB0,10),PKW(pB0,12),PKW(pB0,14)};pw2=(u32x4){PKW(pB1,0),PKW(pB1,2),PKW(pB1,4),PKW(pB1,6)};pw3=(u32x4){PKW(pB1,8),PKW(pB1,10),PKW(pB1,12),PKW(pB1,14)};
    SBAR(); pv(o,vb0+sl_cur,PAF(0),PAF(1),PAF(2),PAF(3)); }
  #undef PKW
  #undef PAF
  #undef VFR
  #undef PIN
  #undef MX3
  #undef GAPA
  #undef GAPB
  #undef EX
  #undef VRD
  #undef KRD
  #undef STEP
  #undef ENDW
  {auto rr=__builtin_amdgcn_permlane32_swap(__float_as_uint(l_reg),__float_as_uint(l_reg),false,false);l_reg=__uint_as_float(rr[0])+__uint_as_float(rr[1]);}
  if(hi==0)wsf[32+r32]=l_reg;asm volatile("s_waitcnt lgkmcnt(0)":::"memory");
  float rli[16];
  #pragma unroll
  for(int r=0;r<16;++r){const float lv=wsf[32+crow(r,hi)]; rli[r]=lv>0.f?__builtin_amdgcn_rcpf(lv):0.f;}
  bf16*Ow=Ow0+(long)(wid*QBLK)*PO;
  { bf16*stg=(bf16*)(shm+LDS_OST)+wid*2048;
    #pragma unroll
    for(int r=0;r<16;++r){const int orow=crow(r,hi);
      #pragma unroll
      for(int d0=0;d0<2;++d0)stg[orow*64+d0*32+r32]=__float2bfloat16(o[d0][r]*rli[r]);}
    asm volatile("s_waitcnt lgkmcnt(0)":::"memory");
    #pragma unroll
    for(int i=0;i<4;++i){const int row=i*8+(lane>>3),ch=lane&7; const u32x4 v=*(const u32x4*)(stg+row*64+ch*8); ATTN_STORE16(Ow+(long)row*PO+ch*8,v);} }
  asm volatile("s_waitcnt lgkmcnt(0)\n\ts_barrier":::"memory");
  #undef DMA_K
  #undef DMA_V
  #undef CMASK
  #undef START
  #undef RESC
  #undef ROT
}

__device__ __forceinline__ void nsa_window_phase(char*lds,const bf16*P,bf16*OW,unsigned*qc,volatile __attribute__((address_space(3))) unsigned*qw){
  for(;;){
    if(threadIdx.x==0) qw[0]=__hip_atomic_fetch_add(qc,1u,__ATOMIC_RELAXED,__HIP_MEMORY_SCOPE_AGENT);
    __syncthreads();
    const int u=__builtin_amdgcn_readfirstlane((int)qw[0]);
    __syncthreads();
    if(u>=2048)break;
    const int qb=63-(u&63),bh=u>>6,b=bh>>4,hd=bh&15,g=hd>>3; const int q0=qb*256; const int nt0=q0>=512?q0/64-8:0; const int NT=q0/64+4-nt0;
    const long rowbase=(long)b*SEQ;
    attn_unitN<8,1,2048,2048,1024>(q0,NT,P+(rowbase+q0)*2048+hd*64,P+(rowbase+64*nt0)*2048+1536+g*64,P+(rowbase+64*nt0)*2048+1664+g*64,OW+(rowbase+q0)*1024+hd*64,lds);
  }
}
constexpr int ATTN_LDS_BYTES=LDS_BYTES;
template<int THRL=8> __device__ __forceinline__ void diff_attn_phase(char*lds,const bf16*Q,const bf16*K,const bf16*V,bf16*O0,bf16*O1,int vcu,int G){
  for(int i=0;;++i){
    const int L=__builtin_amdgcn_readfirstlane(vcu+(i>>1)*G); if(L>=2048)break;
    const int combo=L>>5,x=L&31; const int b=combo>>5,hh=(combo>>1)&15,vh=combo&1; const int h=hh>>1,c=hh&1;
    const int qb=(i&1)?63-x:x;
    attn_unit<THRL>(b,0,qb,Q+hh*64,K+hh*64,V+(2*h+vh)*64,(c?O1:O0)+(2*h+vh)*64,lds);
  }
}
template<int THRL=8> __device__ __forceinline__ void diff_attn_phase2(char*lds,const bf16*Q,const bf16*K,const bf16*V,bf16*O0,bf16*O1,int vcu,int G){
  for(int i=0;;++i){
    const int L=__builtin_amdgcn_readfirstlane(vcu+(i>>1)*G); if(L>=1024)break;
    const int combo=L>>5,x=L&31; const int b=combo>>4,hh=combo&15; const int h=hh>>1,c=hh&1;
    const int qb=(i&1)?63-x:x;
    attn_unit2<THRL>(b,qb,Q+hh*64,K+hh*64,V+h*128,(c?O1:O0)+h*128,lds);
  }
}
#undef SBAR
#undef WAIT_BAR
}

namespace nsa {
typedef short bf16x8 __attribute__((ext_vector_type(8)));
typedef float f32x4 __attribute__((ext_vector_type(4)));
typedef unsigned short bf16_t;
constexpr int S = 16384, PITCH = 2048;
constexpr int COL_KS = 1280, COL_VS = 1408, COL_KW = 1536, COL_VW = 1664, COL_G = 1792;
constexpr float NEG = -1e30f;
__device__ __forceinline__ unsigned pk2(float lo, float hi) { typedef float f2 __attribute__((ext_vector_type(2))); typedef __bf16 b2 __attribute__((ext_vector_type(2))); f2 v = {lo, hi}; b2 b = __builtin_convertvector(v, b2); return __builtin_bit_cast(unsigned, b); }
__device__ __forceinline__ float bf2f(bf16_t x) { return __uint_as_float((unsigned)x << 16); }

__device__ __forceinline__ void qk_group(float (&s)[8], const bf16_t* krow0, int kpitch, const bf16x8 (&qf)[2], int n, int q) {
    const bf16_t* kp = krow0 + (size_t)(8 * (n >> 2) + (n & 3)) * kpitch + q * 8;
    const bf16x8 a00 = *(const bf16x8*)(kp), a01 = *(const bf16x8*)(kp + 32);
    const bf16x8 a10 = *(const bf16x8*)(kp + (size_t)4 * kpitch), a11 = *(const bf16x8*)(kp + (size_t)4 * kpitch + 32);
    f32x4 t0 = {0.f, 0.f, 0.f, 0.f}, t1 = {0.f, 0.f, 0.f, 0.f};
    t0 = __builtin_amdgcn_mfma_f32_16x16x32_bf16(a00, qf[0], t0, 0, 0, 0); t0 = __builtin_amdgcn_mfma_f32_16x16x32_bf16(a01, qf[1], t0, 0, 0, 0);
    t1 = __builtin_amdgcn_mfma_f32_16x16x32_bf16(a10, qf[0], t1, 0, 0, 0); t1 = __builtin_amdgcn_mfma_f32_16x16x32_bf16(a11, qf[1], t1, 0, 0, 0);
#pragma unroll
    for (int i = 0; i < 4; ++i) { s[i] = t0[i]; s[4 + i] = t1[i]; }
}
__device__ __forceinline__ void pv_group(f32x4 (&o)[4], const float (&p)[8], const bf16_t* vt, int n, int q) {
    typedef unsigned u32x4 __attribute__((ext_vector_type(4)));
    u32x4 w; w.x = pk2(p[0], p[1]); w.y = pk2(p[2], p[3]); w.z = pk2(p[4], p[5]); w.w = pk2(p[6], p[7]);
    const bf16x8 pf = __builtin_bit_cast(bf16x8, w);
#pragma unroll
    for (int dt = 0; dt < 4; ++dt) { const bf16x8 vf = *(const bf16x8*)(vt + (16 * dt + n) * 32 + q * 8); o[dt] = __builtin_amdgcn_mfma_f32_16x16x32_bf16(vf, pf, o[dt], 0, 0, 0); }
}
struct Run { f32x4 o[4]; float m, l; };
__device__ __forceinline__ void run_init(Run& r) {
#pragma unroll
    for (int dt = 0; dt < 4; ++dt) r.o[dt] = (f32x4){0.f, 0.f, 0.f, 0.f};
    r.m = NEG; r.l = 0.f;
}
struct Frag { bf16x8 k[4]; bf16x8 v[4]; };
__device__ __forceinline__ void load_kt(Frag& f, const bf16_t* kt, int lane) {
#pragma unroll
    for (int i = 0; i < 4; ++i) f.k[i] = *(const bf16x8*)(kt + i * 512 + lane * 8);
}
__device__ __forceinline__ void load_k(Frag& f, const bf16_t* krow0, int kpitch, int n, int q) {
    const bf16_t* kp = krow0 + (size_t)(8 * (n >> 2) + (n & 3)) * kpitch + q * 8;
    f.k[0] = *(const bf16x8*)(kp); f.k[1] = *(const bf16x8*)(kp + 32); f.k[2] = *(const bf16x8*)(kp + (size_t)4 * kpitch); f.k[3] = *(const bf16x8*)(kp + (size_t)4 * kpitch + 32);
}
__device__ __forceinline__ void load_v(Frag& f, const bf16_t* vt, int n, int q) {
#pragma unroll
    for (int dt = 0; dt < 4; ++dt) f.v[dt] = *(const bf16x8*)(vt + (16 * dt + n) * 32 + q * 8);
}
__device__ __forceinline__ void qk_frag(float (&s)[8], const Frag& f, const bf16x8 (&qf)[2]) {
    f32x4 t0 = {0.f, 0.f, 0.f, 0.f}, t1 = {0.f, 0.f, 0.f, 0.f};
    t0 = __builtin_amdgcn_mfma_f32_16x16x32_bf16(f.k[0], qf[0], t0, 0, 0, 0); t0 = __builtin_amdgcn_mfma_f32_16x16x32_bf16(f.k[1], qf[1], t0, 0, 0, 0);
    t1 = __builtin_amdgcn_mfma_f32_16x16x32_bf16(f.k[2], qf[0], t1, 0, 0, 0); t1 = __builtin_amdgcn_mfma_f32_16x16x32_bf16(f.k[3], qf[1], t1, 0, 0, 0);
#pragma unroll
    for (int i = 0; i < 4; ++i) { s[i] = t0[i]; s[4 + i] = t1[i]; }
}
__device__ __forceinline__ void pv_frag(f32x4 (&o)[4], const float (&p)[8], const Frag& f) {
    typedef unsigned u32x4 __attribute__((ext_vector_type(4)));
    u32x4 w; w.x = pk2(p[0], p[1]); w.y = pk2(p[2], p[3]); w.z = pk2(p[4], p[5]); w.w = pk2(p[6], p[7]);
    const bf16x8 pf = __builtin_bit_cast(bf16x8, w);
#pragma unroll
    for (int dt = 0; dt < 4; ++dt) o[dt] = __builtin_amdgcn_mfma_f32_16x16x32_bf16(f.v[dt], pf, o[dt], 0, 0, 0);
}
template<int CTRL> __device__ __forceinline__ float dppf(float v) { return __int_as_float(__builtin_amdgcn_update_dpp(0, __float_as_int(v), CTRL, 0xF, 0xF, false)); }
template<int CTRL> __device__ __forceinline__ int dppi(int v) { return __builtin_amdgcn_update_dpp(0, v, CTRL, 0xF, 0xF, false); }
__device__ __forceinline__ float xmax_q(float v) {
    auto a = __builtin_amdgcn_permlane16_swap(__float_as_uint(v), __float_as_uint(v), false, false); v = fmaxf(__uint_as_float(a[0]), __uint_as_float(a[1]));
    auto b = __builtin_amdgcn_permlane32_swap(__float_as_uint(v), __float_as_uint(v), false, false); return fmaxf(__uint_as_float(b[0]), __uint_as_float(b[1]));
}
__device__ __forceinline__ float xsum_q(float v) {
    auto a = __builtin_amdgcn_permlane16_swap(__float_as_uint(v), __float_as_uint(v), false, false); v = __uint_as_float(a[0]) + __uint_as_float(a[1]);
    auto b = __builtin_amdgcn_permlane32_swap(__float_as_uint(v), __float_as_uint(v), false, false); return __uint_as_float(b[0]) + __uint_as_float(b[1]);
}
__device__ __forceinline__ float sum8(float v) { v += dppf<0x141>(v); v += dppf<0xB1>(v); v += dppf<0x4E>(v); return v; }
template<bool FULL> __device__ __forceinline__ void flash_step(Run& r, const Frag& f, const bf16x8 (&qf)[2], int lo, int hi, bool act, int q) {
    float s[8]; qk_frag(s, f, qf);
    float gm = NEG;
    if (FULL) {
#pragma unroll
        for (int j = 0; j < 8; ++j) { const int kk = 8 * q + j; const bool ok = (kk >= lo) && (kk <= hi); s[j] = ok ? s[j] : NEG; gm = fmaxf(gm, s[j]); }
    } else {
#pragma unroll
        for (int j = 0; j < 8; ++j) gm = fmaxf(gm, s[j]);
        gm = act ? gm : NEG;
    }
    gm = xmax_q(gm);
    const float mn = fmaxf(r.m, gm), sc = __builtin_amdgcn_exp2f(r.m - mn); r.m = mn;
    float p[8], ps = 0.f;
    if (FULL) {
#pragma unroll
        for (int j = 0; j < 8; ++j) { const int kk = 8 * q + j; const bool ok = (kk >= lo) && (kk <= hi); p[j] = ok ? __builtin_amdgcn_exp2f(s[j] - mn) : 0.f; ps += p[j]; }
    } else {
#pragma unroll
        for (int j = 0; j < 8; ++j) { p[j] = __builtin_amdgcn_exp2f(s[j] - mn); ps += p[j]; }
        ps = act ? ps : 0.f;
    }
    r.l = r.l * sc + ps;
    if (__builtin_amdgcn_ballot_w64(sc != 1.0f) != 0ull) {
#pragma unroll
        for (int dt = 0; dt < 4; ++dt) r.o[dt] = r.o[dt] * sc; }
    typedef unsigned u32x4 __attribute__((ext_vector_type(4)));
    u32x4 w; w.x = pk2(p[0], p[1]); w.y = pk2(p[2], p[3]); w.z = pk2(p[4], p[5]); w.w = pk2(p[6], p[7]);
    if (!FULL) { w.x = act ? w.x : 0u; w.y = act ? w.y : 0u; w.z = act ? w.z : 0u; w.w = act ? w.w : 0u; }
    const bf16x8 pf = __builtin_bit_cast(bf16x8, w);
#pragma unroll
    for (int dt = 0; dt < 4; ++dt) r.o[dt] = __builtin_amdgcn_mfma_f32_16x16x32_bf16(f.v[dt], pf, r.o[dt], 0, 0, 0);
}

typedef unsigned u32x4n __attribute__((ext_vector_type(4)));
__device__ __forceinline__ unsigned fp8x4(float a, float b, float c, float d) { int w = __builtin_amdgcn_cvt_pk_fp8_f32(a, b, 0, false); w = __builtin_amdgcn_cvt_pk_fp8_f32(c, d, w, true); return (unsigned)w; }
__device__ __forceinline__ long mk64(unsigned lo, unsigned hi) { return (long)(((unsigned long long)hi << 32) | (unsigned long long)lo); }
struct Frag8 { u32x4n k[2]; u32x4n v[2]; };
__device__ __forceinline__ void load8(Frag8& f, const unsigned char* kb, const unsigned char* vb, int G, int lane) {
    const unsigned char* kp = kb + (size_t)G * 2048 + lane * 16; const unsigned char* vp = vb + (size_t)G * 2048 + lane * 16;
    f.k[0] = *(const u32x4n*)kp; f.k[1] = *(const u32x4n*)(kp + 1024); f.v[0] = *(const u32x4n*)vp; f.v[1] = *(const u32x4n*)(vp + 1024);
}
__device__ __forceinline__ long q_to_fp8(const bf16x8& v) {
    float x[8];
#pragma unroll
    for (int j = 0; j < 8; ++j) x[j] = __uint_as_float((unsigned)(unsigned short)v[j] << 16);
    return mk64(fp8x4(x[0], x[1], x[2], x[3]), fp8x4(x[4], x[5], x[6], x[7]));
}
template<bool FULL> __device__ __forceinline__ void flash_step8(Run& r, const Frag8& f, const long (&q8)[2], int lo, int hi, bool act, int q) {
    f32x4 t0 = {0.f, 0.f, 0.f, 0.f}, t1 = {0.f, 0.f, 0.f, 0.f};
    t0 = __builtin_amdgcn_mfma_f32_16x16x32_fp8_fp8(mk64(f.k[0].x, f.k[0].y), q8[0], t0, 0, 0, 0); t0 = __builtin_amdgcn_mfma_f32_16x16x32_fp8_fp8(mk64(f.k[0].z, f.k[0].w), q8[1], t0, 0, 0, 0);
    t1 = __builtin_amdgcn_mfma_f32_16x16x32_fp8_fp8(mk64(f.k[1].x, f.k[1].y), q8[0], t1, 0, 0, 0); t1 = __builtin_amdgcn_mfma_f32_16x16x32_fp8_fp8(mk64(f.k[1].z, f.k[1].w), q8[1], t1, 0, 0, 0);
    float s[8];
#pragma unroll
    for (int i = 0; i < 4; ++i) { s[i] = t0[i]; s[4 + i] = t1[i]; }
    float gm = NEG;
    if (FULL) {
#pragma unroll
        for (int j = 0; j < 8; ++j) { const int kk = 8 * q + j; const bool ok = (kk >= lo) && (kk <= hi); s[j] = ok ? s[j] : NEG; gm = fmaxf(gm, s[j]); }
    } else {
#pragma unroll
        for (int j = 0; j < 8; ++j) gm = fmaxf(gm, s[j]);
        gm = act ? gm : NEG;
    }
    gm = xmax_q(gm);
    const float mn = fmaxf(r.m, gm), sc = __builtin_amdgcn_exp2f(r.m - mn); r.m = mn;
    float p[8], ps = 0.f; const float mn8 = mn - 8.0f;
    if (FULL) {
#pragma unroll
        for (int j = 0; j < 8; ++j) { const int kk = 8 * q + j; const bool ok = (kk >= lo) && (kk <= hi); p[j] = ok ? __builtin_amdgcn_exp2f(s[j] - mn8) : 0.f; ps += p[j]; }
    } else {
#pragma unroll
        for (int j = 0; j < 8; ++j) { p[j] = __builtin_amdgcn_exp2f(s[j] - mn8); ps += p[j]; }
        ps = act ? ps : 0.f;
    }
    r.l = r.l * sc + ps;
    if (__builtin_amdgcn_ballot_w64(sc != 1.0f) != 0ull) {
#pragma unroll
        for (int dt = 0; dt < 4; ++dt) r.o[dt] = r.o[dt] * sc; }
    unsigned w0 = fp8x4(p[0], p[1], p[2], p[3]), w1 = fp8x4(p[4], p[5], p[6], p[7]);
    if (!FULL) { w0 = act ? w0 : 0u; w1 = act ? w1 : 0u; }
    const long pf = mk64(w0, w1);
    r.o[0] = __builtin_amdgcn_mfma_f32_16x16x32_fp8_fp8(mk64(f.v[0].x, f.v[0].y), pf, r.o[0], 0, 0, 0); r.o[1] = __builtin_amdgcn_mfma_f32_16x16x32_fp8_fp8(mk64(f.v[0].z, f.v[0].w), pf, r.o[1], 0, 0, 0);
    r.o[2] = __builtin_amdgcn_mfma_f32_16x16x32_fp8_fp8(mk64(f.v[1].x, f.v[1].y), pf, r.o[2], 0, 0, 0); r.o[3] = __builtin_amdgcn_mfma_f32_16x16x32_fp8_fp8(mk64(f.v[1].z, f.v[1].w), pf, r.o[3], 0, 0, 0);
}

__device__ __forceinline__ void qk8(float (&s)[8], const Frag8& f, const long (&q8)[2]) {
    f32x4 t0 = {0.f, 0.f, 0.f, 0.f}, t1 = {0.f, 0.f, 0.f, 0.f};
    t0 = __builtin_amdgcn_mfma_f32_16x16x32_fp8_fp8(mk64(f.k[0].x, f.k[0].y), q8[0], t0, 0, 0, 0); t0 = __builtin_amdgcn_mfma_f32_16x16x32_fp8_fp8(mk64(f.k[0].z, f.k[0].w), q8[1], t0, 0, 0, 0);
    t1 = __builtin_amdgcn_mfma_f32_16x16x32_fp8_fp8(mk64(f.k[1].x, f.k[1].y), q8[0], t1, 0, 0, 0); t1 = __builtin_amdgcn_mfma_f32_16x16x32_fp8_fp8(mk64(f.k[1].z, f.k[1].w), q8[1], t1, 0, 0, 0);
#pragma unroll
    for (int i = 0; i < 4; ++i) { s[i] = t0[i]; s[4 + i] = t1[i]; }
}
__device__ __forceinline__ void pv8(f32x4 (&o)[4], const float (&p)[8], const Frag8& f) {
    const long pf = mk64(fp8x4(p[0] * 256.f, p[1] * 256.f, p[2] * 256.f, p[3] * 256.f), fp8x4(p[4] * 256.f, p[5] * 256.f, p[6] * 256.f, p[7] * 256.f));
    o[0] = __builtin_amdgcn_mfma_f32_16x16x32_fp8_fp8(mk64(f.v[0].x, f.v[0].y), pf, o[0], 0, 0, 0); o[1] = __builtin_amdgcn_mfma_f32_16x16x32_fp8_fp8(mk64(f.v[0].z, f.v[0].w), pf, o[1], 0, 0, 0);
    o[2] = __builtin_amdgcn_mfma_f32_16x16x32_fp8_fp8(mk64(f.v[1].x, f.v[1].y), pf, o[2], 0, 0, 0); o[3] = __builtin_amdgcn_mfma_f32_16x16x32_fp8_fp8(mk64(f.v[1].z, f.v[1].w), pf, o[3], 0, 0, 0);
}
__device__ __forceinline__ void pv8s(f32x4 (&o)[4], const float (&p)[8], const Frag8& f) {
    const long pf = mk64(fp8x4(p[0], p[1], p[2], p[3]), fp8x4(p[4], p[5], p[6], p[7]));
    o[0] = __builtin_amdgcn_mfma_f32_16x16x32_fp8_fp8(mk64(f.v[0].x, f.v[0].y), pf, o[0], 0, 0, 0); o[1] = __builtin_amdgcn_mfma_f32_16x16x32_fp8_fp8(mk64(f.v[0].z, f.v[0].w), pf, o[1], 0, 0, 0);
    o[2] = __builtin_amdgcn_mfma_f32_16x16x32_fp8_fp8(mk64(f.v[1].x, f.v[1].y), pf, o[2], 0, 0, 0); o[3] = __builtin_amdgcn_mfma_f32_16x16x32_fp8_fp8(mk64(f.v[1].z, f.v[1].w), pf, o[3], 0, 0, 0);
}
__device__ __forceinline__ void loadk8(Frag8& f, const unsigned char* kb, int G, int lane) { const unsigned char* kp = kb + (size_t)G * 2048 + lane * 16; f.k[0] = *(const u32x4n*)kp; f.k[1] = *(const u32x4n*)(kp + 1024); }
struct Tensors {
    const bf16_t* P;
    const unsigned char* KC8;
    const unsigned char* K8;
    const unsigned char* VC8;
    const unsigned char* V8;
    const bf16_t* OW;
    bf16_t* O;
};
__device__ __forceinline__ float wmax64(float v) { v = fmaxf(v, dppf<0x128>(v)); v = fmaxf(v, dppf<0x124>(v)); v = fmaxf(v, dppf<0x122>(v)); v = fmaxf(v, dppf<0x121>(v)); return xmax_q(v); }
__device__ __forceinline__ int wmin64(int v) { v = min(v, dppi<0x128>(v)); v = min(v, dppi<0x124>(v)); v = min(v, dppi<0x122>(v)); v = min(v, dppi<0x121>(v));
    auto a = __builtin_amdgcn_permlane16_swap((unsigned)v, (unsigned)v, false, false); v = min((int)a[0], (int)a[1]);
    auto b = __builtin_amdgcn_permlane32_swap((unsigned)v, (unsigned)v, false, false); return min((int)b[0], (int)b[1]); }
__device__ __forceinline__ int select_blocks(const __attribute__((address_space(3))) float* impA, const __attribute__((address_space(3))) float* impB, __attribute__((address_space(3))) int* list, int qblk, int lane) {
    if (qblk <= 15) { if (lane < 16) list[lane] = lane; return qblk + 1; }
    unsigned key[4];
#pragma unroll
    for (int i = 0; i < 4; ++i) { const int j = lane + 64 * i; key[i] = (j >= 1 && j <= qblk - 2) ? (__float_as_uint(impA[j] + impB[j]) + 1u) : 0u; }
    if (lane == 0) { list[0] = 0; list[1] = qblk - 1; list[2] = qblk; }
    unsigned T = 0u;
#pragma unroll 1
    for (int b = 30; b >= 0; --b) { const unsigned c = T | (1u << b);
        const int cnt = __builtin_popcountll(__builtin_amdgcn_ballot_w64(key[0] >= c)) + __builtin_popcountll(__builtin_amdgcn_ballot_w64(key[1] >= c))
                      + __builtin_popcountll(__builtin_amdgcn_ballot_w64(key[2] >= c)) + __builtin_popcountll(__builtin_amdgcn_ballot_w64(key[3] >= c));
        if (cnt >= 13) T = c; }
    int need = 13, base = 0;
#pragma unroll
    for (int i = 0; i < 4; ++i) need -= __builtin_popcountll(__builtin_amdgcn_ballot_w64(key[i] > T));
#pragma unroll
    for (int i = 0; i < 4; ++i) {
        const unsigned long long ge = __builtin_amdgcn_ballot_w64(key[i] > T), eq = __builtin_amdgcn_ballot_w64(key[i] == T);
        const int ce = __builtin_popcountll(eq), take = ce < need ? ce : need; need -= take;
        const int eqrank = (int)__builtin_amdgcn_mbcnt_hi((unsigned)(eq >> 32), __builtin_amdgcn_mbcnt_lo((unsigned)eq, 0u));
        const bool sel = (key[i] > T) || ((key[i] == T) && eqrank < take);
        const unsigned long long sm = __builtin_amdgcn_ballot_w64(sel);
        const int pos = base + (int)__builtin_amdgcn_mbcnt_hi((unsigned)(sm >> 32), __builtin_amdgcn_mbcnt_lo((unsigned)sm, 0u));
        if (sel) list[3 + pos] = lane + 64 * i;
        base += __builtin_popcountll(sm); (void)ge; }
    return 16;
}
__device__ __forceinline__ int select_blocks4(const __attribute__((address_space(3))) float* imp  , __attribute__((address_space(3))) int* lists  , int qblk, int lane) {
    if (qblk <= 15) { if (lane < 16) { lists[lane] = lane; lists[16 + lane] = lane; lists[32 + lane] = lane; lists[48 + lane] = lane; } return qblk + 1; }
    unsigned key[4][4];
#pragma unroll
    for (int k = 0; k < 4; ++k)
#pragma unroll
        for (int i = 0; i < 4; ++i) { const int j = lane + 64 * i; key[k][i] = (j >= 1 && j <= qblk - 2) ? (__float_as_uint(imp[k * 544 + j] + imp[k * 544 + 272 + j]) + 1u) : 0u; }
    if (lane < 4) { lists[16 * lane] = 0; lists[16 * lane + 1] = qblk - 1; lists[16 * lane + 2] = qblk; }
    unsigned T[4] = {0u, 0u, 0u, 0u};
#pragma unroll 1
    for (int b = 30; b >= 0; --b) {
#pragma unroll
        for (int k = 0; k < 4; ++k) { const unsigned c = T[k] | (1u << b);
            const int cnt = __builtin_popcountll(__builtin_amdgcn_ballot_w64(key[k][0] >= c)) + __builtin_popcountll(__builtin_amdgcn_ballot_w64(key[k][1] >= c))
                          + __builtin_popcountll(__builtin_amdgcn_ballot_w64(key[k][2] >= c)) + __builtin_popcountll(__builtin_amdgcn_ballot_w64(key[k][3] >= c));
            if (cnt >= 13) T[k] = c; } }
#pragma unroll
    for (int k = 0; k < 4; ++k) {
        int need = 13, base = 0;
#pragma unroll
        for (int i = 0; i < 4; ++i) need -= __builtin_popcountll(__builtin_amdgcn_ballot_w64(key[k][i] > T[k]));
#pragma unroll
        for (int i = 0; i < 4; ++i) {
            const unsigned long long eq = __builtin_amdgcn_ballot_w64(key[k][i] == T[k]);
            const int ce = __builtin_popcountll(eq), take = ce < need ? ce : need; need -= take;
            const int eqrank = (int)__builtin_amdgcn_mbcnt_hi((unsigned)(eq >> 32), __builtin_amdgcn_mbcnt_lo((unsigned)eq, 0u));
            const bool sel = (key[k][i] > T[k]) || ((key[k][i] == T[k]) && eqrank < take);
            const unsigned long long sm = __builtin_amdgcn_ballot_w64(sel);
            const int pos = base + (int)__builtin_amdgcn_mbcnt_hi((unsigned)(sm >> 32), __builtin_amdgcn_mbcnt_lo((unsigned)sm, 0u));
            if (sel) lists[16 * k + 3 + pos] = lane + 64 * i;
            base += __builtin_popcountll(sm); } }
    return 16;
}
#define NSA_LD(F_, G_) load8(F_, kb, vb, (G_), lane)
__device__ __forceinline__ void sel_joint(const Tensors& T, Run& rsa, Run& rsb, Frag8& fa, Frag8& fb, const long (&qfa)[2], const long (&qfb)[2], const __attribute__((address_space(3))) int* list,
                                          int njoint, int qblk, int bg, int tqa, int tqb, int n, int q, int lane) {
    const unsigned char* kb = T.K8 + (size_t)bg * 512 * 2048; const unsigned char* vb = T.V8 + (size_t)bg * 512 * 2048;
#define NSA_ST2(F_, G_) do { if (jb == qblk) { flash_step8<true>(rsa, F_, qfa, 0, tqa - 32 * (G_), true, q); flash_step8<true>(rsb, F_, qfb, 0, tqb - 32 * (G_), true, q); } \
                             else { flash_step8<false>(rsa, F_, qfa, 0, 31, true, q); flash_step8<false>(rsb, F_, qfb, 0, 31, true, q); } } while (0)
    int jb = __builtin_amdgcn_readfirstlane(list[0]);
    NSA_LD(fa, 2 * jb);
    for (int e = 0; e < njoint; ++e) {
        NSA_LD(fb, 2 * jb + 1);
        NSA_ST2(fa, 2 * jb);
        int jn = 0;
        if (e + 1 < njoint) { jn = __builtin_amdgcn_readfirstlane(list[e + 1]); NSA_LD(fa, 2 * jn); }
        NSA_ST2(fb, 2 * jb + 1);
        jb = jn; }
#undef NSA_ST2
}
__device__ __forceinline__ void flash_dual8(Run& r, const Frag8& fA, const Frag8& fB, const long (&q8)[2], int tok, int q) {
    float sa[8], sb[8], s[8]; qk8(sa, fA, q8); qk8(sb, fB, q8);
    float gm = NEG;
#pragma unroll
    for (int j = 0; j < 8; ++j) { s[j] = tok ? sb[j] : sa[j]; gm = fmaxf(gm, s[j]); }
    gm = xmax_q(gm);
    const float mn = fmaxf(r.m, gm), sc = __builtin_amdgcn_exp2f(r.m - mn); r.m = mn;
    float p[8], ps = 0.f;
    const float mn8 = mn - 8.0f;
#pragma unroll
    for (int j = 0; j < 8; ++j) { p[j] = __builtin_amdgcn_exp2f(s[j] - mn8); ps += p[j]; }
    r.l = r.l * sc + ps;
    if (__builtin_amdgcn_ballot_w64(sc != 1.0f) != 0ull) {
#pragma unroll
        for (int dt = 0; dt < 4; ++dt) r.o[dt] = r.o[dt] * sc; }
    const unsigned w0 = fp8x4(p[0], p[1], p[2], p[3]), w1 = fp8x4(p[4], p[5], p[6], p[7]);
    const long pa = mk64(tok ? 0u : w0, tok ? 0u : w1), pb = mk64(tok ? w0 : 0u, tok ? w1 : 0u);
    r.o[0] = __builtin_amdgcn_mfma_f32_16x16x32_fp8_fp8(mk64(fA.v[0].x, fA.v[0].y), pa, r.o[0], 0, 0, 0); r.o[1] = __builtin_amdgcn_mfma_f32_16x16x32_fp8_fp8(mk64(fA.v[0].z, fA.v[0].w), pa, r.o[1], 0, 0, 0);
    r.o[2] = __builtin_amdgcn_mfma_f32_16x16x32_fp8_fp8(mk64(fA.v[1].x, fA.v[1].y), pa, r.o[2], 0, 0, 0); r.o[3] = __builtin_amdgcn_mfma_f32_16x16x32_fp8_fp8(mk64(fA.v[1].z, fA.v[1].w), pa, r.o[3], 0, 0, 0);
    r.o[0] = __builtin_amdgcn_mfma_f32_16x16x32_fp8_fp8(mk64(fB.v[0].x, fB.v[0].y), pb, r.o[0], 0, 0, 0); r.o[1] = __builtin_amdgcn_mfma_f32_16x16x32_fp8_fp8(mk64(fB.v[0].z, fB.v[0].w), pb, r.o[1], 0, 0, 0);
    r.o[2] = __builtin_amdgcn_mfma_f32_16x16x32_fp8_fp8(mk64(fB.v[1].x, fB.v[1].y), pb, r.o[2], 0, 0, 0); r.o[3] = __builtin_amdgcn_mfma_f32_16x16x32_fp8_fp8(mk64(fB.v[1].z, fB.v[1].w), pb, r.o[3], 0, 0, 0);
}
__device__ __forceinline__ void sel_solo(const Tensors& T, Run& rs, Frag8& fa, Frag8& fb, const long (&qf)[2], const __attribute__((address_space(3))) int* list0, const __attribute__((address_space(3))) int* list1,
                                         int bg, int tok, int n, int q, int lane) {
    const unsigned char* kb = T.K8 + (size_t)bg * 512 * 2048; const unsigned char* vb = T.V8 + (size_t)bg * 512 * 2048;
    Frag8 fc, fd;
    int ja = __builtin_amdgcn_readfirstlane(list0[3]), jb = __builtin_amdgcn_readfirstlane(list1[3]);
    NSA_LD(fa, 2 * ja); NSA_LD(fb, 2 * jb);
    for (int e = 0; e < 13; ++e) {
        NSA_LD(fc, 2 * ja + 1); NSA_LD(fd, 2 * jb + 1);
        flash_dual8(rs, fa, fb, qf, tok, q);
        int na = 0, nb = 0;
        if (e + 1 < 13) { na = __builtin_amdgcn_readfirstlane(list0[4 + e]); nb = __builtin_amdgcn_readfirstlane(list1[4 + e]); NSA_LD(fa, 2 * na); NSA_LD(fb, 2 * nb); }
        flash_dual8(rs, fc, fd, qf, tok, q);
        ja = na; jb = nb; }
}
#undef NSA_LD
__device__ __forceinline__ void out_pair(const Tensors& T, const __attribute__((address_space(3))) unsigned* st, int lane, const Run& rs, size_t rowt, int g, int head, int q) {
    const float ls = xsum_q(rs.l);
    const bf16_t* gp = T.P + rowt * PITCH + COL_G + g * 24 + head * 3;
    const float gc = 1.0f / (1.0f + __expf(-bf2f(gp[0]))), gs = 1.0f / (1.0f + __expf(-bf2f(gp[1]))), gw = 1.0f / (1.0f + __expf(-bf2f(gp[2])));
    const float fs = gs / fmaxf(ls, 1e-30f);
    const bf16_t* wp = T.OW + rowt * 1024 + (g * 8 + head) * 64 + 4 * q;
    bf16_t* op = T.O + rowt * 1024 + (g * 8 + head) * 64 + 4 * q;
#pragma unroll
    for (int dt = 0; dt < 4; ++dt) { float v[4]; typedef unsigned u32x2w __attribute__((ext_vector_type(2))); const u32x2w wv = *(const u32x2w*)(wp + 16 * dt);
        const float ow[4] = {__uint_as_float(wv.x << 16), __uint_as_float(wv.x & 0xffff0000u), __uint_as_float(wv.y << 16), __uint_as_float(wv.y & 0xffff0000u)};
        const unsigned c0 = st[(4 * dt) * 64 + lane], c1 = st[(4 * dt + 1) * 64 + lane]; const float oc[4] = {__uint_as_float(c0 << 16), __uint_as_float(c0 & 0xffff0000u), __uint_as_float(c1 << 16), __uint_as_float(c1 & 0xffff0000u)};
#pragma unroll
        for (int i = 0; i < 4; ++i) v[i] = gc * oc[i] + fs * rs.o[dt][i] + gw * ow[i];
        u32x2w w; w.x = pk2(v[0], v[1]); w.y = pk2(v[2], v[3]);
        *(u32x2w*)(op + 16 * dt) = w; }
}
__device__ __forceinline__ void quad_item(const Tensors& T, int item, __attribute__((address_space(3))) float* wl, int lane) {
    typedef __attribute__((address_space(3))) float lf; typedef __attribute__((address_space(3))) int li;
    const int n = lane & 15, q = lane >> 4, tok = n >> 3, head = n & 7;
    const int bg = item >> 12, t0 = (item & (S / 4 - 1)) * 4, b = bg >> 1, g = bg & 1;
    const int tqa = t0 + tok, tqb = t0 + 2 + tok;
    const size_t row0 = (size_t)b * S + t0;
    lf* impa = wl + tok * 544; lf* impb = wl + (2 + tok) * 544; li* lists = (li*)(wl + 2176);
    bf16x8 qfa[2], qfb[2];
    { const bf16_t* qp = T.P + (row0 + tok) * PITCH + (g * 8 + head) * 64 + q * 8; qfa[0] = *(const bf16x8*)qp; qfa[1] = *(const bf16x8*)(qp + 32);
      qfb[0] = *(const bf16x8*)(qp + 2 * PITCH); qfb[1] = *(const bf16x8*)(qp + 2 * PITCH + 32); }
    for (int i = lane; i < 2176; i += 64) wl[i] = 0.f;
    Frag8 ga, gb;
    const long qa8[2] = {q_to_fp8(qfa[0]), q_to_fp8(qfa[1])}, qb8[2] = {q_to_fp8(qfb[0]), q_to_fp8(qfb[1])};
    const int nva = tqa >= 31 ? ((tqa - 31) >> 4) + 1 : 0, nvb = tqb >= 31 ? ((tqb - 31) >> 4) + 1 : 0;
    const int nv0 = t0 >= 31 ? ((t0 - 31) >> 4) + 1 : 0, nv3 = (t0 + 3) >= 31 ? ((t0 + 3 - 31) >> 4) + 1 : 0;
    f32x4 oca[4], ocb[4];
#pragma unroll
    for (int dt = 0; dt < 4; ++dt) { oca[dt] = (f32x4){0.f, 0.f, 0.f, 0.f}; ocb[dt] = (f32x4){0.f, 0.f, 0.f, 0.f}; }
    if (nv3 > 0) {
        const unsigned char* kb = T.KC8 + (size_t)bg * 32 * 2048; const unsigned char* vb = T.VC8 + (size_t)bg * 32 * 2048; const int ng = (nv3 + 31) >> 5;
        float mca = NEG, lca = 0.f, mcb = NEG, lcb = 0.f;
#define NSA_P1(F_, G_, QF_, NV_, MC_, LC_) do { float s[8]; qk8(s, F_, QF_); const int hi = (NV_) - 1 - 32 * (G_); float gm = NEG; \
            if (32 * (G_) + 32 > nv0) { _Pragma("unroll") for (int j = 0; j < 8; ++j) { const bool ok = (8 * q + j) <= hi; s[j] = ok ? s[j] : NEG; gm = fmaxf(gm, s[j]); } } \
            else { _Pragma("unroll") for (int j = 0; j < 8; ++j) gm = fmaxf(gm, s[j]); } \
            gm = xmax_q(gm); const float mn = fmaxf(MC_, gm); float ps = 0.f; \
            _Pragma("unroll") for (int j = 0; j < 8; ++j) ps += __builtin_amdgcn_exp2f(s[j] - mn); \
            LC_ = LC_ * __builtin_amdgcn_exp2f(MC_ - mn) + ps; MC_ = mn; } while (0)
        loadk8(ga, kb, 0, lane);
        for (int G = 0; G < ng; G += 2) {
            if (G + 1 < ng) loadk8(gb, kb, G + 1, lane);
            NSA_P1(ga, G, qa8, nva, mca, lca); NSA_P1(ga, G, qb8, nvb, mcb, lcb);
            if (G + 1 < ng) { if (G + 2 < ng) loadk8(ga, kb, G + 2, lane); NSA_P1(gb, G + 1, qa8, nva, mca, lca); NSA_P1(gb, G + 1, qb8, nvb, mcb, lcb); }
        }
#undef NSA_P1
        lca = xsum_q(lca); lcb = xsum_q(lcb);
        asm volatile("s_waitcnt lgkmcnt(0)" ::: "memory");
#define NSA_P2(F_, G_, QF_, NV_, C2_, OC_, IMP_) do { float s[8]; qk8(s, F_, QF_); const int hi = (NV_) - 1 - 32 * (G_); float p[8]; \
            if (32 * (G_) + 32 > nv0) { _Pragma("unroll") for (int j = 0; j < 8; ++j) { const bool ok = (8 * q + j) <= hi; p[j] = ok ? __builtin_amdgcn_exp2f(s[j] - C2_) : 0.f; } } \
            else { _Pragma("unroll") for (int j = 0; j < 8; ++j) p[j] = __builtin_amdgcn_exp2f(s[j] - C2_); } \
            pv8s(OC_, p, F_); \
            const float a0 = sum8((p[0] + p[1]) + (p[2] + p[3])), a1 = sum8((p[4] + p[5]) + (p[6] + p[7])), b0 = sum8(p[3]), b1 = sum8(p[7]);     \
            if (head == 0) { const int j0 = 8 * (G_) + 2 * q; IMP_[j0] = a0; IMP_[j0 + 1] = a1; IMP_[272 + j0 + 1] = b0; IMP_[272 + j0 + 2] = b1; } } while (0)
        const float c2a = mca - 8.0f + __builtin_amdgcn_logf(fmaxf(lca, 1e-30f)), c2b = mcb - 8.0f + __builtin_amdgcn_logf(fmaxf(lcb, 1e-30f));
        load8(ga, kb, vb, 0, lane);
        for (int G = 0; G < ng; G += 2) {
            if (G + 1 < ng) load8(gb, kb, vb, G + 1, lane);
            NSA_P2(ga, G, qa8, nva, c2a, oca, impa); NSA_P2(ga, G, qb8, nvb, c2b, ocb, impb);
            if (G + 1 < ng) { if (G + 2 < ng) load8(ga, kb, vb, G + 2, lane);
                NSA_P2(gb, G + 1, qa8, nva, c2a, oca, impa); NSA_P2(gb, G + 1, qb8, nvb, c2b, ocb, impb); }
        }
#undef NSA_P2
#pragma unroll
        for (int dt = 0; dt < 4; ++dt) { oca[dt] = oca[dt] * (1.0f / 256.0f); ocb[dt] = ocb[dt] * (1.0f / 256.0f); }
    }
    { __attribute__((address_space(3))) unsigned* st = (__attribute__((address_space(3))) unsigned*)(wl + 2240);
#pragma unroll
      for (int dt = 0; dt < 4; ++dt) { st[(4 * dt + 0) * 64 + lane] = pk2(oca[dt][0], oca[dt][1]); st[(4 * dt + 1) * 64 + lane] = pk2(oca[dt][2], oca[dt][3]); st[(4 * dt + 2) * 64 + lane] = pk2(ocb[dt][0], ocb[dt][1]); st[(4 * dt + 3) * 64 + lane] = pk2(ocb[dt][2], ocb[dt][3]); } }
    asm volatile("s_waitcnt lgkmcnt(0)" ::: "memory"); __builtin_amdgcn_wave_barrier();
    const int qblk = t0 >> 6;
    const int nsel = select_blocks4(wl, lists, qblk, lane);
    asm volatile("s_waitcnt lgkmcnt(0)" ::: "memory"); __builtin_amdgcn_wave_barrier();
    { Run rsa, rsb; run_init(rsa); run_init(rsb);
      sel_joint(T, rsa, rsb, ga, gb, qa8, qb8, lists, qblk <= 15 ? nsel : 3, qblk, bg, tqa, tqb, n, q, lane);
      if (qblk > 15) sel_solo(T, rsa, ga, gb, qa8, lists, lists + 16, bg, tok, n, q, lane);
      out_pair(T, (const __attribute__((address_space(3))) unsigned*)(wl + 2240), lane, rsa, row0 + tok, g, head, q);
      if (qblk > 15) sel_solo(T, rsb, ga, gb, qb8, lists + 32, lists + 48, bg, tok, n, q, lane);
      out_pair(T, (const __attribute__((address_space(3))) unsigned*)(wl + 2240) + 128, lane, rsb, row0 + 2 + tok, g, head, q); }
    asm volatile("s_waitcnt lgkmcnt(0)" ::: "memory"); __builtin_amdgcn_wave_barrier();
}
}

constexpr int NWAVES = 8;
#ifndef MK_SINGLE
#define MK_SINGLE 1
#endif
constexpr int kB = 2, kS = 16384, kD = 1024, kM = kB * kS;
constexpr float kEps = 1e-6f;
constexpr float kC2 = 0.125f * 1.4426950408889634f;
constexpr int kMpad = 65536 + 32 * 256;
constexpr size_t MiB = 1u << 20;
constexpr size_t WS_CTL = 0, CTL_ZERO_BYTES = 1 * MiB;
constexpr size_t WS_ADAP = 1 * MiB;
constexpr size_t WS_MOD = 2 * MiB + 512 * 1024;
constexpr size_t WS_CBP = WS_MOD + 128 * 1024;
constexpr size_t WS_CBF = WS_CBP + 64 * 1024;
constexpr size_t WS_ROPE = 3 * MiB;
constexpr size_t WS_ROUTE = 5 * MiB;
constexpr size_t WS_ROWTOK = 6 * MiB;
constexpr size_t WS_ROWWT = 6 * MiB + 512 * 1024;
constexpr size_t WS_DUMP = 7 * MiB;
constexpr size_t WS_WR = 7 * MiB + 64 * 1024;
constexpr size_t WS_WC = 7 * MiB + 896 * 1024;
constexpr size_t WS_WQKV = 8 * MiB, WS_WO0 = 14 * MiB, WS_WNSA = 16 * MiB, WS_WO1 = 20 * MiB, WS_W1C = 22 * MiB, WS_W2C = 24 * MiB;
constexpr size_t WS_MOE0 = 26 * MiB, MOE_L = 48 * MiB, MOE_WD = 32 * MiB;
constexpr size_t WS_RA = 122 * MiB, WS_RB = 186 * MiB, WS_RC = 250 * MiB, WS_RD = 314 * MiB, WS_RE = 378 * MiB, WS_RF = 442 * MiB, WS_END = 506 * MiB;
constexpr size_t NS_KC = WS_RF  , NS_HID = WS_RF + 17 * MiB, NS_KCMP = WS_RF + 21 * MiB, NS_VCT = WS_RF + 21 * MiB + 512 * 1024, NS_VTS = WS_RF + 22 * MiB, NS_VTW = WS_RF + 30 * MiB;
constexpr int CW_BAR = 4096;
constexpr int CW_CNT = 16384;
constexpr int CW_QCTR = 16384 + 1024;
constexpr int RING_OFF = 0, RING_BYTES = 131072, LDSCTL_OFF = RING_BYTES, MISC_OFF = LDSCTL_OFF + 320, TPRE_OFF = LDSCTL_OFF + 1024;
constexpr int GTAB_OFF = LDSCTL_OFF + 2048, GTAB_UNITS = 6;
constexpr int LDS_BYTES = 147456;

#define GAS __attribute__((address_space(1)))
#define LAS __attribute__((address_space(3)))
typedef unsigned short bf16;
typedef unsigned v4u __attribute__((ext_vector_type(4)));
typedef unsigned v2u __attribute__((ext_vector_type(2)));
typedef float f32x4 __attribute__((ext_vector_type(4)));
typedef GAS unsigned gu32;
#define RLX_AGENT __ATOMIC_RELAXED, __HIP_MEMORY_SCOPE_AGENT
#define LDS_WAIT() asm volatile("s_waitcnt lgkmcnt(0)" ::: "memory")
__device__ __forceinline__ unsigned pk2(float lo, float hi) { return nsa::pk2(lo, hi); }
__device__ __forceinline__ float bf2f(unsigned short x) { return __uint_as_float((unsigned)x << 16); }
__device__ __forceinline__ float wave_sum(float v) {
#pragma unroll
    for (int o = 1; o < 64; o <<= 1) v += __shfl_xor(v, o);
    return v;
}

#define XB_TMO      128
#define XB_XCNT(j)  (256  + 64 * (j))
#define XB_XSUB(j)  (1280 + 64 * (j))
#define XB_XGEN(j)  (2304 + 64 * (j))
#define XB_TOP      3328
#define XB_TOPGEN   3392
#define XCD_BAR_WORDS 3456
#define XB_SPIN_CAP (1u << 18)

__device__ __forceinline__ unsigned xb_ld(unsigned* p)              { return __hip_atomic_load(p, __ATOMIC_RELAXED, __HIP_MEMORY_SCOPE_AGENT); }
__device__ __forceinline__ unsigned xb_add(unsigned* p, unsigned v) { return __hip_atomic_fetch_add(p, v, __ATOMIC_RELAXED, __HIP_MEMORY_SCOPE_AGENT); }
__device__ __forceinline__ unsigned xb_xcc_id() { return (unsigned)__builtin_amdgcn_s_getreg((3 << 11) | 20) & 0xFu; }
#define XB_SPIN(cond, bar) do { unsigned _sp = 0; while (cond) { __builtin_amdgcn_s_sleep(1); \
    if ((++_sp & 255u) == 0u) { if (xb_ld(&(bar)[XB_TMO])) break; if (_sp > XB_SPIN_CAP) { atomicAdd(&(bar)[XB_TMO], 1u); break; } } } } while (0)

struct XcdBarrier {
    unsigned* bar; unsigned x;
    volatile LAS unsigned* st;
};

__device__ __forceinline__ XcdBarrier xcd_barrier_post(unsigned* bar, volatile LAS unsigned* st) {
    XcdBarrier b; b.bar = bar; b.x = xb_xcc_id(); b.st = st;
    if (threadIdx.x == 0) (void)xb_add(&bar[XB_XCNT(b.x)], 1u);
    return b;
}
__device__ __forceinline__ void xcd_barrier_complete(unsigned* bar, unsigned x, unsigned& nloc, unsigned& nx) {
    const unsigned G = gridDim.x * gridDim.y * gridDim.z;
    unsigned sum, cnt, mine, sp = 0u;
    for (;;) {
        sum = 0u; cnt = 0u; mine = 0u;
#pragma unroll
        for (unsigned j = 0; j < 16; ++j) { const unsigned c = xb_ld(&bar[XB_XCNT(j)]); sum += c; cnt += (c > 0u) ? 1u : 0u; mine = (j == x) ? c : mine; }
        if (sum == G) break;
        __builtin_amdgcn_s_sleep(1);
        if ((++sp & 255u) == 0u) { if (xb_ld(&bar[XB_TMO])) break; if (sp > XB_SPIN_CAP) { atomicAdd(&bar[XB_TMO], 1u); break; } }
    }
    nloc = mine > 0u ? mine : 1u; nx = cnt > 0u ? cnt : 1u;
}

__device__ __forceinline__ void xcd_barrier(const XcdBarrier& b) {
    asm volatile("s_waitcnt vmcnt(0)" ::: "memory");
    __syncthreads();
    if (threadIdx.x == 0) {
        unsigned* bar = b.bar;
        __builtin_amdgcn_s_waitcnt(0);
        unsigned nloc = b.st[0], nx = b.st[1];
        if (nloc == 0u) { xcd_barrier_complete(bar, b.x, nloc, nx); b.st[0] = nloc; b.st[1] = nx; }
        const unsigned old = xb_add(&bar[XB_XSUB(b.x)], 1u);
        const unsigned gen = old / nloc;
        if (old + 1u == (gen + 1u) * nloc) {
            __builtin_amdgcn_fence(__ATOMIC_RELEASE, "agent");
            asm volatile("s_waitcnt vmcnt(0)" ::: "memory");
            const unsigned og = xb_add(&bar[XB_TOP], 1u);
            const unsigned tg = og / nx;
            if (og + 1u == (tg + 1u) * nx) xb_add(&bar[XB_TOPGEN], 1u);
            else XB_SPIN(xb_ld(&bar[XB_TOPGEN]) == tg, bar);
            __builtin_amdgcn_fence(__ATOMIC_ACQUIRE, "agent");
            xb_add(&bar[XB_XGEN(b.x)], 1u);
            asm volatile("s_waitcnt vmcnt(0)" ::: "memory");
        } else {
            XB_SPIN(xb_ld(&bar[XB_XGEN(b.x)]) == gen, bar);
            __builtin_amdgcn_fence(__ATOMIC_ACQUIRE, "agent");
            asm volatile("s_waitcnt vmcnt(0)" ::: "memory");
        }
    }
    __syncthreads();
}


__device__ __forceinline__ void transpose_item(const float* W, int K, int N, bf16* WT, int drow0, int kb, int nb, LAS float* scr, int lane) {
    const int k0 = 64 * kb, n0 = 32 * nb; const int nn = n0 + (lane & 7) * 4; const bool okn = nn < N;
#pragma unroll
    for (int i = 0; i < 8; ++i) { const int kk = 8 * i + (lane >> 3); const f32x4 v = okn ? *(const f32x4*)(W + (size_t)(k0 + kk) * N + nn) : (f32x4){0.f, 0.f, 0.f, 0.f};
        LAS float* d = scr + kk * 33 + (lane & 7) * 4; d[0] = v[0]; d[1] = v[1]; d[2] = v[2]; d[3] = v[3]; }
    LDS_WAIT(); asm volatile("" ::: "memory");
    const int c = lane & 7;
#pragma unroll
    for (int j = 0; j < 4; ++j) { const int n = (lane >> 3) + 8 * j; const LAS float* s = scr + (8 * c) * 33 + n;
        v4u o; o.x = pk2(s[0 * 33], s[1 * 33]); o.y = pk2(s[2 * 33], s[3 * 33]); o.z = pk2(s[4 * 33], s[5 * 33]); o.w = pk2(s[6 * 33], s[7 * 33]);
        *(v4u*)(WT + (size_t)(drow0 + n) * K + k0 + 8 * c) = o; }
    LDS_WAIT(); asm volatile("" ::: "memory");
}
__device__ __forceinline__ void sincos_acc(float ang, float& sn, float& cs) {
    const double a = (double)ang; const double kq = rint(a * 0.63661977236758134308);
    const double r = fma(-kq, 1.57079632679489661923, a) - kq * 6.123233995736766e-17;
    const int qd = (int)((long long)kq & 3);
    const float x = (float)r, x2 = x * x;
    const float sp = x * (1.0f + x2 * (-1.6666667e-1f + x2 * (8.3333338e-3f + x2 * (-1.9841270e-4f + x2 * 2.7557319e-6f))));
    const float cp = 1.0f + x2 * (-0.5f + x2 * (4.1666668e-2f + x2 * (-1.3888889e-3f + x2 * (2.4801587e-5f + x2 * -2.7557319e-7f))));
    const float s1 = (qd & 1) ? cp : sp, c1 = (qd & 1) ? sp : cp;
    sn = (qd & 2) ? -s1 : s1; cs = ((qd + 1) & 2) ? -c1 : c1;
}

struct Ptrs {
    const float* x; const float* c; const int* pos; const float* ada_w; const float* ada_b; const float* norm_g; const float* final_g;
    const float* diff_w_in; const float* diff_w_out; const float* diff_lambda; const float* diff_subln_g;
    const float* nsa_w_in; const float* nsa_w_out; const float* nsa_cmp_pos; const float* nsa_cmp_w1; const float* nsa_cmp_b1; const float* nsa_cmp_w2;
    const float* moe_w_group; const float* moe_b_group; const float* moe_w_expert; const float* moe_b_expert; const float* moe_w_gate; const float* moe_w_up; const float* moe_w_down;
    float* out; unsigned char* ws;
};

__device__ __forceinline__ void ph_prologue(const Ptrs& p, LAS unsigned char* lds, int gw, int NGW, int wave, int lane, int gtid, int NT) {
    LAS float* scr = (LAS float*)(lds + RING_OFF + wave * 16384);
    unsigned char* ws = p.ws;
    constexpr int I_QKV = 16 * 96, I_WO = 16 * 32, I_NSA = 16 * 64, I_W1C = 32 * 8, I_W2C = 4 * 8, I_EXP = 128;
    constexpr int T0 = I_QKV, T1 = T0 + I_WO, T2 = T1 + I_NSA, T3 = T2 + I_WO, T4 = T3 + 2 * I_W1C, T5 = T4 + 2 * I_W2C, T6 = T5 + 64 * 3 * I_EXP;
    struct TrDesc { const float* W; bf16* WT; int K, N, drow0, kb, nb; float sc = 1.0f; };
    auto decode = [&](int it, TrDesc& d) {
        if (it < T0) { const int r = it; d = TrDesc{p.diff_w_in, (bf16*)(ws + WS_WQKV), 1024, 3072, 32 * (r % 96), r / 96, r % 96, (r % 96) < 32 ? kC2 : 1.0f}; }
        else if (it < T1) { const int r = it - T0; d = TrDesc{p.diff_w_out, (bf16*)(ws + WS_WO0), 1024, 1024, 32 * (r % 32), r / 32, r % 32}; }
        else if (it < T2) { const int r = it - T1; d = TrDesc{p.nsa_w_in, (bf16*)(ws + WS_WNSA), 1024, 1840, 32 * (r % 64), r / 64, r % 64, (r % 64) < 32 ? kC2 : 1.0f}; }
        else if (it < T3) { const int r = it - T2; d = TrDesc{p.nsa_w_out, (bf16*)(ws + WS_WO1), 1024, 1024, 32 * (r % 32), r / 32, r % 32}; }
        else if (it < T4) { const int r = it - T3, kv = r / I_W1C, rr = r % I_W1C; d = TrDesc{p.nsa_cmp_w1 + (size_t)kv * 2048 * 256, (bf16*)(ws + WS_W1C) + (size_t)kv * 256 * 2048, 2048, 256, 32 * (rr % 8), rr / 8, rr % 8}; }
        else if (it < T5) { const int r = it - T4, kv = r / I_W2C, rr = r % I_W2C; d = TrDesc{p.nsa_cmp_w2 + (size_t)kv * 256 * 64, (bf16*)(ws + WS_W2C) + (size_t)kv * 256 * 256, 256, 64, 32 * (rr % 8), rr / 8, rr % 8}; }
        else { const int r = it - T5, le = r / (3 * I_EXP), rr = r % (3 * I_EXP), which = rr / I_EXP, ri = rr % I_EXP; const int l = le >> 5, e = le & 31;
            unsigned char* mb = ws + WS_MOE0 + (size_t)l * MOE_L;
            if (which < 2) { const int kb = ri / 8, nb = ri % 8, n0 = 32 * nb;
                d = TrDesc{(which ? p.moe_w_up : p.moe_w_gate) + (size_t)le * 1024 * 256, (bf16*)mb + (size_t)e * 512 * 1024, 1024, 256, (n0 >> 7) * 256 + which * 128 + (n0 & 127), kb, nb}; }
            else { d = TrDesc{p.moe_w_down + (size_t)le * 256 * 1024, (bf16*)(mb + MOE_WD) + (size_t)e * 1024 * 256, 256, 1024, 32 * (ri % 32), ri / 32, ri % 32}; } }
    };
    auto tr_load = [&](const TrDesc& d, f32x4 (&v)[8]) {
        const int k0 = 64 * d.kb, nn = 32 * d.nb + (lane & 7) * 4; const bool okn = nn < d.N;
#pragma unroll
        for (int i = 0; i < 8; ++i) { const int kk = 8 * i + (lane >> 3); v[i] = okn ? *(const f32x4*)(d.W + (size_t)(k0 + kk) * d.N + nn) * d.sc : (f32x4){0.f, 0.f, 0.f, 0.f}; }
    };
    auto tr_finish = [&](const TrDesc& d, const f32x4 (&v)[8]) {
#pragma unroll
        for (int i = 0; i < 8; ++i) { const int kk = 8 * i + (lane >> 3); LAS float* q = scr + kk * 33 + (lane & 7) * 4; q[0] = v[i][0]; q[1] = v[i][1]; q[2] = v[i][2]; q[3] = v[i][3]; }
        LDS_WAIT(); asm volatile("" ::: "memory");
        const int c = lane & 7, k0 = 64 * d.kb;
#pragma unroll
        for (int j = 0; j < 4; ++j) { const int n = (lane >> 3) + 8 * j; const LAS float* s_ = scr + (8 * c) * 33 + n;
            v4u o; o.x = pk2(s_[0 * 33], s_[1 * 33]); o.y = pk2(s_[2 * 33], s_[3 * 33]); o.z = pk2(s_[4 * 33], s_[5 * 33]); o.w = pk2(s_[6 * 33], s_[7 * 33]);
            *(v4u*)(d.WT + (size_t)(d.drow0 + n) * d.K + k0 + 8 * c) = o; }
        LDS_WAIT(); asm volatile("" ::: "memory");
    };
    if (gw < T6) { TrDesc dc; f32x4 vc[8]; decode(gw, dc); tr_load(dc, vc);
        for (int it = gw; it < T6; it += NGW) { TrDesc dn = dc; f32x4 vn[8];
            const bool more = it + NGW < T6;
            if (more) { decode(it + NGW, dn); tr_load(dn, vn); }
            tr_finish(dc, vc);
            if (more) { dc = dn;
#pragma unroll
                for (int i = 0; i < 8; ++i) vc[i] = vn[i]; } } }
    for (int it = gw; it < 2 * 16 * 24; it += NGW) { const int l = it / 384, kc = (it % 384) / 24, cg = it % 24;
        const float* W = p.ada_w + ((size_t)l * 1024 + kc * 64) * 6144 + cg * 256 + lane * 4;
        f32x4 a0 = {0.f, 0.f, 0.f, 0.f}, a1 = {0.f, 0.f, 0.f, 0.f};
#pragma unroll 8
        for (int r = 0; r < 64; ++r) { const f32x4 w = *(const f32x4*)(W + (size_t)r * 6144); const float c0 = p.c[kc * 64 + r], c1 = p.c[1024 + kc * 64 + r];
            const float s0 = c0 / (1.0f + __expf(-c0)), s1 = c1 / (1.0f + __expf(-c1)); a0 = a0 + w * s0; a1 = a1 + w * s1; }
        float* dst = (float*)(ws + WS_ADAP) + ((size_t)(l * 16 + kc) * 2) * 6144 + cg * 256 + lane * 4;
        *(f32x4*)dst = a0; *(f32x4*)(dst + 6144) = a1; }
    for (int i = gtid; i < kM * 8; i += NT) { const int m = i >> 3, j = i & 7;
        const float invf = exp2f(-(float)j * 0.125f * 18.931568569324174f);
        const float ang = (float)p.pos[m] * invf; float sn, cs; sincos_acc(ang, sn, cs);
        float* rp = (float*)(ws + WS_ROPE) + (size_t)m * 16; rp[j] = cs; rp[8 + j] = sn; }
    for (int it = gw; it < 2 * 4 * 32; it += NGW) { const int kv = it >> 7, cg = (it >> 5) & 3, kc = it & 31;
        const float* W = p.nsa_cmp_w1 + ((size_t)kv * 2048 + kc * 64) * 256 + cg * 64 + lane; const float* pe = p.nsa_cmp_pos + kv * 2048 + kc * 64; float a = 0.f;
#pragma unroll 8
        for (int r = 0; r < 64; ++r) a += pe[r] * W[(size_t)r * 256];
        ((float*)(ws + WS_CBP))[kc * 512 + kv * 256 + cg * 64 + lane] = a; }
}
__device__ __forceinline__ void ph_finalize(const Ptrs& p, int gtid, int NT) {
    unsigned char* ws = p.ws;
    for (int i = gtid; i < 2 * 2 * 6144 + 512; i += NT) {
        if (i < 24576) { const int l = i / 12288, b = (i / 6144) & 1, n = i % 6144; float a = p.ada_b[l * 6144 + n];
            const float* pp = (const float*)(ws + WS_ADAP) + ((size_t)(l * 16) * 2 + b) * 6144 + n;
            for (int kc = 0; kc < 16; ++kc) a += pp[(size_t)kc * 2 * 6144];
            ((float*)(ws + WS_MOD))[i] = a; }
        else { const int j = i - 24576; float a = p.nsa_cmp_b1[j]; const float* pp = (const float*)(ws + WS_CBP) + j;
            for (int kc = 0; kc < 32; ++kc) a += pp[kc * 512];
            ((float*)(ws + WS_CBF))[j] = a; }
    }
}
template <bool COMBINE, bool FINAL, bool XBF  >
__device__ __forceinline__ void ph_rows(const Ptrs& p, const float* xin, float* xout, const bf16* Y, const float* modl  , int ch_sh, int ch_g2,
                                        const float* ng, bf16* XN, int layer, int gw, int NGW, int lane, int gtid, int NT) {
    unsigned char* ws = p.ws;
    f32x4 gv[4];
#pragma unroll
    for (int j = 0; j < 4; ++j) gv[j] = *(const f32x4*)(ng + 4 * lane + 256 * j);
    for (int m = gw; m < kM; m += NGW) {
        const int b = m >= kS ? 1 : 0; const float* mb = modl + b * 6144;
        f32x4 v[4];
#pragma unroll
        for (int j = 0; j < 4; ++j) { if (XBF) { const v2u xb = *(const v2u*)((const bf16*)xin + (size_t)m * 1024 + 4 * lane + 256 * j);
                v[j][0] = __uint_as_float(xb.x << 16); v[j][1] = __uint_as_float(xb.x & 0xffff0000u); v[j][2] = __uint_as_float(xb.y << 16); v[j][3] = __uint_as_float(xb.y & 0xffff0000u); }
            else v[j] = *(const f32x4*)(xin + (size_t)m * 1024 + 4 * lane + 256 * j); }
        if (COMBINE) {
#pragma unroll
            for (int j = 0; j < 4; ++j) { const int col = 4 * lane + 256 * j; const f32x4 g2 = *(const f32x4*)(mb + ch_g2 * 1024 + col);
                const v2u y0 = *(const v2u*)(Y + (size_t)m * 1024 + col), y1 = *(const v2u*)(Y + ((size_t)kM + m) * 1024 + col);
                f32x4 ys; ys[0] = __uint_as_float(y0.x << 16) + __uint_as_float(y1.x << 16); ys[1] = __uint_as_float(y0.x & 0xffff0000u) + __uint_as_float(y1.x & 0xffff0000u);
                ys[2] = __uint_as_float(y0.y << 16) + __uint_as_float(y1.y << 16); ys[3] = __uint_as_float(y0.y & 0xffff0000u) + __uint_as_float(y1.y & 0xffff0000u);
                v[j] = v[j] + g2 * ys;
                if (!FINAL) { if (XBF) { v2u xo; xo.x = pk2(v[j][0], v[j][1]); xo.y = pk2(v[j][2], v[j][3]); *(v2u*)((bf16*)xout + (size_t)m * 1024 + col) = xo; } else *(f32x4*)(xout + (size_t)m * 1024 + col) = v[j]; } }
        }
        float ss = 0.f;
#pragma unroll
        for (int j = 0; j < 4; ++j) ss += (v[j][0] * v[j][0] + v[j][1] * v[j][1]) + (v[j][2] * v[j][2] + v[j][3] * v[j][3]);
        const float rs = 1.0f / sqrtf(wave_sum(ss) * (1.0f / 1024.0f) + kEps);
        if (FINAL) {
#pragma unroll
            for (int j = 0; j < 4; ++j) *(f32x4*)(xout + (size_t)m * 1024 + 4 * lane + 256 * j) = v[j] * rs * gv[j];
        } else {
            f32x4 h[4];
#pragma unroll
            for (int j = 0; j < 4; ++j) { const int col = 4 * lane + 256 * j; const f32x4 sh = *(const f32x4*)(mb + ch_sh * 1024 + col), sc = *(const f32x4*)(mb + (ch_sh + 1) * 1024 + col);
                h[j] = (v[j] * rs * gv[j]) * (sc + 1.0f) + sh;
                v2u o; o.x = pk2(h[j][0], h[j][1]); o.y = pk2(h[j][2], h[j][3]); *(v2u*)(XN + (size_t)m * 1024 + col) = o; }
        }
    }
}
__device__ __forceinline__ float router_w(const Ptrs& p, int l, int k, int o) { return o < 4 ? p.moe_w_group[((size_t)l * 1024 + k) * 4 + o] : p.moe_w_expert[(((size_t)l * 4 + ((o - 4) >> 3)) * 1024 + k) * 8 + ((o - 4) & 7)]; }
__device__ __forceinline__ void ph_router_prep(const Ptrs& p, const float* MOD, int gw, int NGW, int lane, int gtid, int NT) {
    bf16* WTH = (bf16*)(p.ws + WS_WR); bf16* WTL = WTH + 4 * 48 * 1024; float* WC = (float*)(p.ws + WS_WC);
    for (int i = gtid; i < 4 * 48 * 1024; i += NT) { const int lb = i / 49152, r = i % 49152, n = r >> 10, k = r & 1023, l = lb >> 1;
        const float* mb = MOD + lb * 6144; const float w = n < 36 ? p.norm_g[(l * 2 + 1) * 1024 + k] * (1.0f + mb[4 * 1024 + k]) * router_w(p, l, k, n) : 0.f;
        const unsigned h = pk2(w, 0.f) & 0xffffu; const float wl = w - __uint_as_float(h << 16);
        WTH[i] = (bf16)h; WTL[i] = (bf16)(pk2(wl, 0.f) & 0xffffu); }
    for (int it = gw; it < 4 * 36; it += NGW) { const int lb = it / 36, o = it % 36, l = lb >> 1; const float* mb = MOD + lb * 6144; float a = 0.f;
        for (int j = 0; j < 16; ++j) { const int k = lane + 64 * j; a += mb[3 * 1024 + k] * router_w(p, l, k, o); }
        a = wave_sum(a);
        if (lane == 0) WC[lb * 48 + o] = a + (o < 4 ? p.moe_b_group[l * 4 + o] : p.moe_b_expert[l * 32 + (o - 4)]); }
}
__device__ __forceinline__ void ph_router(const Ptrs& p, const float* X, int layer, LAS unsigned char* lds, int vcu, int G, int wave, int lane, int gtid, int NT, bool dummy) {
    typedef short bf16x8r __attribute__((ext_vector_type(8)));
    unsigned char* ws = p.ws;
    const int n = lane & 15, q = lane >> 4;
    LAS unsigned* lcnt = (LAS unsigned*)(lds + RING_OFF);
    for (int it0 = vcu * NWAVES; it0 < kM / 16; it0 += G * NWAVES) { const bool valid = it0 + wave < kM / 16; const int it = valid ? it0 + wave : 0;
        if (wave == 0) lcnt[lane] = 0u;
        __syncthreads();
        const int m = it * 16 + n; const int lb = layer * 2 + ((it * 16) >= kS ? 1 : 0);
        const bf16* wth = (const bf16*)(ws + WS_WR) + ((size_t)lb * 48 + n) * 1024 + 8 * q; const bf16* wtl = wth + 4 * 48 * 1024;
        const bf16* xr = (const bf16*)X + (size_t)m * 1024 + 8 * q;
        f32x4 acc[3]; float ssq = 0.f;
#pragma unroll
        for (int t = 0; t < 3; ++t) acc[t] = (f32x4){0.f, 0.f, 0.f, 0.f};
#pragma unroll 2
        for (int i = 0; i < 32; ++i) {
            const v4u hw = *(const v4u*)(xr + 32 * i);
            { const float a0 = __uint_as_float(hw.x << 16), a1 = __uint_as_float(hw.x & 0xffff0000u), a2 = __uint_as_float(hw.y << 16), a3 = __uint_as_float(hw.y & 0xffff0000u),
                          a4 = __uint_as_float(hw.z << 16), a5 = __uint_as_float(hw.z & 0xffff0000u), a6 = __uint_as_float(hw.w << 16), a7 = __uint_as_float(hw.w & 0xffff0000u);
              ssq += ((a0 * a0 + a1 * a1) + (a2 * a2 + a3 * a3)) + ((a4 * a4 + a5 * a5) + (a6 * a6 + a7 * a7)); }
            const bf16x8r xh = __builtin_bit_cast(bf16x8r, hw);
#pragma unroll
            for (int t = 0; t < 3; ++t) { const bf16x8r wh = *(const bf16x8r*)(wth + (size_t)t * 16 * 1024 + 32 * i), wl = *(const bf16x8r*)(wtl + (size_t)t * 16 * 1024 + 32 * i);
                acc[t] = __builtin_amdgcn_mfma_f32_16x16x32_bf16(wh, xh, acc[t], 0, 0, 0); acc[t] = __builtin_amdgcn_mfma_f32_16x16x32_bf16(wl, xh, acc[t], 0, 0, 0); }
        }
        ssq = nsa::xsum_q(ssq);
        const float rs = 1.0f / sqrtf(ssq * (1.0f / 1024.0f) + kEps);
        const float* wc = (const float*)(ws + WS_WC) + lb * 48;
        float t[48];
#pragma unroll
        for (int tt = 0; tt < 3; ++tt)
#pragma unroll
            for (int r = 0; r < 4; ++r) { const float v = acc[tt][r] * rs + wc[16 * tt + 4 * q + r];
                auto a = __builtin_amdgcn_permlane16_swap(__float_as_uint(v), __float_as_uint(v), false, false);
                auto e = __builtin_amdgcn_permlane32_swap(a[0], a[0], false, false); auto o = __builtin_amdgcn_permlane32_swap(a[1], a[1], false, false);
                t[16 * tt + r] = __uint_as_float(e[0]); t[16 * tt + 4 + r] = __uint_as_float(o[0]); t[16 * tt + 8 + r] = __uint_as_float(e[1]); t[16 * tt + 12 + r] = __uint_as_float(o[1]); }
        int ea = 0, eb = 0, s0 = 0, s1 = 0; float w0 = 0.f, w1 = 0.f;
        if (q == 0 && valid) {
            int grp = 0; float lmax = t[0];
#pragma unroll
            for (int i = 1; i < 4; ++i) if (t[i] > lmax) { lmax = t[i]; grp = i; }
            float den = 0.f;
#pragma unroll
            for (int i = 0; i < 4; ++i) den += __expf(t[i] - lmax);
            const float ptop = 1.0f / den;
            float le[8];
#pragma unroll
            for (int e = 0; e < 8; ++e) le[e] = grp == 0 ? t[4 + e] : grp == 1 ? t[12 + e] : grp == 2 ? t[20 + e] : t[28 + e];
            int i0 = 0; float v0 = le[0];
#pragma unroll
            for (int i = 1; i < 8; ++i) if (le[i] > v0) { v0 = le[i]; i0 = i; }
            int i1 = -1; float v1 = -3.0e38f;
#pragma unroll
            for (int i = 0; i < 8; ++i) if (i != i0 && le[i] > v1) { v1 = le[i]; i1 = i; }
            const float ex = __expf(v1 - v0); w0 = ptop / (1.0f + ex); w1 = ptop * ex / (1.0f + ex);
            ea = grp * 8 + i0; eb = grp * 8 + i1;
            s0 = (int)__hip_atomic_fetch_add(lcnt + ea, 1u, __ATOMIC_RELAXED, __HIP_MEMORY_SCOPE_WORKGROUP); s1 = (int)__hip_atomic_fetch_add(lcnt + eb, 1u, __ATOMIC_RELAXED, __HIP_MEMORY_SCOPE_WORKGROUP);
        }
        __syncthreads();
        if (wave == 0 && lane < 32) { const unsigned c = lcnt[lane]; unsigned* cnt = (unsigned*)(ws + WS_CTL) + CW_CNT + layer * 32 + (dummy ? 64 : 0);
            lcnt[32 + lane] = c ? __hip_atomic_fetch_add(cnt + lane, c, RLX_AGENT) : 0u; }
        __syncthreads();
        if (q == 0 && valid) { s0 += (int)lcnt[32 + ea]; s1 += (int)lcnt[32 + eb];
            int* RT = (int*)(ws + (dummy ? WS_RE : WS_RC)); float* RW = (float*)(RT + 32 * 32768);
            RT[ea * 32768 + s0] = m * 2; RW[ea * 32768 + s0] = w0; RT[eb * 32768 + s1] = m * 2 + 1; RW[eb * 32768 + s1] = w1; }
        __syncthreads();
    }
}
__device__ __forceinline__ void ph_diffcombine(const Ptrs& p, const bf16* O0, const bf16* O1, bf16* AO, int gw, int NGW, int lane) {
    const float* lam = p.diff_lambda;
    const float s1 = wave_sum(lam[lane] * lam[64 + lane]), s2 = wave_sum(lam[128 + lane] * lam[192 + lane]);
    const float lam_full = __expf(s1) - __expf(s2) + 0.2f;
    float sg[8];
#pragma unroll
    for (int i = 0; i < 8; ++i) sg[i] = p.diff_subln_g[(8 * lane + i) & 127] * 0.8f;
    for (int m = gw; m < kM; m += NGW) {
#pragma unroll
        for (int j = 0; j < 2; ++j) { const size_t off = (size_t)m * 1024 + 512 * j + 8 * lane;
            const v4u a = *(const v4u*)(O0 + off), c = *(const v4u*)(O1 + off); float v[8];
#pragma unroll
            for (int i = 0; i < 4; ++i) { v[2 * i] = __uint_as_float(a[i] << 16) - lam_full * __uint_as_float(c[i] << 16); v[2 * i + 1] = __uint_as_float(a[i] & 0xffff0000u) - lam_full * __uint_as_float(c[i] & 0xffff0000u); }
            float ss = 0.f;
#pragma unroll
            for (int i = 0; i < 8; ++i) ss += v[i] * v[i];
            ss += __shfl_xor(ss, 1); ss += __shfl_xor(ss, 2); ss += __shfl_xor(ss, 4); ss += __shfl_xor(ss, 8);
            const float rs = 1.0f / sqrtf(ss * (1.0f / 128.0f) + kEps);
            v4u o; o.x = pk2(v[0] * rs * sg[0], v[1] * rs * sg[1]); o.y = pk2(v[2] * rs * sg[2], v[3] * rs * sg[3]); o.z = pk2(v[4] * rs * sg[4], v[5] * rs * sg[5]); o.w = pk2(v[6] * rs * sg[6], v[7] * rs * sg[7]);
            *(v4u*)(AO + off) = o; }
    }
}
__device__ __forceinline__ void moe_tpre(const Ptrs& p, int layer, LAS int* tpre, int tid) {
    if (tid == 0) { const unsigned* cnt = (const unsigned*)(p.ws + WS_CTL) + CW_CNT + layer * 32; int acc = 0;
        int nb = 0, ns = 0;
        for (int e = 0; e < 32; ++e) { const unsigned c_ = __hip_atomic_load(cnt + e, RLX_AGENT); tpre[e] = acc; tpre[40 + e] = (int)c_; const int nt = (int)((c_ + 255u) >> 8); acc += nt;
            const int small = (c_ != 0u && ((c_ - 1u) & 255u) < 128u) ? 1 : 0;
            tpre[80 + e] = nb; nb += nt - small; if (small) tpre[120 + ns++] = e; }
        tpre[32] = acc; tpre[112] = nb; tpre[152] = ns; }
    __syncthreads();
}
__device__ __forceinline__ void ph_gather(const Ptrs& p, const bf16* XN, bf16* Xg, const LAS int* tpre, int gw, int NGW, int lane) {
    unsigned char* ws = p.ws; int* rowtok = (int*)(ws + WS_ROWTOK); float* rowwt = (float*)(ws + WS_ROWWT);
    for (int it = gw; it < 2 * kM; it += NGW) { const int m = it >> 1, k = it & 1; const int* ro = (const int*)(ws + WS_ROUTE) + (size_t)m * 6;
        const int e = ro[k], slot = ro[2 + k]; const float w = ((const float*)ro)[4 + k]; const int row = tpre[e & 31] * 256 + slot;
        const v4u* src = (const v4u*)(XN + (size_t)m * 1024); v4u* dst = (v4u*)(Xg + (size_t)row * 1024);
        dst[lane] = src[lane]; dst[64 + lane] = src[64 + lane];
        if (lane == 0) { rowtok[row] = it; rowwt[row] = w; } }
}
__device__ __forceinline__ void ph_vtrans(const Ptrs& p, const bf16* P, bf16* VTS, bf16* KTS, LAS unsigned char* lds, int gw, int NGW, int wave, int lane) {
    LAS bf16* scr = (LAS bf16*)(lds + RING_OFF + wave * 16384);
    unsigned char* V8 = (unsigned char*)VTS; unsigned char* K8 = (unsigned char*)KTS;
    const int n = lane & 15, q = lane >> 4;
    for (int it = gw; it < 4 * 512; it += NGW) { const int bg = (it >> 9) & 3, G = it & 511, b = bg >> 1, g = bg & 1;
        const bf16* src = P + ((size_t)b * kS + 32 * G) * 2048 + nsa::COL_VS + g * 64;
        { const int kk = lane >> 1, hf = lane & 1; const v4u* sp = (const v4u*)(src + (size_t)kk * 2048 + hf * 32);
#pragma unroll
          for (int c = 0; c < 4; ++c) { const v4u v = sp[c]; LAS unsigned* d = (LAS unsigned*)(scr + kk * 66 + hf * 32 + c * 8); d[0] = v.x; d[1] = v.y; d[2] = v.z; d[3] = v.w; } }
        LDS_WAIT(); asm volatile("" ::: "memory");
#pragma unroll
        for (int h = 0; h < 2; ++h) { unsigned w[4];
#pragma unroll
            for (int e = 0; e < 2; ++e) { const int d = 16 * (2 * h + e) + n; float x[8];
#pragma unroll
                for (int j = 0; j < 8; ++j) x[j] = bf2f(scr[(8 * q + j) * 66 + d]);
                w[2 * e] = nsa::fp8x4(x[0], x[1], x[2], x[3]); w[2 * e + 1] = nsa::fp8x4(x[4], x[5], x[6], x[7]); }
            v4u o; o.x = w[0]; o.y = w[1]; o.z = w[2]; o.w = w[3]; *(v4u*)(V8 + ((size_t)(bg * 512 + G) * 2 + h) * 1024 + lane * 16) = o; }
        LDS_WAIT(); asm volatile("" ::: "memory");
        { const bf16* ks = P + ((size_t)b * kS + 32 * G) * 2048 + nsa::COL_KS + g * 64;
          { const int kk = lane >> 1, hf = lane & 1; const v4u* sp = (const v4u*)(ks + (size_t)kk * 2048 + hf * 32);
#pragma unroll
            for (int c = 0; c < 4; ++c) { const v4u v = sp[c]; LAS unsigned* d = (LAS unsigned*)(scr + kk * 66 + hf * 32 + c * 8); d[0] = v.x; d[1] = v.y; d[2] = v.z; d[3] = v.w; } }
          LDS_WAIT(); asm volatile("" ::: "memory");
#pragma unroll
          for (int T = 0; T < 2; ++T) { const int key = 8 * (n >> 2) + 4 * T + (n & 3); unsigned w[4];
#pragma unroll
              for (int dh = 0; dh < 2; ++dh) { float x[8];
#pragma unroll
                  for (int j = 0; j < 8; ++j) x[j] = bf2f(scr[key * 66 + 32 * dh + 8 * q + j]);
                  w[2 * dh] = nsa::fp8x4(x[0], x[1], x[2], x[3]); w[2 * dh + 1] = nsa::fp8x4(x[4], x[5], x[6], x[7]); }
              v4u o; o.x = w[0]; o.y = w[1]; o.z = w[2]; o.w = w[3]; *(v4u*)(K8 + ((size_t)(bg * 512 + G) * 2 + T) * 1024 + lane * 16) = o; }
          LDS_WAIT(); asm volatile("" ::: "memory"); } }
}

constexpr int N_PHASES = 23;
struct Args { Ptrs p; int ph_lo, ph_hi; };
typedef const unsigned long long __attribute__((address_space(4))) kq_t;
template <class T> __device__ __forceinline__ T* as_global(T* q) { return (T*)(GAS T*)q; }
__global__ void __launch_bounds__(NWAVES * 64, 2) mega_fwd(Args args_unused) {
    extern __shared__ __attribute__((aligned(16))) unsigned char lds_raw[];
    LAS unsigned char* lds = (LAS unsigned char*)lds_raw;
    for (int u = threadIdx.x; u < (LDS_BYTES - LDSCTL_OFF) / 4; u += NWAVES * 64) ((LAS unsigned*)(lds + LDSCTL_OFF))[u] = 0u;
    __syncthreads();
    volatile LAS unsigned* MISC = (volatile LAS unsigned*)(lds + MISC_OFF);
    LAS int* tpre = (LAS int*)(lds + TPRE_OFF);
    int lo, hi;
    { kq_t* kq = (kq_t*)__builtin_amdgcn_kernarg_segment_ptr(); const unsigned long long w = kq[26]; lo = (int)(unsigned)w; hi = (int)(unsigned)(w >> 32); }
#if MK_SINGLE
    XcdBarrier bar;
    { kq_t* kq = (kq_t*)__builtin_amdgcn_kernarg_segment_ptr(); bar = xcd_barrier_post((unsigned*)((unsigned char*)kq[25] + WS_CTL) + CW_BAR, MISC + 8); }
#define GRID_BAR() xcd_barrier(bar)
#else
#define GRID_BAR() do {} while (0)
#endif
#ifndef PH_MASK
#define PH_MASK 0xffffffffu
#endif
#define IN(k) ((((PH_MASK) >> (k)) & 1u) && lo <= (k) && (k) < hi)
#ifndef REP_MASK
#define REP_MASK 0u
#endif
#define PH_REPS(k) (1 + (int)(((REP_MASK) >> (k)) & 1u))
#define SEAM(k) do { if (IN(k) && IN((k) + 1)) GRID_BAR(); } while (0)
#define PH_BEGIN \
    kq_t* kq_ = (kq_t*)__builtin_amdgcn_kernarg_segment_ptr(); asm volatile("" : "+s"(kq_)); \
    Ptrs p; p.x = (const float*)(GAS const float*)(unsigned long long)kq_[0]; p.c = (const float*)(GAS const float*)(unsigned long long)kq_[1]; p.pos = (const int*)(GAS const int*)(unsigned long long)kq_[2]; p.ada_w = (const float*)(GAS const float*)(unsigned long long)kq_[3]; p.ada_b = (const float*)(GAS const float*)(unsigned long long)kq_[4]; p.norm_g = (const float*)(GAS const float*)(unsigned long long)kq_[5]; p.final_g = (const float*)(GAS const float*)(unsigned long long)kq_[6]; p.diff_w_in = (const float*)(GAS const float*)(unsigned long long)kq_[7]; p.diff_w_out = (const float*)(GAS const float*)(unsigned long long)kq_[8]; p.diff_lambda = (const float*)(GAS const float*)(unsigned long long)kq_[9]; p.diff_subln_g = (const float*)(GAS const float*)(unsigned long long)kq_[10]; p.nsa_w_in = (const float*)(GAS const float*)(unsigned long long)kq_[11]; p.nsa_w_out = (const float*)(GAS const float*)(unsigned long long)kq_[12]; p.nsa_cmp_pos = (const float*)(GAS const float*)(unsigned long long)kq_[13]; p.nsa_cmp_w1 = (const float*)(GAS const float*)(unsigned long long)kq_[14]; p.nsa_cmp_b1 = (const float*)(GAS const float*)(unsigned long long)kq_[15]; p.nsa_cmp_w2 = (const float*)(GAS const float*)(unsigned long long)kq_[16]; p.moe_w_group = (const float*)(GAS const float*)(unsigned long long)kq_[17]; p.moe_b_group = (const float*)(GAS const float*)(unsigned long long)kq_[18]; p.moe_w_expert = (const float*)(GAS const float*)(unsigned long long)kq_[19]; p.moe_b_expert = (const float*)(GAS const float*)(unsigned long long)kq_[20]; p.moe_w_gate = (const float*)(GAS const float*)(unsigned long long)kq_[21]; p.moe_w_up = (const float*)(GAS const float*)(unsigned long long)kq_[22]; p.moe_w_down = (const float*)(GAS const float*)(unsigned long long)kq_[23]; p.out = (float*)(GAS float*)(unsigned long long)kq_[24]; p.ws = (unsigned char*)(GAS unsigned char*)(unsigned long long)kq_[25]; \
    unsigned char* ws = p.ws; int G = gridDim.x, bx = blockIdx.x; asm volatile("" : "+s"(G), "+s"(bx)); \
    const int tid = threadIdx.x, lane = tid & 63, wave = __builtin_amdgcn_readfirstlane(tid >> 6); (void)lane; \
    const int vcu = (G % 8 == 0) ? (bx % 8) * (G / 8) + bx / 8 : bx; \
    const int gw = vcu * NWAVES + wave, NGW = G * NWAVES, gtid = bx * (NWAVES * 64) + tid, NT = G * NWAVES * 64; \
    bf16* const RA = (bf16*)(ws + WS_RA); bf16* const RB = (bf16*)(ws + WS_RB); bf16* const RC = (bf16*)(ws + WS_RC); bf16* const RD = (bf16*)(ws + WS_RD); bf16* const RE = (bf16*)(ws + WS_RE); bf16* const RF = (bf16*)(ws + WS_RF); \
    const float* MOD = (const float*)(ws + WS_MOD); const float* ROPE = (const float*)(ws + WS_ROPE); \
    int* rowtok = (int*)(ws + WS_ROWTOK); float* rowwt = (float*)(ws + WS_ROWWT); \
    (void)vcu; (void)gw; (void)NGW; (void)gtid; (void)NT; (void)RA; (void)RB; (void)RC; (void)RD; (void)RE; (void)RF; (void)MOD; (void)ROPE; (void)rowtok; (void)rowwt;

    if (IN(0)) for (int rep_ = 0; rep_ < PH_REPS(0); ++rep_) { const bool dummy_ = rep_ + 1 < PH_REPS(0); if (rep_) __syncthreads(); PH_BEGIN ph_prologue(p, lds, gw, NGW, wave, lane, gtid, NT); } SEAM(0);
    if (IN(1)) for (int rep_ = 0; rep_ < PH_REPS(1); ++rep_) { const bool dummy_ = rep_ + 1 < PH_REPS(1); if (rep_) __syncthreads(); PH_BEGIN ph_finalize(p, gtid, NT); } SEAM(1);
    if (IN(2)) for (int rep_ = 0; rep_ < PH_REPS(2); ++rep_) { const bool dummy_ = rep_ + 1 < PH_REPS(2); if (rep_) __syncthreads(); PH_BEGIN ph_rows<false, false, false>(p, p.x, nullptr, nullptr, MOD, 0, 0, p.norm_g, RA, 0, gw, NGW, lane, gtid, NT); ph_router_prep(p, MOD, gw, NGW, lane, gtid, NT); } SEAM(2);
    if (IN(3)) for (int rep_ = 0; rep_ < PH_REPS(3); ++rep_) { const bool dummy_ = rep_ + 1 < PH_REPS(3); if (rep_) __syncthreads(); PH_BEGIN pg8::Gemm g{RA, (const bf16*)(ws + WS_WQKV), kM, 3072, 1024, 1024}; pg8::StaticOrder S; S.init(kM, 3072, G, bx);
        pg8::EpiQKV E{RB, (size_t)(WS_RC - WS_RB) / 2, pg8::RopeCtx{ROPE, 0xffffu}};
        pg8::gemm_phase<pg8::EpiQKV, pg8::StaticOrder, true, true>(lds + RING_OFF, g, S, E); } SEAM(3);
    if (IN(4)) for (int rep_ = 0; rep_ < PH_REPS(4); ++rep_) { const bool dummy_ = rep_ + 1 < PH_REPS(4); if (rep_) __syncthreads(); PH_BEGIN attn_body::diff_attn_phase2<8>((char*)lds_raw + RING_OFF, (const attn_body::bf16*)RB, (const attn_body::bf16*)RC, (const attn_body::bf16*)RD, (attn_body::bf16*)RE, (attn_body::bf16*)RF, vcu, G); } SEAM(4);
    if (IN(5)) for (int rep_ = 0; rep_ < PH_REPS(5); ++rep_) { const bool dummy_ = rep_ + 1 < PH_REPS(5); if (rep_) __syncthreads(); PH_BEGIN ph_diffcombine(p, RE, RF, RA, gw, NGW, lane); } SEAM(5);
    if (IN(6)) for (int rep_ = 0; rep_ < PH_REPS(6); ++rep_) { const bool dummy_ = rep_ + 1 < PH_REPS(6); if (rep_) __syncthreads(); PH_BEGIN pg8::Gemm g{RA, (const bf16*)(ws + WS_WO0), kM, 1024, 1024, 1024}; pg8::StaticOrder S; S.init(kM, 1024, G, bx);
        pg8::EpiResidB E{p.x, nullptr, RD, MOD + 2 * 1024};
        pg8::gemm_phase<pg8::EpiResidB, pg8::StaticOrder, true, true>(lds + RING_OFF, g, S, E); } SEAM(6);
    if (IN(7)) for (int rep_ = 0; rep_ < PH_REPS(7); ++rep_) { const bool dummy_ = rep_ + 1 < PH_REPS(7); if (rep_) __syncthreads(); PH_BEGIN ph_rows<false, false, true>(p, (const float*)RD, nullptr, nullptr, MOD, 3, 0, p.norm_g + 1024, RB, 0, gw, NGW, lane, gtid, NT); ph_router(p, (const float*)RD, 0, lds, vcu, G, wave, lane, gtid, NT, dummy_); } SEAM(7);
    if (IN(9)) for (int rep_ = 0; rep_ < PH_REPS(9); ++rep_) { const bool dummy_ = rep_ + 1 < PH_REPS(9); (void)dummy_; if (rep_) __syncthreads(); PH_BEGIN
        moe_tpre(p, 0, tpre, tid); pg8::Gemm g{RB, (const bf16*)(ws + WS_MOE0), kMpad, 32 * 512, 1024, 1024}; pg8::MoeOrder S{tpre, 2, G, bx};
        const int* RT = (const int*)(ws + WS_RC); const float* RW = (const float*)(RT + 32 * 32768);
        LAS unsigned* gtab = (LAS unsigned*)(lds + GTAB_OFF);
        for (int i = 0; i < GTAB_UNITS; ++i) { pg8::Unit u; if (!S.next(i, u)) break;
            if (tid < 256) { const int idx = u.ti * 256 + tid; const int tok = idx < u.cnt ? (RT[u.e * 32768 + idx] >> 1) : 0; gtab[i * 256 + tid] = (unsigned)tok * 2048u; } }
        __syncthreads();
        pg8::EpiGateUp E{RF, RW}; pg8::gemm_phase_g<pg8::EpiGateUp, pg8::MoeOrder, true>(lds + RING_OFF, g, S, E, gtab); } SEAM(9);
    if (IN(10)) for (int rep_ = 0; rep_ < PH_REPS(10); ++rep_) { const bool dummy_ = rep_ + 1 < PH_REPS(10); if (rep_) __syncthreads(); PH_BEGIN moe_tpre(p, 0, tpre, tid); pg8::Gemm g{RF, (const bf16*)(ws + WS_MOE0 + MOE_WD), kMpad, 32 * 1024, 256, 256}; pg8::MoeOrder S{tpre, 4, G, bx};
        pg8::EpiScatter E{ws, (unsigned)WS_RA, (unsigned)WS_DUMP, (const int*)(ws + WS_RC)}; pg8::gemm_phase<pg8::EpiScatter, pg8::MoeOrder, true, true>(lds + RING_OFF, g, S, E); } SEAM(10);
    if (IN(11)) for (int rep_ = 0; rep_ < PH_REPS(11); ++rep_) { const bool dummy_ = rep_ + 1 < PH_REPS(11); if (rep_) __syncthreads(); PH_BEGIN ph_rows<true, false, true>(p, (const float*)RD, dummy_ ? (float*)RE : p.out, RA, MOD, 12, 5, p.norm_g + 2048, RC, 1, gw, NGW, lane, gtid, NT); }         SEAM(11);
    if (IN(12)) for (int rep_ = 0; rep_ < PH_REPS(12); ++rep_) { const bool dummy_ = rep_ + 1 < PH_REPS(12); if (rep_) __syncthreads(); PH_BEGIN pg8::Gemm g{RC, (const bf16*)(ws + WS_WNSA), kM, 2048, 1024, 1024}; pg8::StaticOrder S; S.init(kM, 2048, G, bx);
        pg8::EpiNsaProj E{RD, (bf16*)(ws + NS_KC), pg8::RopeCtx{ROPE, 0x3cffu}};
        pg8::gemm_phase<pg8::EpiNsaProj, pg8::StaticOrder, true, true>(lds + RING_OFF, g, S, E); } SEAM(12);
    if (IN(13)) for (int rep_ = 0; rep_ < PH_REPS(13); ++rep_) { const bool dummy_ = rep_ + 1 < PH_REPS(13); (void)dummy_; if (rep_) __syncthreads();
        { PH_BEGIN pg8::Gemm g{(const bf16*)(ws + NS_KC), (const bf16*)(ws + WS_W1C), 8192, 512, 2048, 1024}; pg8::CmpOrder S{G, bx};
          pg8::EpiCmp1 E{(bf16*)(ws + NS_HID), (const float*)(ws + WS_CBF)};
          pg8::gemm_phase<pg8::EpiCmp1, pg8::CmpOrder, true, true>(lds + RING_OFF, g, S, E); }
        asm volatile("s_waitcnt vmcnt(0)" ::: "memory"); __builtin_amdgcn_fence(__ATOMIC_RELEASE, "workgroup"); __syncthreads(); __builtin_amdgcn_fence(__ATOMIC_ACQUIRE, "workgroup");
        { PH_BEGIN pg8::Gemm g{(const bf16*)(ws + NS_HID), (const bf16*)(ws + WS_W2C), 8192, 512, 256, 256}; pg8::CmpOrder S{G, bx};
          pg8::EpiCmp2 E{(unsigned char*)(ws + NS_KCMP), (unsigned char*)(ws + NS_VCT)};
          pg8::gemm_phase<pg8::EpiCmp2, pg8::CmpOrder, true, true>(lds + RING_OFF, g, S, E); }
        __syncthreads();
        { PH_BEGIN ph_vtrans(p, RD, (bf16*)(ws + NS_VTS), (bf16*)(ws + NS_VTW), lds, gw, NGW, wave, lane); }
        __syncthreads();
        { PH_BEGIN attn_body::nsa_window_phase((char*)lds_raw + RING_OFF, (const attn_body::bf16*)RD, (attn_body::bf16*)RB, (unsigned*)(ws + WS_CTL) + CW_QCTR + 128 + rep_ * 64, MISC + 16); }
    } SEAM(13);
    if (IN(16)) for (int rep_ = 0; rep_ < PH_REPS(16); ++rep_) { const bool dummy_ = rep_ + 1 < PH_REPS(16); if (rep_) __syncthreads(); PH_BEGIN const nsa::Tensors T{RD, (const unsigned char*)(ws + NS_KCMP), (const unsigned char*)(ws + NS_VTW), (const unsigned char*)(ws + NS_VCT), (const unsigned char*)(ws + NS_VTS), RB, RA};
        LAS float* wl = (LAS float*)(lds + RING_OFF + wave * 16384);
        unsigned* qbase = (unsigned*)(ws + WS_CTL) + CW_QCTR + 1024 + rep_ * 512;
        const unsigned xcc = xb_xcc_id() & 7u;
        for (unsigned qi = 0; qi < 8u; ++qi) { const unsigned qq = (xcc + qi) & 7u; unsigned* qc = qbase + qq * 64;
            for (;;) { unsigned it = 0; if (lane == 0) it = __hip_atomic_fetch_add(qc, 1u, RLX_AGENT); it = (unsigned)__builtin_amdgcn_readfirstlane((int)it);
                if (it >= 2048u) break;
                nsa::quad_item(T, (int)(((qq >> 1) << 12) | ((qq & 1u) * 2048u + 2047u - it)), wl, lane); } } } SEAM(16);
    if (IN(17)) for (int rep_ = 0; rep_ < PH_REPS(17); ++rep_) { const bool dummy_ = rep_ + 1 < PH_REPS(17); if (rep_) __syncthreads(); PH_BEGIN pg8::Gemm g{RA, (const bf16*)(ws + WS_WO1), kM, 1024, 1024, 1024}; pg8::StaticOrder S; S.init(kM, 1024, G, bx);
        pg8::EpiResidB E{nullptr, (const bf16*)p.out, dummy_ ? RE : RD, MOD + 12288 + 2 * 1024};
        pg8::gemm_phase<pg8::EpiResidB, pg8::StaticOrder, true, true>(lds + RING_OFF, g, S, E); } SEAM(17);
    if (IN(18)) for (int rep_ = 0; rep_ < PH_REPS(18); ++rep_) { const bool dummy_ = rep_ + 1 < PH_REPS(18); if (rep_) __syncthreads(); PH_BEGIN ph_rows<false, false, true>(p, (const float*)RD, nullptr, nullptr, MOD + 12288, 3, 0, p.norm_g + 3072, RB, 1, gw, NGW, lane, gtid, NT); ph_router(p, (const float*)RD, 1, lds, vcu, G, wave, lane, gtid, NT, dummy_); } SEAM(18);
    if (IN(20)) for (int rep_ = 0; rep_ < PH_REPS(20); ++rep_) { const bool dummy_ = rep_ + 1 < PH_REPS(20); (void)dummy_; if (rep_) __syncthreads(); PH_BEGIN
        moe_tpre(p, 1, tpre, tid); pg8::Gemm g{RB, (const bf16*)(ws + WS_MOE0 + MOE_L), kMpad, 32 * 512, 1024, 1024}; pg8::MoeOrder S{tpre, 2, G, bx};
        const int* RT = (const int*)(ws + WS_RC); const float* RW = (const float*)(RT + 32 * 32768);
        LAS unsigned* gtab = (LAS unsigned*)(lds + GTAB_OFF);
        for (int i = 0; i < GTAB_UNITS; ++i) { pg8::Unit u; if (!S.next(i, u)) break;
            if (tid < 256) { const int idx = u.ti * 256 + tid; const int tok = idx < u.cnt ? (RT[u.e * 32768 + idx] >> 1) : 0; gtab[i * 256 + tid] = (unsigned)tok * 2048u; } }
        __syncthreads();
        pg8::EpiGateUp E{RF, RW}; pg8::gemm_phase_g<pg8::EpiGateUp, pg8::MoeOrder, true>(lds + RING_OFF, g, S, E, gtab); } SEAM(20);
    if (IN(21)) for (int rep_ = 0; rep_ < PH_REPS(21); ++rep_) { const bool dummy_ = rep_ + 1 < PH_REPS(21); if (rep_) __syncthreads(); PH_BEGIN moe_tpre(p, 1, tpre, tid); pg8::Gemm g{RF, (const bf16*)(ws + WS_MOE0 + MOE_L + MOE_WD), kMpad, 32 * 1024, 256, 256}; pg8::MoeOrder S{tpre, 4, G, bx};
        pg8::EpiScatter E{ws, (unsigned)WS_RA, (unsigned)WS_DUMP, (const int*)(ws + WS_RC)}; pg8::gemm_phase<pg8::EpiScatter, pg8::MoeOrder, true, true>(lds + RING_OFF, g, S, E); } SEAM(21);
    if (IN(22)) for (int rep_ = 0; rep_ < PH_REPS(22); ++rep_) { const bool dummy_ = rep_ + 1 < PH_REPS(22); if (rep_) __syncthreads(); PH_BEGIN ph_rows<true, true, true>(p, (const float*)RD, dummy_ ? (float*)RE : p.out, RA, MOD + 12288, 0, 5, p.final_g, nullptr, 1, gw, NGW, lane, gtid, NT); }
#undef IN
#undef SEAM
}

extern "C" void kernel_launch(void* const* d_in, const int* in_sizes, int n_in, void* d_out, int out_size, void* d_ws, size_t ws_size, hipStream_t stream) {
    static int grid = 0;
    if (grid == 0) {
        if (n_in != 24 || in_sizes[0] != kM * kD || out_size != kM * kD || ws_size < WS_END) { fprintf(stderr, "kernel_launch: unexpected shapes (n_in %d, in0 %d, out %d, ws %zu)\n", n_in, n_in > 0 ? in_sizes[0] : -1, out_size, ws_size); grid = -1; return; }
        int dev = 0, cus = 0, per_cu = 0;
        if (hipGetDevice(&dev) != hipSuccess || hipDeviceGetAttribute(&cus, hipDeviceAttributeMultiprocessorCount, dev) != hipSuccess) { grid = -1; return; }
        if (hipFuncSetAttribute((const void*)mega_fwd, hipFuncAttributeMaxDynamicSharedMemorySize, LDS_BYTES) != hipSuccess) { fprintf(stderr, "kernel_launch: hipFuncSetAttribute failed\n"); grid = -1; return; }
        if (hipOccupancyMaxActiveBlocksPerMultiprocessor(&per_cu, (const void*)mega_fwd, NWAVES * 64, LDS_BYTES) != hipSuccess || per_cu < 1) { fprintf(stderr, "kernel_launch: occupancy query says %d\n", per_cu); }
        (void)hipGetLastError();
        grid = cus;
    }
    if (grid < 0) return;
    if (hipMemsetAsync((char*)d_ws + WS_CTL, 0, CTL_ZERO_BYTES, stream) != hipSuccess) return;
    Args a{};
    const void** pp = (const void**)&a.p;
    for (int i = 0; i < 24; ++i) pp[i] = d_in[i];
    a.p.out = (float*)d_out; a.p.ws = (unsigned char*)d_ws;
#if MK_SINGLE
    a.ph_lo = 0; a.ph_hi = N_PHASES;
    hipLaunchKernelGGL(mega_fwd, dim3(grid), dim3(NWAVES * 64), LDS_BYTES, stream, a);
#else
    for (int ph = 0; ph < N_PHASES; ++ph) { a.ph_lo = ph; a.ph_hi = ph + 1; hipLaunchKernelGGL(mega_fwd, dim3(grid), dim3(NWAVES * 64), LDS_BYTES, stream, a); }
#endif
}
```

```cpp
#define REP_MASK ((1u<<5))
#include <hip/hip_runtime.h>
#include <cstdio>
#include <cstdint>
namespace pg8 {
#define PG8_LAS __attribute__((address_space(3)))
typedef unsigned short bf16_t;
typedef short bf16x8 __attribute__((ext_vector_type(8)));
typedef float f32x4 __attribute__((ext_vector_type(4)));
typedef unsigned u32x4 __attribute__((ext_vector_type(4)));
constexpr int BM = 256, BK = 64, HALF = 128, HTB = HALF * BK * 2  , STAGE_BYTES = 8 * HTB, NXCD = 8, WGM = 8;

__host__ __device__ __forceinline__ int lds_byte(int r, int c) { const int st = (r >> 4) * 2 + (c >> 5), rr = r & 15, cc = c & 31, ob = rr * 64 + cc * 2; return st * 1024 + (ob ^ (((ob >> 9) & 1) << 5)); }
__host__ __device__ __forceinline__ void stage_rc(int b, int& R, int& C) { const int st = b / 1024, sb = b % 1024, swz = sb ^ (((sb >> 9) & 1) << 5); R = (st >> 1) * 16 + swz / 64; C = (st & 1) * 32 + (swz % 64) / 2; }
__host__ __device__ __forceinline__ int perm32(int rho) { const int n = rho >> 4, i = rho & 15; return 8 * (i >> 2) + 4 * n + (i & 3); }

struct Unit { int pm, pn, e, ti, cnt, half = 0; };
struct Gemm { const bf16_t* A; const bf16_t* Bt; int M, N, K, lda; };

struct StaticOrder {
    int nM, nN, nwg, G, c;
    __host__ __device__ void init(int M, int N, int G_, int c_) { nM = M / BM; nN = N / BM; nwg = nM * nN; G = G_; c = c_; }
    __host__ __device__ bool next(int i, Unit& u) const {
        const long L = (long)i * G + c; if (L >= nwg) return false;
        int wgid = (int)L; { const int q = nwg / NXCD, r = nwg % NXCD, xcd = wgid % NXCD, off = wgid / NXCD; wgid = (xcd < r ? xcd * (q + 1) : r * (q + 1) + (xcd - r) * q) + off; }
        const int nig = WGM * nN, gid = wgid / nig, fm = gid * WGM, gsz = (nM - fm) < WGM ? (nM - fm) : WGM;
        u.pm = fm + ((wgid % nig) % gsz); u.pn = (wgid % nig) / gsz; return true;
    }
    __device__ __forceinline__ void a_ready(const Unit&) const {}
    __device__ __forceinline__ void done(const Unit&) const {}
};

__device__ __forceinline__ unsigned cvt_pk_bf16(float lo, float hi) { unsigned r; asm volatile("v_cvt_pk_bf16_f32 %0, %1, %2" : "=v"(r) : "v"(lo), "v"(hi)); return r; }
typedef float f32x2 __attribute__((ext_vector_type(2)));

constexpr int kSeq = 16384, kTok = 32768;
struct RopeCtx { const float* rope; unsigned ropemask; };
__device__ __forceinline__ void rope8p(f32x4& v0, f32x4& v1, const RopeCtx& R, int ch, int wc, int fq, int bp, const f32x4 (&t)[4]) {
    if (((R.ropemask >> ch) & 1u) && ((wc & 1) == 0)) {
        f32x4 o0, o1;
#pragma unroll
        for (int i = 0; i < 4; ++i) { o0[i] = __int_as_float(__builtin_amdgcn_ds_bpermute(bp, __float_as_int(v0[i]))); o1[i] = __int_as_float(__builtin_amdgcn_ds_bpermute(bp, __float_as_int(v1[i]))); }
        if (fq < 2) { v0 = v0 * t[0] + o0 * t[2]; v1 = v1 * t[1] + o1 * t[3]; }
    }
}
__device__ __forceinline__ u32x4 pack8(const f32x4& v0, const f32x4& v1) { u32x4 w; w.x = cvt_pk_bf16(v0[0], v0[1]); w.y = cvt_pk_bf16(v0[2], v0[3]); w.z = cvt_pk_bf16(v1[0], v1[1]); w.w = cvt_pk_bf16(v1[2], v1[3]); return w; }

struct EpiQKV {
    static constexpr bool PERM = true, AFTER_DRAIN = false;
    bf16_t* O; size_t tstride; RopeCtx R;
    __device__ __forceinline__ void operator()(const f32x4 (&acc)[2][2][4][2], const Unit& u, int wr, int wc, int fr, int fq) const {
        const int row0 = u.pm * BM + wr * 64 + fr, bp = (((fq ^ 1) & 3) * 16 + fr) * 4;
#pragma unroll
        for (int ai = 0; ai < 2; ++ai)
        { f32x4 rt[4][4];
            if (((R.ropemask >> (2 * u.pn)) & 3u) && ((wc & 1) == 0) && fq < 2) { const float sg = (fq == 0) ? -1.f : 1.f;
#pragma unroll
                for (int m = 0; m < 4; ++m) { const f32x4* rp = (const f32x4*)(R.rope + (size_t)(row0 + ai * HALF + m * 16) * 16); rt[m][0] = rp[0]; rt[m][1] = rp[1]; rt[m][2] = rp[2] * sg; rt[m][3] = rp[3] * sg; } }
#pragma unroll
            for (int m = 0; m < 4; ++m) { const int row = row0 + ai * HALF + m * 16;
#pragma unroll
                for (int bj = 0; bj < 2; ++bj) { const int ch = 2 * u.pn + bj, t = ch >> 3, col = (ch & 7) * 128 + wc * 32 + 8 * fq;
                    f32x4 v0 = acc[ai][bj][m][0], v1 = acc[ai][bj][m][1]; rope8p(v0, v1, R, ch, wc, fq, bp, rt[m]);
                    *(u32x4*)(O + (size_t)t * tstride + (size_t)row * 1024 + col) = pack8(v0, v1); } } }
    }
};
struct EpiNsaProj {
    static constexpr bool PERM = true, AFTER_DRAIN = false;
    bf16_t* P; bf16_t* KC; RopeCtx R;
    __device__ __forceinline__ void operator()(const f32x4 (&acc)[2][2][4][2], const Unit& u, int wr, int wc, int fr, int fq) const {
        const int row0 = u.pm * BM + wr * 64 + fr, bp = (((fq ^ 1) & 3) * 16 + fr) * 4;
#pragma unroll
        for (int ai = 0; ai < 2; ++ai) { f32x4 rt[4][4];
            if (((R.ropemask >> (2 * u.pn)) & 3u) && ((wc & 1) == 0) && fq < 2) { const float sg = (fq == 0) ? -1.f : 1.f;
#pragma unroll
                for (int m = 0; m < 4; ++m) { const f32x4* rp = (const f32x4*)(R.rope + (size_t)(row0 + ai * HALF + m * 16) * 16); rt[m][0] = rp[0]; rt[m][1] = rp[1]; rt[m][2] = rp[2] * sg; rt[m][3] = rp[3] * sg; } }
#pragma unroll
            for (int m = 0; m < 4; ++m) { const int row = row0 + ai * HALF + m * 16;
#pragma unroll
                for (int bj = 0; bj < 2; ++bj) { const int ch = 2 * u.pn + bj;
                    f32x4 v0 = acc[ai][bj][m][0], v1 = acc[ai][bj][m][1]; rope8p(v0, v1, R, ch, wc, fq, bp, rt[m]);
                    bf16_t* dst;
                    if (ch == 8 || ch == 9) { const int kv = ch - 8, b = row >= kSeq ? 1 : 0, t = row - b * kSeq, gi = wc >> 1;
                        dst = KC + ((size_t)((kv * 2 + b) * 2 + gi) * kSeq + t) * 64 + (wc & 1) * 32 + 8 * fq; }
                    else dst = P + (size_t)row * 2048 + ch * 128 + wc * 32 + 8 * fq;
                    *(u32x4*)dst = pack8(v0, v1); } } }
    }
};
struct EpiResid {
    static constexpr bool PERM = false, AFTER_DRAIN = false;
    const float* base; float* out; const float* gate;
    __device__ __forceinline__ void operator()(const f32x4 (&acc)[2][2][4][2], const Unit& u, int wr, int wc, int fr, int fq) const {
        const int row0 = u.pm * BM + wr * 64 + fr, col0 = u.pn * BM + wc * 32 + 4 * fq;
        const float* gp = gate + ((u.pm * BM) >= kSeq ? 6144 : 0);
        f32x4 gv[2][2];
#pragma unroll
        for (int bj = 0; bj < 2; ++bj)
#pragma unroll
            for (int n = 0; n < 2; ++n) gv[bj][n] = *(const f32x4*)(gp + col0 + bj * HALF + n * 16);
#pragma unroll
        for (int ai = 0; ai < 2; ++ai)
#pragma unroll
            for (int m = 0; m < 4; ++m) { const size_t off = (size_t)(row0 + ai * HALF + m * 16) * 1024 + col0;
#pragma unroll
                for (int bj = 0; bj < 2; ++bj)
#pragma unroll
                    for (int n = 0; n < 2; ++n) { const f32x4 bs = *(const f32x4*)(base + off + bj * HALF + n * 16);
                        *(f32x4*)(out + off + bj * HALF + n * 16) = bs + gv[bj][n] * acc[ai][bj][m][n]; } }
    }
};
struct EpiResidB {
    static constexpr bool PERM = true, AFTER_DRAIN = false;
    const float* basef; const bf16_t* baseh; bf16_t* out; const float* gate;
    __device__ __forceinline__ void operator()(const f32x4 (&acc)[2][2][4][2], const Unit& u, int wr, int wc, int fr, int fq) const {
        const int row0 = u.pm * BM + wr * 64 + fr, col0 = u.pn * BM + wc * 32 + 8 * fq;
        const float* gp = gate + ((u.pm * BM) >= kSeq ? 6144 : 0);
        f32x4 gv[2][2];
#pragma unroll
        for (int bj = 0; bj < 2; ++bj) { gv[bj][0] = *(const f32x4*)(gp + col0 + bj * HALF); gv[bj][1] = *(const f32x4*)(gp + col0 + bj * HALF + 4); }
        if (basef) {
#pragma unroll
            for (int am = 0; am < 4; ++am) { const int ai = am >> 1, m0 = (am & 1) * 2; f32x4 bb[2][2][2];
#pragma unroll
                for (int m = 0; m < 2; ++m) { const size_t off = (size_t)(row0 + ai * HALF + (m0 + m) * 16) * 1024 + col0;
#pragma unroll
                    for (int bj = 0; bj < 2; ++bj) { bb[m][bj][0] = *(const f32x4*)(basef + off + bj * HALF); bb[m][bj][1] = *(const f32x4*)(basef + off + bj * HALF + 4); } }
#pragma unroll
                for (int m = 0; m < 2; ++m) { const size_t off = (size_t)(row0 + ai * HALF + (m0 + m) * 16) * 1024 + col0;
#pragma unroll
                    for (int bj = 0; bj < 2; ++bj) *(u32x4*)(out + off + bj * HALF) = pack8(bb[m][bj][0] + gv[bj][0] * acc[ai][bj][m0 + m][0], bb[m][bj][1] + gv[bj][1] * acc[ai][bj][m0 + m][1]); } }
        } else {
            u32x4 hb[2][4][2];
#pragma unroll
            for (int ai = 0; ai < 2; ++ai)
#pragma unroll
                for (int m = 0; m < 4; ++m) { const size_t off = (size_t)(row0 + ai * HALF + m * 16) * 1024 + col0;
#pragma unroll
                    for (int bj = 0; bj < 2; ++bj) hb[ai][m][bj] = *(const u32x4*)(baseh + off + bj * HALF); }
#pragma unroll
            for (int ai = 0; ai < 2; ++ai)
#pragma unroll
                for (int m = 0; m < 4; ++m) { const size_t off = (size_t)(row0 + ai * HALF + m * 16) * 1024 + col0;
#pragma unroll
                    for (int bj = 0; bj < 2; ++bj) { const u32x4 h = hb[ai][m][bj];
                        const f32x4 b0 = (f32x4){__uint_as_float(h.x << 16), __uint_as_float(h.x & 0xffff0000u), __uint_as_float(h.y << 16), __uint_as_float(h.y & 0xffff0000u)};
                        const f32x4 b1 = (f32x4){__uint_as_float(h.z << 16), __uint_as_float(h.z & 0xffff0000u), __uint_as_float(h.w << 16), __uint_as_float(h.w & 0xffff0000u)};
                        *(u32x4*)(out + off + bj * HALF) = pack8(b0 + gv[bj][0] * acc[ai][bj][m][0], b1 + gv[bj][1] * acc[ai][bj][m][1]); } }
        }
    }
};
struct EpiGateUp {
    static constexpr bool PERM = true, AFTER_DRAIN = false;
    bf16_t* ACT; const float* RW;
    __device__ __forceinline__ void operator()(const f32x4 (&acc)[2][2][4][2], const Unit& u, int wr, int wc, int fr, int fq) const {
        const int rl0 = wr * 64 + fr, col = (u.pn & 1) * 128 + wc * 32 + 8 * fq; const float* rwp = RW + u.e * 32768 + u.ti * 256; const int lim = u.cnt - u.ti * 256;
        float wtw[2];
#pragma unroll
        for (int ai = 0; ai < 2; ++ai) { const int rl = wr * 64 + ai * HALF + fq * 16 + fr; const float wv = rwp[rl < lim ? rl : 0]; wtw[ai] = rl < lim ? wv : 0.f; }
#pragma unroll
        for (int ai = 0; ai < 2; ++ai) { if (ai == 1 && u.half) break;
#pragma unroll
            for (int m = 0; m < 4; ++m) { const int rl = rl0 + ai * HALF + m * 16; const float wt = __int_as_float(__builtin_amdgcn_ds_bpermute((m * 16 + fr) * 4, __float_as_int(wtw[ai])));
                f32x4 a[2];
#pragma unroll
                for (int n = 0; n < 2; ++n)
#pragma unroll
                    for (int i = 0; i < 4; ++i) { const float g = acc[ai][0][m][n][i], up = acc[ai][1][m][n][i];
                        const float sg = g * __builtin_amdgcn_rcpf(1.0f + __builtin_amdgcn_exp2f(-1.4426950408889634f * g)); a[n][i] = sg * up * wt; }
                *(u32x4*)(ACT + (size_t)(u.pm * BM + rl) * 256 + col) = pack8(a[0], a[1]); } }
    }
};
struct EpiScatter {
    static constexpr bool PERM = true, AFTER_DRAIN = false;
    unsigned char* B; unsigned yoff, doff; const int* RT;
    __device__ __forceinline__ void operator()(const f32x4 (&acc)[2][2][4][2], const Unit& u, int wr, int wc, int fr, int fq) const {
        asm volatile("" : "+v"(fr), "+v"(fq));
        const int rl0 = wr * 64 + fr, col0 = (u.pn & 3) * BM + wc * 32 + 8 * fq; const int* rtp = RT + u.e * 32768 + u.ti * 256; const int lim = u.cnt - u.ti * 256;
        int tkw[2];
#pragma unroll
        for (int ai = 0; ai < 2; ++ai) { const int rl = wr * 64 + ai * HALF + fq * 16 + fr; const int tv = rtp[rl < lim ? rl : 0]; tkw[ai] = rl < lim ? tv : -1; }
#pragma unroll
        for (int ai = 0; ai < 2; ++ai) { if (ai == 1 && u.half) break;
#pragma unroll
            for (int m = 0; m < 4; ++m) { const int tk = __builtin_amdgcn_ds_bpermute((m * 16 + fr) * 4, tkw[ai]);
                const unsigned yo = (tk >= 0 ? yoff + ((unsigned)(tk & 1) * (unsigned)kTok + (unsigned)(tk >> 1)) * 2048u : doff) + (unsigned)col0 * 2u;
#pragma unroll
                for (int bj = 0; bj < 2; ++bj) *(u32x4*)(B + (size_t)(yo + (unsigned)(bj * HALF * 2))) = pack8(acc[ai][bj][m][0], acc[ai][bj][m][1]);
                asm volatile("" ::: "memory"); } }
    }
};
__device__ __forceinline__ float gelu_tanh(float x) {
    const float z = 0.7978845608028654f * (x + 0.044715f * x * x * x);
    return x * __builtin_amdgcn_rcpf(1.0f + __builtin_amdgcn_exp2f(-2.0f * 1.4426950408889634f * z));
}
struct EpiCmp1 {
    static constexpr bool PERM = true, AFTER_DRAIN = false;
    bf16_t* HID; const float* biasF;
    __device__ __forceinline__ void operator()(const f32x4 (&acc)[2][2][4][2], const Unit& u, int wr, int wc, int fr, int fq) const {
        const int row0 = u.pm * BM + wr * 64 + fr;
#pragma unroll
        for (int bj = 0; bj < 2; ++bj) { const int col = bj * HALF + wc * 32 + 8 * fq;
            const f32x4 b0 = *(const f32x4*)(biasF + u.pn * 256 + col), b1 = *(const f32x4*)(biasF + u.pn * 256 + col + 4);
#pragma unroll
            for (int ai = 0; ai < 2; ++ai)
#pragma unroll
                for (int m = 0; m < 4; ++m) { const int row = row0 + ai * HALF + m * 16; f32x4 v0 = acc[ai][bj][m][0] + b0, v1 = acc[ai][bj][m][1] + b1;
#pragma unroll
                    for (int i = 0; i < 4; ++i) { v0[i] = gelu_tanh(v0[i]); v1[i] = gelu_tanh(v1[i]); }
                    *(u32x4*)(HID + (size_t)row * 256 + col) = pack8(v0, v1); } }
    }
};
struct EpiCmp2 {
    static constexpr bool PERM = true, AFTER_DRAIN = false;
    unsigned char* KC8; unsigned char* VC8;
    __device__ __forceinline__ void operator()(const f32x4 (&acc)[2][2][4][2], const Unit& u, int wr, int wc, int fr, int fq) const {
        if (wc >= 2) return;
        const int row0 = u.pm * BM + wr * 64 + fr, kv = u.pn;
#pragma unroll
        for (int ai = 0; ai < 2; ++ai)
#pragma unroll
            for (int m = 0; m < 4; ++m) { const int row = row0 + ai * HALF + m * 16, r2 = row - kv * 4096, bg = r2 >> 10, n = r2 & 1023, G = n >> 5, k32 = n & 31;
                const f32x4 a0 = acc[ai][0][m][0], a1 = acc[ai][0][m][1];
                int w0 = __builtin_amdgcn_cvt_pk_fp8_f32(a0[0], a0[1], 0, false); w0 = __builtin_amdgcn_cvt_pk_fp8_f32(a0[2], a0[3], w0, true);
                int w1 = __builtin_amdgcn_cvt_pk_fp8_f32(a1[0], a1[1], 0, false); w1 = __builtin_amdgcn_cvt_pk_fp8_f32(a1[2], a1[3], w1, true);
                if (kv == 0) { const int T = (k32 >> 2) & 1, mrow = ((k32 >> 3) << 2) | (k32 & 3);
                    typedef unsigned u32x2 __attribute__((ext_vector_type(2))); u32x2 w; w.x = (unsigned)w0; w.y = (unsigned)w1;
                    *(u32x2*)(KC8 + ((size_t)(bg * 32 + G) * 2 + T) * 1024 + (fq * 16 + mrow) * 16 + wc * 8) = w; }
                else { const int qq = k32 >> 3, j = k32 & 7;
                    unsigned char* vp = VC8 + ((size_t)(bg * 32 + G) * 2 + wc) * 1024 + (qq * 16 + 8 * (fq & 1)) * 16 + (fq >> 1) * 8 + j;
#pragma unroll
                    for (int i = 0; i < 8; ++i) { const unsigned x = (i < 4) ? (unsigned)w0 : (unsigned)w1; vp[i * 16] = (unsigned char)((x >> (8 * (i & 3))) & 0xffu); } } }
    }
};
struct CmpOrder {
    int G, c;
    __device__ __forceinline__ bool next(int i, Unit& u) const { const int L = i * G + c; if (L >= 32) return false; u.pm = L; u.pn = L >> 4; return true; }
    __device__ __forceinline__ void a_ready(const Unit&) const {}
    __device__ __forceinline__ void done(const Unit&) const {}
};
struct MoeOrder {
    const PG8_LAS int* tpre; int npn, G, c;
    __device__ __forceinline__ bool next(int i, Unit& u) const {
        const int L = i * G + c, nbig = __builtin_amdgcn_readfirstlane(tpre[112]) * npn, total = nbig + __builtin_amdgcn_readfirstlane(tpre[152]) * npn; if (L >= total) return false;
        int e, ti, pl, half;
        if (L < nbig) { const int rt = L / npn; pl = L - rt * npn; e = 0; half = 0;
#pragma unroll
            for (int st = 16; st >= 1; st >>= 1) { const int v = __builtin_amdgcn_readfirstlane(tpre[80 + e + st]); e += (rt >= v) ? st : 0; }
            ti = rt - __builtin_amdgcn_readfirstlane(tpre[80 + e]); }
        else { const int Ls = L - nbig, j = Ls / npn; pl = Ls - j * npn; e = __builtin_amdgcn_readfirstlane(tpre[120 + j]); ti = __builtin_amdgcn_readfirstlane(tpre[e + 1] - tpre[e]) - 1; half = 1; }
        u.pm = __builtin_amdgcn_readfirstlane(tpre[e] + ti); u.pn = __builtin_amdgcn_readfirstlane(e * npn + pl); u.e = __builtin_amdgcn_readfirstlane(e); u.ti = __builtin_amdgcn_readfirstlane(ti); u.cnt = __builtin_amdgcn_readfirstlane(tpre[40 + e]); u.half = half; return true;
    }
    __device__ __forceinline__ void a_ready(const Unit&) const {}
    __device__ __forceinline__ void done(const Unit&) const {}
};

template <class Epi, class Sched, bool ALIGN_EPI = false, bool SP2 = false>
__device__ __forceinline__ void gemm_phase(PG8_LAS unsigned char* lds, const Gemm g, const Sched& S, const Epi& E) {
    const int tid = threadIdx.x, wid = __builtin_amdgcn_readfirstlane(tid >> 6), lane = tid & 63, wr = wid >> 2, wc = wid & 3, fr = lane & 15, fq = lane >> 4;
    const int K = g.K, nt = K / BK;
    unsigned voffA[2], voffB[2];
#pragma unroll
    for (int i = 0; i < 2; ++i) { int R, C; stage_rc(tid * 16 + i * 8192, R, C); const int Rb = Epi::PERM ? ((R & ~31) + perm32(R & 31)) : R;
        voffA[i] = (unsigned)(R * g.lda + C) * 2u; voffB[i] = (unsigned)(Rb * K + C) * 2u; }
    const size_t kstep = (size_t)(BK * 2);
    const size_t hstep = (size_t)HALF * K * 2;
    const size_t tstep = 2 * hstep; const size_t hstepA = (size_t)HALF * g.lda * 2, tstepA = 2 * hstepA;
    const unsigned ldsw = (unsigned)wid * 1024u;
    const int aoff = lds_byte(wr * 64 + fr, fq * 8), boff = lds_byte(wc * 32 + fr, fq * 8);
#define PG8_SA(b, h) (((b) * 2 + (h)) * HTB)
#define PG8_SB(b, h) ((4 + (b) * 2 + (h)) * HTB)
#define PG8_STAGE(bufoff, gbase, voff) do { _Pragma("unroll") for (int _i = 0; _i < 2; ++_i) \
        __builtin_amdgcn_global_load_lds((const unsigned*)((const char*)(gbase) + (voff)[_i]), (PG8_LAS unsigned*)(lds + (bufoff) + ldsw + _i * 8192), 16, 0, 0); } while (0)
#define PG8_LDA(dst, b, h) do { _Pragma("unroll") for (int m = 0; m < 4; ++m) _Pragma("unroll") for (int k = 0; k < 2; ++k) dst[m][k] = *(const PG8_LAS bf16x8*)(lds + PG8_SA(b, h) + aoff + m * 2048 + k * 1024); } while (0)
#define PG8_LDB(dst, b, h) do { _Pragma("unroll") for (int n = 0; n < 2; ++n) _Pragma("unroll") for (int k = 0; k < 2; ++k) dst[n][k] = *(const PG8_LAS bf16x8*)(lds + PG8_SB(b, h) + boff + n * 2048 + k * 1024); } while (0)
#define PG8_MMA(ai, bj, At, Bt) do { __builtin_amdgcn_s_setprio(1); _Pragma("unroll") for (int m = 0; m < 4; ++m) _Pragma("unroll") for (int n = 0; n < 2; ++n) _Pragma("unroll") for (int k = 0; k < 2; ++k) \
        acc[ai][bj][m][n] = __builtin_amdgcn_mfma_f32_16x16x32_bf16(Bt[n][k], At[m][k], acc[ai][bj][m][n], 0, 0, 0); __builtin_amdgcn_s_setprio(0); } while (0)
#define PG8_WAIT_V(n) asm volatile("s_waitcnt vmcnt(" #n ")" ::: "memory")
#define PG8_WAIT_L(n) asm volatile("s_waitcnt lgkmcnt(" #n ")" ::: "memory")
#define PG8_BAR __builtin_amdgcn_s_barrier()
#define PG8_SCHED __builtin_amdgcn_sched_barrier(0)
    Unit cur, nxt; int ui = 0;
    if (!S.next(0, cur)) return;
    f32x4 acc[2][2][4][2];
#pragma unroll
    for (int a = 0; a < 2; ++a)
#pragma unroll
        for (int b = 0; b < 2; ++b)
#pragma unroll
            for (int m = 0; m < 4; ++m)
#pragma unroll
                for (int n = 0; n < 2; ++n) acc[a][b][m][n] = (f32x4){0.f, 0.f, 0.f, 0.f};
    bf16x8 At[4][2], B0[2][2], B1[2][2];
    const char* cA = (const char*)g.A + (size_t)cur.pm * tstepA; const char* cB = (const char*)g.Bt + (size_t)cur.pn * tstep;
    S.a_ready(cur);
    if constexpr (SP2) {
        PG8_STAGE(PG8_SB(0, 0), cB, voffB); PG8_STAGE(PG8_SB(0, 1), cB + hstep, voffB); PG8_STAGE(PG8_SA(0, 0), cA, voffA); PG8_STAGE(PG8_SA(0, 1), cA + hstepA, voffA);
        if (wr == 1) PG8_BAR;
        PG8_WAIT_V(2); PG8_BAR;
        PG8_STAGE(PG8_SB(1, 0), cB + kstep, voffB); PG8_STAGE(PG8_SA(1, 0), cA + kstep, voffA); PG8_STAGE(PG8_SB(1, 1), cB + hstep + kstep, voffB);
        PG8_WAIT_V(6); PG8_BAR;
    } else {
        PG8_STAGE(PG8_SB(0, 0), cB, voffB); PG8_STAGE(PG8_SA(0, 0), cA, voffA); PG8_STAGE(PG8_SB(0, 1), cB + hstep, voffB); PG8_STAGE(PG8_SA(0, 1), cA + hstepA, voffA);
        if (wr == 1) PG8_BAR;
        PG8_WAIT_V(4); PG8_BAR;
        PG8_STAGE(PG8_SB(1, 0), cB + kstep, voffB); PG8_STAGE(PG8_SA(1, 0), cA + kstep, voffA); PG8_STAGE(PG8_SB(1, 1), cB + hstep + kstep, voffB);
        PG8_WAIT_V(6); PG8_BAR;
    }
    for (;;) {
        const bool has_next = S.next(ui + 1, nxt);
        const char* nA = has_next ? (const char*)g.A + (size_t)nxt.pm * tstepA : cA; const char* nB = has_next ? (const char*)g.Bt + (size_t)nxt.pn * tstep : cB;
        for (int t = 0; t < nt; t += 2) {
            const bool last = (t == nt - 2);
            const char* a1 = cA + (size_t)(t + 1) * kstep;
            const char* a2 = last ? nA : cA + (size_t)(t + 2) * kstep; const char* b2 = last ? nB : cB + (size_t)(t + 2) * kstep;
            const char* a3 = a2 + kstep; const char* b3 = b2 + kstep;
            if (last && has_next) S.a_ready(nxt);
            if constexpr (SP2) {
            PG8_LDB(B0, 0, 0); PG8_LDB(B1, 0, 1); PG8_SCHED; PG8_LDA(At, 0, 0); PG8_STAGE(PG8_SA(1, 1), a1 + hstepA, voffA);
            PG8_WAIT_V(8); PG8_WAIT_L(0); PG8_BAR; PG8_MMA(0, 0, At, B0); PG8_MMA(0, 1, At, B1); PG8_BAR; PG8_SCHED;
            PG8_LDA(At, 0, 1); PG8_STAGE(PG8_SB(0, 0), b2, voffB); PG8_STAGE(PG8_SB(0, 1), b2 + hstep, voffB); PG8_STAGE(PG8_SA(0, 0), a2, voffA);
            PG8_WAIT_V(8); PG8_WAIT_L(0); PG8_BAR; if (!cur.half) { PG8_MMA(1, 0, At, B0); PG8_MMA(1, 1, At, B1); } PG8_BAR; PG8_SCHED;
            PG8_LDB(B0, 1, 0); PG8_LDB(B1, 1, 1); PG8_SCHED; PG8_LDA(At, 1, 0); PG8_STAGE(PG8_SA(0, 1), a2 + hstepA, voffA);
            PG8_WAIT_V(8); PG8_WAIT_L(0); PG8_BAR; PG8_MMA(0, 0, At, B0); PG8_MMA(0, 1, At, B1); PG8_BAR; PG8_SCHED;
            PG8_LDA(At, 1, 1); PG8_STAGE(PG8_SB(1, 0), b3, voffB); PG8_STAGE(PG8_SB(1, 1), b3 + hstep, voffB); PG8_STAGE(PG8_SA(1, 0), a3, voffA);
            PG8_WAIT_V(8); PG8_WAIT_L(0); PG8_BAR; if (!cur.half) { PG8_MMA(1, 0, At, B0); PG8_MMA(1, 1, At, B1); } PG8_BAR; PG8_SCHED;
            } else {
            PG8_LDB(B0, 0, 0); PG8_SCHED; PG8_LDA(At, 0, 0); PG8_STAGE(PG8_SA(1, 1), a1 + hstepA, voffA);
            PG8_WAIT_L(8); PG8_BAR; PG8_WAIT_L(0); PG8_MMA(0, 0, At, B0); PG8_BAR; PG8_SCHED;
            PG8_LDB(B1, 0, 1); PG8_STAGE(PG8_SB(0, 0), b2, voffB);
            PG8_BAR; PG8_WAIT_L(0); PG8_MMA(0, 1, At, B1); PG8_BAR;
            PG8_LDA(At, 0, 1); PG8_STAGE(PG8_SA(0, 0), a2, voffA);
            PG8_BAR; PG8_WAIT_L(0); PG8_MMA(1, 0, At, B0); PG8_BAR; PG8_SCHED;
            PG8_STAGE(PG8_SB(0, 1), b2 + hstep, voffB);
            PG8_WAIT_V(6); PG8_BAR; PG8_MMA(1, 1, At, B1); PG8_BAR;
            PG8_LDB(B0, 1, 0); PG8_SCHED; PG8_LDA(At, 1, 0); PG8_STAGE(PG8_SA(0, 1), a2 + hstepA, voffA);
            PG8_WAIT_L(8); PG8_BAR; PG8_WAIT_L(0); PG8_MMA(0, 0, At, B0); PG8_BAR; PG8_SCHED;
            PG8_LDB(B1, 1, 1); PG8_STAGE(PG8_SB(1, 0), b3, voffB);
            PG8_BAR; PG8_WAIT_L(0); PG8_MMA(0, 1, At, B1); PG8_BAR;
            PG8_LDA(At, 1, 1); PG8_STAGE(PG8_SA(1, 0), a3, voffA);
            PG8_BAR; PG8_WAIT_L(0); PG8_MMA(1, 0, At, B0); PG8_BAR; PG8_SCHED;
            PG8_STAGE(PG8_SB(1, 1), b3 + hstep, voffB);
            PG8_WAIT_V(6); PG8_BAR; PG8_MMA(1, 1, At, B1); PG8_BAR;
            }
        }
        if constexpr (ALIGN_EPI) { if (wr == 0) PG8_BAR; }
        if constexpr (!Epi::AFTER_DRAIN) { E(acc, cur, wr, wc, fr, fq); S.done(cur); }
        if (!has_next) break;
#pragma unroll
        for (int a = 0; a < 2; ++a)
#pragma unroll
            for (int b = 0; b < 2; ++b)
#pragma unroll
                for (int m = 0; m < 4; ++m)
#pragma unroll
                    for (int n = 0; n < 2; ++n) acc[a][b][m][n] = (f32x4){0.f, 0.f, 0.f, 0.f};
        cur = nxt; cA = nA; cB = nB; ++ui;
        if constexpr (ALIGN_EPI) { if (wr == 1) PG8_BAR; }
    }
    PG8_WAIT_V(0);
    if constexpr (!ALIGN_EPI) { if (wr == 0) PG8_BAR; }
    PG8_BAR;
    if constexpr (Epi::AFTER_DRAIN) { E.fused(acc, cur, wr, wc, fr, fq, lds, wid, lane); S.done(cur); }
#undef PG8_SA
#undef PG8_SB
#undef PG8_STAGE
#undef PG8_LDA
#undef PG8_LDB
#undef PG8_MMA
#undef PG8_WAIT_V
#undef PG8_WAIT_L
#undef PG8_BAR
#undef PG8_SCHED
}
template <class Epi, class Sched, bool ALIGN_EPI = false>
__device__ __forceinline__ void gemm_phase_g(PG8_LAS unsigned char* lds, const Gemm g, const Sched& S, const Epi& E, const PG8_LAS unsigned* gtab) {
    constexpr bool SP2 = true;
    const int tid = threadIdx.x, wid = __builtin_amdgcn_readfirstlane(tid >> 6), lane = tid & 63, wr = wid >> 2, wc = wid & 3, fr = lane & 15, fq = lane >> 4;
    const int K = g.K, nt = K / BK;
    unsigned voffB[2], cofsA[2]; int rowA[2];
#pragma unroll
    for (int i = 0; i < 2; ++i) { int R, C; stage_rc(tid * 16 + i * 8192, R, C); const int Rb = Epi::PERM ? ((R & ~31) + perm32(R & 31)) : R;
        rowA[i] = R; cofsA[i] = (unsigned)C * 2u; voffB[i] = (unsigned)(Rb * K + C) * 2u; }
    unsigned vC0[2], vC1[2], vN0[2], vN1[2];
#define PG8_GV(dst0, dst1, u_) do { _Pragma("unroll") for (int _i = 0; _i < 2; ++_i) { dst0[_i] = gtab[(u_) * 256 + rowA[_i]] + cofsA[_i]; dst1[_i] = gtab[(u_) * 256 + 128 + rowA[_i]] + cofsA[_i]; } } while (0)
    const size_t kstep = (size_t)(BK * 2);
    const size_t hstep = (size_t)HALF * K * 2;
    const size_t tstep = 2 * hstep; const size_t hstepA = (size_t)HALF * g.lda * 2, tstepA = 2 * hstepA;
    const unsigned ldsw = (unsigned)wid * 1024u;
    const int aoff = lds_byte(wr * 64 + fr, fq * 8), boff = lds_byte(wc * 32 + fr, fq * 8);
#define PG8_SA(b, h) (((b) * 2 + (h)) * HTB)
#define PG8_SB(b, h) ((4 + (b) * 2 + (h)) * HTB)
#define PG8_STAGE(bufoff, gbase, voff) do { _Pragma("unroll") for (int _i = 0; _i < 2; ++_i) \
        __builtin_amdgcn_global_load_lds((const unsigned*)((const char*)(gbase) + (voff)[_i]), (PG8_LAS unsigned*)(lds + (bufoff) + ldsw + _i * 8192), 16, 0, 0); } while (0)
#define PG8_LDA(dst, b, h) do { _Pragma("unroll") for (int m = 0; m < 4; ++m) _Pragma("unroll") for (int k = 0; k < 2; ++k) dst[m][k] = *(const PG8_LAS bf16x8*)(lds + PG8_SA(b, h) + aoff + m * 2048 + k * 1024); } while (0)
#define PG8_LDB(dst, b, h) do { _Pragma("unroll") for (int n = 0; n < 2; ++n) _Pragma("unroll") for (int k = 0; k < 2; ++k) dst[n][k] = *(const PG8_LAS bf16x8*)(lds + PG8_SB(b, h) + boff + n * 2048 + k * 1024); } while (0)
#define PG8_MMA(ai, bj, At, Bt) do { __builtin_amdgcn_s_setprio(1); _Pragma("unroll") for (int m = 0; m < 4; ++m) _Pragma("unroll") for (int n = 0; n < 2; ++n) _Pragma("unroll") for (int k = 0; k < 2; ++k) \
        acc[ai][bj][m][n] = __builtin_amdgcn_mfma_f32_16x16x32_bf16(Bt[n][k], At[m][k], acc[ai][bj][m][n], 0, 0, 0); __builtin_amdgcn_s_setprio(0); } while (0)
#define PG8_WAIT_V(n) asm volatile("s_waitcnt vmcnt(" #n ")" ::: "memory")
#define PG8_WAIT_L(n) asm volatile("s_waitcnt lgkmcnt(" #n ")" ::: "memory")
#define PG8_BAR __builtin_amdgcn_s_barrier()
#define PG8_SCHED __builtin_amdgcn_sched_barrier(0)
    Unit cur, nxt; int ui = 0;
    if (!S.next(0, cur)) return;
    f32x4 acc[2][2][4][2];
#pragma unroll
    for (int a = 0; a < 2; ++a)
#pragma unroll
        for (int b = 0; b < 2; ++b)
#pragma unroll
            for (int m = 0; m < 4; ++m)
#pragma unroll
                for (int n = 0; n < 2; ++n) acc[a][b][m][n] = (f32x4){0.f, 0.f, 0.f, 0.f};
    bf16x8 At[4][2], B0[2][2], B1[2][2];
    const char* cA = (const char*)g.A; const char* cB = (const char*)g.Bt + (size_t)cur.pn * tstep;
    PG8_GV(vC0, vC1, 0);
    S.a_ready(cur);
    if constexpr (SP2) {
        PG8_STAGE(PG8_SB(0, 0), cB, voffB); PG8_STAGE(PG8_SB(0, 1), cB + hstep, voffB); PG8_STAGE(PG8_SA(0, 0), cA, vC0); PG8_STAGE(PG8_SA(0, 1), cA, vC1);
        if (wr == 1) PG8_BAR;
        PG8_WAIT_V(2); PG8_BAR;
        PG8_STAGE(PG8_SB(1, 0), cB + kstep, voffB); PG8_STAGE(PG8_SA(1, 0), cA + kstep, vC0); PG8_STAGE(PG8_SB(1, 1), cB + hstep + kstep, voffB);
        PG8_WAIT_V(6); PG8_BAR;
    } else {
        PG8_STAGE(PG8_SB(0, 0), cB, voffB); PG8_STAGE(PG8_SA(0, 0), cA, vC0); PG8_STAGE(PG8_SB(0, 1), cB + hstep, voffB); PG8_STAGE(PG8_SA(0, 1), cA, vC1);
        if (wr == 1) PG8_BAR;
        PG8_WAIT_V(4); PG8_BAR;
        PG8_STAGE(PG8_SB(1, 0), cB + kstep, voffB); PG8_STAGE(PG8_SA(1, 0), cA + kstep, vC0); PG8_STAGE(PG8_SB(1, 1), cB + hstep + kstep, voffB);
        PG8_WAIT_V(6); PG8_BAR;
    }
    for (;;) {
        const bool has_next = S.next(ui + 1, nxt);
        const char* nA = cA; const char* nB = has_next ? (const char*)g.Bt + (size_t)nxt.pn * tstep : cB;
        if (has_next) PG8_GV(vN0, vN1, ui + 1); else { _Pragma("unroll") for (int _i = 0; _i < 2; ++_i) { vN0[_i] = vC0[_i]; vN1[_i] = vC1[_i]; } }
        for (int t = 0; t < nt; t += 2) {
            const bool last = (t == nt - 2);
            const char* a1 = cA + (size_t)(t + 1) * kstep;
            const unsigned va0[2] = {last ? vN0[0] : vC0[0], last ? vN0[1] : vC0[1]}, va1[2] = {last ? vN1[0] : vC1[0], last ? vN1[1] : vC1[1]};
            const char* a2 = last ? nA : cA + (size_t)(t + 2) * kstep; const char* b2 = last ? nB : cB + (size_t)(t + 2) * kstep;
            const char* a3 = a2 + kstep; const char* b3 = b2 + kstep;
            if (last && has_next) S.a_ready(nxt);
            if constexpr (SP2) {
            PG8_LDB(B0, 0, 0); PG8_LDB(B1, 0, 1); PG8_SCHED; PG8_LDA(At, 0, 0); PG8_STAGE(PG8_SA(1, 1), a1, vC1);
            PG8_WAIT_V(8); PG8_WAIT_L(0); PG8_BAR; PG8_MMA(0, 0, At, B0); PG8_MMA(0, 1, At, B1); PG8_BAR; PG8_SCHED;
            PG8_LDA(At, 0, 1); PG8_STAGE(PG8_SB(0, 0), b2, voffB); PG8_STAGE(PG8_SB(0, 1), b2 + hstep, voffB); PG8_STAGE(PG8_SA(0, 0), a2, va0);
            PG8_WAIT_V(8); PG8_WAIT_L(0); PG8_BAR; if (!cur.half) { PG8_MMA(1, 0, At, B0); PG8_MMA(1, 1, At, B1); } PG8_BAR; PG8_SCHED;
            PG8_LDB(B0, 1, 0); PG8_LDB(B1, 1, 1); PG8_SCHED; PG8_LDA(At, 1, 0); PG8_STAGE(PG8_SA(0, 1), a2, va1);
            PG8_WAIT_V(8); PG8_WAIT_L(0); PG8_BAR; PG8_MMA(0, 0, At, B0); PG8_MMA(0, 1, At, B1); PG8_BAR; PG8_SCHED;
            PG8_LDA(At, 1, 1); PG8_STAGE(PG8_SB(1, 0), b3, voffB); PG8_STAGE(PG8_SB(1, 1), b3 + hstep, voffB); PG8_STAGE(PG8_SA(1, 0), a3, va0);
            PG8_WAIT_V(8); PG8_WAIT_L(0); PG8_BAR; if (!cur.half) { PG8_MMA(1, 0, At, B0); PG8_MMA(1, 1, At, B1); } PG8_BAR; PG8_SCHED;
            } else {
            PG8_LDB(B0, 0, 0); PG8_SCHED; PG8_LDA(At, 0, 0); PG8_STAGE(PG8_SA(1, 1), a1, vC1);
            PG8_WAIT_L(8); PG8_BAR; PG8_WAIT_L(0); PG8_MMA(0, 0, At, B0); PG8_BAR; PG8_SCHED;
            PG8_LDB(B1, 0, 1); PG8_STAGE(PG8_SB(0, 0), b2, voffB);
            PG8_BAR; PG8_WAIT_L(0); PG8_MMA(0, 1, At, B1); PG8_BAR;
            PG8_LDA(At, 0, 1); PG8_STAGE(PG8_SA(0, 0), a2, va0);
            PG8_BAR; PG8_WAIT_L(0); PG8_MMA(1, 0, At, B0); PG8_BAR; PG8_SCHED;
            PG8_STAGE(PG8_SB(0, 1), b2 + hstep, voffB);
            PG8_WAIT_V(6); PG8_BAR; PG8_MMA(1, 1, At, B1); PG8_BAR;
            PG8_LDB(B0, 1, 0); PG8_SCHED; PG8_LDA(At, 1, 0); PG8_STAGE(PG8_SA(0, 1), a2, va1);
            PG8_WAIT_L(8); PG8_BAR; PG8_WAIT_L(0); PG8_MMA(0, 0, At, B0); PG8_BAR; PG8_SCHED;
            PG8_LDB(B1, 1, 1); PG8_STAGE(PG8_SB(1, 0), b3, voffB);
            PG8_BAR; PG8_WAIT_L(0); PG8_MMA(0, 1, At, B1); PG8_BAR;
            PG8_LDA(At, 1, 1); PG8_STAGE(PG8_SA(1, 0), a3, va0);
            PG8_BAR; PG8_WAIT_L(0); PG8_MMA(1, 0, At, B0); PG8_BAR; PG8_SCHED;
            PG8_STAGE(PG8_SB(1, 1), b3 + hstep, voffB);
            PG8_WAIT_V(6); PG8_BAR; PG8_MMA(1, 1, At, B1); PG8_BAR;
            }
        }
        if constexpr (ALIGN_EPI) { if (wr == 0) PG8_BAR; }
        if constexpr (!Epi::AFTER_DRAIN) { E(acc, cur, wr, wc, fr, fq); S.done(cur); }
        if (!has_next) break;
#pragma unroll
        for (int a = 0; a < 2; ++a)
#pragma unroll
            for (int b = 0; b < 2; ++b)
#pragma unroll
                for (int m = 0; m < 4; ++m)
#pragma unroll
                    for (int n = 0; n < 2; ++n) acc[a][b][m][n] = (f32x4){0.f, 0.f, 0.f, 0.f};
        cur = nxt; cA = nA; cB = nB; ++ui;
        { _Pragma("unroll") for (int _i = 0; _i < 2; ++_i) { vC0[_i] = vN0[_i]; vC1[_i] = vN1[_i]; } }
        if constexpr (ALIGN_EPI) { if (wr == 1) PG8_BAR; }
    }
    PG8_WAIT_V(0);
    if constexpr (!ALIGN_EPI) { if (wr == 0) PG8_BAR; }
    PG8_BAR;
    if constexpr (Epi::AFTER_DRAIN) { E.fused(acc, cur, wr, wc, fr, fq, lds, wid, lane); S.done(cur); }
#undef PG8_SA
#undef PG8_SB
#undef PG8_STAGE
#undef PG8_LDA
#undef PG8_LDB
#undef PG8_MMA
#undef PG8_WAIT_V
#undef PG8_WAIT_L
#undef PG8_BAR
#undef PG8_SCHED
#undef PG8_GV
}

}

#include <hip/hip_bf16.h>
#include <cmath>
namespace attn_body {
using bf16=__hip_bfloat16;
using bf16x8=__attribute__((ext_vector_type(8)))short;
using s16x4=__attribute__((ext_vector_type(4)))short;
using f32x16=__attribute__((ext_vector_type(16)))float;
using u32x4=__attribute__((ext_vector_type(4)))unsigned;
constexpr int BATCH=2,NHEAD=16,SEQ=16384,D=64,DM=NHEAD*D;
constexpr int NW=8,QBLK=32,QB=QBLK*NW,KVBLK=64,NQB=SEQ/QB;
constexpr int ATTN_PITCH=DM, ATTN_UNIT_ROWS=QB;
__device__ __forceinline__ int crow(int r,int hi){return (r&3)+8*(r>>2)+4*hi;}
#define SBAR() __builtin_amdgcn_sched_barrier(0)
__device__ __forceinline__ void cmask(f32x16&p0,f32x16&p1,int jb,int qrel,int hi){
  const float NEG=-INFINITY; int kb=64*jb+4*hi;
  #pragma unroll
  for(int r=0;r<16;++r){int kv=kb+(r&3)+8*(r>>2); if(kv>qrel)p0[r]=NEG; if(kv+32>qrel)p1[r]=NEG;}
}

constexpr int NSLOT=3, SLOTB=8192;
constexpr int LDS_K=0, LDS_V=NSLOT*SLOTB, LDS_WS=2*NSLOT*SLOTB, LDS_OST=LDS_WS+NW*64*4, LDS_BYTES=LDS_OST+NW*4096;
constexpr float C2=0.125f*1.4426950408889634f;
__device__ __forceinline__ void glds16(const void*gsrc,unsigned lds_dst){unsigned keep;
  asm volatile("s_mov_b32 %0, m0\n\ts_mov_b32 m0, %2\n\ts_nop 0\n\tglobal_load_lds_dwordx4 %1, off\n\ts_mov_b32 m0, %0":"=&s"(keep):"v"(gsrc),"s"(lds_dst):"memory");}
__device__ __forceinline__ float max3f(float a,float b,float c){float r;asm("v_max3_f32 %0, %1, %2, %3":"=v"(r):"v"(a),"v"(b),"v"(c));return r;}
__device__ __forceinline__ float max2f(float a,float b){float r;asm("v_max_f32_e32 %0, %1, %2":"=v"(r):"v"(a),"v"(b));return r;}
__device__ __forceinline__ float fadd_s(float a,float b){float r;asm("v_add_f32_e32 %0, %1, %2":"=v"(r):"v"(a),"v"(b));return r;}
__device__ __forceinline__ float fsub_s(float a,float b){float r;asm("v_sub_f32_e32 %0, %1, %2":"=v"(r):"v"(a),"v"(b));return r;}
typedef float f32x2_t __attribute__((ext_vector_type(2))); typedef __bf16 bf16x2_t __attribute__((ext_vector_type(2)));
__device__ __forceinline__ unsigned cvtpk_s(float lo,float hi){f32x2_t v={lo,hi};bf16x2_t b=__builtin_convertvector(v,bf16x2_t);return __builtin_bit_cast(unsigned,b);}
#define WAIT_BAR(N) asm volatile("s_waitcnt vmcnt(" #N ") lgkmcnt(0)\n\ts_barrier":::"memory")

__device__ __forceinline__ void qkt(f32x16&p0,f32x16&p1,const char*Kslot,const bf16x8*qr,const f32x16&negm,int r32,int hi){
  const char*kb=Kslot+hi*1024+r32*16;
  #pragma unroll
  for(int d0=0;d0<4;++d0){
    const bf16x8 b0=*reinterpret_cast<const bf16x8*>(kb+d0*2048);
    const bf16x8 b1=*reinterpret_cast<const bf16x8*>(kb+d0*2048+512);
    if(d0==0){p0=__builtin_amdgcn_mfma_f32_32x32x16_bf16(b0,qr[0],negm,0,0,0);p1=__builtin_amdgcn_mfma_f32_32x32x16_bf16(b1,qr[0],negm,0,0,0);}
    else{p0=__builtin_amdgcn_mfma_f32_32x32x16_bf16(b0,qr[d0],p0,0,0,0);p1=__builtin_amdgcn_mfma_f32_32x32x16_bf16(b1,qr[d0],p1,0,0,0);}}
}
typedef __attribute__((address_space(3))) const char* lds_cptr;
typedef short v4i16_t __attribute__((ext_vector_type(4)));
__device__ __forceinline__ void kload8(bf16x8*kf,lds_cptr kp){
  kf[0]=*(const __attribute__((address_space(3))) bf16x8*)(kp);      kf[1]=*(const __attribute__((address_space(3))) bf16x8*)(kp+512);
  kf[2]=*(const __attribute__((address_space(3))) bf16x8*)(kp+2048); kf[3]=*(const __attribute__((address_space(3))) bf16x8*)(kp+2560);
  kf[4]=*(const __attribute__((address_space(3))) bf16x8*)(kp+4096); kf[5]=*(const __attribute__((address_space(3))) bf16x8*)(kp+4608);
  kf[6]=*(const __attribute__((address_space(3))) bf16x8*)(kp+6144); kf[7]=*(const __attribute__((address_space(3))) bf16x8*)(kp+6656);
}
__device__ __forceinline__ void kload2(bf16x8*kf,lds_cptr kp,int j){ kf[2*j]=*(const __attribute__((address_space(3))) bf16x8*)(kp+j*2048); kf[2*j+1]=*(const __attribute__((address_space(3))) bf16x8*)(kp+j*2048+512); }
__device__ __forceinline__ s16x4 vtr(lds_cptr p){ return __builtin_bit_cast(s16x4,__builtin_amdgcn_ds_read_tr16_b64_v4i16((__attribute__((address_space(3))) v4i16_t*)p)); }
__device__ __forceinline__ float rowmax(const f32x16&p0,const f32x16&p1){
  float a=max3f(p0[0],p0[1],p1[0]),b=max3f(p0[2],p0[3],p1[1]);a=max3f(a,p1[2],p1[3]);
  #pragma unroll
  for(int r=4;r<16;r+=4){a=max3f(a,p0[r],p0[r+1]);b=max3f(b,p0[r+2],p0[r+3]);a=max3f(a,p1[r],p1[r+1]);b=max3f(b,p1[r+2],p1[r+3]);}
  const float m=max2f(a,b);
  auto rr=__builtin_amdgcn_permlane32_swap(__float_as_uint(m),__float_as_uint(m),false,false);
  return max2f(__uint_as_float(rr[0]),__uint_as_float(rr[1]));
}
__device__ __forceinline__ void pv(f32x16*o,int vb,bf16x8 pa0,bf16x8 pa1,bf16x8 pa2,bf16x8 pa3){
  #pragma unroll
  for(int d0=0;d0<2;++d0){s16x4 lo[4],hi[4];
    #pragma unroll
    for(int ks=0;ks<4;++ks){
      asm volatile("ds_read_b64_tr_b16 %0,%1 offset:%c2":"=&v"(lo[ks]):"v"(vb),"i"(d0*4096+ks*1024):"memory");
      asm volatile("ds_read_b64_tr_b16 %0,%1 offset:%c2":"=&v"(hi[ks]):"v"(vb),"i"(d0*4096+ks*1024+512):"memory");}
    asm volatile("s_waitcnt lgkmcnt(0)":::"memory");SBAR();
    #define PK(k) (bf16x8){lo[k][0],lo[k][1],lo[k][2],lo[k][3],hi[k][0],hi[k][1],hi[k][2],hi[k][3]}
    o[d0]=__builtin_amdgcn_mfma_f32_32x32x16_bf16(pa0,PK(0),o[d0],0,0,0);
    o[d0]=__builtin_amdgcn_mfma_f32_32x32x16_bf16(pa1,PK(1),o[d0],0,0,0);
    o[d0]=__builtin_amdgcn_mfma_f32_32x32x16_bf16(pa2,PK(2),o[d0],0,0,0);
    o[d0]=__builtin_amdgcn_mfma_f32_32x32x16_bf16(pa3,PK(3),o[d0],0,0,0);
    #undef PK
  }
}

#ifndef ATTN_STORE16
#define ATTN_STORE16(p,v) (*(u32x4*)(p)=(v))
#endif
template<int THRL> __device__ __forceinline__ void attn_unit(int b,int h,int qb,const bf16*Q,const bf16*__restrict__ K,const bf16*__restrict__ V,bf16*O,char*shm){
  int tid_=threadIdx.x; asm volatile("":"+v"(tid_)); const int tid=tid_,lane=tid&63,r32=lane&31,hi=lane>>5; const int wid=__builtin_amdgcn_readfirstlane(tid>>6);
  const long rowbase=(long)b*SEQ; const int q0=qb*QB;
  const bf16*Qw=Q+(rowbase+q0+wid*QBLK)*DM+h*D;
  const bf16*Kh=K+rowbase*DM+h*D,*Vh=V+rowbase*DM+h*D;
  const unsigned lds0=(unsigned)(uintptr_t)shm;
  float*wsf=(float*)(shm+LDS_WS)+wid*64;
  const bf16*ksrc=Kh+(long)lane*DM+wid*8;
  const bf16*vsrc=Vh+(long)(16*(wid&3)+(lane>>2))*DM+(wid>>2)*32+(lane&3)*8;
  const unsigned kdst=lds0+LDS_K+wid*1024, vdst=lds0+LDS_V+wid*1024;
  #define DMA_K(t,slot) glds16(ksrc+(long)(t)*KVBLK*DM,(unsigned)__builtin_amdgcn_readfirstlane(kdst+(slot)))
  #define DMA_V(t,slot) glds16(vsrc+(long)(t)*KVBLK*DM,(unsigned)__builtin_amdgcn_readfirstlane(vdst+(slot)))
  const int vb0=(int)(lds0+LDS_V)+((lane>>4)&1)*32+(lane&3)*8+(4*hi+((lane&15)>>2))*64;
  const char*Kbase=shm+LDS_K; bf16x8 kf[8];
  const lds_cptr shm3=(lds_cptr)shm; const lds_cptr kp0=shm3+LDS_K+hi*1024+r32*16; const lds_cptr vp0=shm3+LDS_V+((lane>>4)&1)*32+(lane&3)*8+(4*hi+((lane&15)>>2))*64;
  const int NT=(q0+QB)/KVBLK;
  DMA_K(0,0);DMA_V(0,0);DMA_K(1,SLOTB);
  bf16x8 qr[4];
  #pragma unroll
  for(int d0=0;d0<4;++d0)qr[d0]=*reinterpret_cast<const bf16x8*>(&Qw[(long)r32*DM+d0*16+hi*8]);
  float mhat=0.f,l_reg=0.f;f32x16 o[2];o[0]=f32x16{};o[1]=f32x16{};f32x16 negm=f32x16{};asm volatile("":"+v"(negm));
  const int qrel=wid*QBLK+r32;
  #define CMASK(P0,P1,t) do{int jb_=(t)-(NT-4); if(jb_>=0)cmask(P0,P1,jb_,qrel,hi);}while(0)
  bool resc=false;
  #define START(P0,P1) do{ const float rm=rowmax(P0,P1); resc=false; \
    { const float dl=rm; mhat=fadd_s(mhat,dl); \
      _Pragma("unroll") for(int r=0;r<16;++r){P0[r]=fsub_s(P0[r],dl);P1[r]=fsub_s(P1[r],dl);} \
      _Pragma("unroll") for(int r=0;r<16;++r)negm[r]=-mhat; asm volatile("":"+v"(negm)); } \
    _Pragma("unroll") for(int r=0;r<16;++r)P0[r]=__builtin_amdgcn_exp2f(P0[r]); }while(0)
  #define RESC() do{ if(resc){ asm volatile("s_waitcnt lgkmcnt(0)":::"memory"); \
      _Pragma("unroll") for(int d_=0;d_<2;++d_) _Pragma("unroll") for(int r=0;r<16;++r)o[d_][r]*=wsf[crow(r,hi)]; } }while(0)
  f32x16 pA0,pA1,pB0,pB1;
  int sl_prev=0,sl_cur=0,sl_next=SLOTB;
  #define ROT() do{sl_prev=sl_cur;sl_cur=sl_next;sl_next=(sl_next==(NSLOT-1)*SLOTB)?0:sl_next+SLOTB;}while(0)
  DMA_K(2,2*SLOTB);
  WAIT_BAR(3);
  qkt(pA0,pA1,Kbase,qr,negm,r32,hi);asm volatile("s_nop 15\n\ts_nop 7":"+v"(pA0),"+v"(pA1));CMASK(pA0,pA1,0);
  START(pA0,pA1);
  _Pragma("unroll") for(int r=0;r<16;++r)pA1[r]=__builtin_amdgcn_exp2f(pA1[r]);
  WAIT_BAR(0);
  DMA_K(3,0);DMA_V(1,SLOTB);
  ROT();
  kload8(kf,kp0+sl_cur);
  WAIT_BAR(2);
  s16x4 vlo[8],vhi[8]; u32x4 pw0,pw1,pw2,pw3;
  #define PKW(P,B) cvtpk_s(P[B],P[B+1])
  #define PAF(k) __builtin_bit_cast(bf16x8,pw##k)
  #define VFR(i) (bf16x8){vlo[i][0],vlo[i][1],vlo[i][2],vlo[i][3],vhi[i][0],vhi[i][1],vhi[i][2],vhi[i][3]}
  #define PIN(x) asm volatile("":"+v"(x))
  #define MX3(a,b,c) __builtin_fmaxf(__builtin_fmaxf((a),(b)),(c))
  #define GAPA(MF,A0,A1,A2,A3,W0,W1,PW) do{ MF; sacc+=A0; sacc+=A1; sacc+=A2; sacc+=A3; PIN(sacc); W0; W1; PIN(PW); SBAR(); }while(0)
  #define EX(v) __builtin_amdgcn_exp2f(v)
  #define GAPB(MF,X,B) do{ MF; X[B]=EX(X[B]); X[B+1]=EX(X[B+1]); X[B+2]=EX(X[B+2]); X[B+3]=EX(X[B+3]); PIN(X); SBAR(); }while(0)
  #define VRD(i) do{ vlo[i]=vtr(vp_+(((i)>>2)*4096+((i)&3)*1024)); vhi[i]=vtr(vp_+(((i)>>2)*4096+((i)&3)*1024+512)); }while(0)
  #define KRD(G,j) do{ if(G){ kload2(kf,kp0+sl_next,j); SBAR(); } }while(0)
  #define STEP(C0,C1,P0,P1,t,GK,GV,GL) do{ SBAR(); \
    const lds_cptr vp_=vp0+sl_prev; \
    VRD(0); SBAR(); float sacc=(P0[0]+P0[1]); \
    GAPA(C0=__builtin_amdgcn_mfma_f32_32x32x16_bf16(kf[0],qr[0],negm,0,0,0), P0[2],P0[3],P0[4],P0[5],     pw0[0]=PKW(P0,0), pw0[1]=PKW(P0,2), pw0); \
    VRD(4); SBAR(); GAPA(C1=__builtin_amdgcn_mfma_f32_32x32x16_bf16(kf[1],qr[0],negm,0,0,0), P0[6],P0[7],P0[8],P0[9],     pw0[2]=PKW(P0,4), pw0[3]=PKW(P0,6), pw0); \
    VRD(1); SBAR(); GAPA(C0=__builtin_amdgcn_mfma_f32_32x32x16_bf16(kf[2],qr[1],C0,0,0,0),   P0[10],P0[11],P0[12],P0[13], pw1[0]=PKW(P0,8), pw1[1]=PKW(P0,10), pw1); \
    VRD(5); SBAR(); GAPA(C1=__builtin_amdgcn_mfma_f32_32x32x16_bf16(kf[3],qr[1],C1,0,0,0),   P0[14],P0[15],P1[0],P1[1],   pw1[2]=PKW(P0,12),pw1[3]=PKW(P0,14), pw1); \
    VRD(2); SBAR(); GAPA(C0=__builtin_amdgcn_mfma_f32_32x32x16_bf16(kf[4],qr[2],C0,0,0,0),   P1[2],P1[3],P1[4],P1[5],     pw2[0]=PKW(P1,0), pw2[1]=PKW(P1,2), pw2); \
    VRD(6); SBAR(); GAPA(C1=__builtin_amdgcn_mfma_f32_32x32x16_bf16(kf[5],qr[2],C1,0,0,0),   P1[6],P1[7],P1[8],P1[9],     pw2[2]=PKW(P1,4), pw2[3]=PKW(P1,6), pw2); \
    VRD(3); SBAR(); GAPA(C0=__builtin_amdgcn_mfma_f32_32x32x16_bf16(kf[6],qr[3],C0,0,0,0),   P1[10],P1[11],P1[12],P1[13], pw3[0]=PKW(P1,8), pw3[1]=PKW(P1,10), pw3); \
    VRD(7); SBAR(); GAPA(C1=__builtin_amdgcn_mfma_f32_32x32x16_bf16(kf[7],qr[3],C1,0,0,0),   P1[14],P1[15],0.f,0.f,       pw3[2]=PKW(P1,12),pw3[3]=PKW(P1,14), pw3); \
    l_reg+=sacc; \
    if(GK){DMA_K((t)+3,sl_cur);} if(GV){DMA_V((t)+1,sl_next);} \
    CMASK(C0,C1,t); \
    { float a=MX3(C0[0],C0[1],C1[0]),b=MX3(C0[2],C0[3],C1[1]); a=MX3(a,C1[2],C1[3]); \
      _Pragma("unroll") for(int r=4;r<16;r+=4){a=MX3(a,C0[r],C0[r+1]);b=MX3(b,C0[r+2],C0[r+3]);a=MX3(a,C1[r],C1[r+1]);b=MX3(b,C1[r+2],C1[r+3]);} \
      float rm=__builtin_fmaxf(a,b); { auto rr=__builtin_amdgcn_permlane32_swap(__float_as_uint(rm),__float_as_uint(rm),false,false); rm=__builtin_fmaxf(__uint_as_float(rr[0]),__uint_as_float(rr[1])); } \
      resc=false; \
      if(__builtin_expect(__any(rm>(float)THRL),0)){ const float dl=__builtin_fmaxf(rm,0.f); mhat+=dl; \
        _Pragma("unroll") for(int r=0;r<16;++r){C0[r]-=dl;C1[r]-=dl;} \
        _Pragma("unroll") for(int r=0;r<16;++r)negm[r]=-mhat; asm volatile("":"+v"(negm)); \
        const float f=__builtin_amdgcn_exp2f(-dl); l_reg*=f; if(hi==0)wsf[r32]=f; resc=true; } } \
    SBAR(); \
    GAPB(o[0]=__builtin_amdgcn_mfma_f32_32x32x16_bf16(PAF(0),VFR(0),o[0],0,0,0), C0,0); \
    GAPB(o[1]=__builtin_amdgcn_mfma_f32_32x32x16_bf16(PAF(0),VFR(4),o[1],0,0,0), C0,4); \
    KRD(GL,0); GAPB(o[0]=__builtin_amdgcn_mfma_f32_32x32x16_bf16(PAF(1),VFR(1),o[0],0,0,0), C0,8); \
    KRD(GL,1); GAPB(o[1]=__builtin_amdgcn_mfma_f32_32x32x16_bf16(PAF(1),VFR(5),o[1],0,0,0), C0,12); \
    KRD(GL,2); GAPB(o[0]=__builtin_amdgcn_mfma_f32_32x32x16_bf16(PAF(2),VFR(2),o[0],0,0,0), C1,0); \
    KRD(GL,3); GAPB(o[1]=__builtin_amdgcn_mfma_f32_32x32x16_bf16(PAF(2),VFR(6),o[1],0,0,0), C1,4); \
    GAPB(o[0]=__builtin_amdgcn_mfma_f32_32x32x16_bf16(PAF(3),VFR(3),o[0],0,0,0), C1,8); \
    GAPB(o[1]=__builtin_amdgcn_mfma_f32_32x32x16_bf16(PAF(3),VFR(7),o[1],0,0,0), C1,12); \
    }while(0)
  int t=1;
  #undef CMASK
  #define CMASK(P0,P1,t) do{}while(0)
  for(;t+5<NT;t+=2){
    STEP(pB0,pB1,pA0,pA1,t,true,true,true);     WAIT_BAR(2); RESC(); ROT();
    STEP(pA0,pA1,pB0,pB1,t+1,true,true,true);   WAIT_BAR(2); RESC(); ROT();
  }
  #undef CMASK
  #define CMASK(P0,P1,t) do{int jb_=(t)-(NT-4); if(jb_>=0)cmask(P0,P1,jb_,qrel,hi);}while(0)
  #define ENDW(tt) do{ if((tt)+3<NT){WAIT_BAR(2);} else if((tt)+2<NT){WAIT_BAR(1);} else {WAIT_BAR(0);} }while(0)
  for(;t+1<NT;t+=2){
    STEP(pB0,pB1,pA0,pA1,t,(t+3<NT),(t+1<NT),(t+1<NT));       ENDW(t);   RESC(); ROT();
    STEP(pA0,pA1,pB0,pB1,t+1,(t+4<NT),(t+2<NT),(t+2<NT));     ENDW(t+1); RESC(); ROT();
  }
  STEP(pB0,pB1,pA0,pA1,NT-1,false,false,false); RESC();
  { float sacc=pB0[0]+pB0[1]; _Pragma("unroll") for(int r=2;r<16;++r)sacc+=pB0[r]; _Pragma("unroll") for(int r=0;r<16;++r)sacc+=pB1[r]; l_reg+=sacc;
    pw0=(u32x4){PKW(pB0,0),PKW(pB0,2),PKW(pB0,4),PKW(pB0,6)};pw1=(u32x4){PKW(pB0,8),PKW(pB0,10),PKW(pB0,12),PKW(pB0,14)};pw2=(u32x4){PKW(pB1,0),PKW(pB1,2),PKW(pB1,4),PKW(pB1,6)};pw3=(u32x4){PKW(pB1,8),PKW(pB1,10),PKW(pB1,12),PKW(pB1,14)};
    SBAR(); pv(o,vb0+sl_cur,PAF(0),PAF(1),PAF(2),PAF(3)); }
  #undef PKW
  #undef PAF
  #undef VFR
  #undef PIN
  #undef MX3
  #undef GAPA
  #undef GAPB
  #undef EX
  #undef VRD
  #undef KRD
  #undef STEP
  #undef ENDW
  {auto rr=__builtin_amdgcn_permlane32_swap(__float_as_uint(l_reg),__float_as_uint(l_reg),false,false);l_reg=__uint_as_float(rr[0])+__uint_as_float(rr[1]);}
  if(hi==0)wsf[32+r32]=l_reg;asm volatile("s_waitcnt lgkmcnt(0)":::"memory");
  float rli[16];
  #pragma unroll
  for(int r=0;r<16;++r)rli[r]=__builtin_amdgcn_rcpf(wsf[32+crow(r,hi)]);
  bf16*Ow=O+(rowbase+q0+wid*QBLK)*DM+h*D;
  { bf16*stg=(bf16*)(shm+LDS_OST)+wid*2048;
    #pragma unroll
    for(int r=0;r<16;++r){const int orow=crow(r,hi);
      #pragma unroll
      for(int d0=0;d0<2;++d0)stg[orow*64+d0*32+r32]=__float2bfloat16(o[d0][r]*rli[r]);}
    asm volatile("s_waitcnt lgkmcnt(0)":::"memory");
    #pragma unroll
    for(int i=0;i<4;++i){const int row=i*8+(lane>>3),ch=lane&7; const u32x4 v=*(const u32x4*)(stg+row*64+ch*8); ATTN_STORE16(Ow+(long)row*DM+ch*8,v);} }
  asm volatile("s_waitcnt lgkmcnt(0)\n\ts_barrier":::"memory");
  #undef DMA_K
  #undef DMA_V
  #undef CMASK
  #undef START
  #undef RESC
  #undef ROT
}
constexpr int V2SLOT=16384;
constexpr int L2_K=0, L2_V=NSLOT*SLOTB, L2_WS=L2_V+NSLOT*V2SLOT, L2_OST=L2_WS+NW*64*4, L2_BYTES=L2_OST+NW*4096;
__device__ __forceinline__ void pv4(f32x16*o,int vb,bf16x8 pa0,bf16x8 pa1,bf16x8 pa2,bf16x8 pa3){
  #pragma unroll
  for(int d0=0;d0<4;++d0){s16x4 lo[4],hi[4];
    #pragma unroll
    for(int ks=0;ks<4;++ks){
      asm volatile("ds_read_b64_tr_b16 %0,%1 offset:%c2":"=&v"(lo[ks]):"v"(vb),"i"(d0*4096+ks*1024):"memory");
      asm volatile("ds_read_b64_tr_b16 %0,%1 offset:%c2":"=&v"(hi[ks]):"v"(vb),"i"(d0*4096+ks*1024+512):"memory");}
    asm volatile("s_waitcnt lgkmcnt(0)":::"memory");SBAR();
    #define PK(k) (bf16x8){lo[k][0],lo[k][1],lo[k][2],lo[k][3],hi[k][0],hi[k][1],hi[k][2],hi[k][3]}
    o[d0]=__builtin_amdgcn_mfma_f32_32x32x16_bf16(pa0,PK(0),o[d0],0,0,0);
    o[d0]=__builtin_amdgcn_mfma_f32_32x32x16_bf16(pa1,PK(1),o[d0],0,0,0);
    o[d0]=__builtin_amdgcn_mfma_f32_32x32x16_bf16(pa2,PK(2),o[d0],0,0,0);
    o[d0]=__builtin_amdgcn_mfma_f32_32x32x16_bf16(pa3,PK(3),o[d0],0,0,0);
    #undef PK
  }
}
template<int THRL> __device__ __forceinline__ void attn_unit2(int b,int qb,const bf16*Q,const bf16*__restrict__ K,const bf16*__restrict__ V,bf16*O,char*shm){
  int tid_=threadIdx.x; asm volatile("":"+v"(tid_)); const int tid=tid_,lane=tid&63,r32=lane&31,hi=lane>>5; const int wid=__builtin_amdgcn_readfirstlane(tid>>6);
  const long rowbase=(long)b*SEQ; const int q0=qb*QB;
  if(wid>=4)__builtin_amdgcn_s_setprio(1);
  const bf16*Qw=Q+(rowbase+q0+wid*QBLK)*DM;
  const bf16*Kh=K+rowbase*DM,*Vh=V+rowbase*DM;
  const unsigned lds0=(unsigned)(uintptr_t)shm;
  float*wsf=(float*)(shm+L2_WS)+wid*64;
  const bf16*ksrc=Kh+(long)lane*DM+wid*8;
  const bf16*vsrc=Vh+(long)(16*(wid&3)+(lane>>2))*DM+(wid>>2)*32+(lane&3)*8;
  const unsigned kdst=lds0+L2_K+wid*1024, vdst=lds0+L2_V+wid*1024;
  #define DMA_K(t,slot) glds16(ksrc+(long)(t)*KVBLK*DM,(unsigned)__builtin_amdgcn_readfirstlane(kdst+(slot)))
  #define DMA_V(t,slot) do{ glds16(vsrc+(long)(t)*KVBLK*DM,(unsigned)__builtin_amdgcn_readfirstlane(vdst+2*(slot))); glds16(vsrc+64+(long)(t)*KVBLK*DM,(unsigned)__builtin_amdgcn_readfirstlane(vdst+2*(slot)+8192)); }while(0)
  const int vb0=(int)(lds0+L2_V)+((lane>>4)&1)*32+(lane&3)*8+(4*hi+((lane&15)>>2))*64;
  const char*Kbase=shm+L2_K; bf16x8 kf[8];
  const lds_cptr shm3=(lds_cptr)shm; const lds_cptr kp0=shm3+L2_K+hi*1024+r32*16; const lds_cptr vp0=shm3+L2_V+((lane>>4)&1)*32+(lane&3)*8+(4*hi+((lane&15)>>2))*64;
  const int NT=(q0+QB)/KVBLK;
  DMA_K(0,0);DMA_V(0,0);DMA_K(1,SLOTB);
  bf16x8 qr[4];
  #pragma unroll
  for(int d0=0;d0<4;++d0)qr[d0]=*reinterpret_cast<const bf16x8*>(&Qw[(long)r32*DM+d0*16+hi*8]);
  float mhat=0.f,l_reg=0.f;f32x16 o[4];o[0]=f32x16{};o[1]=f32x16{};o[2]=f32x16{};o[3]=f32x16{};f32x16 negm=f32x16{};asm volatile("":"+v"(negm));
  const int qrel=wid*QBLK+r32;
  #define CMASK(P0,P1,t) do{int jb_=(t)-(NT-4); if(jb_>=0)cmask(P0,P1,jb_,qrel,hi);}while(0)
  bool resc=false;
  #define START(P0,P1) do{ const float rm=rowmax(P0,P1); resc=false; \
    { const float dl=rm; mhat=fadd_s(mhat,dl); \
      _Pragma("unroll") for(int r=0;r<16;++r){P0[r]=fsub_s(P0[r],dl);P1[r]=fsub_s(P1[r],dl);} \
      _Pragma("unroll") for(int r=0;r<16;++r)negm[r]=-mhat; asm volatile("":"+v"(negm)); } \
    _Pragma("unroll") for(int r=0;r<16;++r)P0[r]=__builtin_amdgcn_exp2f(P0[r]); }while(0)
  #define RESC() do{ if(resc){ asm volatile("s_waitcnt lgkmcnt(0)":::"memory"); \
      _Pragma("unroll") for(int d_=0;d_<4;++d_) _Pragma("unroll") for(int r=0;r<16;++r)o[d_][r]*=wsf[crow(r,hi)]; } }while(0)
  f32x16 pA0,pA1,pB0,pB1;
  int sl_prev=0,sl_cur=0,sl_next=SLOTB;
  #define ROT() do{sl_prev=sl_cur;sl_cur=sl_next;sl_next=(sl_next==(NSLOT-1)*SLOTB)?0:sl_next+SLOTB;}while(0)
  DMA_K(2,2*SLOTB);
  WAIT_BAR(4);
  qkt(pA0,pA1,Kbase,qr,negm,r32,hi);asm volatile("s_nop 15\n\ts_nop 7":"+v"(pA0),"+v"(pA1));CMASK(pA0,pA1,0);
  START(pA0,pA1);
  _Pragma("unroll") for(int r=0;r<16;++r)pA1[r]=__builtin_amdgcn_exp2f(pA1[r]);
  WAIT_BAR(0);
  DMA_K(3,0);DMA_V(1,SLOTB);
  ROT();
  kload8(kf,kp0+sl_cur);
  WAIT_BAR(3);
  s16x4 vlo[8],vhi[8]; u32x4 pw0,pw1,pw2,pw3;
  #define VRD2(rg,i) do{ vlo[rg]=vtr(vp_+(((i)>>2)*4096+((i)&3)*1024)); vhi[rg]=vtr(vp_+(((i)>>2)*4096+((i)&3)*1024+512)); }while(0)
  #define GAPB2(MF,X,B) do{ MF; X[B]=EX(X[B]); X[B+1]=EX(X[B+1]); PIN(X); SBAR(); }while(0)
  #define PKW(P,B) cvtpk_s(P[B],P[B+1])
  #define PAF(k) __builtin_bit_cast(bf16x8,pw##k)
  #define VFR(i) (bf16x8){vlo[i][0],vlo[i][1],vlo[i][2],vlo[i][3],vhi[i][0],vhi[i][1],vhi[i][2],vhi[i][3]}
  #define PIN(x) asm volatile("":"+v"(x))
  #define MX3(a,b,c) __builtin_fmaxf(__builtin_fmaxf((a),(b)),(c))
  #define GAPA(MF,A0,A1,A2,A3,W0,W1,PW) do{ MF; sacc+=A0; sacc+=A1; sacc+=A2; sacc+=A3; PIN(sacc); W0; W1; PIN(PW); SBAR(); }while(0)
  #define EX(v) __builtin_amdgcn_exp2f(v)
  #define GAPB(MF,X,B) do{ MF; X[B]=EX(X[B]); X[B+1]=EX(X[B+1]); X[B+2]=EX(X[B+2]); X[B+3]=EX(X[B+3]); PIN(X); SBAR(); }while(0)
  #define VRD(i) do{ vlo[i]=vtr(vp_+(((i)>>2)*4096+((i)&3)*1024)); vhi[i]=vtr(vp_+(((i)>>2)*4096+((i)&3)*1024+512)); }while(0)
  #define KRD(G,j) do{ if(G){ kload2(kf,kp0+sl_next,j); SBAR(); } }while(0)
  #define STEP(C0,C1,P0,P1,t,GK,GV,GL) do{ SBAR(); \
    const lds_cptr vp_=vp0+2*sl_prev; \
    VRD2(0,0); SBAR(); float sacc=(P0[0]+P0[1]); \
    GAPA(C0=__builtin_amdgcn_mfma_f32_32x32x16_bf16(kf[0],qr[0],negm,0,0,0), P0[2],P0[3],P0[4],P0[5],     pw0[0]=PKW(P0,0), pw0[1]=PKW(P0,2), pw0); \
    VRD2(1,4); SBAR(); GAPA(C1=__builtin_amdgcn_mfma_f32_32x32x16_bf16(kf[1],qr[0],negm,0,0,0), P0[6],P0[7],P0[8],P0[9],     pw0[2]=PKW(P0,4), pw0[3]=PKW(P0,6), pw0); \
    VRD2(2,8); SBAR(); GAPA(C0=__builtin_amdgcn_mfma_f32_32x32x16_bf16(kf[2],qr[1],C0,0,0,0),   P0[10],P0[11],P0[12],P0[13], pw1[0]=PKW(P0,8), pw1[1]=PKW(P0,10), pw1); \
    VRD2(3,12); SBAR(); GAPA(C1=__builtin_amdgcn_mfma_f32_32x32x16_bf16(kf[3],qr[1],C1,0,0,0),   P0[14],P0[15],P1[0],P1[1],   pw1[2]=PKW(P0,12),pw1[3]=PKW(P0,14), pw1); \
    VRD2(4,1); SBAR(); GAPA(C0=__builtin_amdgcn_mfma_f32_32x32x16_bf16(kf[4],qr[2],C0,0,0,0),   P1[2],P1[3],P1[4],P1[5],     pw2[0]=PKW(P1,0), pw2[1]=PKW(P1,2), pw2); \
    VRD2(5,5); SBAR(); GAPA(C1=__builtin_amdgcn_mfma_f32_32x32x16_bf16(kf[5],qr[2],C1,0,0,0),   P1[6],P1[7],P1[8],P1[9],     pw2[2]=PKW(P1,4), pw2[3]=PKW(P1,6), pw2); \
    VRD2(6,9); SBAR(); GAPA(C0=__builtin_amdgcn_mfma_f32_32x32x16_bf16(kf[6],qr[3],C0,0,0,0),   P1[10],P1[11],P1[12],P1[13], pw3[0]=PKW(P1,8), pw3[1]=PKW(P1,10), pw3); \
    VRD2(7,13); SBAR(); GAPA(C1=__builtin_amdgcn_mfma_f32_32x32x16_bf16(kf[7],qr[3],C1,0,0,0),   P1[14],P1[15],0.f,0.f,       pw3[2]=PKW(P1,12),pw3[3]=PKW(P1,14), pw3); \
    l_reg+=sacc; \
    if(GK){DMA_K((t)+3,sl_cur);} if(GV){DMA_V((t)+1,sl_next);} \
    CMASK(C0,C1,t); \
    { float a=MX3(C0[0],C0[1],C1[0]),b=MX3(C0[2],C0[3],C1[1]); a=MX3(a,C1[2],C1[3]); \
      _Pragma("unroll") for(int r=4;r<16;r+=4){a=MX3(a,C0[r],C0[r+1]);b=MX3(b,C0[r+2],C0[r+3]);a=MX3(a,C1[r],C1[r+1]);b=MX3(b,C1[r+2],C1[r+3]);} \
      float rm=__builtin_fmaxf(a,b); { auto rr=__builtin_amdgcn_permlane32_swap(__float_as_uint(rm),__float_as_uint(rm),false,false); rm=__builtin_fmaxf(__uint_as_float(rr[0]),__uint_as_float(rr[1])); } \
      resc=false; \
      if(__builtin_expect(__any(rm>(float)THRL),0)){ const float dl=__builtin_fmaxf(rm,0.f); mhat+=dl; \
        _Pragma("unroll") for(int r=0;r<16;++r){C0[r]-=dl;C1[r]-=dl;} \
        _Pragma("unroll") for(int r=0;r<16;++r)negm[r]=-mhat; asm volatile("":"+v"(negm)); \
        const float f=__builtin_amdgcn_exp2f(-dl); l_reg*=f; if(hi==0)wsf[r32]=f; resc=true; } } \
    SBAR(); \
    GAPB2(o[0]=__builtin_amdgcn_mfma_f32_32x32x16_bf16(PAF(0),VFR(0),o[0],0,0,0), C0,0); VRD2(0,2); SBAR(); \
    GAPB2(o[1]=__builtin_amdgcn_mfma_f32_32x32x16_bf16(PAF(0),VFR(1),o[1],0,0,0), C0,2); VRD2(1,6); SBAR(); \
    GAPB2(o[2]=__builtin_amdgcn_mfma_f32_32x32x16_bf16(PAF(0),VFR(2),o[2],0,0,0), C0,4); VRD2(2,10); SBAR(); \
    GAPB2(o[3]=__builtin_amdgcn_mfma_f32_32x32x16_bf16(PAF(0),VFR(3),o[3],0,0,0), C0,6); VRD2(3,14); SBAR(); \
    GAPB2(o[0]=__builtin_amdgcn_mfma_f32_32x32x16_bf16(PAF(1),VFR(4),o[0],0,0,0), C0,8); VRD2(4,3); SBAR(); \
    GAPB2(o[1]=__builtin_amdgcn_mfma_f32_32x32x16_bf16(PAF(1),VFR(5),o[1],0,0,0), C0,10); VRD2(5,7); SBAR(); \
    GAPB2(o[2]=__builtin_amdgcn_mfma_f32_32x32x16_bf16(PAF(1),VFR(6),o[2],0,0,0), C0,12); VRD2(6,11); SBAR(); \
    GAPB2(o[3]=__builtin_amdgcn_mfma_f32_32x32x16_bf16(PAF(1),VFR(7),o[3],0,0,0), C0,14); VRD2(7,15); SBAR(); \
    KRD(GL,0); GAPB2(o[0]=__builtin_amdgcn_mfma_f32_32x32x16_bf16(PAF(2),VFR(0),o[0],0,0,0), C1,0); \
    KRD(GL,1); GAPB2(o[1]=__builtin_amdgcn_mfma_f32_32x32x16_bf16(PAF(2),VFR(1),o[1],0,0,0), C1,2); \
    KRD(GL,2); GAPB2(o[2]=__builtin_amdgcn_mfma_f32_32x32x16_bf16(PAF(2),VFR(2),o[2],0,0,0), C1,4); \
    KRD(GL,3); GAPB2(o[3]=__builtin_amdgcn_mfma_f32_32x32x16_bf16(PAF(2),VFR(3),o[3],0,0,0), C1,6); \
    GAPB2(o[0]=__builtin_amdgcn_mfma_f32_32x32x16_bf16(PAF(3),VFR(4),o[0],0,0,0), C1,8); \
    GAPB2(o[1]=__builtin_amdgcn_mfma_f32_32x32x16_bf16(PAF(3),VFR(5),o[1],0,0,0), C1,10); \
    GAPB2(o[2]=__builtin_amdgcn_mfma_f32_32x32x16_bf16(PAF(3),VFR(6),o[2],0,0,0), C1,12); \
    GAPB2(o[3]=__builtin_amdgcn_mfma_f32_32x32x16_bf16(PAF(3),VFR(7),o[3],0,0,0), C1,14); \
    }while(0)
  int t=1;
  #undef CMASK
  #define CMASK(P0,P1,t) do{}while(0)
  for(;t+5<NT;t+=2){
    STEP(pB0,pB1,pA0,pA1,t,true,true,true);     WAIT_BAR(3); RESC(); ROT();
    STEP(pA0,pA1,pB0,pB1,t+1,true,true,true);   WAIT_BAR(3); RESC(); ROT();
  }
  #undef CMASK
  #define CMASK(P0,P1,t) do{int jb_=(t)-(NT-4); if(jb_>=0)cmask(P0,P1,jb_,qrel,hi);}while(0)
  #define ENDW(tt) do{ if((tt)+3<NT){WAIT_BAR(3);} else if((tt)+2<NT){WAIT_BAR(2);} else {WAIT_BAR(0);} }while(0)
  for(;t+1<NT;t+=2){
    STEP(pB0,pB1,pA0,pA1,t,(t+3<NT),(t+1<NT),(t+1<NT));       ENDW(t);   RESC(); ROT();
    STEP(pA0,pA1,pB0,pB1,t+1,(t+4<NT),(t+2<NT),(t+2<NT));     ENDW(t+1); RESC(); ROT();
  }
  STEP(pB0,pB1,pA0,pA1,NT-1,false,false,false); RESC();
  { float sacc=pB0[0]+pB0[1]; _Pragma("unroll") for(int r=2;r<16;++r)sacc+=pB0[r]; _Pragma("unroll") for(int r=0;r<16;++r)sacc+=pB1[r]; l_reg+=sacc;
    pw0=(u32x4){PKW(pB0,0),PKW(pB0,2),PKW(pB0,4),PKW(pB0,6)};pw1=(u32x4){PKW(pB0,8),PKW(pB0,10),PKW(pB0,12),PKW(pB0,14)};pw2=(u32x4){PKW(pB1,0),PKW(pB1,2),PKW(pB1,4),PKW(pB1,6)};pw3=(u32x4){PKW(pB1,8),PKW(pB1,10),PKW(pB1,12),PKW(pB1,14)};
    SBAR(); pv4(o,vb0+2*sl_cur,PAF(0),PAF(1),PAF(2),PAF(3)); }
  #undef PKW
  #undef PAF
  #undef VFR
  #undef PIN
  #undef MX3
  #undef GAPA
  #undef GAPB
  #undef EX
  #undef VRD
  #undef VRD2
  #undef GAPB2
  #undef KRD
  #undef STEP
  #undef ENDW
  {auto rr=__builtin_amdgcn_permlane32_swap(__float_as_uint(l_reg),__float_as_uint(l_reg),false,false);l_reg=__uint_as_float(rr[0])+__uint_as_float(rr[1]);}
  if(hi==0)wsf[32+r32]=l_reg;asm volatile("s_waitcnt lgkmcnt(0)":::"memory");
  float rli[16];
  #pragma unroll
  for(int r=0;r<16;++r)rli[r]=__builtin_amdgcn_rcpf(wsf[32+crow(r,hi)]);
  bf16*Ow=O+(rowbase+q0+wid*QBLK)*DM;
  { bf16*stg=(bf16*)(shm+L2_OST)+wid*2048;
    #pragma unroll
    for(int hf=0;hf<2;++hf){
      #pragma unroll
      for(int r=0;r<16;++r){const int orow=crow(r,hi);
        #pragma unroll
        for(int d0=0;d0<2;++d0)stg[orow*64+d0*32+r32]=__float2bfloat16(o[2*hf+d0][r]*rli[r]);}
      asm volatile("s_waitcnt lgkmcnt(0)":::"memory");
      #pragma unroll
      for(int i=0;i<4;++i){const int row=i*8+(lane>>3),ch=lane&7; const u32x4 v=*(const u32x4*)(stg+row*64+ch*8); ATTN_STORE16(Ow+(long)row*DM+hf*64+ch*8,v);}
      asm volatile("s_waitcnt lgkmcnt(0)":::"memory"); } }
  asm volatile("s_waitcnt lgkmcnt(0)\n\ts_barrier":::"memory");
  __builtin_amdgcn_s_setprio(0);
  #undef DMA_K
  #undef DMA_V
  #undef CMASK
  #undef START
  #undef RESC
  #undef ROT
}

__device__ __forceinline__ void wmask(f32x16&p0,f32x16&p1,int thr,int hi){
  const float NEG=-INFINITY; const int kb=4*hi;
  #pragma unroll
  for(int r=0;r<16;++r){const int kv=kb+(r&3)+8*(r>>2); if(kv<thr)p0[r]=NEG; if(kv+32<thr)p1[r]=NEG;}
}
__device__ __forceinline__ void cmask2(f32x16&p0,f32x16&p1,int nb,int lim,int hi){
  const float NEG=-INFINITY; const int kb=nb+4*hi;
  #pragma unroll
  for(int r=0;r<16;++r){const int kv=kb+(r&3)+8*(r>>2); if(kv>lim)p0[r]=NEG; if(kv+32>lim)p1[r]=NEG;}
}
template<int THRL,int MODE,int PQ,int PKV,int PO> __device__ __forceinline__ void attn_unitN(int q0,int NT,const bf16*Qw0,const bf16*__restrict__ Kh,const bf16*__restrict__ Vh,bf16*Ow0,char*shm){
  int tid_=threadIdx.x; asm volatile("":"+v"(tid_)); const int tid=tid_,lane=tid&63,r32=lane&31,hi=lane>>5; const int wid=__builtin_amdgcn_readfirstlane(tid>>6);
  const bf16*Qw=Qw0+(long)(wid*QBLK)*PQ;
  const unsigned lds0=(unsigned)(uintptr_t)shm;
  float*wsf=(float*)(shm+LDS_WS)+wid*64;
  const bf16*ksrc=Kh+(long)lane*PKV+wid*8;
  const bf16*vsrc=Vh+(long)(16*(wid&3)+(lane>>2))*PKV+(wid>>2)*32+(lane&3)*8;
  const unsigned kdst=lds0+LDS_K+wid*1024, vdst=lds0+LDS_V+wid*1024;
  #define DMA_K(t,slot) glds16(ksrc+(long)(t)*KVBLK*PKV,(unsigned)__builtin_amdgcn_readfirstlane(kdst+(slot)))
  #define DMA_V(t,slot) glds16(vsrc+(long)(t)*KVBLK*PKV,(unsigned)__builtin_amdgcn_readfirstlane(vdst+(slot)))
  const int vb0=(int)(lds0+LDS_V)+((lane>>4)&1)*32+(lane&3)*8+(4*hi+((lane&15)>>2))*64;
  const char*Kbase=shm+LDS_K; bf16x8 kf[8];
  const lds_cptr shm3=(lds_cptr)shm; const lds_cptr kp0=shm3+LDS_K+hi*1024+r32*16; const lds_cptr vp0=shm3+LDS_V+((lane>>4)&1)*32+(lane&3)*8+(4*hi+((lane&15)>>2))*64;
  DMA_K(0,0);DMA_V(0,0);DMA_K(1,SLOTB);
  bf16x8 qr[4];
  #pragma unroll
  for(int d0=0;d0<4;++d0)qr[d0]=*reinterpret_cast<const bf16x8*>(&Qw[(long)r32*PQ+d0*16+hi*8]);
  float mhat=0.f,l_reg=0.f;f32x16 o[2];o[0]=f32x16{};o[1]=f32x16{};const f32x16 negm=f32x16{};
  const int qrel=wid*QBLK+r32; const int clim=(q0+qrel-31)>>4; (void)clim;
  #define CMASK(P0,P1,t) do{int jb_=(t)-(NT-4); if(jb_>=0){ if(MODE==2)cmask2(P0,P1,64*(t),clim,hi); else cmask(P0,P1,jb_,qrel,hi);} else if(MODE==1&&(t)<NT-8)wmask(P0,P1,qrel-511-64*jb_,hi);}while(0)
  bool resc=false;
  #define START(P0,P1) do{ const float rm=__builtin_fmaxf(rowmax(P0,P1),-32.f); resc=false; \
    { const float dl=rm; mhat=fadd_s(mhat,dl); \
      _Pragma("unroll") for(int r=0;r<16;++r){P0[r]=fsub_s(P0[r],dl);P1[r]=fsub_s(P1[r],dl);} \
      } \
    _Pragma("unroll") for(int r=0;r<16;++r)P0[r]=__builtin_amdgcn_exp2f(P0[r]); }while(0)
  #define RESC() do{ if(resc){ asm volatile("s_waitcnt lgkmcnt(0)":::"memory"); \
      _Pragma("unroll") for(int d_=0;d_<2;++d_) _Pragma("unroll") for(int r=0;r<16;++r)o[d_][r]*=wsf[crow(r,hi)]; } }while(0)
  f32x16 pA0,pA1,pB0,pB1;
  int sl_prev=0,sl_cur=0,sl_next=SLOTB;
  #define ROT() do{sl_prev=sl_cur;sl_cur=sl_next;sl_next=(sl_next==(NSLOT-1)*SLOTB)?0:sl_next+SLOTB;}while(0)
  DMA_K(2,2*SLOTB);
  WAIT_BAR(3);
  qkt(pA0,pA1,Kbase,qr,negm,r32,hi);asm volatile("s_nop 15\n\ts_nop 7":"+v"(pA0),"+v"(pA1));CMASK(pA0,pA1,0);
  START(pA0,pA1);
  _Pragma("unroll") for(int r=0;r<16;++r)pA1[r]=__builtin_amdgcn_exp2f(pA1[r]);
  WAIT_BAR(0);
  DMA_K(3,0);DMA_V(1,SLOTB);
  ROT();
  kload8(kf,kp0+sl_cur);
  WAIT_BAR(2);
  s16x4 vlo[8],vhi[8]; u32x4 pw0,pw1,pw2,pw3;
  #define PKW(P,B) cvtpk_s(P[B],P[B+1])
  #define PAF(k) __builtin_bit_cast(bf16x8,pw##k)
  #define VFR(i) (bf16x8){vlo[i][0],vlo[i][1],vlo[i][2],vlo[i][3],vhi[i][0],vhi[i][1],vhi[i][2],vhi[i][3]}
  #define PIN(x) asm volatile("":"+v"(x))
  #define MX3(a,b,c) __builtin_fmaxf(__builtin_fmaxf((a),(b)),(c))
  #define GAPA(MF,A0,A1,A2,A3,W0,W1,PW) do{ MF; sacc+=A0; sacc+=A1; sacc+=A2; sacc+=A3; PIN(sacc); W0; W1; PIN(PW); SBAR(); }while(0)
  #define EX(v) __builtin_amdgcn_exp2f(v)
  #define GAPB(MF,X,B) do{ MF; X[B]=EX(X[B]); X[B+1]=EX(X[B+1]); X[B+2]=EX(X[B+2]); X[B+3]=EX(X[B+3]); PIN(X); SBAR(); }while(0)
  #define VRD(i) do{ vlo[i]=vtr(vp_+(((i)>>2)*4096+((i)&3)*1024)); vhi[i]=vtr(vp_+(((i)>>2)*4096+((i)&3)*1024+512)); }while(0)
  #define KRD(G,j) do{ if(G){ kload2(kf,kp0+sl_next,j); SBAR(); } }while(0)
  #define STEP(C0,C1,P0,P1,t,GK,GV,GL) do{ SBAR(); \
    const lds_cptr vp_=vp0+sl_prev; \
    VRD(0); SBAR(); float sacc=(P0[0]+P0[1]); \
    GAPA(C0=__builtin_amdgcn_mfma_f32_32x32x16_bf16(kf[0],qr[0],negm,0,0,0), P0[2],P0[3],P0[4],P0[5],     pw0[0]=PKW(P0,0), pw0[1]=PKW(P0,2), pw0); \
    VRD(4); SBAR(); GAPA(C1=__builtin_amdgcn_mfma_f32_32x32x16_bf16(kf[1],qr[0],negm,0,0,0), P0[6],P0[7],P0[8],P0[9],     pw0[2]=PKW(P0,4), pw0[3]=PKW(P0,6), pw0); \
    VRD(1); SBAR(); GAPA(C0=__builtin_amdgcn_mfma_f32_32x32x16_bf16(kf[2],qr[1],C0,0,0,0),   P0[10],P0[11],P0[12],P0[13], pw1[0]=PKW(P0,8), pw1[1]=PKW(P0,10), pw1); \
    VRD(5); SBAR(); GAPA(C1=__builtin_amdgcn_mfma_f32_32x32x16_bf16(kf[3],qr[1],C1,0,0,0),   P0[14],P0[15],P1[0],P1[1],   pw1[2]=PKW(P0,12),pw1[3]=PKW(P0,14), pw1); \
    VRD(2); SBAR(); GAPA(C0=__builtin_amdgcn_mfma_f32_32x32x16_bf16(kf[4],qr[2],C0,0,0,0),   P1[2],P1[3],P1[4],P1[5],     pw2[0]=PKW(P1,0), pw2[1]=PKW(P1,2), pw2); \
    VRD(6); SBAR(); GAPA(C1=__builtin_amdgcn_mfma_f32_32x32x16_bf16(kf[5],qr[2],C1,0,0,0),   P1[6],P1[7],P1[8],P1[9],     pw2[2]=PKW(P1,4), pw2[3]=PKW(P1,6), pw2); \
    VRD(3); SBAR(); GAPA(C0=__builtin_amdgcn_mfma_f32_32x32x16_bf16(kf[6],qr[3],C0,0,0,0),   P1[10],P1[11],P1[12],P1[13], pw3[0]=PKW(P1,8), pw3[1]=PKW(P1,10), pw3); \
    VRD(7); SBAR(); GAPA(C1=__builtin_amdgcn_mfma_f32_32x32x16_bf16(kf[7],qr[3],C1,0,0,0),   P1[14],P1[15],0.f,0.f,       pw3[2]=PKW(P1,12),pw3[3]=PKW(P1,14), pw3); \
    l_reg+=sacc; \
    if(GK){DMA_K((t)+3,sl_cur);} if(GV){DMA_V((t)+1,sl_next);} \
    C0=C0-mhat; C1=C1-mhat; \
    CMASK(C0,C1,t); \
    { float a=MX3(C0[0],C0[1],C1[0]),b=MX3(C0[2],C0[3],C1[1]); a=MX3(a,C1[2],C1[3]); \
      _Pragma("unroll") for(int r=4;r<16;r+=4){a=MX3(a,C0[r],C0[r+1]);b=MX3(b,C0[r+2],C0[r+3]);a=MX3(a,C1[r],C1[r+1]);b=MX3(b,C1[r+2],C1[r+3]);} \
      float rm=__builtin_fmaxf(a,b); { auto rr=__builtin_amdgcn_permlane32_swap(__float_as_uint(rm),__float_as_uint(rm),false,false); rm=__builtin_fmaxf(__uint_as_float(rr[0]),__uint_as_float(rr[1])); } \
      resc=false; \
      if(__builtin_expect(__any(rm>(float)THRL),0)){ const float dl=__builtin_fmaxf(rm,0.f); mhat+=dl; \
        _Pragma("unroll") for(int r=0;r<16;++r){C0[r]-=dl;C1[r]-=dl;} \
        const float f=__builtin_amdgcn_exp2f(-dl); l_reg*=f; if(hi==0)wsf[r32]=f; resc=true; } } \
    SBAR(); \
    GAPB(o[0]=__builtin_amdgcn_mfma_f32_32x32x16_bf16(PAF(0),VFR(0),o[0],0,0,0), C0,0); \
    GAPB(o[1]=__builtin_amdgcn_mfma_f32_32x32x16_bf16(PAF(0),VFR(4),o[1],0,0,0), C0,4); \
    KRD(GL,0); GAPB(o[0]=__builtin_amdgcn_mfma_f32_32x32x16_bf16(PAF(1),VFR(1),o[0],0,0,0), C0,8); \
    KRD(GL,1); GAPB(o[1]=__builtin_amdgcn_mfma_f32_32x32x16_bf16(PAF(1),VFR(5),o[1],0,0,0), C0,12); \
    KRD(GL,2); GAPB(o[0]=__builtin_amdgcn_mfma_f32_32x32x16_bf16(PAF(2),VFR(2),o[0],0,0,0), C1,0); \
    KRD(GL,3); GAPB(o[1]=__builtin_amdgcn_mfma_f32_32x32x16_bf16(PAF(2),VFR(6),o[1],0,0,0), C1,4); \
    GAPB(o[0]=__builtin_amdgcn_mfma_f32_32x32x16_bf16(PAF(3),VFR(3),o[0],0,0,0), C1,8); \
    GAPB(o[1]=__builtin_amdgcn_mfma_f32_32x32x16_bf16(PAF(3),VFR(7),o[1],0,0,0), C1,12); \
    }while(0)
  int t=1;
  #undef CMASK
  #define CMASK(P0,P1,t) do{ if(MODE==1&&(t)<NT-8)wmask(P0,P1,qrel-511-64*((t)-(NT-4)),hi); }while(0)
  for(;t+5<NT;t+=2){
    STEP(pB0,pB1,pA0,pA1,t,true,true,true);     WAIT_BAR(2); RESC(); ROT();
    STEP(pA0,pA1,pB0,pB1,t+1,true,true,true);   WAIT_BAR(2); RESC(); ROT();
  }
  #undef CMASK
  #define CMASK(P0,P1,t) do{int jb_=(t)-(NT-4); if(jb_>=0){ if(MODE==2)cmask2(P0,P1,64*(t),clim,hi); else cmask(P0,P1,jb_,qrel,hi);} else if(MODE==1&&(t)<NT-8)wmask(P0,P1,qrel-511-64*jb_,hi);}while(0)
  #define ENDW(tt) do{ if((tt)+3<NT){WAIT_BAR(2);} else if((tt)+2<NT){WAIT_BAR(1);} else {WAIT_BAR(0);} }while(0)
  for(;t+1<NT;t+=2){
    STEP(pB0,pB1,pA0,pA1,t,(t+3<NT),(t+1<NT),(t+1<NT));       ENDW(t);   RESC(); ROT();
    STEP(pA0,pA1,pB0,pB1,t+1,(t+4<NT),(t+2<NT),(t+2<NT));     ENDW(t+1); RESC(); ROT();
  }
  STEP(pB0,pB1,pA0,pA1,NT-1,false,false,false); RESC();
  { float sacc=pB0[0]+pB0[1]; _Pragma("unroll") for(int r=2;r<16;++r)sacc+=pB0[r]; _Pragma("unroll") for(int r=0;r<16;++r)sacc+=pB1[r]; l_reg+=sacc;
    pw0=(u32x4){PKW(pB0,0),PKW(pB0,2),PKW(pB0,4),PKW(pB0,6)};pw1=(u32x4){PKW(pB0,8),PKW(pB0,10),PKW(pB0,12),PKW(pB0,14)};pw2=(u32x4){PKW(pB1,0),PKW(pB1,2),PKW(pB1,4),PKW(pB1,6)};pw3=(u32x4){PKW(pB1,8),PKW(pB1,10),PKW(pB1,12),PKW(pB1,14)};
    SBAR(); pv(o,vb0+sl_cur,PAF(0),PAF(1),PAF(2),PAF(3)); }
  #undef PKW
  #undef PAF
  #undef VFR
  #undef PIN
  #undef MX3
  #undef GAPA
  #undef GAPB
  #undef EX
  #undef VRD
  #undef KRD
  #undef STEP
  #undef ENDW
  {auto rr=__builtin_amdgcn_permlane32_swap(__float_as_uint(l_reg),__float_as_uint(l_reg),false,false);l_reg=__uint_as_float(rr[0])+__uint_as_float(rr[1]);}
  if(hi==0)wsf[32+r32]=l_reg;asm volatile("s_waitcnt lgkmcnt(0)":::"memory");
  float rli[16];
  #pragma unroll
  for(int r=0;r<16;++r){const float lv=wsf[32+crow(r,hi)]; rli[r]=lv>0.f?__builtin_amdgcn_rcpf(lv):0.f;}
  bf16*Ow=Ow0+(long)(wid*QBLK)*PO;
  { bf16*stg=(bf16*)(shm+LDS_OST)+wid*2048;
    #pragma unroll
    for(int r=0;r<16;++r){const int orow=crow(r,hi);
      #pragma unroll
      for(int d0=0;d0<2;++d0)stg[orow*64+d0*32+r32]=__float2bfloat16(o[d0][r]*rli[r]);}
    asm volatile("s_waitcnt lgkmcnt(0)":::"memory");
    #pragma unroll
    for(int i=0;i<4;++i){const int row=i*8+(lane>>3),ch=lane&7; const u32x4 v=*(const u32x4*)(stg+row*64+ch*8); ATTN_STORE16(Ow+(long)row*PO+ch*8,v);} }
  asm volatile("s_waitcnt lgkmcnt(0)\n\ts_barrier":::"memory");
  #undef DMA_K
  #undef DMA_V
  #undef CMASK
  #undef START
  #undef RESC
  #undef ROT
}

__device__ __forceinline__ void nsa_window_phase(char*lds,const bf16*P,bf16*OW,unsigned*qc,volatile __attribute__((address_space(3))) unsigned*qw){
  for(;;){
    if(threadIdx.x==0) qw[0]=__hip_atomic_fetch_add(qc,1u,__ATOMIC_RELAXED,__HIP_MEMORY_SCOPE_AGENT);
    __syncthreads();
    const int u=__builtin_amdgcn_readfirstlane((int)qw[0]);
    __syncthreads();
    if(u>=2048)break;
    const int qb=63-(u&63),bh=u>>6,b=bh>>4,hd=bh&15,g=hd>>3; const int q0=qb*256; const int nt0=q0>=512?q0/64-8:0; const int NT=q0/64+4-nt0;
    const long rowbase=(long)b*SEQ;
    attn_unitN<8,1,2048,2048,1024>(q0,NT,P+(rowbase+q0)*2048+hd*64,P+(rowbase+64*nt0)*2048+1536+g*64,P+(rowbase+64*nt0)*2048+1664+g*64,OW+(rowbase+q0)*1024+hd*64,lds);
  }
}
constexpr int ATTN_LDS_BYTES=LDS_BYTES;
template<int THRL=8> __device__ __forceinline__ void diff_attn_phase(char*lds,const bf16*Q,const bf16*K,const bf16*V,bf16*O0,bf16*O1,int vcu,int G){
  for(int i=0;;++i){
    const int L=__builtin_amdgcn_readfirstlane(vcu+(i>>1)*G); if(L>=2048)break;
    const int combo=L>>5,x=L&31; const int b=combo>>5,hh=(combo>>1)&15,vh=combo&1; const int h=hh>>1,c=hh&1;
    const int qb=(i&1)?63-x:x;
    attn_unit<THRL>(b,0,qb,Q+hh*64,K+hh*64,V+(2*h+vh)*64,(c?O1:O0)+(2*h+vh)*64,lds);
  }
}
template<int THRL=8> __device__ __forceinline__ void diff_attn_phase2(char*lds,const bf16*Q,const bf16*K,const bf16*V,bf16*O0,bf16*O1,int vcu,int G){
  for(int i=0;;++i){
    const int L=__builtin_amdgcn_readfirstlane(vcu+(i>>1)*G); if(L>=1024)break;
    const int combo=L>>5,x=L&31; const int b=combo>>4,hh=combo&15; const int h=hh>>1,c=hh&1;
    const int qb=(i&1)?63-x:x;
    attn_unit2<THRL>(b,qb,Q+hh*64,K+hh*64,V+h*128,(c?O1:O0)+h*128,lds);
  }
}
#undef SBAR
#undef WAIT_BAR
}

namespace nsa {
typedef short bf16x8 __attribute__((ext_vector_type(8)));
typedef float f32x4 __attribute__((ext_vector_type(4)));
typedef unsigned short bf16_t;
constexpr int S = 16384, PITCH = 2048;
constexpr int COL_KS = 1280, COL_VS = 1408, COL_KW = 1536, COL_VW = 1664, COL_G = 1792;
constexpr float NEG = -1e30f;
__device__ __forceinline__ unsigned pk2(float lo, float hi) { typedef float f2 __attribute__((ext_vector_type(2))); typedef __bf16 b2 __attribute__((ext_vector_type(2))); f2 v = {lo, hi}; b2 b = __builtin_convertvector(v, b2); return __builtin_bit_cast(unsigned, b); }
__device__ __forceinline__ float bf2f(bf16_t x) { return __uint_as_float((unsigned)x << 16); }

__device__ __forceinline__ void qk_group(float (&s)[8], const bf16_t* krow0, int kpitch, const bf16x8 (&qf)[2], int n, int q) {
    const bf16_t* kp = krow0 + (size_t)(8 * (n >> 2) + (n & 3)) * kpitch + q * 8;
    const bf16x8 a00 = *(const bf16x8*)(kp), a01 = *(const bf16x8*)(kp + 32);
    const bf16x8 a10 = *(const bf16x8*)(kp + (size_t)4 * kpitch), a11 = *(const bf16x8*)(kp + (size_t)4 * kpitch + 32);
    f32x4 t0 = {0.f, 0.f, 0.f, 0.f}, t1 = {0.f, 0.f, 0.f, 0.f};
    t0 = __builtin_amdgcn_mfma_f32_16x16x32_bf16(a00, qf[0], t0, 0, 0, 0); t0 = __builtin_amdgcn_mfma_f32_16x16x32_bf16(a01, qf[1], t0, 0, 0, 0);
    t1 = __builtin_amdgcn_mfma_f32_16x16x32_bf16(a10, qf[0], t1, 0, 0, 0); t1 = __builtin_amdgcn_mfma_f32_16x16x32_bf16(a11, qf[1], t1, 0, 0, 0);
#pragma unroll
    for (int i = 0; i < 4; ++i) { s[i] = t0[i]; s[4 + i] = t1[i]; }
}
__device__ __forceinline__ void pv_group(f32x4 (&o)[4], const float (&p)[8], const bf16_t* vt, int n, int q) {
    typedef unsigned u32x4 __attribute__((ext_vector_type(4)));
    u32x4 w; w.x = pk2(p[0], p[1]); w.y = pk2(p[2], p[3]); w.z = pk2(p[4], p[5]); w.w = pk2(p[6], p[7]);
    const bf16x8 pf = __builtin_bit_cast(bf16x8, w);
#pragma unroll
    for (int dt = 0; dt < 4; ++dt) { const bf16x8 vf = *(const bf16x8*)(vt + (16 * dt + n) * 32 + q * 8); o[dt] = __builtin_amdgcn_mfma_f32_16x16x32_bf16(vf, pf, o[dt], 0, 0, 0); }
}
struct Run { f32x4 o[4]; float m, l; };
__device__ __forceinline__ void run_init(Run& r) {
#pragma unroll
    for (int dt = 0; dt < 4; ++dt) r.o[dt] = (f32x4){0.f, 0.f, 0.f, 0.f};
    r.m = NEG; r.l = 0.f;
}
struct Frag { bf16x8 k[4]; bf16x8 v[4]; };
__device__ __forceinline__ void load_kt(Frag& f, const bf16_t* kt, int lane) {
#pragma unroll
    for (int i = 0; i < 4; ++i) f.k[i] = *(const bf16x8*)(kt + i * 512 + lane * 8);
}
__device__ __forceinline__ void load_k(Frag& f, const bf16_t* krow0, int kpitch, int n, int q) {
    const bf16_t* kp = krow0 + (size_t)(8 * (n >> 2) + (n & 3)) * kpitch + q * 8;
    f.k[0] = *(const bf16x8*)(kp); f.k[1] = *(const bf16x8*)(kp + 32); f.k[2] = *(const bf16x8*)(kp + (size_t)4 * kpitch); f.k[3] = *(const bf16x8*)(kp + (size_t)4 * kpitch + 32);
}
__device__ __forceinline__ void load_v(Frag& f, const bf16_t* vt, int n, int q) {
#pragma unroll
    for (int dt = 0; dt < 4; ++dt) f.v[dt] = *(const bf16x8*)(vt + (16 * dt + n) * 32 + q * 8);
}
__device__ __forceinline__ void qk_frag(float (&s)[8], const Frag& f, const bf16x8 (&qf)[2]) {
    f32x4 t0 = {0.f, 0.f, 0.f, 0.f}, t1 = {0.f, 0.f, 0.f, 0.f};
    t0 = __builtin_amdgcn_mfma_f32_16x16x32_bf16(f.k[0], qf[0], t0, 0, 0, 0); t0 = __builtin_amdgcn_mfma_f32_16x16x32_bf16(f.k[1], qf[1], t0, 0, 0, 0);
    t1 = __builtin_amdgcn_mfma_f32_16x16x32_bf16(f.k[2], qf[0], t1, 0, 0, 0); t1 = __builtin_amdgcn_mfma_f32_16x16x32_bf16(f.k[3], qf[1], t1, 0, 0, 0);
#pragma unroll
    for (int i = 0; i < 4; ++i) { s[i] = t0[i]; s[4 + i] = t1[i]; }
}
__device__ __forceinline__ void pv_frag(f32x4 (&o)[4], const float (&p)[8], const Frag& f) {
    typedef unsigned u32x4 __attribute__((ext_vector_type(4)));
    u32x4 w; w.x = pk2(p[0], p[1]); w.y = pk2(p[2], p[3]); w.z = pk2(p[4], p[5]); w.w = pk2(p[6], p[7]);
    const bf16x8 pf = __builtin_bit_cast(bf16x8, w);
#pragma unroll
    for (int dt = 0; dt < 4; ++dt) o[dt] = __builtin_amdgcn_mfma_f32_16x16x32_bf16(f.v[dt], pf, o[dt], 0, 0, 0);
}
template<int CTRL> __device__ __forceinline__ float dppf(float v) { return __int_as_float(__builtin_amdgcn_update_dpp(0, __float_as_int(v), CTRL, 0xF, 0xF, false)); }
template<int CTRL> __device__ __forceinline__ int dppi(int v) { return __builtin_amdgcn_update_dpp(0, v, CTRL, 0xF, 0xF, false); }
__device__ __forceinline__ float xmax_q(float v) {
    auto a = __builtin_amdgcn_permlane16_swap(__float_as_uint(v), __float_as_uint(v), false, false); v = fmaxf(__uint_as_float(a[0]), __uint_as_float(a[1]));
    auto b = __builtin_amdgcn_permlane32_swap(__float_as_uint(v), __float_as_uint(v), false, false); return fmaxf(__uint_as_float(b[0]), __uint_as_float(b[1]));
}
__device__ __forceinline__ float xsum_q(float v) {
    auto a = __builtin_amdgcn_permlane16_swap(__float_as_uint(v), __float_as_uint(v), false, false); v = __uint_as_float(a[0]) + __uint_as_float(a[1]);
    auto b = __builtin_amdgcn_permlane32_swap(__float_as_uint(v), __float_as_uint(v), false, false); return __uint_as_float(b[0]) + __uint_as_float(b[1]);
}
__device__ __forceinline__ float sum8(float v) { v += dppf<0x141>(v); v += dppf<0xB1>(v); v += dppf<0x4E>(v); return v; }
template<bool FULL> __device__ __forceinline__ void flash_step(Run& r, const Frag& f, const bf16x8 (&qf)[2], int lo, int hi, bool act, int q) {
    float s[8]; qk_frag(s, f, qf);
    float gm = NEG;
    if (FULL) {
#pragma unroll
        for (int j = 0; j < 8; ++j) { const int kk = 8 * q + j; const bool ok = (kk >= lo) && (kk <= hi); s[j] = ok ? s[j] : NEG; gm = fmaxf(gm, s[j]); }
    } else {
#pragma unroll
        for (int j = 0; j < 8; ++j) gm = fmaxf(gm, s[j]);
        gm = act ? gm : NEG;
    }
    gm = xmax_q(gm);
    const float mn = fmaxf(r.m, gm), sc = __builtin_amdgcn_exp2f(r.m - mn); r.m = mn;
    float p[8], ps = 0.f;
    if (FULL) {
#pragma unroll
        for (int j = 0; j < 8; ++j) { const int kk = 8 * q + j; const bool ok = (kk >= lo) && (kk <= hi); p[j] = ok ? __builtin_amdgcn_exp2f(s[j] - mn) : 0.f; ps += p[j]; }
    } else {
#pragma unroll
        for (int j = 0; j < 8; ++j) { p[j] = __builtin_amdgcn_exp2f(s[j] - mn); ps += p[j]; }
        ps = act ? ps : 0.f;
    }
    r.l = r.l * sc + ps;
    if (__builtin_amdgcn_ballot_w64(sc != 1.0f) != 0ull) {
#pragma unroll
        for (int dt = 0; dt < 4; ++dt) r.o[dt] = r.o[dt] * sc; }
    typedef unsigned u32x4 __attribute__((ext_vector_type(4)));
    u32x4 w; w.x = pk2(p[0], p[1]); w.y = pk2(p[2], p[3]); w.z = pk2(p[4], p[5]); w.w = pk2(p[6], p[7]);
    if (!FULL) { w.x = act ? w.x : 0u; w.y = act ? w.y : 0u; w.z = act ? w.z : 0u; w.w = act ? w.w : 0u; }
    const bf16x8 pf = __builtin_bit_cast(bf16x8, w);
#pragma unroll
    for (int dt = 0; dt < 4; ++dt) r.o[dt] = __builtin_amdgcn_mfma_f32_16x16x32_bf16(f.v[dt], pf, r.o[dt], 0, 0, 0);
}

typedef unsigned u32x4n __attribute__((ext_vector_type(4)));
__device__ __forceinline__ unsigned fp8x4(float a, float b, float c, float d) { int w = __builtin_amdgcn_cvt_pk_fp8_f32(a, b, 0, false); w = __builtin_amdgcn_cvt_pk_fp8_f32(c, d, w, true); return (unsigned)w; }
__device__ __forceinline__ long mk64(unsigned lo, unsigned hi) { return (long)(((unsigned long long)hi << 32) | (unsigned long long)lo); }
struct Frag8 { u32x4n k[2]; u32x4n v[2]; };
__device__ __forceinline__ void load8(Frag8& f, const unsigned char* kb, const unsigned char* vb, int G, int lane) {
    const unsigned char* kp = kb + (size_t)G * 2048 + lane * 16; const unsigned char* vp = vb + (size_t)G * 2048 + lane * 16;
    f.k[0] = *(const u32x4n*)kp; f.k[1] = *(const u32x4n*)(kp + 1024); f.v[0] = *(const u32x4n*)vp; f.v[1] = *(const u32x4n*)(vp + 1024);
}
__device__ __forceinline__ long q_to_fp8(const bf16x8& v) {
    float x[8];
#pragma unroll
    for (int j = 0; j < 8; ++j) x[j] = __uint_as_float((unsigned)(unsigned short)v[j] << 16);
    return mk64(fp8x4(x[0], x[1], x[2], x[3]), fp8x4(x[4], x[5], x[6], x[7]));
}
template<bool FULL> __device__ __forceinline__ void flash_step8(Run& r, const Frag8& f, const long (&q8)[2], int lo, int hi, bool act, int q) {
    f32x4 t0 = {0.f, 0.f, 0.f, 0.f}, t1 = {0.f, 0.f, 0.f, 0.f};
    t0 = __builtin_amdgcn_mfma_f32_16x16x32_fp8_fp8(mk64(f.k[0].x, f.k[0].y), q8[0], t0, 0, 0, 0); t0 = __builtin_amdgcn_mfma_f32_16x16x32_fp8_fp8(mk64(f.k[0].z, f.k[0].w), q8[1], t0, 0, 0, 0);
    t1 = __builtin_amdgcn_mfma_f32_16x16x32_fp8_fp8(mk64(f.k[1].x, f.k[1].y), q8[0], t1, 0, 0, 0); t1 = __builtin_amdgcn_mfma_f32_16x16x32_fp8_fp8(mk64(f.k[1].z, f.k[1].w), q8[1], t1, 0, 0, 0);
    float s[8];
#pragma unroll
    for (int i = 0; i < 4; ++i) { s[i] = t0[i]; s[4 + i] = t1[i]; }
    float gm = NEG;
    if (FULL) {
#pragma unroll
        for (int j = 0; j < 8; ++j) { const int kk = 8 * q + j; const bool ok = (kk >= lo) && (kk <= hi); s[j] = ok ? s[j] : NEG; gm = fmaxf(gm, s[j]); }
    } else {
#pragma unroll
        for (int j = 0; j < 8; ++j) gm = fmaxf(gm, s[j]);
        gm = act ? gm : NEG;
    }
    gm = xmax_q(gm);
    const float mn = fmaxf(r.m, gm), sc = __builtin_amdgcn_exp2f(r.m - mn); r.m = mn;
    float p[8], ps = 0.f; const float mn8 = mn - 8.0f;
    if (FULL) {
#pragma unroll
        for (int j = 0; j < 8; ++j) { const int kk = 8 * q + j; const bool ok = (kk >= lo) && (kk <= hi); p[j] = ok ? __builtin_amdgcn_exp2f(s[j] - mn8) : 0.f; ps += p[j]; }
    } else {
#pragma unroll
        for (int j = 0; j < 8; ++j) { p[j] = __builtin_amdgcn_exp2f(s[j] - mn8); ps += p[j]; }
        ps = act ? ps : 0.f;
    }
    r.l = r.l * sc + ps;
    if (__builtin_amdgcn_ballot_w64(sc != 1.0f) != 0ull) {
#pragma unroll
        for (int dt = 0; dt < 4; ++dt) r.o[dt] = r.o[dt] * sc; }
    unsigned w0 = fp8x4(p[0], p[1], p[2], p[3]), w1 = fp8x4(p[4], p[5], p[6], p[7]);
    if (!FULL) { w0 = act ? w0 : 0u; w1 = act ? w1 : 0u; }
    const long pf = mk64(w0, w1);
    r.o[0] = __builtin_amdgcn_mfma_f32_16x16x32_fp8_fp8(mk64(f.v[0].x, f.v[0].y), pf, r.o[0], 0, 0, 0); r.o[1] = __builtin_amdgcn_mfma_f32_16x16x32_fp8_fp8(mk64(f.v[0].z, f.v[0].w), pf, r.o[1], 0, 0, 0);
    r.o[2] = __builtin_amdgcn_mfma_f32_16x16x32_fp8_fp8(mk64(f.v[1].x, f.v[1].y), pf, r.o[2], 0, 0, 0); r.o[3] = __builtin_amdgcn_mfma_f32_16x16x32_fp8_fp8(mk64(f.v[1].z, f.v[1].w), pf, r.o[3], 0, 0, 0);
}

__device__ __forceinline__ void qk8(float (&s)[8], const Frag8& f, const long (&q8)[2]) {
    f32x4 t0 = {0.f, 0.f, 0.f, 0.f}, t1 = {0.f, 0.f, 0.f, 0.f};
    t0 = __builtin_amdgcn_mfma_f32_16x16x32_fp8_fp8(mk64(f.k[0].x, f.k[0].y), q8[0], t0, 0, 0, 0); t0 = __builtin_amdgcn_mfma_f32_16x16x32_fp8_fp8(mk64(f.k[0].z, f.k[0].w), q8[1], t0, 0, 0, 0);
    t1 = __builtin_amdgcn_mfma_f32_16x16x32_fp8_fp8(mk64(f.k[1].x, f.k[1].y), q8[0], t1, 0, 0, 0); t1 = __builtin_amdgcn_mfma_f32_16x16x32_fp8_fp8(mk64(f.k[1].z, f.k[1].w), q8[1], t1, 0, 0, 0);
#pragma unroll
    for (int i = 0; i < 4; ++i) { s[i] = t0[i]; s[4 + i] = t1[i]; }
}
__device__ __forceinline__ void pv8(f32x4 (&o)[4], const float (&p)[8], const Frag8& f) {
    const long pf = mk64(fp8x4(p[0] * 256.f, p[1] * 256.f, p[2] * 256.f, p[3] * 256.f), fp8x4(p[4] * 256.f, p[5] * 256.f, p[6] * 256.f, p[7] * 256.f));
    o[0] = __builtin_amdgcn_mfma_f32_16x16x32_fp8_fp8(mk64(f.v[0].x, f.v[0].y), pf, o[0], 0, 0, 0); o[1] = __builtin_amdgcn_mfma_f32_16x16x32_fp8_fp8(mk64(f.v[0].z, f.v[0].w), pf, o[1], 0, 0, 0);
    o[2] = __builtin_amdgcn_mfma_f32_16x16x32_fp8_fp8(mk64(f.v[1].x, f.v[1].y), pf, o[2], 0, 0, 0); o[3] = __builtin_amdgcn_mfma_f32_16x16x32_fp8_fp8(mk64(f.v[1].z, f.v[1].w), pf, o[3], 0, 0, 0);
}
__device__ __forceinline__ void pv8s(f32x4 (&o)[4], const float (&p)[8], const Frag8& f) {
    const long pf = mk64(fp8x4(p[0], p[1], p[2], p[3]), fp8x4(p[4], p[5], p[6], p[7]));
    o[0] = __builtin_amdgcn_mfma_f32_16x16x32_fp8_fp8(mk64(f.v[0].x, f.v[0].y), pf, o[0], 0, 0, 0); o[1] = __builtin_amdgcn_mfma_f32_16x16x32_fp8_fp8(mk64(f.v[0].z, f.v[0].w), pf, o[1], 0, 0, 0);
    o[2] = __builtin_amdgcn_mfma_f32_16x16x32_fp8_fp8(mk64(f.v[1].x, f.v[1].y), pf, o[2], 0, 0, 0); o[3] = __builtin_amdgcn_mfma_f32_16x16x32_fp8_fp8(mk64(f.v[1].z, f.v[1].w), pf, o[3], 0, 0, 0);
}
__device__ __forceinline__ void loadk8(Frag8& f, const unsigned char* kb, int G, int lane) { const unsigned char* kp = kb + (size_t)G * 2048 + lane * 16; f.k[0] = *(const u32x4n*)kp; f.k[1] = *(const u32x4n*)(kp + 1024); }
struct Tensors {
    const bf16_t* P;
    const unsigned char* KC8;
    const unsigned char* K8;
    const unsigned char* VC8;
    const unsigned char* V8;
    const bf16_t* OW;
    bf16_t* O;
};
__device__ __forceinline__ float wmax64(float v) { v = fmaxf(v, dppf<0x128>(v)); v = fmaxf(v, dppf<0x124>(v)); v = fmaxf(v, dppf<0x122>(v)); v = fmaxf(v, dppf<0x121>(v)); return xmax_q(v); }
__device__ __forceinline__ int wmin64(int v) { v = min(v, dppi<0x128>(v)); v = min(v, dppi<0x124>(v)); v = min(v, dppi<0x122>(v)); v = min(v, dppi<0x121>(v));
    auto a = __builtin_amdgcn_permlane16_swap((unsigned)v, (unsigned)v, false, false); v = min((int)a[0], (int)a[1]);
    auto b = __builtin_amdgcn_permlane32_swap((unsigned)v, (unsigned)v, false, false); return min((int)b[0], (int)b[1]); }
__device__ __forceinline__ int select_blocks(const __attribute__((address_space(3))) float* impA, const __attribute__((address_space(3))) float* impB, __attribute__((address_space(3))) int* list, int qblk, int lane) {
    if (qblk <= 15) { if (lane < 16) list[lane] = lane; return qblk + 1; }
    unsigned key[4];
#pragma unroll
    for (int i = 0; i < 4; ++i) { const int j = lane + 64 * i; key[i] = (j >= 1 && j <= qblk - 2) ? (__float_as_uint(impA[j] + impB[j]) + 1u) : 0u; }
    if (lane == 0) { list[0] = 0; list[1] = qblk - 1; list[2] = qblk; }
    unsigned T = 0u;
#pragma unroll 1
    for (int b = 30; b >= 0; --b) { const unsigned c = T | (1u << b);
        const int cnt = __builtin_popcountll(__builtin_amdgcn_ballot_w64(key[0] >= c)) + __builtin_popcountll(__builtin_amdgcn_ballot_w64(key[1] >= c))
                      + __builtin_popcountll(__builtin_amdgcn_ballot_w64(key[2] >= c)) + __builtin_popcountll(__builtin_amdgcn_ballot_w64(key[3] >= c));
        if (cnt >= 13) T = c; }
    int need = 13, base = 0;
#pragma unroll
    for (int i = 0; i < 4; ++i) need -= __builtin_popcountll(__builtin_amdgcn_ballot_w64(key[i] > T));
#pragma unroll
    for (int i = 0; i < 4; ++i) {
        const unsigned long long ge = __builtin_amdgcn_ballot_w64(key[i] > T), eq = __builtin_amdgcn_ballot_w64(key[i] == T);
        const int ce = __builtin_popcountll(eq), take = ce < need ? ce : need; need -= take;
        const int eqrank = (int)__builtin_amdgcn_mbcnt_hi((unsigned)(eq >> 32), __builtin_amdgcn_mbcnt_lo((unsigned)eq, 0u));
        const bool sel = (key[i] > T) || ((key[i] == T) && eqrank < take);
        const unsigned long long sm = __builtin_amdgcn_ballot_w64(sel);
        const int pos = base + (int)__builtin_amdgcn_mbcnt_hi((unsigned)(sm >> 32), __builtin_amdgcn_mbcnt_lo((unsigned)sm, 0u));
        if (sel) list[3 + pos] = lane + 64 * i;
        base += __builtin_popcountll(sm); (void)ge; }
    return 16;
}
__device__ __forceinline__ int select_blocks4(const __attribute__((address_space(3))) float* imp  , __attribute__((address_space(3))) int* lists  , int qblk, int lane) {
    if (qblk <= 15) { if (lane < 16) { lists[lane] = lane; lists[16 + lane] = lane; lists[32 + lane] = lane; lists[48 + lane] = lane; } return qblk + 1; }
    unsigned key[4][4];
#pragma unroll
    for (int k = 0; k < 4; ++k)
#pragma unroll
        for (int i = 0; i < 4; ++i) { const int j = lane + 64 * i; key[k][i] = (j >= 1 && j <= qblk - 2) ? (__float_as_uint(imp[k * 544 + j] + imp[k * 544 + 272 + j]) + 1u) : 0u; }
    if (lane < 4) { lists[16 * lane] = 0; lists[16 * lane + 1] = qblk - 1; lists[16 * lane + 2] = qblk; }
    unsigned T[4] = {0u, 0u, 0u, 0u};
#pragma unroll 1
    for (int b = 30; b >= 0; --b) {
#pragma unroll
        for (int k = 0; k < 4; ++k) { const unsigned c = T[k] | (1u << b);
            const int cnt = __builtin_popcountll(__builtin_amdgcn_ballot_w64(key[k][0] >= c)) + __builtin_popcountll(__builtin_amdgcn_ballot_w64(key[k][1] >= c))
                          + __builtin_popcountll(__builtin_amdgcn_ballot_w64(key[k][2] >= c)) + __builtin_popcountll(__builtin_amdgcn_ballot_w64(key[k][3] >= c));
            if (cnt >= 13) T[k] = c; } }
#pragma unroll
    for (int k = 0; k < 4; ++k) {
        int need = 13, base = 0;
#pragma unroll
        for (int i = 0; i < 4; ++i) need -= __builtin_popcountll(__builtin_amdgcn_ballot_w64(key[k][i] > T[k]));
#pragma unroll
        for (int i = 0; i < 4; ++i) {
            const unsigned long long eq = __builtin_amdgcn_ballot_w64(key[k][i] == T[k]);
            const int ce = __builtin_popcountll(eq), take = ce < need ? ce : need; need -= take;
            const int eqrank = (int)__builtin_amdgcn_mbcnt_hi((unsigned)(eq >> 32), __builtin_amdgcn_mbcnt_lo((unsigned)eq, 0u));
            const bool sel = (key[k][i] > T[k]) || ((key[k][i] == T[k]) && eqrank < take);
            const unsigned long long sm = __builtin_amdgcn_ballot_w64(sel);
            const int pos = base + (int)__builtin_amdgcn_mbcnt_hi((unsigned)(sm >> 32), __builtin_amdgcn_mbcnt_lo((unsigned)sm, 0u));
            if (sel) lists[16 * k + 3 + pos] = lane + 64 * i;
            base += __builtin_popcountll(sm); } }
    return 16;
}
#define NSA_LD(F_, G_) load8(F_, kb, vb, (G_), lane)
__device__ __forceinline__ void sel_joint(const Tensors& T, Run& rsa, Run& rsb, Frag8& fa, Frag8& fb, const long (&qfa)[2], const long (&qfb)[2], const __attribute__((address_space(3))) int* list,
                                          int njoint, int qblk, int bg, int tqa, int tqb, int n, int q, int lane) {
    const unsigned char* kb = T.K8 + (size_t)bg * 512 * 2048; const unsigned char* vb = T.V8 + (size_t)bg * 512 * 2048;
#define NSA_ST2(F_, G_) do { if (jb == qblk) { flash_step8<true>(rsa, F_, qfa, 0, tqa - 32 * (G_), true, q); flash_step8<true>(rsb, F_, qfb, 0, tqb - 32 * (G_), true, q); } \
                             else { flash_step8<false>(rsa, F_, qfa, 0, 31, true, q); flash_step8<false>(rsb, F_, qfb, 0, 31, true, q); } } while (0)
    int jb = __builtin_amdgcn_readfirstlane(list[0]);
    NSA_LD(fa, 2 * jb);
    for (int e = 0; e < njoint; ++e) {
        NSA_LD(fb, 2 * jb + 1);
        NSA_ST2(fa, 2 * jb);
        int jn = 0;
        if (e + 1 < njoint) { jn = __builtin_amdgcn_readfirstlane(list[e + 1]); NSA_LD(fa, 2 * jn); }
        NSA_ST2(fb, 2 * jb + 1);
        jb = jn; }
#undef NSA_ST2
}
__device__ __forceinline__ void flash_dual8(Run& r, const Frag8& fA, const Frag8& fB, const long (&q8)[2], int tok, int q) {
    float sa[8], sb[8], s[8]; qk8(sa, fA, q8); qk8(sb, fB, q8);
    float gm = NEG;
#pragma unroll
    for (int j = 0; j < 8; ++j) { s[j] = tok ? sb[j] : sa[j]; gm = fmaxf(gm, s[j]); }
    gm = xmax_q(gm);
    const float mn = fmaxf(r.m, gm), sc = __builtin_amdgcn_exp2f(r.m - mn); r.m = mn;
    float p[8], ps = 0.f;
    const float mn8 = mn - 8.0f;
#pragma unroll
    for (int j = 0; j < 8; ++j) { p[j] = __builtin_amdgcn_exp2f(s[j] - mn8); ps += p[j]; }
    r.l = r.l * sc + ps;
    if (__builtin_amdgcn_ballot_w64(sc != 1.0f) != 0ull) {
#pragma unroll
        for (int dt = 0; dt < 4; ++dt) r.o[dt] = r.o[dt] * sc; }
    const unsigned w0 = fp8x4(p[0], p[1], p[2], p[3]), w1 = fp8x4(p[4], p[5], p[6], p[7]);
    const long pa = mk64(tok ? 0u : w0, tok ? 0u : w1), pb = mk64(tok ? w0 : 0u, tok ? w1 : 0u);
    r.o[0] = __builtin_amdgcn_mfma_f32_16x16x32_fp8_fp8(mk64(fA.v[0].x, fA.v[0].y), pa, r.o[0], 0, 0, 0); r.o[1] = __builtin_amdgcn_mfma_f32_16x16x32_fp8_fp8(mk64(fA.v[0].z, fA.v[0].w), pa, r.o[1], 0, 0, 0);
    r.o[2] = __builtin_amdgcn_mfma_f32_16x16x32_fp8_fp8(mk64(fA.v[1].x, fA.v[1].y), pa, r.o[2], 0, 0, 0); r.o[3] = __builtin_amdgcn_mfma_f32_16x16x32_fp8_fp8(mk64(fA.v[1].z, fA.v[1].w), pa, r.o[3], 0, 0, 0);
    r.o[0] = __builtin_amdgcn_mfma_f32_16x16x32_fp8_fp8(mk64(fB.v[0].x, fB.v[0].y), pb, r.o[0], 0, 0, 0); r.o[1] = __builtin_amdgcn_mfma_f32_16x16x32_fp8_fp8(mk64(fB.v[0].z, fB.v[0].w), pb, r.o[1], 0, 0, 0);
    r.o[2] = __builtin_amdgcn_mfma_f32_16x16x32_fp8_fp8(mk64(fB.v[1].x, fB.v[1].y), pb, r.o[2], 0, 0, 0); r.o[3] = __builtin_amdgcn_mfma_f32_16x16x32_fp8_fp8(mk64(fB.v[1].z, fB.v[1].w), pb, r.o[3], 0, 0, 0);
}
__device__ __forceinline__ void sel_solo(const Tensors& T, Run& rs, Frag8& fa, Frag8& fb, const long (&qf)[2], const __attribute__((address_space(3))) int* list0, const __attribute__((address_space(3))) int* list1,
                                         int bg, int tok, int n, int q, int lane) {
    const unsigned char* kb = T.K8 + (size_t)bg * 512 * 2048; const unsigned char* vb = T.V8 + (size_t)bg * 512 * 2048;
    Frag8 fc, fd;
    int ja = __builtin_amdgcn_readfirstlane(list0[3]), jb = __builtin_amdgcn_readfirstlane(list1[3]);
    NSA_LD(fa, 2 * ja); NSA_LD(fb, 2 * jb);
    for (int e = 0; e < 13; ++e) {
        NSA_LD(fc, 2 * ja + 1); NSA_LD(fd, 2 * jb + 1);
        flash_dual8(rs, fa, fb, qf, tok, q);
        int na = 0, nb = 0;
        if (e + 1 < 13) { na = __builtin_amdgcn_readfirstlane(list0[4 + e]); nb = __builtin_amdgcn_readfirstlane(list1[4 + e]); NSA_LD(fa, 2 * na); NSA_LD(fb, 2 * nb); }
        flash_dual8(rs, fc, fd, qf, tok, q);
        ja = na; jb = nb; }
}
#undef NSA_LD
__device__ __forceinline__ void out_pair(const Tensors& T, const __attribute__((address_space(3))) unsigned* st, int lane, const Run& rs, size_t rowt, int g, int head, int q) {
    const float ls = xsum_q(rs.l);
    const bf16_t* gp = T.P + rowt * PITCH + COL_G + g * 24 + head * 3;
    const float gc = 1.0f / (1.0f + __expf(-bf2f(gp[0]))), gs = 1.0f / (1.0f + __expf(-bf2f(gp[1]))), gw = 1.0f / (1.0f + __expf(-bf2f(gp[2])));
    const float fs = gs / fmaxf(ls, 1e-30f);
    const bf16_t* wp = T.OW + rowt * 1024 + (g * 8 + head) * 64 + 4 * q;
    bf16_t* op = T.O + rowt * 1024 + (g * 8 + head) * 64 + 4 * q;
#pragma unroll
    for (int dt = 0; dt < 4; ++dt) { float v[4]; typedef unsigned u32x2w __attribute__((ext_vector_type(2))); const u32x2w wv = *(const u32x2w*)(wp + 16 * dt);
        const float ow[4] = {__uint_as_float(wv.x << 16), __uint_as_float(wv.x & 0xffff0000u), __uint_as_float(wv.y << 16), __uint_as_float(wv.y & 0xffff0000u)};
        const unsigned c0 = st[(4 * dt) * 64 + lane], c1 = st[(4 * dt + 1) * 64 + lane]; const float oc[4] = {__uint_as_float(c0 << 16), __uint_as_float(c0 & 0xffff0000u), __uint_as_float(c1 << 16), __uint_as_float(c1 & 0xffff0000u)};
#pragma unroll
        for (int i = 0; i < 4; ++i) v[i] = gc * oc[i] + fs * rs.o[dt][i] + gw * ow[i];
        u32x2w w; w.x = pk2(v[0], v[1]); w.y = pk2(v[2], v[3]);
        *(u32x2w*)(op + 16 * dt) = w; }
}
__device__ __forceinline__ void quad_item(const Tensors& T, int item, __attribute__((address_space(3))) float* wl, int lane) {
    typedef __attribute__((address_space(3))) float lf; typedef __attribute__((address_space(3))) int li;
    const int n = lane & 15, q = lane >> 4, tok = n >> 3, head = n & 7;
    const int bg = item >> 12, t0 = (item & (S / 4 - 1)) * 4, b = bg >> 1, g = bg & 1;
    const int tqa = t0 + tok, tqb = t0 + 2 + tok;
    const size_t row0 = (size_t)b * S + t0;
    lf* impa = wl + tok * 544; lf* impb = wl + (2 + tok) * 544; li* lists = (li*)(wl + 2176);
    bf16x8 qfa[2], qfb[2];
    { const bf16_t* qp = T.P + (row0 + tok) * PITCH + (g * 8 + head) * 64 + q * 8; qfa[0] = *(const bf16x8*)qp; qfa[1] = *(const bf16x8*)(qp + 32);
      qfb[0] = *(const bf16x8*)(qp + 2 * PITCH); qfb[1] = *(const bf16x8*)(qp + 2 * PITCH + 32); }
    for (int i = lane; i < 2176; i += 64) wl[i] = 0.f;
    Frag8 ga, gb;
    const long qa8[2] = {q_to_fp8(qfa[0]), q_to_fp8(qfa[1])}, qb8[2] = {q_to_fp8(qfb[0]), q_to_fp8(qfb[1])};
    const int nva = tqa >= 31 ? ((tqa - 31) >> 4) + 1 : 0, nvb = tqb >= 31 ? ((tqb - 31) >> 4) + 1 : 0;
    const int nv0 = t0 >= 31 ? ((t0 - 31) >> 4) + 1 : 0, nv3 = (t0 + 3) >= 31 ? ((t0 + 3 - 31) >> 4) + 1 : 0;
    f32x4 oca[4], ocb[4];
#pragma unroll
    for (int dt = 0; dt < 4; ++dt) { oca[dt] = (f32x4){0.f, 0.f, 0.f, 0.f}; ocb[dt] = (f32x4){0.f, 0.f, 0.f, 0.f}; }
    if (nv3 > 0) {
        const unsigned char* kb = T.KC8 + (size_t)bg * 32 * 2048; const unsigned char* vb = T.VC8 + (size_t)bg * 32 * 2048; const int ng = (nv3 + 31) >> 5;
        float mca = NEG, lca = 0.f, mcb = NEG, lcb = 0.f;
#define NSA_P1(F_, G_, QF_, NV_, MC_, LC_) do { float s[8]; qk8(s, F_, QF_); const int hi = (NV_) - 1 - 32 * (G_); float gm = NEG; \
            if (32 * (G_) + 32 > nv0) { _Pragma("unroll") for (int j = 0; j < 8; ++j) { const bool ok = (8 * q + j) <= hi; s[j] = ok ? s[j] : NEG; gm = fmaxf(gm, s[j]); } } \
            else { _Pragma("unroll") for (int j = 0; j < 8; ++j) gm = fmaxf(gm, s[j]); } \
            gm = xmax_q(gm); const float mn = fmaxf(MC_, gm); float ps = 0.f; \
            _Pragma("unroll") for (int j = 0; j < 8; ++j) ps += __builtin_amdgcn_exp2f(s[j] - mn); \
            LC_ = LC_ * __builtin_amdgcn_exp2f(MC_ - mn) + ps; MC_ = mn; } while (0)
        loadk8(ga, kb, 0, lane);
        for (int G = 0; G < ng; G += 2) {
            if (G + 1 < ng) loadk8(gb, kb, G + 1, lane);
            NSA_P1(ga, G, qa8, nva, mca, lca); NSA_P1(ga, G, qb8, nvb, mcb, lcb);
            if (G + 1 < ng) { if (G + 2 < ng) loadk8(ga, kb, G + 2, lane); NSA_P1(gb, G + 1, qa8, nva, mca, lca); NSA_P1(gb, G + 1, qb8, nvb, mcb, lcb); }
        }
#undef NSA_P1
        lca = xsum_q(lca); lcb = xsum_q(lcb);
        asm volatile("s_waitcnt lgkmcnt(0)" ::: "memory");
#define NSA_P2(F_, G_, QF_, NV_, C2_, OC_, IMP_) do { float s[8]; qk8(s, F_, QF_); const int hi = (NV_) - 1 - 32 * (G_); float p[8]; \
            if (32 * (G_) + 32 > nv0) { _Pragma("unroll") for (int j = 0; j < 8; ++j) { const bool ok = (8 * q + j) <= hi; p[j] = ok ? __builtin_amdgcn_exp2f(s[j] - C2_) : 0.f; } } \
            else { _Pragma("unroll") for (int j = 0; j < 8; ++j) p[j] = __builtin_amdgcn_exp2f(s[j] - C2_); } \
            pv8s(OC_, p, F_); \
            const float a0 = sum8((p[0] + p[1]) + (p[2] + p[3])), a1 = sum8((p[4] + p[5]) + (p[6] + p[7])), b0 = sum8(p[3]), b1 = sum8(p[7]);     \
            if (head == 0) { const int j0 = 8 * (G_) + 2 * q; IMP_[j0] = a0; IMP_[j0 + 1] = a1; IMP_[272 + j0 + 1] = b0; IMP_[272 + j0 + 2] = b1; } } while (0)
        const float c2a = mca - 8.0f + __builtin_amdgcn_logf(fmaxf(lca, 1e-30f)), c2b = mcb - 8.0f + __builtin_amdgcn_logf(fmaxf(lcb, 1e-30f));
        load8(ga, kb, vb, 0, lane);
        for (int G = 0; G < ng; G += 2) {
            if (G + 1 < ng) load8(gb, kb, vb, G + 1, lane);
            NSA_P2(ga, G, qa8, nva, c2a, oca, impa); NSA_P2(ga, G, qb8, nvb, c2b, ocb, impb);
            if (G + 1 < ng) { if (G + 2 < ng) load8(ga, kb, vb, G + 2, lane);
                NSA_P2(gb, G + 1, qa8, nva, c2a, oca, impa); NSA_P2(gb, G + 1, qb8, nvb, c2b, ocb, impb); }
        }
#undef NSA_P2
#pragma unroll
        for (int dt = 0; dt < 4; ++dt) { oca[dt] = oca[dt] * (1.0f / 256.0f); ocb[dt] = ocb[dt] * (1.0f / 256.0f); }
    }
    { __attribute__((address_space(3))) unsigned* st = (__attribute__((address_space(3))) unsigned*)(wl + 2240);
#pragma unroll
      for (int dt = 0; dt < 4; ++dt) { st[(4 * dt + 0) * 64 + lane] = pk2(oca[dt][0], oca[dt][1]); st[(4 * dt + 1) * 64 + lane] = pk2(oca[dt][2], oca[dt][3]); st[(4 * dt + 2) * 64 + lane] = pk2(ocb[dt][0], ocb[dt][1]); st[(4 * dt + 3) * 64 + lane] = pk2(ocb[dt][2], ocb[dt][3]); } }
    asm volatile("s_waitcnt lgkmcnt(0)" ::: "memory"); __builtin_amdgcn_wave_barrier();
    const int qblk = t0 >> 6;
    const int nsel = select_blocks4(wl, lists, qblk, lane);
    asm volatile("s_waitcnt lgkmcnt(0)" ::: "memory"); __builtin_amdgcn_wave_barrier();
    { Run rsa, rsb; run_init(rsa); run_init(rsb);
      sel_joint(T, rsa, rsb, ga, gb, qa8, qb8, lists, qblk <= 15 ? nsel : 3, qblk, bg, tqa, tqb, n, q, lane);
      if (qblk > 15) sel_solo(T, rsa, ga, gb, qa8, lists, lists + 16, bg, tok, n, q, lane);
      out_pair(T, (const __attribute__((address_space(3))) unsigned*)(wl + 2240), lane, rsa, row0 + tok, g, head, q);
      if (qblk > 15) sel_solo(T, rsb, ga, gb, qb8, lists + 32, lists + 48, bg, tok, n, q, lane);
      out_pair(T, (const __attribute__((address_space(3))) unsigned*)(wl + 2240) + 128, lane, rsb, row0 + 2 + tok, g, head, q); }
    asm volatile("s_waitcnt lgkmcnt(0)" ::: "memory"); __builtin_amdgcn_wave_barrier();
}
}

constexpr int NWAVES = 8;
#ifndef MK_SINGLE
#define MK_SINGLE 1
#endif
constexpr int kB = 2, kS = 16384, kD = 1024, kM = kB * kS;
constexpr float kEps = 1e-6f;
constexpr float kC2 = 0.125f * 1.4426950408889634f;
constexpr int kMpad = 65536 + 32 * 256;
constexpr size_t MiB = 1u << 20;
constexpr size_t WS_CTL = 0, CTL_ZERO_BYTES = 1 * MiB;
constexpr size_t WS_ADAP = 1 * MiB;
constexpr size_t WS_MOD = 2 * MiB + 512 * 1024;
constexpr size_t WS_CBP = WS_MOD + 128 * 1024;
constexpr size_t WS_CBF = WS_CBP + 64 * 1024;
constexpr size_t WS_ROPE = 3 * MiB;
constexpr size_t WS_ROUTE = 5 * MiB;
constexpr size_t WS_ROWTOK = 6 * MiB;
constexpr size_t WS_ROWWT = 6 * MiB + 512 * 1024;
constexpr size_t WS_DUMP = 7 * MiB;
constexpr size_t WS_WR = 7 * MiB + 64 * 1024;
constexpr size_t WS_WC = 7 * MiB + 896 * 1024;
constexpr size_t WS_WQKV = 8 * MiB, WS_WO0 = 14 * MiB, WS_WNSA = 16 * MiB, WS_WO1 = 20 * MiB, WS_W1C = 22 * MiB, WS_W2C = 24 * MiB;
constexpr size_t WS_MOE0 = 26 * MiB, MOE_L = 48 * MiB, MOE_WD = 32 * MiB;
constexpr size_t WS_RA = 122 * MiB, WS_RB = 186 * MiB, WS_RC = 250 * MiB, WS_RD = 314 * MiB, WS_RE = 378 * MiB, WS_RF = 442 * MiB, WS_END = 506 * MiB;
constexpr size_t NS_KC = WS_RF  , NS_HID = WS_RF + 17 * MiB, NS_KCMP = WS_RF + 21 * MiB, NS_VCT = WS_RF + 21 * MiB + 512 * 1024, NS_VTS = WS_RF + 22 * MiB, NS_VTW = WS_RF + 30 * MiB;
constexpr int CW_BAR = 4096;
constexpr int CW_CNT = 16384;
constexpr int CW_QCTR = 16384 + 1024;
constexpr int RING_OFF = 0, RING_BYTES = 131072, LDSCTL_OFF = RING_BYTES, MISC_OFF = LDSCTL_OFF + 320, TPRE_OFF = LDSCTL_OFF + 1024;
constexpr int GTAB_OFF = LDSCTL_OFF + 2048, GTAB_UNITS = 6;
constexpr int LDS_BYTES = 147456;

#define GAS __attribute__((address_space(1)))
#define LAS __attribute__((address_space(3)))
typedef unsigned short bf16;
typedef unsigned v4u __attribute__((ext_vector_type(4)));
typedef unsigned v2u __attribute__((ext_vector_type(2)));
typedef float f32x4 __attribute__((ext_vector_type(4)));
typedef GAS unsigned gu32;
#define RLX_AGENT __ATOMIC_RELAXED, __HIP_MEMORY_SCOPE_AGENT
#define LDS_WAIT() asm volatile("s_waitcnt lgkmcnt(0)" ::: "memory")
__device__ __forceinline__ unsigned pk2(float lo, float hi) { return nsa::pk2(lo, hi); }
__device__ __forceinline__ float bf2f(unsigned short x) { return __uint_as_float((unsigned)x << 16); }
__device__ __forceinline__ float wave_sum(float v) {
#pragma unroll
    for (int o = 1; o < 64; o <<= 1) v += __shfl_xor(v, o);
    return v;
}

#define XB_TMO      128
#define XB_XCNT(j)  (256  + 64 * (j))
#define XB_XSUB(j)  (1280 + 64 * (j))
#define XB_XGEN(j)  (2304 + 64 * (j))
#define XB_TOP      3328
#define XB_TOPGEN   3392
#define XCD_BAR_WORDS 3456
#define XB_SPIN_CAP (1u << 18)

__device__ __forceinline__ unsigned xb_ld(unsigned* p)              { return __hip_atomic_load(p, __ATOMIC_RELAXED, __HIP_MEMORY_SCOPE_AGENT); }
__device__ __forceinline__ unsigned xb_add(unsigned* p, unsigned v) { return __hip_atomic_fetch_add(p, v, __ATOMIC_RELAXED, __HIP_MEMORY_SCOPE_AGENT); }
__device__ __forceinline__ unsigned xb_xcc_id() { return (unsigned)__builtin_amdgcn_s_getreg((3 << 11) | 20) & 0xFu; }
#define XB_SPIN(cond, bar) do { unsigned _sp = 0; while (cond) { __builtin_amdgcn_s_sleep(1); \
    if ((++_sp & 255u) == 0u) { if (xb_ld(&(bar)[XB_TMO])) break; if (_sp > XB_SPIN_CAP) { atomicAdd(&(bar)[XB_TMO], 1u); break; } } } } while (0)

struct XcdBarrier {
    unsigned* bar; unsigned x;
    volatile LAS unsigned* st;
};

__device__ __forceinline__ XcdBarrier xcd_barrier_post(unsigned* bar, volatile LAS unsigned* st) {
    XcdBarrier b; b.bar = bar; b.x = xb_xcc_id(); b.st = st;
    if (threadIdx.x == 0) (void)xb_add(&bar[XB_XCNT(b.x)], 1u);
    return b;
}
__device__ __forceinline__ void xcd_barrier_complete(unsigned* bar, unsigned x, unsigned& nloc, unsigned& nx) {
    const unsigned G = gridDim.x * gridDim.y * gridDim.z;
    unsigned sum, cnt, mine, sp = 0u;
    for (;;) {
        sum = 0u; cnt = 0u; mine = 0u;
#pragma unroll
        for (unsigned j = 0; j < 16; ++j) { const unsigned c = xb_ld(&bar[XB_XCNT(j)]); sum += c; cnt += (c > 0u) ? 1u : 0u; mine = (j == x) ? c : mine; }
        if (sum == G) break;
        __builtin_amdgcn_s_sleep(1);
        if ((++sp & 255u) == 0u) { if (xb_ld(&bar[XB_TMO])) break; if (sp > XB_SPIN_CAP) { atomicAdd(&bar[XB_TMO], 1u); break; } }
    }
    nloc = mine > 0u ? mine : 1u; nx = cnt > 0u ? cnt : 1u;
}

__device__ __forceinline__ void xcd_barrier(const XcdBarrier& b) {
    asm volatile("s_waitcnt vmcnt(0)" ::: "memory");
    __syncthreads();
    if (threadIdx.x == 0) {
        unsigned* bar = b.bar;
        __builtin_amdgcn_s_waitcnt(0);
        unsigned nloc = b.st[0], nx = b.st[1];
        if (nloc == 0u) { xcd_barrier_complete(bar, b.x, nloc, nx); b.st[0] = nloc; b.st[1] = nx; }
        const unsigned old = xb_add(&bar[XB_XSUB(b.x)], 1u);
        const unsigned gen = old / nloc;
        if (old + 1u == (gen + 1u) * nloc) {
            __builtin_amdgcn_fence(__ATOMIC_RELEASE, "agent");
            asm volatile("s_waitcnt vmcnt(0)" ::: "memory");
            const unsigned og = xb_add(&bar[XB_TOP], 1u);
            const unsigned tg = og / nx;
            if (og + 1u == (tg + 1u) * nx) xb_add(&bar[XB_TOPGEN], 1u);
            else XB_SPIN(xb_ld(&bar[XB_TOPGEN]) == tg, bar);
            __builtin_amdgcn_fence(__ATOMIC_ACQUIRE, "agent");
            xb_add(&bar[XB_XGEN(b.x)], 1u);
            asm volatile("s_waitcnt vmcnt(0)" ::: "memory");
        } else {
            XB_SPIN(xb_ld(&bar[XB_XGEN(b.x)]) == gen, bar);
            __builtin_amdgcn_fence(__ATOMIC_ACQUIRE, "agent");
            asm volatile("s_waitcnt vmcnt(0)" ::: "memory");
        }
    }
    __syncthreads();
}


__device__ __forceinline__ void transpose_item(const float* W, int K, int N, bf16* WT, int drow0, int kb, int nb, LAS float* scr, int lane) {
    const int k0 = 64 * kb, n0 = 32 * nb; const int nn = n0 + (lane & 7) * 4; const bool okn = nn < N;
#pragma unroll
    for (int i = 0; i < 8; ++i) { const int kk = 8 * i + (lane >> 3); const f32x4 v = okn ? *(const f32x4*)(W + (size_t)(k0 + kk) * N + nn) : (f32x4){0.f, 0.f, 0.f, 0.f};
        LAS float* d = scr + kk * 33 + (lane & 7) * 4; d[0] = v[0]; d[1] = v[1]; d[2] = v[2]; d[3] = v[3]; }
    LDS_WAIT(); asm volatile("" ::: "memory");
    const int c = lane & 7;
#pragma unroll
    for (int j = 0; j < 4; ++j) { const int n = (lane >> 3) + 8 * j; const LAS float* s = scr + (8 * c) * 33 + n;
        v4u o; o.x = pk2(s[0 * 33], s[1 * 33]); o.y = pk2(s[2 * 33], s[3 * 33]); o.z = pk2(s[4 * 33], s[5 * 33]); o.w = pk2(s[6 * 33], s[7 * 33]);
        *(v4u*)(WT + (size_t)(drow0 + n) * K + k0 + 8 * c) = o; }
    LDS_WAIT(); asm volatile("" ::: "memory");
}
__device__ __forceinline__ void sincos_acc(float ang, float& sn, float& cs) {
    const double a = (double)ang; const double kq = rint(a * 0.63661977236758134308);
    const double r = fma(-kq, 1.57079632679489661923, a) - kq * 6.123233995736766e-17;
    const int qd = (int)((long long)kq & 3);
    const float x = (float)r, x2 = x * x;
    const float sp = x * (1.0f + x2 * (-1.6666667e-1f + x2 * (8.3333338e-3f + x2 * (-1.9841270e-4f + x2 * 2.7557319e-6f))));
    const float cp = 1.0f + x2 * (-0.5f + x2 * (4.1666668e-2f + x2 * (-1.3888889e-3f + x2 * (2.4801587e-5f + x2 * -2.7557319e-7f))));
    const float s1 = (qd & 1) ? cp : sp, c1 = (qd & 1) ? sp : cp;
    sn = (qd & 2) ? -s1 : s1; cs = ((qd + 1) & 2) ? -c1 : c1;
}

struct Ptrs {
    const float* x; const float* c; const int* pos; const float* ada_w; const float* ada_b; const float* norm_g; const float* final_g;
    const float* diff_w_in; const float* diff_w_out; const float* diff_lambda; const float* diff_subln_g;
    const float* nsa_w_in; const float* nsa_w_out; const float* nsa_cmp_pos; const float* nsa_cmp_w1; const float* nsa_cmp_b1; const float* nsa_cmp_w2;
    const float* moe_w_group; const float* moe_b_group; const float* moe_w_expert; const float* moe_b_expert; const float* moe_w_gate; const float* moe_w_up; const float* moe_w_down;
    float* out; unsigned char* ws;
};

__device__ __forceinline__ void ph_prologue(const Ptrs& p, LAS unsigned char* lds, int gw, int NGW, int wave, int lane, int gtid, int NT) {
    LAS float* scr = (LAS float*)(lds + RING_OFF + wave * 16384);
    unsigned char* ws = p.ws;
    constexpr int I_QKV = 16 * 96, I_WO = 16 * 32, I_NSA = 16 * 64, I_W1C = 32 * 8, I_W2C = 4 * 8, I_EXP = 128;
    constexpr int T0 = I_QKV, T1 = T0 + I_WO, T2 = T1 + I_NSA, T3 = T2 + I_WO, T4 = T3 + 2 * I_W1C, T5 = T4 + 2 * I_W2C, T6 = T5 + 64 * 3 * I_EXP;
    struct TrDesc { const float* W; bf16* WT; int K, N, drow0, kb, nb; float sc = 1.0f; };
    auto decode = [&](int it, TrDesc& d) {
        if (it < T0) { const int r = it; d = TrDesc{p.diff_w_in, (bf16*)(ws + WS_WQKV), 1024, 3072, 32 * (r % 96), r / 96, r % 96, (r % 96) < 32 ? kC2 : 1.0f}; }
        else if (it < T1) { const int r = it - T0; d = TrDesc{p.diff_w_out, (bf16*)(ws + WS_WO0), 1024, 1024, 32 * (r % 32), r / 32, r % 32}; }
        else if (it < T2) { const int r = it - T1; d = TrDesc{p.nsa_w_in, (bf16*)(ws + WS_WNSA), 1024, 1840, 32 * (r % 64), r / 64, r % 64, (r % 64) < 32 ? kC2 : 1.0f}; }
        else if (it < T3) { const int r = it - T2; d = TrDesc{p.nsa_w_out, (bf16*)(ws + WS_WO1), 1024, 1024, 32 * (r % 32), r / 32, r % 32}; }
        else if (it < T4) { const int r = it - T3, kv = r / I_W1C, rr = r % I_W1C; d = TrDesc{p.nsa_cmp_w1 + (size_t)kv * 2048 * 256, (bf16*)(ws + WS_W1C) + (size_t)kv * 256 * 2048, 2048, 256, 32 * (rr % 8), rr / 8, rr % 8}; }
        else if (it < T5) { const int r = it - T4, kv = r / I_W2C, rr = r % I_W2C; d = TrDesc{p.nsa_cmp_w2 + (size_t)kv * 256 * 64, (bf16*)(ws + WS_W2C) + (size_t)kv * 256 * 256, 256, 64, 32 * (rr % 8), rr / 8, rr % 8}; }
        else { const int r = it - T5, le = r / (3 * I_EXP), rr = r % (3 * I_EXP), which = rr / I_EXP, ri = rr % I_EXP; const int l = le >> 5, e = le & 31;
            unsigned char* mb = ws + WS_MOE0 + (size_t)l * MOE_L;
            if (which < 2) { const int kb = ri / 8, nb = ri % 8, n0 = 32 * nb;
                d = TrDesc{(which ? p.moe_w_up : p.moe_w_gate) + (size_t)le * 1024 * 256, (bf16*)mb + (size_t)e * 512 * 1024, 1024, 256, (n0 >> 7) * 256 + which * 128 + (n0 & 127), kb, nb}; }
            else { d = TrDesc{p.moe_w_down + (size_t)le * 256 * 1024, (bf16*)(mb + MOE_WD) + (size_t)e * 1024 * 256, 256, 1024, 32 * (ri % 32), ri / 32, ri % 32}; } }
    };
    auto tr_load = [&](const TrDesc& d, f32x4 (&v)[8]) {
        const int k0 = 64 * d.kb, nn = 32 * d.nb + (lane & 7) * 4; const bool okn = nn < d.N;
#pragma unroll
        for (int i = 0; i < 8; ++i) { const int kk = 8 * i + (lane >> 3); v[i] = okn ? *(const f32x4*)(d.W + (size_t)(k0 + kk) * d.N + nn) * d.sc : (f32x4){0.f, 0.f, 0.f, 0.f}; }
    };
    auto tr_finish = [&](const TrDesc& d, const f32x4 (&v)[8]) {
#pragma unroll
        for (int i = 0; i < 8; ++i) { const int kk = 8 * i + (lane >> 3); LAS float* q = scr + kk * 33 + (lane & 7) * 4; q[0] = v[i][0]; q[1] = v[i][1]; q[2] = v[i][2]; q[3] = v[i][3]; }
        LDS_WAIT(); asm volatile("" ::: "memory");
        const int c = lane & 7, k0 = 64 * d.kb;
#pragma unroll
        for (int j = 0; j < 4; ++j) { const int n = (lane >> 3) + 8 * j; const LAS float* s_ = scr + (8 * c) * 33 + n;
            v4u o; o.x = pk2(s_[0 * 33], s_[1 * 33]); o.y = pk2(s_[2 * 33], s_[3 * 33]); o.z = pk2(s_[4 * 33], s_[5 * 33]); o.w = pk2(s_[6 * 33], s_[7 * 33]);
            *(v4u*)(d.WT + (size_t)(d.drow0 + n) * d.K + k0 + 8 * c) = o; }
        LDS_WAIT(); asm volatile("" ::: "memory");
    };
    if (gw < T6) { TrDesc dc; f32x4 vc[8]; decode(gw, dc); tr_load(dc, vc);
        for (int it = gw; it < T6; it += NGW) { TrDesc dn = dc; f32x4 vn[8];
            const bool more = it + NGW < T6;
            if (more) { decode(it + NGW, dn); tr_load(dn, vn); }
            tr_finish(dc, vc);
            if (more) { dc = dn;
#pragma unroll
                for (int i = 0; i < 8; ++i) vc[i] = vn[i]; } } }
    for (int it = gw; it < 2 * 16 * 24; it += NGW) { const int l = it / 384, kc = (it % 384) / 24, cg = it % 24;
        const float* W = p.ada_w + ((size_t)l * 1024 + kc * 64) * 6144 + cg * 256 + lane * 4;
        f32x4 a0 = {0.f, 0.f, 0.f, 0.f}, a1 = {0.f, 0.f, 0.f, 0.f};
#pragma unroll 8
        for (int r = 0; r < 64; ++r) { const f32x4 w = *(const f32x4*)(W + (size_t)r * 6144); const float c0 = p.c[kc * 64 + r], c1 = p.c[1024 + kc * 64 + r];
            const float s0 = c0 / (1.0f + __expf(-c0)), s1 = c1 / (1.0f + __expf(-c1)); a0 = a0 + w * s0; a1 = a1 + w * s1; }
        float* dst = (float*)(ws + WS_ADAP) + ((size_t)(l * 16 + kc) * 2) * 6144 + cg * 256 + lane * 4;
        *(f32x4*)dst = a0; *(f32x4*)(dst + 6144) = a1; }
    for (int i = gtid; i < kM * 8; i += NT) { const int m = i >> 3, j = i & 7;
        const float invf = exp2f(-(float)j * 0.125f * 18.931568569324174f);
        const float ang = (float)p.pos[m] * invf; float sn, cs; sincos_acc(ang, sn, cs);
        float* rp = (float*)(ws + WS_ROPE) + (size_t)m * 16; rp[j] = cs; rp[8 + j] = sn; }
    for (int it = gw; it < 2 * 4 * 32; it += NGW) { const int kv = it >> 7, cg = (it >> 5) & 3, kc = it & 31;
        const float* W = p.nsa_cmp_w1 + ((size_t)kv * 2048 + kc * 64) * 256 + cg * 64 + lane; const float* pe = p.nsa_cmp_pos + kv * 2048 + kc * 64; float a = 0.f;
#pragma unroll 8
        for (int r = 0; r < 64; ++r) a += pe[r] * W[(size_t)r * 256];
        ((float*)(ws + WS_CBP))[kc * 512 + kv * 256 + cg * 64 + lane] = a; }
}
__device__ __forceinline__ void ph_finalize(const Ptrs& p, int gtid, int NT) {
    unsigned char* ws = p.ws;
    for (int i = gtid; i < 2 * 2 * 6144 + 512; i += NT) {
        if (i < 24576) { const int l = i / 12288, b = (i / 6144) & 1, n = i % 6144; float a = p.ada_b[l * 6144 + n];
            const float* pp = (const float*)(ws + WS_ADAP) + ((size_t)(l * 16) * 2 + b) * 6144 + n;
            for (int kc = 0; kc < 16; ++kc) a += pp[(size_t)kc * 2 * 6144];
            ((float*)(ws + WS_MOD))[i] = a; }
        else { const int j = i - 24576; float a = p.nsa_cmp_b1[j]; const float* pp = (const float*)(ws + WS_CBP) + j;
            for (int kc = 0; kc < 32; ++kc) a += pp[kc * 512];
            ((float*)(ws + WS_CBF))[j] = a; }
    }
}
template <bool COMBINE, bool FINAL, bool XBF  >
__device__ __forceinline__ void ph_rows(const Ptrs& p, const float* xin, float* xout, const bf16* Y, const float* modl  , int ch_sh, int ch_g2,
                                        const float* ng, bf16* XN, int layer, int gw, int NGW, int lane, int gtid, int NT) {
    unsigned char* ws = p.ws;
    f32x4 gv[4];
#pragma unroll
    for (int j = 0; j < 4; ++j) gv[j] = *(const f32x4*)(ng + 4 * lane + 256 * j);
    for (int m = gw; m < kM; m += NGW) {
        const int b = m >= kS ? 1 : 0; const float* mb = modl + b * 6144;
        f32x4 v[4];
#pragma unroll
        for (int j = 0; j < 4; ++j) { if (XBF) { const v2u xb = *(const v2u*)((const bf16*)xin + (size_t)m * 1024 + 4 * lane + 256 * j);
                v[j][0] = __uint_as_float(xb.x << 16); v[j][1] = __uint_as_float(xb.x & 0xffff0000u); v[j][2] = __uint_as_float(xb.y << 16); v[j][3] = __uint_as_float(xb.y & 0xffff0000u); }
            else v[j] = *(const f32x4*)(xin + (size_t)m * 1024 + 4 * lane + 256 * j); }
        if (COMBINE) {
#pragma unroll
            for (int j = 0; j < 4; ++j) { const int col = 4 * lane + 256 * j; const f32x4 g2 = *(const f32x4*)(mb + ch_g2 * 1024 + col);
                const v2u y0 = *(const v2u*)(Y + (size_t)m * 1024 + col), y1 = *(const v2u*)(Y + ((size_t)kM + m) * 1024 + col);
                f32x4 ys; ys[0] = __uint_as_float(y0.x << 16) + __uint_as_float(y1.x << 16); ys[1] = __uint_as_float(y0.x & 0xffff0000u) + __uint_as_float(y1.x & 0xffff0000u);
                ys[2] = __uint_as_float(y0.y << 16) + __uint_as_float(y1.y << 16); ys[3] = __uint_as_float(y0.y & 0xffff0000u) + __uint_as_float(y1.y & 0xffff0000u);
                v[j] = v[j] + g2 * ys;
                if (!FINAL) { if (XBF) { v2u xo; xo.x = pk2(v[j][0], v[j][1]); xo.y = pk2(v[j][2], v[j][3]); *(v2u*)((bf16*)xout + (size_t)m * 1024 + col) = xo; } else *(f32x4*)(xout + (size_t)m * 1024 + col) = v[j]; } }
        }
        float ss = 0.f;
#pragma unroll
        for (int j = 0; j < 4; ++j) ss += (v[j][0] * v[j][0] + v[j][1] * v[j][1]) + (v[j][2] * v[j][2] + v[j][3] * v[j][3]);
        const float rs = 1.0f / sqrtf(wave_sum(ss) * (1.0f / 1024.0f) + kEps);
        if (FINAL) {
#pragma unroll
            for (int j = 0; j < 4; ++j) *(f32x4*)(xout + (size_t)m * 1024 + 4 * lane + 256 * j) = v[j] * rs * gv[j];
        } else {
            f32x4 h[4];
#pragma unroll
            for (int j = 0; j < 4; ++j) { const int col = 4 * lane + 256 * j; const f32x4 sh = *(const f32x4*)(mb + ch_sh * 1024 + col), sc = *(const f32x4*)(mb + (ch_sh + 1) * 1024 + col);
                h[j] = (v[j] * rs * gv[j]) * (sc + 1.0f) + sh;
                v2u o; o.x = pk2(h[j][0], h[j][1]); o.y = pk2(h[j][2], h[j][3]); *(v2u*)(XN + (size_t)m * 1024 + col) = o; }
        }
    }
}
__device__ __forceinline__ float router_w(const Ptrs& p, int l, int k, int o) { return o < 4 ? p.moe_w_group[((size_t)l * 1024 + k) * 4 + o] : p.moe_w_expert[(((size_t)l * 4 + ((o - 4) >> 3)) * 1024 + k) * 8 + ((o - 4) & 7)]; }
__device__ __forceinline__ void ph_router_prep(const Ptrs& p, const float* MOD, int gw, int NGW, int lane, int gtid, int NT) {
    bf16* WTH = (bf16*)(p.ws + WS_WR); bf16* WTL = WTH + 4 * 48 * 1024; float* WC = (float*)(p.ws + WS_WC);
    for (int i = gtid; i < 4 * 48 * 1024; i += NT) { const int lb = i / 49152, r = i % 49152, n = r >> 10, k = r & 1023, l = lb >> 1;
        const float* mb = MOD + lb * 6144; const float w = n < 36 ? p.norm_g[(l * 2 + 1) * 1024 + k] * (1.0f + mb[4 * 1024 + k]) * router_w(p, l, k, n) : 0.f;
        const unsigned h = pk2(w, 0.f) & 0xffffu; const float wl = w - __uint_as_float(h << 16);
        WTH[i] = (bf16)h; WTL[i] = (bf16)(pk2(wl, 0.f) & 0xffffu); }
    for (int it = gw; it < 4 * 36; it += NGW) { const int lb = it / 36, o = it % 36, l = lb >> 1; const float* mb = MOD + lb * 6144; float a = 0.f;
        for (int j = 0; j < 16; ++j) { const int k = lane + 64 * j; a += mb[3 * 1024 + k] * router_w(p, l, k, o); }
        a = wave_sum(a);
        if (lane == 0) WC[lb * 48 + o] = a + (o < 4 ? p.moe_b_group[l * 4 + o] : p.moe_b_expert[l * 32 + (o - 4)]); }
}
__device__ __forceinline__ void ph_router(const Ptrs& p, const float* X, int layer, LAS unsigned char* lds, int vcu, int G, int wave, int lane, int gtid, int NT, bool dummy) {
    typedef short bf16x8r __attribute__((ext_vector_type(8)));
    unsigned char* ws = p.ws;
    const int n = lane & 15, q = lane >> 4;
    LAS unsigned* lcnt = (LAS unsigned*)(lds + RING_OFF);
    for (int it0 = vcu * NWAVES; it0 < kM / 16; it0 += G * NWAVES) { const bool valid = it0 + wave < kM / 16; const int it = valid ? it0 + wave : 0;
        if (wave == 0) lcnt[lane] = 0u;
        __syncthreads();
        const int m = it * 16 + n; const int lb = layer * 2 + ((it * 16) >= kS ? 1 : 0);
        const bf16* wth = (const bf16*)(ws + WS_WR) + ((size_t)lb * 48 + n) * 1024 + 8 * q; const bf16* wtl = wth + 4 * 48 * 1024;
        const bf16* xr = (const bf16*)X + (size_t)m * 1024 + 8 * q;
        f32x4 acc[3]; float ssq = 0.f;
#pragma unroll
        for (int t = 0; t < 3; ++t) acc[t] = (f32x4){0.f, 0.f, 0.f, 0.f};
#pragma unroll 2
        for (int i = 0; i < 32; ++i) {
            const v4u hw = *(const v4u*)(xr + 32 * i);
            { const float a0 = __uint_as_float(hw.x << 16), a1 = __uint_as_float(hw.x & 0xffff0000u), a2 = __uint_as_float(hw.y << 16), a3 = __uint_as_float(hw.y & 0xffff0000u),
                          a4 = __uint_as_float(hw.z << 16), a5 = __uint_as_float(hw.z & 0xffff0000u), a6 = __uint_as_float(hw.w << 16), a7 = __uint_as_float(hw.w & 0xffff0000u);
              ssq += ((a0 * a0 + a1 * a1) + (a2 * a2 + a3 * a3)) + ((a4 * a4 + a5 * a5) + (a6 * a6 + a7 * a7)); }
            const bf16x8r xh = __builtin_bit_cast(bf16x8r, hw);
#pragma unroll
            for (int t = 0; t < 3; ++t) { const bf16x8r wh = *(const bf16x8r*)(wth + (size_t)t * 16 * 1024 + 32 * i), wl = *(const bf16x8r*)(wtl + (size_t)t * 16 * 1024 + 32 * i);
                acc[t] = __builtin_amdgcn_mfma_f32_16x16x32_bf16(wh, xh, acc[t], 0, 0, 0); acc[t] = __builtin_amdgcn_mfma_f32_16x16x32_bf16(wl, xh, acc[t], 0, 0, 0); }
        }
        ssq = nsa::xsum_q(ssq);
        const float rs = 1.0f / sqrtf(ssq * (1.0f / 1024.0f) + kEps);
        const float* wc = (const float*)(ws + WS_WC) + lb * 48;
        float t[48];
#pragma unroll
        for (int tt = 0; tt < 3; ++tt)
#pragma unroll
            for (int r = 0; r < 4; ++r) { const float v = acc[tt][r] * rs + wc[16 * tt + 4 * q + r];
                auto a = __builtin_amdgcn_permlane16_swap(__float_as_uint(v), __float_as_uint(v), false, false);
                auto e = __builtin_amdgcn_permlane32_swap(a[0], a[0], false, false); auto o = __builtin_amdgcn_permlane32_swap(a[1], a[1], false, false);
                t[16 * tt + r] = __uint_as_float(e[0]); t[16 * tt + 4 + r] = __uint_as_float(o[0]); t[16 * tt + 8 + r] = __uint_as_float(e[1]); t[16 * tt + 12 + r] = __uint_as_float(o[1]); }
        int ea = 0, eb = 0, s0 = 0, s1 = 0; float w0 = 0.f, w1 = 0.f;
        if (q == 0 && valid) {
            int grp = 0; float lmax = t[0];
#pragma unroll
            for (int i = 1; i < 4; ++i) if (t[i] > lmax) { lmax = t[i]; grp = i; }
            float den = 0.f;
#pragma unroll
            for (int i = 0; i < 4; ++i) den += __expf(t[i] - lmax);
            const float ptop = 1.0f / den;
            float le[8];
#pragma unroll
            for (int e = 0; e < 8; ++e) le[e] = grp == 0 ? t[4 + e] : grp == 1 ? t[12 + e] : grp == 2 ? t[20 + e] : t[28 + e];
            int i0 = 0; float v0 = le[0];
#pragma unroll
            for (int i = 1; i < 8; ++i) if (le[i] > v0) { v0 = le[i]; i0 = i; }
            int i1 = -1; float v1 = -3.0e38f;
#pragma unroll
            for (int i = 0; i < 8; ++i) if (i != i0 && le[i] > v1) { v1 = le[i]; i1 = i; }
            const float ex = __expf(v1 - v0); w0 = ptop / (1.0f + ex); w1 = ptop * ex / (1.0f + ex);
            ea = grp * 8 + i0; eb = grp * 8 + i1;
            s0 = (int)__hip_atomic_fetch_add(lcnt + ea, 1u, __ATOMIC_RELAXED, __HIP_MEMORY_SCOPE_WORKGROUP); s1 = (int)__hip_atomic_fetch_add(lcnt + eb, 1u, __ATOMIC_RELAXED, __HIP_MEMORY_SCOPE_WORKGROUP);
        }
        __syncthreads();
        if (wave == 0 && lane < 32) { const unsigned c = lcnt[lane]; unsigned* cnt = (unsigned*)(ws + WS_CTL) + CW_CNT + layer * 32 + (dummy ? 64 : 0);
            lcnt[32 + lane] = c ? __hip_atomic_fetch_add(cnt + lane, c, RLX_AGENT) : 0u; }
        __syncthreads();
        if (q == 0 && valid) { s0 += (int)lcnt[32 + ea]; s1 += (int)lcnt[32 + eb];
            int* RT = (int*)(ws + (dummy ? WS_RE : WS_RC)); float* RW = (float*)(RT + 32 * 32768);
            RT[ea * 32768 + s0] = m * 2; RW[ea * 32768 + s0] = w0; RT[eb * 32768 + s1] = m * 2 + 1; RW[eb * 32768 + s1] = w1; }
        __syncthreads();
    }
}
__device__ __forceinline__ void ph_diffcombine(const Ptrs& p, const bf16* O0, const bf16* O1, bf16* AO, int gw, int NGW, int lane) {
    const float* lam = p.diff_lambda;
    const float s1 = wave_sum(lam[lane] * lam[64 + lane]), s2 = wave_sum(lam[128 + lane] * lam[192 + lane]);
    const float lam_full = __expf(s1) - __expf(s2) + 0.2f;
    float sg[8];
#pragma unroll
    for (int i = 0; i < 8; ++i) sg[i] = p.diff_subln_g[(8 * lane + i) & 127] * 0.8f;
    for (int m = gw; m < kM; m += NGW) {
#pragma unroll
        for (int j = 0; j < 2; ++j) { const size_t off = (size_t)m * 1024 + 512 * j + 8 * lane;
            const v4u a = *(const v4u*)(O0 + off), c = *(const v4u*)(O1 + off); float v[8];
#pragma unroll
            for (int i = 0; i < 4; ++i) { v[2 * i] = __uint_as_float(a[i] << 16) - lam_full * __uint_as_float(c[i] << 16); v[2 * i + 1] = __uint_as_float(a[i] & 0xffff0000u) - lam_full * __uint_as_float(c[i] & 0xffff0000u); }
            float ss = 0.f;
#pragma unroll
            for (int i = 0; i < 8; ++i) ss += v[i] * v[i];
            ss += __shfl_xor(ss, 1); ss += __shfl_xor(ss, 2); ss += __shfl_xor(ss, 4); ss += __shfl_xor(ss, 8);
            const float rs = 1.0f / sqrtf(ss * (1.0f / 128.0f) + kEps);
            v4u o; o.x = pk2(v[0] * rs * sg[0], v[1] * rs * sg[1]); o.y = pk2(v[2] * rs * sg[2], v[3] * rs * sg[3]); o.z = pk2(v[4] * rs * sg[4], v[5] * rs * sg[5]); o.w = pk2(v[6] * rs * sg[6], v[7] * rs * sg[7]);
            *(v4u*)(AO + off) = o; }
    }
}
__device__ __forceinline__ void moe_tpre(const Ptrs& p, int layer, LAS int* tpre, int tid) {
    if (tid < 32) { const unsigned* cnt = (const unsigned*)(p.ws + WS_CTL) + CW_CNT + layer * 32; tpre[40 + tid] = (int)__hip_atomic_load(cnt + tid, RLX_AGENT); }
    __syncthreads();
    if (tid < 32) { int acc = 0, nb = 0, ns = 0, nt_me = 0, sm_me = 0;
#pragma unroll 8
        for (int j = 0; j < 32; ++j) { const unsigned c_ = (unsigned)tpre[40 + j]; const int nt = (int)((c_ + 255u) >> 8);
            const int small = (c_ != 0u && ((c_ - 1u) & 255u) < 128u) ? 1 : 0;
            if (j < tid) { acc += nt; nb += nt - small; ns += small; }
            if (j == tid) { nt_me = nt; sm_me = small; } }
        tpre[tid] = acc; tpre[80 + tid] = nb; if (sm_me) tpre[120 + ns] = tid;
        if (tid == 31) { tpre[32] = acc + nt_me; tpre[112] = nb + nt_me - sm_me; tpre[152] = ns + sm_me; } }
    __syncthreads();
}
__device__ __forceinline__ void ph_gather(const Ptrs& p, const bf16* XN, bf16* Xg, const LAS int* tpre, int gw, int NGW, int lane) {
    unsigned char* ws = p.ws; int* rowtok = (int*)(ws + WS_ROWTOK); float* rowwt = (float*)(ws + WS_ROWWT);
    for (int it = gw; it < 2 * kM; it += NGW) { const int m = it >> 1, k = it & 1; const int* ro = (const int*)(ws + WS_ROUTE) + (size_t)m * 6;
        const int e = ro[k], slot = ro[2 + k]; const float w = ((const float*)ro)[4 + k]; const int row = tpre[e & 31] * 256 + slot;
        const v4u* src = (const v4u*)(XN + (size_t)m * 1024); v4u* dst = (v4u*)(Xg + (size_t)row * 1024);
        dst[lane] = src[lane]; dst[64 + lane] = src[64 + lane];
        if (lane == 0) { rowtok[row] = it; rowwt[row] = w; } }
}
__device__ __forceinline__ void ph_vtrans(const Ptrs& p, const bf16* P, bf16* VTS, bf16* KTS, LAS unsigned char* lds, int gw, int NGW, int wave, int lane) {
    LAS bf16* scr = (LAS bf16*)(lds + RING_OFF + wave * 16384);
    unsigned char* V8 = (unsigned char*)VTS; unsigned char* K8 = (unsigned char*)KTS;
    const int n = lane & 15, q = lane >> 4;
    for (int it = gw; it < 4 * 512; it += NGW) { const int bg = (it >> 9) & 3, G = it & 511, b = bg >> 1, g = bg & 1;
        const bf16* src = P + ((size_t)b * kS + 32 * G) * 2048 + nsa::COL_VS + g * 64;
        { const int kk = lane >> 1, hf = lane & 1; const v4u* sp = (const v4u*)(src + (size_t)kk * 2048 + hf * 32);
#pragma unroll
          for (int c = 0; c < 4; ++c) { const v4u v = sp[c]; LAS unsigned* d = (LAS unsigned*)(scr + kk * 66 + hf * 32 + c * 8); d[0] = v.x; d[1] = v.y; d[2] = v.z; d[3] = v.w; } }
        LDS_WAIT(); asm volatile("" ::: "memory");
#pragma unroll
        for (int h = 0; h < 2; ++h) { unsigned w[4];
#pragma unroll
            for (int e = 0; e < 2; ++e) { const int d = 16 * (2 * h + e) + n; float x[8];
#pragma unroll
                for (int j = 0; j < 8; ++j) x[j] = bf2f(scr[(8 * q + j) * 66 + d]);
                w[2 * e] = nsa::fp8x4(x[0], x[1], x[2], x[3]); w[2 * e + 1] = nsa::fp8x4(x[4], x[5], x[6], x[7]); }
            v4u o; o.x = w[0]; o.y = w[1]; o.z = w[2]; o.w = w[3]; *(v4u*)(V8 + ((size_t)(bg * 512 + G) * 2 + h) * 1024 + lane * 16) = o; }
        LDS_WAIT(); asm volatile("" ::: "memory");
        { const bf16* ks = P + ((size_t)b * kS + 32 * G) * 2048 + nsa::COL_KS + g * 64;
          { const int kk = lane >> 1, hf = lane & 1; const v4u* sp = (const v4u*)(ks + (size_t)kk * 2048 + hf * 32);
#pragma unroll
            for (int c = 0; c < 4; ++c) { const v4u v = sp[c]; LAS unsigned* d = (LAS unsigned*)(scr + kk * 66 + hf * 32 + c * 8); d[0] = v.x; d[1] = v.y; d[2] = v.z; d[3] = v.w; } }
          LDS_WAIT(); asm volatile("" ::: "memory");
#pragma unroll
          for (int T = 0; T < 2; ++T) { const int key = 8 * (n >> 2) + 4 * T + (n & 3); unsigned w[4];
#pragma unroll
              for (int dh = 0; dh < 2; ++dh) { float x[8];
#pragma unroll
                  for (int j = 0; j < 8; ++j) x[j] = bf2f(scr[key * 66 + 32 * dh + 8 * q + j]);
                  w[2 * dh] = nsa::fp8x4(x[0], x[1], x[2], x[3]); w[2 * dh + 1] = nsa::fp8x4(x[4], x[5], x[6], x[7]); }
              v4u o; o.x = w[0]; o.y = w[1]; o.z = w[2]; o.w = w[3]; *(v4u*)(K8 + ((size_t)(bg * 512 + G) * 2 + T) * 1024 + lane * 16) = o; }
          LDS_WAIT(); asm volatile("" ::: "memory"); } }
}

constexpr int N_PHASES = 23;
struct Args { Ptrs p; int ph_lo, ph_hi; };
typedef const unsigned long long __attribute__((address_space(4))) kq_t;
template <class T> __device__ __forceinline__ T* as_global(T* q) { return (T*)(GAS T*)q; }
__global__ void __launch_bounds__(NWAVES * 64, 2) mega_fwd(Args args_unused) {
    extern __shared__ __attribute__((aligned(16))) unsigned char lds_raw[];
    LAS unsigned char* lds = (LAS unsigned char*)lds_raw;
    for (int u = threadIdx.x; u < (LDS_BYTES - LDSCTL_OFF) / 4; u += NWAVES * 64) ((LAS unsigned*)(lds + LDSCTL_OFF))[u] = 0u;
    __syncthreads();
    volatile LAS unsigned* MISC = (volatile LAS unsigned*)(lds + MISC_OFF);
    LAS int* tpre = (LAS int*)(lds + TPRE_OFF);
    int lo, hi;
    { kq_t* kq = (kq_t*)__builtin_amdgcn_kernarg_segment_ptr(); const unsigned long long w = kq[26]; lo = (int)(unsigned)w; hi = (int)(unsigned)(w >> 32); }
#if MK_SINGLE
    XcdBarrier bar;
    { kq_t* kq = (kq_t*)__builtin_amdgcn_kernarg_segment_ptr(); bar = xcd_barrier_post((unsigned*)((unsigned char*)kq[25] + WS_CTL) + CW_BAR, MISC + 8); }
#define GRID_BAR() xcd_barrier(bar)
#else
#define GRID_BAR() do {} while (0)
#endif
#ifndef PH_MASK
#define PH_MASK 0xffffffffu
#endif
#define IN(k) ((((PH_MASK) >> (k)) & 1u) && lo <= (k) && (k) < hi)
#ifndef REP_MASK
#define REP_MASK 0u
#endif
#define PH_REPS(k) (1 + (int)(((REP_MASK) >> (k)) & 1u))
#define SEAM(k) do { if (IN(k) && IN((k) + 1)) GRID_BAR(); } while (0)
#define PH_BEGIN \
    kq_t* kq_ = (kq_t*)__builtin_amdgcn_kernarg_segment_ptr(); asm volatile("" : "+s"(kq_)); \
    Ptrs p; p.x = (const float*)(GAS const float*)(unsigned long long)kq_[0]; p.c = (const float*)(GAS const float*)(unsigned long long)kq_[1]; p.pos = (const int*)(GAS const int*)(unsigned long long)kq_[2]; p.ada_w = (const float*)(GAS const float*)(unsigned long long)kq_[3]; p.ada_b = (const float*)(GAS const float*)(unsigned long long)kq_[4]; p.norm_g = (const float*)(GAS const float*)(unsigned long long)kq_[5]; p.final_g = (const float*)(GAS const float*)(unsigned long long)kq_[6]; p.diff_w_in = (const float*)(GAS const float*)(unsigned long long)kq_[7]; p.diff_w_out = (const float*)(GAS const float*)(unsigned long long)kq_[8]; p.diff_lambda = (const float*)(GAS const float*)(unsigned long long)kq_[9]; p.diff_subln_g = (const float*)(GAS const float*)(unsigned long long)kq_[10]; p.nsa_w_in = (const float*)(GAS const float*)(unsigned long long)kq_[11]; p.nsa_w_out = (const float*)(GAS const float*)(unsigned long long)kq_[12]; p.nsa_cmp_pos = (const float*)(GAS const float*)(unsigned long long)kq_[13]; p.nsa_cmp_w1 = (const float*)(GAS const float*)(unsigned long long)kq_[14]; p.nsa_cmp_b1 = (const float*)(GAS const float*)(unsigned long long)kq_[15]; p.nsa_cmp_w2 = (const float*)(GAS const float*)(unsigned long long)kq_[16]; p.moe_w_group = (const float*)(GAS const float*)(unsigned long long)kq_[17]; p.moe_b_group = (const float*)(GAS const float*)(unsigned long long)kq_[18]; p.moe_w_expert = (const float*)(GAS const float*)(unsigned long long)kq_[19]; p.moe_b_expert = (const float*)(GAS const float*)(unsigned long long)kq_[20]; p.moe_w_gate = (const float*)(GAS const float*)(unsigned long long)kq_[21]; p.moe_w_up = (const float*)(GAS const float*)(unsigned long long)kq_[22]; p.moe_w_down = (const float*)(GAS const float*)(unsigned long long)kq_[23]; p.out = (float*)(GAS float*)(unsigned long long)kq_[24]; p.ws = (unsigned char*)(GAS unsigned char*)(unsigned long long)kq_[25]; \
    unsigned char* ws = p.ws; int G = gridDim.x, bx = blockIdx.x; asm volatile("" : "+s"(G), "+s"(bx)); \
    const int tid = threadIdx.x, lane = tid & 63, wave = __builtin_amdgcn_readfirstlane(tid >> 6); (void)lane; \
    const int vcu = (G % 8 == 0) ? (bx % 8) * (G / 8) + bx / 8 : bx; \
    const int gw = vcu * NWAVES + wave, NGW = G * NWAVES, gtid = bx * (NWAVES * 64) + tid, NT = G * NWAVES * 64; \
    bf16* const RA = (bf16*)(ws + WS_RA); bf16* const RB = (bf16*)(ws + WS_RB); bf16* const RC = (bf16*)(ws + WS_RC); bf16* const RD = (bf16*)(ws + WS_RD); bf16* const RE = (bf16*)(ws + WS_RE); bf16* const RF = (bf16*)(ws + WS_RF); \
    const float* MOD = (const float*)(ws + WS_MOD); const float* ROPE = (const float*)(ws + WS_ROPE); \
    int* rowtok = (int*)(ws + WS_ROWTOK); float* rowwt = (float*)(ws + WS_ROWWT); \
    (void)vcu; (void)gw; (void)NGW; (void)gtid; (void)NT; (void)RA; (void)RB; (void)RC; (void)RD; (void)RE; (void)RF; (void)MOD; (void)ROPE; (void)rowtok; (void)rowwt;

    if (IN(0)) for (int rep_ = 0; rep_ < PH_REPS(0); ++rep_) { const bool dummy_ = rep_ + 1 < PH_REPS(0); if (rep_) __syncthreads(); PH_BEGIN ph_prologue(p, lds, gw, NGW, wave, lane, gtid, NT); } SEAM(0);
    if (IN(1)) for (int rep_ = 0; rep_ < PH_REPS(1); ++rep_) { const bool dummy_ = rep_ + 1 < PH_REPS(1); if (rep_) __syncthreads(); PH_BEGIN ph_finalize(p, gtid, NT); } SEAM(1);
    if (IN(2)) for (int rep_ = 0; rep_ < PH_REPS(2); ++rep_) { const bool dummy_ = rep_ + 1 < PH_REPS(2); if (rep_) __syncthreads(); PH_BEGIN ph_rows<false, false, false>(p, p.x, nullptr, nullptr, MOD, 0, 0, p.norm_g, RA, 0, gw, NGW, lane, gtid, NT); ph_router_prep(p, MOD, gw, NGW, lane, gtid, NT); } SEAM(2);
    if (IN(3)) for (int rep_ = 0; rep_ < PH_REPS(3); ++rep_) { const bool dummy_ = rep_ + 1 < PH_REPS(3); if (rep_) __syncthreads(); PH_BEGIN pg8::Gemm g{RA, (const bf16*)(ws + WS_WQKV), kM, 3072, 1024, 1024}; pg8::StaticOrder S; S.init(kM, 3072, G, bx);
        pg8::EpiQKV E{RB, (size_t)(WS_RC - WS_RB) / 2, pg8::RopeCtx{ROPE, 0xffffu}};
        pg8::gemm_phase<pg8::EpiQKV, pg8::StaticOrder, true, true>(lds + RING_OFF, g, S, E); } SEAM(3);
    if (IN(4)) for (int rep_ = 0; rep_ < PH_REPS(4); ++rep_) { const bool dummy_ = rep_ + 1 < PH_REPS(4); if (rep_) __syncthreads(); PH_BEGIN attn_body::diff_attn_phase2<8>((char*)lds_raw + RING_OFF, (const attn_body::bf16*)RB, (const attn_body::bf16*)RC, (const attn_body::bf16*)RD, (attn_body::bf16*)RE, (attn_body::bf16*)RF, vcu, G); } SEAM(4);
    if (IN(5)) for (int rep_ = 0; rep_ < PH_REPS(5); ++rep_) { const bool dummy_ = rep_ + 1 < PH_REPS(5); if (rep_) __syncthreads(); PH_BEGIN ph_diffcombine(p, RE, RF, RA, gw, NGW, lane); } SEAM(5);
    if (IN(6)) for (int rep_ = 0; rep_ < PH_REPS(6); ++rep_) { const bool dummy_ = rep_ + 1 < PH_REPS(6); if (rep_) __syncthreads(); PH_BEGIN pg8::Gemm g{RA, (const bf16*)(ws + WS_WO0), kM, 1024, 1024, 1024}; pg8::StaticOrder S; S.init(kM, 1024, G, bx);
        pg8::EpiResidB E{p.x, nullptr, RD, MOD + 2 * 1024};
        pg8::gemm_phase<pg8::EpiResidB, pg8::StaticOrder, true, true>(lds + RING_OFF, g, S, E); } SEAM(6);
    if (IN(7)) for (int rep_ = 0; rep_ < PH_REPS(7); ++rep_) { const bool dummy_ = rep_ + 1 < PH_REPS(7); if (rep_) __syncthreads(); PH_BEGIN ph_rows<false, false, true>(p, (const float*)RD, nullptr, nullptr, MOD, 3, 0, p.norm_g + 1024, RB, 0, gw, NGW, lane, gtid, NT); ph_router(p, (const float*)RD, 0, lds, vcu, G, wave, lane, gtid, NT, dummy_); } SEAM(7);
    if (IN(9)) for (int rep_ = 0; rep_ < PH_REPS(9); ++rep_) { const bool dummy_ = rep_ + 1 < PH_REPS(9); (void)dummy_; if (rep_) __syncthreads(); PH_BEGIN
        moe_tpre(p, 0, tpre, tid); pg8::Gemm g{RB, (const bf16*)(ws + WS_MOE0), kMpad, 32 * 512, 1024, 1024}; pg8::MoeOrder S{tpre, 2, G, bx};
        const int* RT = (const int*)(ws + WS_RC); const float* RW = (const float*)(RT + 32 * 32768);
        LAS unsigned* gtab = (LAS unsigned*)(lds + GTAB_OFF);
        for (int i = 0; i < GTAB_UNITS; ++i) { pg8::Unit u; if (!S.next(i, u)) break;
            if (tid < 256) { const int idx = u.ti * 256 + tid; const int tok = idx < u.cnt ? (RT[u.e * 32768 + idx] >> 1) : 0; gtab[i * 256 + tid] = (unsigned)tok * 2048u; } }
        __syncthreads();
        pg8::EpiGateUp E{RF, RW}; pg8::gemm_phase_g<pg8::EpiGateUp, pg8::MoeOrder, true>(lds + RING_OFF, g, S, E, gtab); } SEAM(9);
    if (IN(10)) for (int rep_ = 0; rep_ < PH_REPS(10); ++rep_) { const bool dummy_ = rep_ + 1 < PH_REPS(10); if (rep_) __syncthreads(); PH_BEGIN moe_tpre(p, 0, tpre, tid); pg8::Gemm g{RF, (const bf16*)(ws + WS_MOE0 + MOE_WD), kMpad, 32 * 1024, 256, 256}; pg8::MoeOrder S{tpre, 4, G, bx};
        pg8::EpiScatter E{ws, (unsigned)WS_RA, (unsigned)WS_DUMP, (const int*)(ws + WS_RC)}; pg8::gemm_phase<pg8::EpiScatter, pg8::MoeOrder, true, true>(lds + RING_OFF, g, S, E); } SEAM(10);
    if (IN(11)) for (int rep_ = 0; rep_ < PH_REPS(11); ++rep_) { const bool dummy_ = rep_ + 1 < PH_REPS(11); if (rep_) __syncthreads(); PH_BEGIN ph_rows<true, false, true>(p, (const float*)RD, dummy_ ? (float*)RE : p.out, RA, MOD, 12, 5, p.norm_g + 2048, RC, 1, gw, NGW, lane, gtid, NT); }         SEAM(11);
    if (IN(12)) for (int rep_ = 0; rep_ < PH_REPS(12); ++rep_) { const bool dummy_ = rep_ + 1 < PH_REPS(12); if (rep_) __syncthreads(); PH_BEGIN pg8::Gemm g{RC, (const bf16*)(ws + WS_WNSA), kM, 2048, 1024, 1024}; pg8::StaticOrder S; S.init(kM, 2048, G, bx);
        pg8::EpiNsaProj E{RD, (bf16*)(ws + NS_KC), pg8::RopeCtx{ROPE, 0x3cffu}};
        pg8::gemm_phase<pg8::EpiNsaProj, pg8::StaticOrder, true, true>(lds + RING_OFF, g, S, E); } SEAM(12);
    if (IN(13)) for (int rep_ = 0; rep_ < PH_REPS(13); ++rep_) { const bool dummy_ = rep_ + 1 < PH_REPS(13); (void)dummy_; if (rep_) __syncthreads();
        { PH_BEGIN pg8::Gemm g{(const bf16*)(ws + NS_KC), (const bf16*)(ws + WS_W1C), 8192, 512, 2048, 1024}; pg8::CmpOrder S{G, bx};
          pg8::EpiCmp1 E{(bf16*)(ws + NS_HID), (const float*)(ws + WS_CBF)};
          pg8::gemm_phase<pg8::EpiCmp1, pg8::CmpOrder, true, true>(lds + RING_OFF, g, S, E); }
        asm volatile("s_waitcnt vmcnt(0)" ::: "memory"); __builtin_amdgcn_fence(__ATOMIC_RELEASE, "workgroup"); __syncthreads(); __builtin_amdgcn_fence(__ATOMIC_ACQUIRE, "workgroup");
        { PH_BEGIN pg8::Gemm g{(const bf16*)(ws + NS_HID), (const bf16*)(ws + WS_W2C), 8192, 512, 256, 256}; pg8::CmpOrder S{G, bx};
          pg8::EpiCmp2 E{(unsigned char*)(ws + NS_KCMP), (unsigned char*)(ws + NS_VCT)};
          pg8::gemm_phase<pg8::EpiCmp2, pg8::CmpOrder, true, true>(lds + RING_OFF, g, S, E); }
        __syncthreads();
        { PH_BEGIN ph_vtrans(p, RD, (bf16*)(ws + NS_VTS), (bf16*)(ws + NS_VTW), lds, gw, NGW, wave, lane); }
        __syncthreads();
        { PH_BEGIN attn_body::nsa_window_phase((char*)lds_raw + RING_OFF, (const attn_body::bf16*)RD, (attn_body::bf16*)RB, (unsigned*)(ws + WS_CTL) + CW_QCTR + 128 + rep_ * 64, MISC + 16); }
    } SEAM(13);
    if (IN(16)) for (int rep_ = 0; rep_ < PH_REPS(16); ++rep_) { const bool dummy_ = rep_ + 1 < PH_REPS(16); if (rep_) __syncthreads(); PH_BEGIN const nsa::Tensors T{RD, (const unsigned char*)(ws + NS_KCMP), (const unsigned char*)(ws + NS_VTW), (const unsigned char*)(ws + NS_VCT), (const unsigned char*)(ws + NS_VTS), RB, RA};
        LAS float* wl = (LAS float*)(lds + RING_OFF + wave * 16384);
        unsigned* qbase = (unsigned*)(ws + WS_CTL) + CW_QCTR + 1024 + rep_ * 512;
        const unsigned xcc = xb_xcc_id() & 7u;
        for (unsigned qi = 0; qi < 8u; ++qi) { const unsigned qq = (xcc + qi) & 7u; unsigned* qc = qbase + qq * 64;
            for (;;) { unsigned it = 0; if (lane == 0) it = __hip_atomic_fetch_add(qc, 1u, RLX_AGENT); it = (unsigned)__builtin_amdgcn_readfirstlane((int)it);
                if (it >= 2048u) break;
                nsa::quad_item(T, (int)(((qq >> 1) << 12) | ((qq & 1u) * 2048u + 2047u - it)), wl, lane); } } } SEAM(16);
    if (IN(17)) for (int rep_ = 0; rep_ < PH_REPS(17); ++rep_) { const bool dummy_ = rep_ + 1 < PH_REPS(17); if (rep_) __syncthreads(); PH_BEGIN pg8::Gemm g{RA, (const bf16*)(ws + WS_WO1), kM, 1024, 1024, 1024}; pg8::StaticOrder S; S.init(kM, 1024, G, bx);
        pg8::EpiResidB E{nullptr, (const bf16*)p.out, dummy_ ? RE : RD, MOD + 12288 + 2 * 1024};
        pg8::gemm_phase<pg8::EpiResidB, pg8::StaticOrder, true, true>(lds + RING_OFF, g, S, E); } SEAM(17);
    if (IN(18)) for (int rep_ = 0; rep_ < PH_REPS(18); ++rep_) { const bool dummy_ = rep_ + 1 < PH_REPS(18); if (rep_) __syncthreads(); PH_BEGIN ph_rows<false, false, true>(p, (const float*)RD, nullptr, nullptr, MOD + 12288, 3, 0, p.norm_g + 3072, RB, 1, gw, NGW, lane, gtid, NT); ph_router(p, (const float*)RD, 1, lds, vcu, G, wave, lane, gtid, NT, dummy_); } SEAM(18);
    if (IN(20)) for (int rep_ = 0; rep_ < PH_REPS(20); ++rep_) { const bool dummy_ = rep_ + 1 < PH_REPS(20); (void)dummy_; if (rep_) __syncthreads(); PH_BEGIN
        moe_tpre(p, 1, tpre, tid); pg8::Gemm g{RB, (const bf16*)(ws + WS_MOE0 + MOE_L), kMpad, 32 * 512, 1024, 1024}; pg8::MoeOrder S{tpre, 2, G, bx};
        const int* RT = (const int*)(ws + WS_RC); const float* RW = (const float*)(RT + 32 * 32768);
        LAS unsigned* gtab = (LAS unsigned*)(lds + GTAB_OFF);
        for (int i = 0; i < GTAB_UNITS; ++i) { pg8::Unit u; if (!S.next(i, u)) break;
            if (tid < 256) { const int idx = u.ti * 256 + tid; const int tok = idx < u.cnt ? (RT[u.e * 32768 + idx] >> 1) : 0; gtab[i * 256 + tid] = (unsigned)tok * 2048u; } }
        __syncthreads();
        pg8::EpiGateUp E{RF, RW}; pg8::gemm_phase_g<pg8::EpiGateUp, pg8::MoeOrder, true>(lds + RING_OFF, g, S, E, gtab); } SEAM(20);
    if (IN(21)) for (int rep_ = 0; rep_ < PH_REPS(21); ++rep_) { const bool dummy_ = rep_ + 1 < PH_REPS(21); if (rep_) __syncthreads(); PH_BEGIN moe_tpre(p, 1, tpre, tid); pg8::Gemm g{RF, (const bf16*)(ws + WS_MOE0 + MOE_L + MOE_WD), kMpad, 32 * 1024, 256, 256}; pg8::MoeOrder S{tpre, 4, G, bx};
        pg8::EpiScatter E{ws, (unsigned)WS_RA, (unsigned)WS_DUMP, (const int*)(ws + WS_RC)}; pg8::gemm_phase<pg8::EpiScatter, pg8::MoeOrder, true, true>(lds + RING_OFF, g, S, E); } SEAM(21);
    if (IN(22)) for (int rep_ = 0; rep_ < PH_REPS(22); ++rep_) { const bool dummy_ = rep_ + 1 < PH_REPS(22); if (rep_) __syncthreads(); PH_BEGIN ph_rows<true, true, true>(p, (const float*)RD, dummy_ ? (float*)RE : p.out, RA, MOD + 12288, 0, 5, p.final_g, nullptr, 1, gw, NGW, lane, gtid, NT); }
#undef IN
#undef SEAM
}

extern "C" void kernel_launch(void* const* d_in, const int* in_sizes, int n_in, void* d_out, int out_size, void* d_ws, size_t ws_size, hipStream_t stream) {
    static int grid = 0;
    if (grid == 0) {
        if (n_in != 24 || in_sizes[0] != kM * kD || out_size != kM * kD || ws_size < WS_END) { fprintf(stderr, "kernel_launch: unexpected shapes (n_in %d, in0 %d, out %d, ws %zu)\n", n_in, n_in > 0 ? in_sizes[0] : -1, out_size, ws_size); grid = -1; return; }
        int dev = 0, cus = 0, per_cu = 0;
        if (hipGetDevice(&dev) != hipSuccess || hipDeviceGetAttribute(&cus, hipDeviceAttributeMultiprocessorCount, dev) != hipSuccess) { grid = -1; return; }
        if (hipFuncSetAttribute((const void*)mega_fwd, hipFuncAttributeMaxDynamicSharedMemorySize, LDS_BYTES) != hipSuccess) { fprintf(stderr, "kernel_launch: hipFuncSetAttribute failed\n"); grid = -1; return; }
        if (hipOccupancyMaxActiveBlocksPerMultiprocessor(&per_cu, (const void*)mega_fwd, NWAVES * 64, LDS_BYTES) != hipSuccess || per_cu < 1) { fprintf(stderr, "kernel_launch: occupancy query says %d\n", per_cu); }
        (void)hipGetLastError();
        grid = cus;
    }
    if (grid < 0) return;
    if (hipMemsetAsync((char*)d_ws + WS_CTL, 0, CTL_ZERO_BYTES, stream) != hipSuccess) return;
    Args a{};
    const void** pp = (const void**)&a.p;
    for (int i = 0; i < 24; ++i) pp[i] = d_in[i];
    a.p.out = (float*)d_out; a.p.ws = (unsigned char*)d_ws;
#if MK_SINGLE
    a.ph_lo = 0; a.ph_hi = N_PHASES;
    hipLaunchKernelGGL(mega_fwd, dim3(grid), dim3(NWAVES * 64), LDS_BYTES, stream, a);
#else
    for (int ph = 0; ph < N_PHASES; ++ph) { a.ph_lo = ph; a.ph_hi = ph + 1; hipLaunchKernelGGL(mega_fwd, dim3(grid), dim3(NWAVES * 64), LDS_BYTES, stream, a); }
#endif
}
```

```cpp
#include <hip/hip_runtime.h>
#include <cstdio>
#include <cstdint>
namespace pg8 {
#define PG8_LAS __attribute__((address_space(3)))
typedef unsigned short bf16_t;
typedef short bf16x8 __attribute__((ext_vector_type(8)));
typedef float f32x4 __attribute__((ext_vector_type(4)));
typedef unsigned u32x4 __attribute__((ext_vector_type(4)));
constexpr int BM = 256, BK = 64, HALF = 128, HTB = HALF * BK * 2  , STAGE_BYTES = 8 * HTB, NXCD = 8, WGM = 8;

__host__ __device__ __forceinline__ int lds_byte(int r, int c) { const int st = (r >> 4) * 2 + (c >> 5), rr = r & 15, cc = c & 31, ob = rr * 64 + cc * 2; return st * 1024 + (ob ^ (((ob >> 9) & 1) << 5)); }
__host__ __device__ __forceinline__ void stage_rc(int b, int& R, int& C) { const int st = b / 1024, sb = b % 1024, swz = sb ^ (((sb >> 9) & 1) << 5); R = (st >> 1) * 16 + swz / 64; C = (st & 1) * 32 + (swz % 64) / 2; }
__host__ __device__ __forceinline__ int perm32(int rho) { const int n = rho >> 4, i = rho & 15; return 8 * (i >> 2) + 4 * n + (i & 3); }

struct Unit { int pm, pn, e, ti, cnt; };
struct Gemm { const bf16_t* A; const bf16_t* Bt; int M, N, K, lda; };

struct StaticOrder {
    int nM, nN, nwg, G, c;
    __host__ __device__ void init(int M, int N, int G_, int c_) { nM = M / BM; nN = N / BM; nwg = nM * nN; G = G_; c = c_; }
    __host__ __device__ bool next(int i, Unit& u) const {
        const long L = (long)i * G + c; if (L >= nwg) return false;
        int wgid = (int)L; { const int q = nwg / NXCD, r = nwg % NXCD, xcd = wgid % NXCD, off = wgid / NXCD; wgid = (xcd < r ? xcd * (q + 1) : r * (q + 1) + (xcd - r) * q) + off; }
        const int nig = WGM * nN, gid = wgid / nig, fm = gid * WGM, gsz = (nM - fm) < WGM ? (nM - fm) : WGM;
        u.pm = fm + ((wgid % nig) % gsz); u.pn = (wgid % nig) / gsz; return true;
    }
    __device__ __forceinline__ void a_ready(const Unit&) const {}
    __device__ __forceinline__ void done(const Unit&) const {}
};

__device__ __forceinline__ unsigned cvt_pk_bf16(float lo, float hi) { unsigned r; asm volatile("v_cvt_pk_bf16_f32 %0, %1, %2" : "=v"(r) : "v"(lo), "v"(hi)); return r; }
typedef float f32x2 __attribute__((ext_vector_type(2)));

constexpr int kSeq = 16384, kTok = 32768;
struct RopeCtx { const float* rope; unsigned ropemask; };
__device__ __forceinline__ void rope8p(f32x4& v0, f32x4& v1, const RopeCtx& R, int ch, int wc, int fq, int bp, const f32x4 (&t)[4]) {
    if (((R.ropemask >> ch) & 1u) && ((wc & 1) == 0)) {
        f32x4 o0, o1;
#pragma unroll
        for (int i = 0; i < 4; ++i) { o0[i] = __int_as_float(__builtin_amdgcn_ds_bpermute(bp, __float_as_int(v0[i]))); o1[i] = __int_as_float(__builtin_amdgcn_ds_bpermute(bp, __float_as_int(v1[i]))); }
        if (fq < 2) { v0 = v0 * t[0] + o0 * t[2]; v1 = v1 * t[1] + o1 * t[3]; }
    }
}
__device__ __forceinline__ u32x4 pack8(const f32x4& v0, const f32x4& v1) { u32x4 w; w.x = cvt_pk_bf16(v0[0], v0[1]); w.y = cvt_pk_bf16(v0[2], v0[3]); w.z = cvt_pk_bf16(v1[0], v1[1]); w.w = cvt_pk_bf16(v1[2], v1[3]); return w; }

struct EpiQKV {
    static constexpr bool PERM = true, AFTER_DRAIN = false;
    bf16_t* O; size_t tstride; RopeCtx R;
    __device__ __forceinline__ void operator()(const f32x4 (&acc)[2][2][4][2], const Unit& u, int wr, int wc, int fr, int fq) const {
        const int row0 = u.pm * BM + wr * 64 + fr, bp = (((fq ^ 1) & 3) * 16 + fr) * 4;
#pragma unroll
        for (int ai = 0; ai < 2; ++ai)
        { f32x4 rt[4][4];
            if (((R.ropemask >> (2 * u.pn)) & 3u) && ((wc & 1) == 0) && fq < 2) { const float sg = (fq == 0) ? -1.f : 1.f;
#pragma unroll
                for (int m = 0; m < 4; ++m) { const f32x4* rp = (const f32x4*)(R.rope + (size_t)(row0 + ai * HALF + m * 16) * 16); rt[m][0] = rp[0]; rt[m][1] = rp[1]; rt[m][2] = rp[2] * sg; rt[m][3] = rp[3] * sg; } }
#pragma unroll
            for (int m = 0; m < 4; ++m) { const int row = row0 + ai * HALF + m * 16;
#pragma unroll
                for (int bj = 0; bj < 2; ++bj) { const int ch = 2 * u.pn + bj, t = ch >> 3, col = (ch & 7) * 128 + wc * 32 + 8 * fq;
                    f32x4 v0 = acc[ai][bj][m][0], v1 = acc[ai][bj][m][1]; rope8p(v0, v1, R, ch, wc, fq, bp, rt[m]);
                    *(u32x4*)(O + (size_t)t * tstride + (size_t)row * 1024 + col) = pack8(v0, v1); } } }
    }
};
struct EpiNsaProj {
    static constexpr bool PERM = true, AFTER_DRAIN = false;
    bf16_t* P; bf16_t* KC; RopeCtx R;
    __device__ __forceinline__ void operator()(const f32x4 (&acc)[2][2][4][2], const Unit& u, int wr, int wc, int fr, int fq) const {
        const int row0 = u.pm * BM + wr * 64 + fr, bp = (((fq ^ 1) & 3) * 16 + fr) * 4;
#pragma unroll
        for (int ai = 0; ai < 2; ++ai) { f32x4 rt[4][4];
            if (((R.ropemask >> (2 * u.pn)) & 3u) && ((wc & 1) == 0) && fq < 2) { const float sg = (fq == 0) ? -1.f : 1.f;
#pragma unroll
                for (int m = 0; m < 4; ++m) { const f32x4* rp = (const f32x4*)(R.rope + (size_t)(row0 + ai * HALF + m * 16) * 16); rt[m][0] = rp[0]; rt[m][1] = rp[1]; rt[m][2] = rp[2] * sg; rt[m][3] = rp[3] * sg; } }
#pragma unroll
            for (int m = 0; m < 4; ++m) { const int row = row0 + ai * HALF + m * 16;
#pragma unroll
                for (int bj = 0; bj < 2; ++bj) { const int ch = 2 * u.pn + bj;
                    f32x4 v0 = acc[ai][bj][m][0], v1 = acc[ai][bj][m][1]; rope8p(v0, v1, R, ch, wc, fq, bp, rt[m]);
                    bf16_t* dst;
                    if (ch == 8 || ch == 9) { const int kv = ch - 8, b = row >= kSeq ? 1 : 0, t = row - b * kSeq, gi = wc >> 1;
                        dst = KC + ((size_t)((kv * 2 + b) * 2 + gi) * kSeq + t) * 64 + (wc & 1) * 32 + 8 * fq; }
                    else dst = P + (size_t)row * 2048 + ch * 128 + wc * 32 + 8 * fq;
                    *(u32x4*)dst = pack8(v0, v1); } } }
    }
};
struct EpiResid {
    static constexpr bool PERM = false, AFTER_DRAIN = false;
    const float* base; float* out; const float* gate;
    __device__ __forceinline__ void operator()(const f32x4 (&acc)[2][2][4][2], const Unit& u, int wr, int wc, int fr, int fq) const {
        const int row0 = u.pm * BM + wr * 64 + fr, col0 = u.pn * BM + wc * 32 + 4 * fq;
        const float* gp = gate + ((u.pm * BM) >= kSeq ? 6144 : 0);
        f32x4 gv[2][2];
#pragma unroll
        for (int bj = 0; bj < 2; ++bj)
#pragma unroll
            for (int n = 0; n < 2; ++n) gv[bj][n] = *(const f32x4*)(gp + col0 + bj * HALF + n * 16);
#pragma unroll
        for (int ai = 0; ai < 2; ++ai)
#pragma unroll
            for (int m = 0; m < 4; ++m) { const size_t off = (size_t)(row0 + ai * HALF + m * 16) * 1024 + col0;
#pragma unroll
                for (int bj = 0; bj < 2; ++bj)
#pragma unroll
                    for (int n = 0; n < 2; ++n) { const f32x4 bs = *(const f32x4*)(base + off + bj * HALF + n * 16);
                        *(f32x4*)(out + off + bj * HALF + n * 16) = bs + gv[bj][n] * acc[ai][bj][m][n]; } }
    }
};
struct EpiResidB {
    static constexpr bool PERM = true, AFTER_DRAIN = false;
    const float* basef; const bf16_t* baseh; bf16_t* out; const float* gate;
    __device__ __forceinline__ void operator()(const f32x4 (&acc)[2][2][4][2], const Unit& u, int wr, int wc, int fr, int fq) const {
        const int row0 = u.pm * BM + wr * 64 + fr, col0 = u.pn * BM + wc * 32 + 8 * fq;
        const float* gp = gate + ((u.pm * BM) >= kSeq ? 6144 : 0);
        f32x4 gv[2][2];
#pragma unroll
        for (int bj = 0; bj < 2; ++bj) { gv[bj][0] = *(const f32x4*)(gp + col0 + bj * HALF); gv[bj][1] = *(const f32x4*)(gp + col0 + bj * HALF + 4); }
        if (basef) {
#pragma unroll
            for (int am = 0; am < 4; ++am) { const int ai = am >> 1, m0 = (am & 1) * 2; f32x4 bb[2][2][2];
#pragma unroll
                for (int m = 0; m < 2; ++m) { const size_t off = (size_t)(row0 + ai * HALF + (m0 + m) * 16) * 1024 + col0;
#pragma unroll
                    for (int bj = 0; bj < 2; ++bj) { bb[m][bj][0] = *(const f32x4*)(basef + off + bj * HALF); bb[m][bj][1] = *(const f32x4*)(basef + off + bj * HALF + 4); } }
#pragma unroll
                for (int m = 0; m < 2; ++m) { const size_t off = (size_t)(row0 + ai * HALF + (m0 + m) * 16) * 1024 + col0;
#pragma unroll
                    for (int bj = 0; bj < 2; ++bj) *(u32x4*)(out + off + bj * HALF) = pack8(bb[m][bj][0] + gv[bj][0] * acc[ai][bj][m0 + m][0], bb[m][bj][1] + gv[bj][1] * acc[ai][bj][m0 + m][1]); } }
        } else {
            u32x4 hb[2][4][2];
#pragma unroll
            for (int ai = 0; ai < 2; ++ai)
#pragma unroll
                for (int m = 0; m < 4; ++m) { const size_t off = (size_t)(row0 + ai * HALF + m * 16) * 1024 + col0;
#pragma unroll
                    for (int bj = 0; bj < 2; ++bj) hb[ai][m][bj] = *(const u32x4*)(baseh + off + bj * HALF); }
#pragma unroll
            for (int ai = 0; ai < 2; ++ai)
#pragma unroll
                for (int m = 0; m < 4; ++m) { const size_t off = (size_t)(row0 + ai * HALF + m * 16) * 1024 + col0;
#pragma unroll
                    for (int bj = 0; bj < 2; ++bj) { const u32x4 h = hb[ai][m][bj];
                        const f32x4 b0 = (f32x4){__uint_as_float(h.x << 16), __uint_as_float(h.x & 0xffff0000u), __uint_as_float(h.y << 16), __uint_as_float(h.y & 0xffff0000u)};
                        const f32x4 b1 = (f32x4){__uint_as_float(h.z << 16), __uint_as_float(h.z & 0xffff0000u), __uint_as_float(h.w << 16), __uint_as_float(h.w & 0xffff0000u)};
                        *(u32x4*)(out + off + bj * HALF) = pack8(b0 + gv[bj][0] * acc[ai][bj][m][0], b1 + gv[bj][1] * acc[ai][bj][m][1]); } }
        }
    }
};
struct EpiGateUp {
    static constexpr bool PERM = true, AFTER_DRAIN = false;
    bf16_t* ACT; const float* RW;
    __device__ __forceinline__ void operator()(const f32x4 (&acc)[2][2][4][2], const Unit& u, int wr, int wc, int fr, int fq) const {
        const int rl0 = wr * 64 + fr, col = (u.pn & 1) * 128 + wc * 32 + 8 * fq; const float* rwp = RW + u.e * 32768 + u.ti * 256; const int lim = u.cnt - u.ti * 256;
        float wtw[2];
#pragma unroll
        for (int ai = 0; ai < 2; ++ai) { const int rl = wr * 64 + ai * HALF + fq * 16 + fr; const float wv = rwp[rl < lim ? rl : 0]; wtw[ai] = rl < lim ? wv : 0.f; }
#pragma unroll
        for (int ai = 0; ai < 2; ++ai)
#pragma unroll
            for (int m = 0; m < 4; ++m) { const int rl = rl0 + ai * HALF + m * 16; const float wt = __int_as_float(__builtin_amdgcn_ds_bpermute((m * 16 + fr) * 4, __float_as_int(wtw[ai])));
                f32x4 a[2];
#pragma unroll
                for (int n = 0; n < 2; ++n)
#pragma unroll
                    for (int i = 0; i < 4; ++i) { const float g = acc[ai][0][m][n][i], up = acc[ai][1][m][n][i];
                        const float sg = g * __builtin_amdgcn_rcpf(1.0f + __builtin_amdgcn_exp2f(-1.4426950408889634f * g)); a[n][i] = sg * up * wt; }
                *(u32x4*)(ACT + (size_t)(u.pm * BM + rl) * 256 + col) = pack8(a[0], a[1]); }
    }
};
struct EpiScatter {
    static constexpr bool PERM = true, AFTER_DRAIN = false;
    unsigned char* B; unsigned yoff, doff; const int* RT;
    __device__ __forceinline__ void operator()(const f32x4 (&acc)[2][2][4][2], const Unit& u, int wr, int wc, int fr, int fq) const {
        asm volatile("" : "+v"(fr), "+v"(fq));
        const int rl0 = wr * 64 + fr, col0 = (u.pn & 3) * BM + wc * 32 + 8 * fq; const int* rtp = RT + u.e * 32768 + u.ti * 256; const int lim = u.cnt - u.ti * 256;
        int tkw[2];
#pragma unroll
        for (int ai = 0; ai < 2; ++ai) { const int rl = wr * 64 + ai * HALF + fq * 16 + fr; const int tv = rtp[rl < lim ? rl : 0]; tkw[ai] = rl < lim ? tv : -1; }
#pragma unroll
        for (int ai = 0; ai < 2; ++ai)
#pragma unroll
            for (int m = 0; m < 4; ++m) { const int tk = __builtin_amdgcn_ds_bpermute((m * 16 + fr) * 4, tkw[ai]);
                const unsigned yo = (tk >= 0 ? yoff + ((unsigned)(tk & 1) * (unsigned)kTok + (unsigned)(tk >> 1)) * 2048u : doff) + (unsigned)col0 * 2u;
#pragma unroll
                for (int bj = 0; bj < 2; ++bj) *(u32x4*)(B + (size_t)(yo + (unsigned)(bj * HALF * 2))) = pack8(acc[ai][bj][m][0], acc[ai][bj][m][1]);
                asm volatile("" ::: "memory"); }
    }
};
__device__ __forceinline__ float gelu_tanh(float x) {
    const float z = 0.7978845608028654f * (x + 0.044715f * x * x * x);
    return x * __builtin_amdgcn_rcpf(1.0f + __builtin_amdgcn_exp2f(-2.0f * 1.4426950408889634f * z));
}
struct EpiCmp1 {
    static constexpr bool PERM = true, AFTER_DRAIN = false;
    bf16_t* HID; const float* biasF;
    __device__ __forceinline__ void operator()(const f32x4 (&acc)[2][2][4][2], const Unit& u, int wr, int wc, int fr, int fq) const {
        const int row0 = u.pm * BM + wr * 64 + fr;
#pragma unroll
        for (int bj = 0; bj < 2; ++bj) { const int col = bj * HALF + wc * 32 + 8 * fq;
            const f32x4 b0 = *(const f32x4*)(biasF + u.pn * 256 + col), b1 = *(const f32x4*)(biasF + u.pn * 256 + col + 4);
#pragma unroll
            for (int ai = 0; ai < 2; ++ai)
#pragma unroll
                for (int m = 0; m < 4; ++m) { const int row = row0 + ai * HALF + m * 16; f32x4 v0 = acc[ai][bj][m][0] + b0, v1 = acc[ai][bj][m][1] + b1;
#pragma unroll
                    for (int i = 0; i < 4; ++i) { v0[i] = gelu_tanh(v0[i]); v1[i] = gelu_tanh(v1[i]); }
                    *(u32x4*)(HID + (size_t)row * 256 + col) = pack8(v0, v1); } }
    }
};
struct EpiCmp2 {
    static constexpr bool PERM = true, AFTER_DRAIN = false;
    unsigned char* KC8; unsigned char* VC8;
    __device__ __forceinline__ void operator()(const f32x4 (&acc)[2][2][4][2], const Unit& u, int wr, int wc, int fr, int fq) const {
        if (wc >= 2) return;
        const int row0 = u.pm * BM + wr * 64 + fr, kv = u.pn;
#pragma unroll
        for (int ai = 0; ai < 2; ++ai)
#pragma unroll
            for (int m = 0; m < 4; ++m) { const int row = row0 + ai * HALF + m * 16, r2 = row - kv * 4096, bg = r2 >> 10, n = r2 & 1023, G = n >> 5, k32 = n & 31;
                const f32x4 a0 = acc[ai][0][m][0], a1 = acc[ai][0][m][1];
                int w0 = __builtin_amdgcn_cvt_pk_fp8_f32(a0[0], a0[1], 0, false); w0 = __builtin_amdgcn_cvt_pk_fp8_f32(a0[2], a0[3], w0, true);
                int w1 = __builtin_amdgcn_cvt_pk_fp8_f32(a1[0], a1[1], 0, false); w1 = __builtin_amdgcn_cvt_pk_fp8_f32(a1[2], a1[3], w1, true);
                if (kv == 0) { const int T = (k32 >> 2) & 1, mrow = ((k32 >> 3) << 2) | (k32 & 3);
                    typedef unsigned u32x2 __attribute__((ext_vector_type(2))); u32x2 w; w.x = (unsigned)w0; w.y = (unsigned)w1;
                    *(u32x2*)(KC8 + ((size_t)(bg * 32 + G) * 2 + T) * 1024 + (fq * 16 + mrow) * 16 + wc * 8) = w; }
                else { const int qq = k32 >> 3, j = k32 & 7;
                    unsigned char* vp = VC8 + ((size_t)(bg * 32 + G) * 2 + wc) * 1024 + (qq * 16 + 8 * (fq & 1)) * 16 + (fq >> 1) * 8 + j;
#pragma unroll
                    for (int i = 0; i < 8; ++i) { const unsigned x = (i < 4) ? (unsigned)w0 : (unsigned)w1; vp[i * 16] = (unsigned char)((x >> (8 * (i & 3))) & 0xffu); } } }
    }
};
struct CmpOrder {
    int G, c;
    __device__ __forceinline__ bool next(int i, Unit& u) const { const int L = i * G + c; if (L >= 32) return false; u.pm = L; u.pn = L >> 4; return true; }
    __device__ __forceinline__ void a_ready(const Unit&) const {}
    __device__ __forceinline__ void done(const Unit&) const {}
};
struct MoeOrder {
    const PG8_LAS int* tpre; int npn, G, c;
    __device__ __forceinline__ bool next(int i, Unit& u) const {
        const int L = i * G + c, total = __builtin_amdgcn_readfirstlane(tpre[32]) * npn; if (L >= total) return false;
        const int rt = L / npn, pl = L - rt * npn; int e = 0;
#pragma unroll
        for (int st = 16; st >= 1; st >>= 1) { const int v = __builtin_amdgcn_readfirstlane(tpre[e + st]); e += (rt >= v) ? st : 0; }
        u.pm = __builtin_amdgcn_readfirstlane(rt); u.pn = __builtin_amdgcn_readfirstlane(e * npn + pl); u.e = e; u.ti = __builtin_amdgcn_readfirstlane(rt - tpre[e]); u.cnt = __builtin_amdgcn_readfirstlane(tpre[40 + e]); return true;
    }
    __device__ __forceinline__ void a_ready(const Unit&) const {}
    __device__ __forceinline__ void done(const Unit&) const {}
};

template <class Epi, class Sched, bool ALIGN_EPI = false, bool SP2 = false>
__device__ __forceinline__ void gemm_phase(PG8_LAS unsigned char* lds, const Gemm g, const Sched& S, const Epi& E) {
    const int tid = threadIdx.x, wid = __builtin_amdgcn_readfirstlane(tid >> 6), lane = tid & 63, wr = wid >> 2, wc = wid & 3, fr = lane & 15, fq = lane >> 4;
    const int K = g.K, nt = K / BK;
    unsigned voffA[2], voffB[2];
#pragma unroll
    for (int i = 0; i < 2; ++i) { int R, C; stage_rc(tid * 16 + i * 8192, R, C); const int Rb = Epi::PERM ? ((R & ~31) + perm32(R & 31)) : R;
        voffA[i] = (unsigned)(R * g.lda + C) * 2u; voffB[i] = (unsigned)(Rb * K + C) * 2u; }
    const size_t kstep = (size_t)(BK * 2);
    const size_t hstep = (size_t)HALF * K * 2;
    const size_t tstep = 2 * hstep; const size_t hstepA = (size_t)HALF * g.lda * 2, tstepA = 2 * hstepA;
    const unsigned ldsw = (unsigned)wid * 1024u;
    const int aoff = lds_byte(wr * 64 + fr, fq * 8), boff = lds_byte(wc * 32 + fr, fq * 8);
#define PG8_SA(b, h) (((b) * 2 + (h)) * HTB)
#define PG8_SB(b, h) ((4 + (b) * 2 + (h)) * HTB)
#define PG8_STAGE(bufoff, gbase, voff) do { _Pragma("unroll") for (int _i = 0; _i < 2; ++_i) \
        __builtin_amdgcn_global_load_lds((const unsigned*)((const char*)(gbase) + (voff)[_i]), (PG8_LAS unsigned*)(lds + (bufoff) + ldsw + _i * 8192), 16, 0, 0); } while (0)
#define PG8_LDA(dst, b, h) do { _Pragma("unroll") for (int m = 0; m < 4; ++m) _Pragma("unroll") for (int k = 0; k < 2; ++k) dst[m][k] = *(const PG8_LAS bf16x8*)(lds + PG8_SA(b, h) + aoff + m * 2048 + k * 1024); } while (0)
#define PG8_LDB(dst, b, h) do { _Pragma("unroll") for (int n = 0; n < 2; ++n) _Pragma("unroll") for (int k = 0; k < 2; ++k) dst[n][k] = *(const PG8_LAS bf16x8*)(lds + PG8_SB(b, h) + boff + n * 2048 + k * 1024); } while (0)
#define PG8_MMA(ai, bj, At, Bt) do { __builtin_amdgcn_s_setprio(1); _Pragma("unroll") for (int m = 0; m < 4; ++m) _Pragma("unroll") for (int n = 0; n < 2; ++n) _Pragma("unroll") for (int k = 0; k < 2; ++k) \
        acc[ai][bj][m][n] = __builtin_amdgcn_mfma_f32_16x16x32_bf16(Bt[n][k], At[m][k], acc[ai][bj][m][n], 0, 0, 0); __builtin_amdgcn_s_setprio(0); } while (0)
#define PG8_WAIT_V(n) asm volatile("s_waitcnt vmcnt(" #n ")" ::: "memory")
#define PG8_WAIT_L(n) asm volatile("s_waitcnt lgkmcnt(" #n ")" ::: "memory")
#define PG8_BAR __builtin_amdgcn_s_barrier()
#define PG8_SCHED __builtin_amdgcn_sched_barrier(0)
    Unit cur, nxt; int ui = 0;
    if (!S.next(0, cur)) return;
    f32x4 acc[2][2][4][2];
#pragma unroll
    for (int a = 0; a < 2; ++a)
#pragma unroll
        for (int b = 0; b < 2; ++b)
#pragma unroll
            for (int m = 0; m < 4; ++m)
#pragma unroll
                for (int n = 0; n < 2; ++n) acc[a][b][m][n] = (f32x4){0.f, 0.f, 0.f, 0.f};
    bf16x8 At[4][2], B0[2][2], B1[2][2];
    const char* cA = (const char*)g.A + (size_t)cur.pm * tstepA; const char* cB = (const char*)g.Bt + (size_t)cur.pn * tstep;
    S.a_ready(cur);
    if constexpr (SP2) {
        PG8_STAGE(PG8_SB(0, 0), cB, voffB); PG8_STAGE(PG8_SB(0, 1), cB + hstep, voffB); PG8_STAGE(PG8_SA(0, 0), cA, voffA); PG8_STAGE(PG8_SA(0, 1), cA + hstepA, voffA);
        if (wr == 1) PG8_BAR;
        PG8_WAIT_V(2); PG8_BAR;
        PG8_STAGE(PG8_SB(1, 0), cB + kstep, voffB); PG8_STAGE(PG8_SA(1, 0), cA + kstep, voffA); PG8_STAGE(PG8_SB(1, 1), cB + hstep + kstep, voffB);
        PG8_WAIT_V(6); PG8_BAR;
    } else {
        PG8_STAGE(PG8_SB(0, 0), cB, voffB); PG8_STAGE(PG8_SA(0, 0), cA, voffA); PG8_STAGE(PG8_SB(0, 1), cB + hstep, voffB); PG8_STAGE(PG8_SA(0, 1), cA + hstepA, voffA);
        if (wr == 1) PG8_BAR;
        PG8_WAIT_V(4); PG8_BAR;
        PG8_STAGE(PG8_SB(1, 0), cB + kstep, voffB); PG8_STAGE(PG8_SA(1, 0), cA + kstep, voffA); PG8_STAGE(PG8_SB(1, 1), cB + hstep + kstep, voffB);
        PG8_WAIT_V(6); PG8_BAR;
    }
    for (;;) {
        const bool has_next = S.next(ui + 1, nxt);
        const char* nA = has_next ? (const char*)g.A + (size_t)nxt.pm * tstepA : cA; const char* nB = has_next ? (const char*)g.Bt + (size_t)nxt.pn * tstep : cB;
        for (int t = 0; t < nt; t += 2) {
            const bool last = (t == nt - 2);
            const char* a1 = cA + (size_t)(t + 1) * kstep;
            const char* a2 = last ? nA : cA + (size_t)(t + 2) * kstep; const char* b2 = last ? nB : cB + (size_t)(t + 2) * kstep;
            const char* a3 = a2 + kstep; const char* b3 = b2 + kstep;
            if (last && has_next) S.a_ready(nxt);
            if constexpr (SP2) {
            PG8_LDB(B0, 0, 0); PG8_LDB(B1, 0, 1); PG8_SCHED; PG8_LDA(At, 0, 0); PG8_STAGE(PG8_SA(1, 1), a1 + hstepA, voffA);
            PG8_WAIT_V(8); PG8_WAIT_L(0); PG8_BAR; PG8_MMA(0, 0, At, B0); PG8_MMA(0, 1, At, B1); PG8_BAR; PG8_SCHED;
            PG8_LDA(At, 0, 1); PG8_STAGE(PG8_SB(0, 0), b2, voffB); PG8_STAGE(PG8_SB(0, 1), b2 + hstep, voffB); PG8_STAGE(PG8_SA(0, 0), a2, voffA);
            PG8_WAIT_V(8); PG8_WAIT_L(0); PG8_BAR; PG8_MMA(1, 0, At, B0); PG8_MMA(1, 1, At, B1); PG8_BAR; PG8_SCHED;
            PG8_LDB(B0, 1, 0); PG8_LDB(B1, 1, 1); PG8_SCHED; PG8_LDA(At, 1, 0); PG8_STAGE(PG8_SA(0, 1), a2 + hstepA, voffA);
            PG8_WAIT_V(8); PG8_WAIT_L(0); PG8_BAR; PG8_MMA(0, 0, At, B0); PG8_MMA(0, 1, At, B1); PG8_BAR; PG8_SCHED;
            PG8_LDA(At, 1, 1); PG8_STAGE(PG8_SB(1, 0), b3, voffB); PG8_STAGE(PG8_SB(1, 1), b3 + hstep, voffB); PG8_STAGE(PG8_SA(1, 0), a3, voffA);
            PG8_WAIT_V(8); PG8_WAIT_L(0); PG8_BAR; PG8_MMA(1, 0, At, B0); PG8_MMA(1, 1, At, B1); PG8_BAR; PG8_SCHED;
            } else {
            PG8_LDB(B0, 0, 0); PG8_SCHED; PG8_LDA(At, 0, 0); PG8_STAGE(PG8_SA(1, 1), a1 + hstepA, voffA);
            PG8_WAIT_L(8); PG8_BAR; PG8_WAIT_L(0); PG8_MMA(0, 0, At, B0); PG8_BAR; PG8_SCHED;
            PG8_LDB(B1, 0, 1); PG8_STAGE(PG8_SB(0, 0), b2, voffB);
            PG8_BAR; PG8_WAIT_L(0); PG8_MMA(0, 1, At, B1); PG8_BAR;
            PG8_LDA(At, 0, 1); PG8_STAGE(PG8_SA(0, 0), a2, voffA);
            PG8_BAR; PG8_WAIT_L(0); PG8_MMA(1, 0, At, B0); PG8_BAR; PG8_SCHED;
            PG8_STAGE(PG8_SB(0, 1), b2 + hstep, voffB);
            PG8_WAIT_V(6); PG8_BAR; PG8_MMA(1, 1, At, B1); PG8_BAR;
            PG8_LDB(B0, 1, 0); PG8_SCHED; PG8_LDA(At, 1, 0); PG8_STAGE(PG8_SA(0, 1), a2 + hstepA, voffA);
            PG8_WAIT_L(8); PG8_BAR; PG8_WAIT_L(0); PG8_MMA(0, 0, At, B0); PG8_BAR; PG8_SCHED;
            PG8_LDB(B1, 1, 1); PG8_STAGE(PG8_SB(1, 0), b3, voffB);
            PG8_BAR; PG8_WAIT_L(0); PG8_MMA(0, 1, At, B1); PG8_BAR;
            PG8_LDA(At, 1, 1); PG8_STAGE(PG8_SA(1, 0), a3, voffA);
            PG8_BAR; PG8_WAIT_L(0); PG8_MMA(1, 0, At, B0); PG8_BAR; PG8_SCHED;
            PG8_STAGE(PG8_SB(1, 1), b3 + hstep, voffB);
            PG8_WAIT_V(6); PG8_BAR; PG8_MMA(1, 1, At, B1); PG8_BAR;
            }
        }
        if constexpr (ALIGN_EPI) { if (wr == 0) PG8_BAR; }
        if constexpr (!Epi::AFTER_DRAIN) { E(acc, cur, wr, wc, fr, fq); S.done(cur); }
        if (!has_next) break;
#pragma unroll
        for (int a = 0; a < 2; ++a)
#pragma unroll
            for (int b = 0; b < 2; ++b)
#pragma unroll
                for (int m = 0; m < 4; ++m)
#pragma unroll
                    for (int n = 0; n < 2; ++n) acc[a][b][m][n] = (f32x4){0.f, 0.f, 0.f, 0.f};
        cur = nxt; cA = nA; cB = nB; ++ui;
        if constexpr (ALIGN_EPI) { if (wr == 1) PG8_BAR; }
    }
    PG8_WAIT_V(0);
    if constexpr (!ALIGN_EPI) { if (wr == 0) PG8_BAR; }
    PG8_BAR;
    if constexpr (Epi::AFTER_DRAIN) { E.fused(acc, cur, wr, wc, fr, fq, lds, wid, lane); S.done(cur); }
#undef PG8_SA
#undef PG8_SB
#undef PG8_STAGE
#undef PG8_LDA
#undef PG8_LDB
#undef PG8_MMA
#undef PG8_WAIT_V
#undef PG8_WAIT_L
#undef PG8_BAR
#undef PG8_SCHED
}
template <class Epi, class Sched, bool ALIGN_EPI = false>
__device__ __forceinline__ void gemm_phase_g(PG8_LAS unsigned char* lds, const Gemm g, const Sched& S, const Epi& E, const PG8_LAS unsigned* gtab) {
    constexpr bool SP2 = true;
    const int tid = threadIdx.x, wid = __builtin_amdgcn_readfirstlane(tid >> 6), lane = tid & 63, wr = wid >> 2, wc = wid & 3, fr = lane & 15, fq = lane >> 4;
    const int K = g.K, nt = K / BK;
    unsigned voffB[2], cofsA[2]; int rowA[2];
#pragma unroll
    for (int i = 0; i < 2; ++i) { int R, C; stage_rc(tid * 16 + i * 8192, R, C); const int Rb = Epi::PERM ? ((R & ~31) + perm32(R & 31)) : R;
        rowA[i] = R; cofsA[i] = (unsigned)C * 2u; voffB[i] = (unsigned)(Rb * K + C) * 2u; }
    unsigned vC0[2], vC1[2], vN0[2], vN1[2];
#define PG8_GV(dst0, dst1, u_) do { _Pragma("unroll") for (int _i = 0; _i < 2; ++_i) { dst0[_i] = gtab[(u_) * 256 + rowA[_i]] + cofsA[_i]; dst1[_i] = gtab[(u_) * 256 + 128 + rowA[_i]] + cofsA[_i]; } } while (0)
    const size_t kstep = (size_t)(BK * 2);
    const size_t hstep = (size_t)HALF * K * 2;
    const size_t tstep = 2 * hstep; const size_t hstepA = (size_t)HALF * g.lda * 2, tstepA = 2 * hstepA;
    const unsigned ldsw = (unsigned)wid * 1024u;
    const int aoff = lds_byte(wr * 64 + fr, fq * 8), boff = lds_byte(wc * 32 + fr, fq * 8);
#define PG8_SA(b, h) (((b) * 2 + (h)) * HTB)
#define PG8_SB(b, h) ((4 + (b) * 2 + (h)) * HTB)
#define PG8_STAGE(bufoff, gbase, voff) do { _Pragma("unroll") for (int _i = 0; _i < 2; ++_i) \
        __builtin_amdgcn_global_load_lds((const unsigned*)((const char*)(gbase) + (voff)[_i]), (PG8_LAS unsigned*)(lds + (bufoff) + ldsw + _i * 8192), 16, 0, 0); } while (0)
#define PG8_LDA(dst, b, h) do { _Pragma("unroll") for (int m = 0; m < 4; ++m) _Pragma("unroll") for (int k = 0; k < 2; ++k) dst[m][k] = *(const PG8_LAS bf16x8*)(lds + PG8_SA(b, h) + aoff + m * 2048 + k * 1024); } while (0)
#define PG8_LDB(dst, b, h) do { _Pragma("unroll") for (int n = 0; n < 2; ++n) _Pragma("unroll") for (int k = 0; k < 2; ++k) dst[n][k] = *(const PG8_LAS bf16x8*)(lds + PG8_SB(b, h) + boff + n * 2048 + k * 1024); } while (0)
#define PG8_MMA(ai, bj, At, Bt) do { __builtin_amdgcn_s_setprio(1); _Pragma("unroll") for (int m = 0; m < 4; ++m) _Pragma("unroll") for (int n = 0; n < 2; ++n) _Pragma("unroll") for (int k = 0; k < 2; ++k) \
        acc[ai][bj][m][n] = __builtin_amdgcn_mfma_f32_16x16x32_bf16(Bt[n][k], At[m][k], acc[ai][bj][m][n], 0, 0, 0); __builtin_amdgcn_s_setprio(0); } while (0)
#define PG8_WAIT_V(n) asm volatile("s_waitcnt vmcnt(" #n ")" ::: "memory")
#define PG8_WAIT_L(n) asm volatile("s_waitcnt lgkmcnt(" #n ")" ::: "memory")
#define PG8_BAR __builtin_amdgcn_s_barrier()
#define PG8_SCHED __builtin_amdgcn_sched_barrier(0)
    Unit cur, nxt; int ui = 0;
    if (!S.next(0, cur)) return;
    f32x4 acc[2][2][4][2];
#pragma unroll
    for (int a = 0; a < 2; ++a)
#pragma unroll
        for (int b = 0; b < 2; ++b)
#pragma unroll
            for (int m = 0; m < 4; ++m)
#pragma unroll
                for (int n = 0; n < 2; ++n) acc[a][b][m][n] = (f32x4){0.f, 0.f, 0.f, 0.f};
    bf16x8 At[4][2], B0[2][2], B1[2][2];
    const char* cA = (const char*)g.A; const char* cB = (const char*)g.Bt + (size_t)cur.pn * tstep;
    PG8_GV(vC0, vC1, 0);
    S.a_ready(cur);
    if constexpr (SP2) {
        PG8_STAGE(PG8_SB(0, 0), cB, voffB); PG8_STAGE(PG8_SB(0, 1), cB + hstep, voffB); PG8_STAGE(PG8_SA(0, 0), cA, vC0); PG8_STAGE(PG8_SA(0, 1), cA, vC1);
        if (wr == 1) PG8_BAR;
        PG8_WAIT_V(2); PG8_BAR;
        PG8_STAGE(PG8_SB(1, 0), cB + kstep, voffB); PG8_STAGE(PG8_SA(1, 0), cA + kstep, vC0); PG8_STAGE(PG8_SB(1, 1), cB + hstep + kstep, voffB);
        PG8_WAIT_V(6); PG8_BAR;
    } else {
        PG8_STAGE(PG8_SB(0, 0), cB, voffB); PG8_STAGE(PG8_SA(0, 0), cA, vC0); PG8_STAGE(PG8_SB(0, 1), cB + hstep, voffB); PG8_STAGE(PG8_SA(0, 1), cA, vC1);
        if (wr == 1) PG8_BAR;
        PG8_WAIT_V(4); PG8_BAR;
        PG8_STAGE(PG8_SB(1, 0), cB + kstep, voffB); PG8_STAGE(PG8_SA(1, 0), cA + kstep, vC0); PG8_STAGE(PG8_SB(1, 1), cB + hstep + kstep, voffB);
        PG8_WAIT_V(6); PG8_BAR;
    }
    for (;;) {
        const bool has_next = S.next(ui + 1, nxt);
        const char* nA = cA; const char* nB = has_next ? (const char*)g.Bt + (size_t)nxt.pn * tstep : cB;
        if (has_next) PG8_GV(vN0, vN1, ui + 1); else { _Pragma("unroll") for (int _i = 0; _i < 2; ++_i) { vN0[_i] = vC0[_i]; vN1[_i] = vC1[_i]; } }
        for (int t = 0; t < nt; t += 2) {
            const bool last = (t == nt - 2);
            const char* a1 = cA + (size_t)(t + 1) * kstep;
            const unsigned va0[2] = {last ? vN0[0] : vC0[0], last ? vN0[1] : vC0[1]}, va1[2] = {last ? vN1[0] : vC1[0], last ? vN1[1] : vC1[1]};
            const char* a2 = last ? nA : cA + (size_t)(t + 2) * kstep; const char* b2 = last ? nB : cB + (size_t)(t + 2) * kstep;
            const char* a3 = a2 + kstep; const char* b3 = b2 + kstep;
            if (last && has_next) S.a_ready(nxt);
            if constexpr (SP2) {
            PG8_LDB(B0, 0, 0); PG8_LDB(B1, 0, 1); PG8_SCHED; PG8_LDA(At, 0, 0); PG8_STAGE(PG8_SA(1, 1), a1, vC1);
            PG8_WAIT_V(8); PG8_WAIT_L(0); PG8_BAR; PG8_MMA(0, 0, At, B0); PG8_MMA(0, 1, At, B1); PG8_BAR; PG8_SCHED;
            PG8_LDA(At, 0, 1); PG8_STAGE(PG8_SB(0, 0), b2, voffB); PG8_STAGE(PG8_SB(0, 1), b2 + hstep, voffB); PG8_STAGE(PG8_SA(0, 0), a2, va0);
            PG8_WAIT_V(8); PG8_WAIT_L(0); PG8_BAR; PG8_MMA(1, 0, At, B0); PG8_MMA(1, 1, At, B1); PG8_BAR; PG8_SCHED;
            PG8_LDB(B0, 1, 0); PG8_LDB(B1, 1, 1); PG8_SCHED; PG8_LDA(At, 1, 0); PG8_STAGE(PG8_SA(0, 1), a2, va1);
            PG8_WAIT_V(8); PG8_WAIT_L(0); PG8_BAR; PG8_MMA(0, 0, At, B0); PG8_MMA(0, 1, At, B1); PG8_BAR; PG8_SCHED;
            PG8_LDA(At, 1, 1); PG8_STAGE(PG8_SB(1, 0), b3, voffB); PG8_STAGE(PG8_SB(1, 1), b3 + hstep, voffB); PG8_STAGE(PG8_SA(1, 0), a3, va0);
            PG8_WAIT_V(8); PG8_WAIT_L(0); PG8_BAR; PG8_MMA(1, 0, At, B0); PG8_MMA(1, 1, At, B1); PG8_BAR; PG8_SCHED;
            } else {
            PG8_LDB(B0, 0, 0); PG8_SCHED; PG8_LDA(At, 0, 0); PG8_STAGE(PG8_SA(1, 1), a1, vC1);
            PG8_WAIT_L(8); PG8_BAR; PG8_WAIT_L(0); PG8_MMA(0, 0, At, B0); PG8_BAR; PG8_SCHED;
            PG8_LDB(B1, 0, 1); PG8_STAGE(PG8_SB(0, 0), b2, voffB);
            PG8_BAR; PG8_WAIT_L(0); PG8_MMA(0, 1, At, B1); PG8_BAR;
            PG8_LDA(At, 0, 1); PG8_STAGE(PG8_SA(0, 0), a2, va0);
            PG8_BAR; PG8_WAIT_L(0); PG8_MMA(1, 0, At, B0); PG8_BAR; PG8_SCHED;
            PG8_STAGE(PG8_SB(0, 1), b2 + hstep, voffB);
            PG8_WAIT_V(6); PG8_BAR; PG8_MMA(1, 1, At, B1); PG8_BAR;
            PG8_LDB(B0, 1, 0); PG8_SCHED; PG8_LDA(At, 1, 0); PG8_STAGE(PG8_SA(0, 1), a2, va1);
            PG8_WAIT_L(8); PG8_BAR; PG8_WAIT_L(0); PG8_MMA(0, 0, At, B0); PG8_BAR; PG8_SCHED;
            PG8_LDB(B1, 1, 1); PG8_STAGE(PG8_SB(1, 0), b3, voffB);
            PG8_BAR; PG8_WAIT_L(0); PG8_MMA(0, 1, At, B1); PG8_BAR;
            PG8_LDA(At, 1, 1); PG8_STAGE(PG8_SA(1, 0), a3, va0);
            PG8_BAR; PG8_WAIT_L(0); PG8_MMA(1, 0, At, B0); PG8_BAR; PG8_SCHED;
            PG8_STAGE(PG8_SB(1, 1), b3 + hstep, voffB);
            PG8_WAIT_V(6); PG8_BAR; PG8_MMA(1, 1, At, B1); PG8_BAR;
            }
        }
        if constexpr (ALIGN_EPI) { if (wr == 0) PG8_BAR; }
        if constexpr (!Epi::AFTER_DRAIN) { E(acc, cur, wr, wc, fr, fq); S.done(cur); }
        if (!has_next) break;
#pragma unroll
        for (int a = 0; a < 2; ++a)
#pragma unroll
            for (int b = 0; b < 2; ++b)
#pragma unroll
                for (int m = 0; m < 4; ++m)
#pragma unroll
                    for (int n = 0; n < 2; ++n) acc[a][b][m][n] = (f32x4){0.f, 0.f, 0.f, 0.f};
        cur = nxt; cA = nA; cB = nB; ++ui;
        { _Pragma("unroll") for (int _i = 0; _i < 2; ++_i) { vC0[_i] = vN0[_i]; vC1[_i] = vN1[_i]; } }
        if constexpr (ALIGN_EPI) { if (wr == 1) PG8_BAR; }
    }
    PG8_WAIT_V(0);
    if constexpr (!ALIGN_EPI) { if (wr == 0) PG8_BAR; }
    PG8_BAR;
    if constexpr (Epi::AFTER_DRAIN) { E.fused(acc, cur, wr, wc, fr, fq, lds, wid, lane); S.done(cur); }
#undef PG8_SA
#undef PG8_SB
#undef PG8_STAGE
#undef PG8_LDA
#undef PG8_LDB
#undef PG8_MMA
#undef PG8_WAIT_V
#undef PG8_WAIT_L
#undef PG8_BAR
#undef PG8_SCHED
#undef PG8_GV
}

}

#include <hip/hip_bf16.h>
#include <cmath>
namespace attn_body {
using bf16=__hip_bfloat16;
using bf16x8=__attribute__((ext_vector_type(8)))short;
using s16x4=__attribute__((ext_vector_type(4)))short;
using f32x16=__attribute__((ext_vector_type(16)))float;
using u32x4=__attribute__((ext_vector_type(4)))unsigned;
constexpr int BATCH=2,NHEAD=16,SEQ=16384,D=64,DM=NHEAD*D;
constexpr int NW=8,QBLK=32,QB=QBLK*NW,KVBLK=64,NQB=SEQ/QB;
constexpr int ATTN_PITCH=DM, ATTN_UNIT_ROWS=QB;
__device__ __forceinline__ int crow(int r,int hi){return (r&3)+8*(r>>2)+4*hi;}
#define SBAR() __builtin_amdgcn_sched_barrier(0)
__device__ __forceinline__ void cmask(f32x16&p0,f32x16&p1,int jb,int qrel,int hi){
  const float NEG=-INFINITY; int kb=64*jb+4*hi;
  #pragma unroll
  for(int r=0;r<16;++r){int kv=kb+(r&3)+8*(r>>2); if(kv>qrel)p0[r]=NEG; if(kv+32>qrel)p1[r]=NEG;}
}

constexpr int NSLOT=3, SLOTB=8192;
constexpr int LDS_K=0, LDS_V=NSLOT*SLOTB, LDS_WS=2*NSLOT*SLOTB, LDS_OST=LDS_WS+NW*64*4, LDS_BYTES=LDS_OST+NW*4096;
constexpr float C2=0.125f*1.4426950408889634f;
__device__ __forceinline__ void glds16(const void*gsrc,unsigned lds_dst){unsigned keep;
  asm volatile("s_mov_b32 %0, m0\n\ts_mov_b32 m0, %2\n\ts_nop 0\n\tglobal_load_lds_dwordx4 %1, off\n\ts_mov_b32 m0, %0":"=&s"(keep):"v"(gsrc),"s"(lds_dst):"memory");}
__device__ __forceinline__ float max3f(float a,float b,float c){float r;asm("v_max3_f32 %0, %1, %2, %3":"=v"(r):"v"(a),"v"(b),"v"(c));return r;}
__device__ __forceinline__ float max2f(float a,float b){float r;asm("v_max_f32_e32 %0, %1, %2":"=v"(r):"v"(a),"v"(b));return r;}
__device__ __forceinline__ float fadd_s(float a,float b){float r;asm("v_add_f32_e32 %0, %1, %2":"=v"(r):"v"(a),"v"(b));return r;}
__device__ __forceinline__ float fsub_s(float a,float b){float r;asm("v_sub_f32_e32 %0, %1, %2":"=v"(r):"v"(a),"v"(b));return r;}
typedef float f32x2_t __attribute__((ext_vector_type(2))); typedef __bf16 bf16x2_t __attribute__((ext_vector_type(2)));
__device__ __forceinline__ unsigned cvtpk_s(float lo,float hi){f32x2_t v={lo,hi};bf16x2_t b=__builtin_convertvector(v,bf16x2_t);return __builtin_bit_cast(unsigned,b);}
#define WAIT_BAR(N) asm volatile("s_waitcnt vmcnt(" #N ") lgkmcnt(0)\n\ts_barrier":::"memory")

__device__ __forceinline__ void qkt(f32x16&p0,f32x16&p1,const char*Kslot,const bf16x8*qr,const f32x16&negm,int r32,int hi){
  const char*kb=Kslot+hi*1024+r32*16;
  #pragma unroll
  for(int d0=0;d0<4;++d0){
    const bf16x8 b0=*reinterpret_cast<const bf16x8*>(kb+d0*2048);
    const bf16x8 b1=*reinterpret_cast<const bf16x8*>(kb+d0*2048+512);
    if(d0==0){p0=__builtin_amdgcn_mfma_f32_32x32x16_bf16(b0,qr[0],negm,0,0,0);p1=__builtin_amdgcn_mfma_f32_32x32x16_bf16(b1,qr[0],negm,0,0,0);}
    else{p0=__builtin_amdgcn_mfma_f32_32x32x16_bf16(b0,qr[d0],p0,0,0,0);p1=__builtin_amdgcn_mfma_f32_32x32x16_bf16(b1,qr[d0],p1,0,0,0);}}
}
typedef __attribute__((address_space(3))) const char* lds_cptr;
typedef short v4i16_t __attribute__((ext_vector_type(4)));
__device__ __forceinline__ void kload8(bf16x8*kf,lds_cptr kp){
  kf[0]=*(const __attribute__((address_space(3))) bf16x8*)(kp);      kf[1]=*(const __attribute__((address_space(3))) bf16x8*)(kp+512);
  kf[2]=*(const __attribute__((address_space(3))) bf16x8*)(kp+2048); kf[3]=*(const __attribute__((address_space(3))) bf16x8*)(kp+2560);
  kf[4]=*(const __attribute__((address_space(3))) bf16x8*)(kp+4096); kf[5]=*(const __attribute__((address_space(3))) bf16x8*)(kp+4608);
  kf[6]=*(const __attribute__((address_space(3))) bf16x8*)(kp+6144); kf[7]=*(const __attribute__((address_space(3))) bf16x8*)(kp+6656);
}
__device__ __forceinline__ void kload2(bf16x8*kf,lds_cptr kp,int j){ kf[2*j]=*(const __attribute__((address_space(3))) bf16x8*)(kp+j*2048); kf[2*j+1]=*(const __attribute__((address_space(3))) bf16x8*)(kp+j*2048+512); }
__device__ __forceinline__ s16x4 vtr(lds_cptr p){ return __builtin_bit_cast(s16x4,__builtin_amdgcn_ds_read_tr16_b64_v4i16((__attribute__((address_space(3))) v4i16_t*)p)); }
__device__ __forceinline__ float rowmax(const f32x16&p0,const f32x16&p1){
  float a=max3f(p0[0],p0[1],p1[0]),b=max3f(p0[2],p0[3],p1[1]);a=max3f(a,p1[2],p1[3]);
  #pragma unroll
  for(int r=4;r<16;r+=4){a=max3f(a,p0[r],p0[r+1]);b=max3f(b,p0[r+2],p0[r+3]);a=max3f(a,p1[r],p1[r+1]);b=max3f(b,p1[r+2],p1[r+3]);}
  const float m=max2f(a,b);
  auto rr=__builtin_amdgcn_permlane32_swap(__float_as_uint(m),__float_as_uint(m),false,false);
  return max2f(__uint_as_float(rr[0]),__uint_as_float(rr[1]));
}
__device__ __forceinline__ void pv(f32x16*o,int vb,bf16x8 pa0,bf16x8 pa1,bf16x8 pa2,bf16x8 pa3){
  #pragma unroll
  for(int d0=0;d0<2;++d0){s16x4 lo[4],hi[4];
    #pragma unroll
    for(int ks=0;ks<4;++ks){
      asm volatile("ds_read_b64_tr_b16 %0,%1 offset:%c2":"=&v"(lo[ks]):"v"(vb),"i"(d0*4096+ks*1024):"memory");
      asm volatile("ds_read_b64_tr_b16 %0,%1 offset:%c2":"=&v"(hi[ks]):"v"(vb),"i"(d0*4096+ks*1024+512):"memory");}
    asm volatile("s_waitcnt lgkmcnt(0)":::"memory");SBAR();
    #define PK(k) (bf16x8){lo[k][0],lo[k][1],lo[k][2],lo[k][3],hi[k][0],hi[k][1],hi[k][2],hi[k][3]}
    o[d0]=__builtin_amdgcn_mfma_f32_32x32x16_bf16(pa0,PK(0),o[d0],0,0,0);
    o[d0]=__builtin_amdgcn_mfma_f32_32x32x16_bf16(pa1,PK(1),o[d0],0,0,0);
    o[d0]=__builtin_amdgcn_mfma_f32_32x32x16_bf16(pa2,PK(2),o[d0],0,0,0);
    o[d0]=__builtin_amdgcn_mfma_f32_32x32x16_bf16(pa3,PK(3),o[d0],0,0,0);
    #undef PK
  }
}

#ifndef ATTN_STORE16
#define ATTN_STORE16(p,v) (*(u32x4*)(p)=(v))
#endif
template<int THRL> __device__ __forceinline__ void attn_unit(int b,int h,int qb,const bf16*Q,const bf16*__restrict__ K,const bf16*__restrict__ V,bf16*O,char*shm){
  int tid_=threadIdx.x; asm volatile("":"+v"(tid_)); const int tid=tid_,lane=tid&63,r32=lane&31,hi=lane>>5; const int wid=__builtin_amdgcn_readfirstlane(tid>>6);
  const long rowbase=(long)b*SEQ; const int q0=qb*QB;
  const bf16*Qw=Q+(rowbase+q0+wid*QBLK)*DM+h*D;
  const bf16*Kh=K+rowbase*DM+h*D,*Vh=V+rowbase*DM+h*D;
  const unsigned lds0=(unsigned)(uintptr_t)shm;
  float*wsf=(float*)(shm+LDS_WS)+wid*64;
  const bf16*ksrc=Kh+(long)lane*DM+wid*8;
  const bf16*vsrc=Vh+(long)(16*(wid&3)+(lane>>2))*DM+(wid>>2)*32+(lane&3)*8;
  const unsigned kdst=lds0+LDS_K+wid*1024, vdst=lds0+LDS_V+wid*1024;
  #define DMA_K(t,slot) glds16(ksrc+(long)(t)*KVBLK*DM,(unsigned)__builtin_amdgcn_readfirstlane(kdst+(slot)))
  #define DMA_V(t,slot) glds16(vsrc+(long)(t)*KVBLK*DM,(unsigned)__builtin_amdgcn_readfirstlane(vdst+(slot)))
  const int vb0=(int)(lds0+LDS_V)+((lane>>4)&1)*32+(lane&3)*8+(4*hi+((lane&15)>>2))*64;
  const char*Kbase=shm+LDS_K; bf16x8 kf[8];
  const lds_cptr shm3=(lds_cptr)shm; const lds_cptr kp0=shm3+LDS_K+hi*1024+r32*16; const lds_cptr vp0=shm3+LDS_V+((lane>>4)&1)*32+(lane&3)*8+(4*hi+((lane&15)>>2))*64;
  const int NT=(q0+QB)/KVBLK;
  DMA_K(0,0);DMA_V(0,0);DMA_K(1,SLOTB);
  bf16x8 qr[4];
  #pragma unroll
  for(int d0=0;d0<4;++d0)qr[d0]=*reinterpret_cast<const bf16x8*>(&Qw[(long)r32*DM+d0*16+hi*8]);
  float mhat=0.f,l_reg=0.f;f32x16 o[2];o[0]=f32x16{};o[1]=f32x16{};f32x16 negm=f32x16{};asm volatile("":"+v"(negm));
  const int qrel=wid*QBLK+r32;
  #define CMASK(P0,P1,t) do{int jb_=(t)-(NT-4); if(jb_>=0)cmask(P0,P1,jb_,qrel,hi);}while(0)
  bool resc=false;
  #define START(P0,P1) do{ const float rm=rowmax(P0,P1); resc=false; \
    { const float dl=rm; mhat=fadd_s(mhat,dl); \
      _Pragma("unroll") for(int r=0;r<16;++r){P0[r]=fsub_s(P0[r],dl);P1[r]=fsub_s(P1[r],dl);} \
      _Pragma("unroll") for(int r=0;r<16;++r)negm[r]=-mhat; asm volatile("":"+v"(negm)); } \
    _Pragma("unroll") for(int r=0;r<16;++r)P0[r]=__builtin_amdgcn_exp2f(P0[r]); }while(0)
  #define RESC() do{ if(resc){ asm volatile("s_waitcnt lgkmcnt(0)":::"memory"); \
      _Pragma("unroll") for(int d_=0;d_<2;++d_) _Pragma("unroll") for(int r=0;r<16;++r)o[d_][r]*=wsf[crow(r,hi)]; } }while(0)
  f32x16 pA0,pA1,pB0,pB1;
  int sl_prev=0,sl_cur=0,sl_next=SLOTB;
  #define ROT() do{sl_prev=sl_cur;sl_cur=sl_next;sl_next=(sl_next==(NSLOT-1)*SLOTB)?0:sl_next+SLOTB;}while(0)
  DMA_K(2,2*SLOTB);
  WAIT_BAR(3);
  qkt(pA0,pA1,Kbase,qr,negm,r32,hi);asm volatile("s_nop 15\n\ts_nop 7":"+v"(pA0),"+v"(pA1));CMASK(pA0,pA1,0);
  START(pA0,pA1);
  _Pragma("unroll") for(int r=0;r<16;++r)pA1[r]=__builtin_amdgcn_exp2f(pA1[r]);
  WAIT_BAR(0);
  DMA_K(3,0);DMA_V(1,SLOTB);
  ROT();
  kload8(kf,kp0+sl_cur);
  WAIT_BAR(2);
  s16x4 vlo[8],vhi[8]; u32x4 pw0,pw1,pw2,pw3;
  #define PKW(P,B) cvtpk_s(P[B],P[B+1])
  #define PAF(k) __builtin_bit_cast(bf16x8,pw##k)
  #define VFR(i) (bf16x8){vlo[i][0],vlo[i][1],vlo[i][2],vlo[i][3],vhi[i][0],vhi[i][1],vhi[i][2],vhi[i][3]}
  #define PIN(x) asm volatile("":"+v"(x))
  #define MX3(a,b,c) __builtin_fmaxf(__builtin_fmaxf((a),(b)),(c))
  #define GAPA(MF,A0,A1,A2,A3,W0,W1,PW) do{ MF; sacc+=A0; sacc+=A1; sacc+=A2; sacc+=A3; PIN(sacc); W0; W1; PIN(PW); SBAR(); }while(0)
  #define EX(v) __builtin_amdgcn_exp2f(v)
  #define GAPB(MF,X,B) do{ MF; X[B]=EX(X[B]); X[B+1]=EX(X[B+1]); X[B+2]=EX(X[B+2]); X[B+3]=EX(X[B+3]); PIN(X); SBAR(); }while(0)
  #define VRD(i) do{ vlo[i]=vtr(vp_+(((i)>>2)*4096+((i)&3)*1024)); vhi[i]=vtr(vp_+(((i)>>2)*4096+((i)&3)*1024+512)); }while(0)
  #define KRD(G,j) do{ if(G){ kload2(kf,kp0+sl_next,j); SBAR(); } }while(0)
  #define STEP(C0,C1,P0,P1,t,GK,GV,GL) do{ SBAR(); \
    const lds_cptr vp_=vp0+sl_prev; \
    VRD(0); SBAR(); float sacc=(P0[0]+P0[1]); \
    GAPA(C0=__builtin_amdgcn_mfma_f32_32x32x16_bf16(kf[0],qr[0],negm,0,0,0), P0[2],P0[3],P0[4],P0[5],     pw0[0]=PKW(P0,0), pw0[1]=PKW(P0,2), pw0); \
    VRD(4); SBAR(); GAPA(C1=__builtin_amdgcn_mfma_f32_32x32x16_bf16(kf[1],qr[0],negm,0,0,0), P0[6],P0[7],P0[8],P0[9],     pw0[2]=PKW(P0,4), pw0[3]=PKW(P0,6), pw0); \
    VRD(1); SBAR(); GAPA(C0=__builtin_amdgcn_mfma_f32_32x32x16_bf16(kf[2],qr[1],C0,0,0,0),   P0[10],P0[11],P0[12],P0[13], pw1[0]=PKW(P0,8), pw1[1]=PKW(P0,10), pw1); \
    VRD(5); SBAR(); GAPA(C1=__builtin_amdgcn_mfma_f32_32x32x16_bf16(kf[3],qr[1],C1,0,0,0),   P0[14],P0[15],P1[0],P1[1],   pw1[2]=PKW(P0,12),pw1[3]=PKW(P0,14), pw1); \
    VRD(2); SBAR(); GAPA(C0=__builtin_amdgcn_mfma_f32_32x32x16_bf16(kf[4],qr[2],C0,0,0,0),   P1[2],P1[3],P1[4],P1[5],     pw2[0]=PKW(P1,0), pw2[1]=PKW(P1,2), pw2); \
    VRD(6); SBAR(); GAPA(C1=__builtin_amdgcn_mfma_f32_32x32x16_bf16(kf[5],qr[2],C1,0,0,0),   P1[6],P1[7],P1[8],P1[9],     pw2[2]=PKW(P1,4), pw2[3]=PKW(P1,6), pw2); \
    VRD(3); SBAR(); GAPA(C0=__builtin_amdgcn_mfma_f32_32x32x16_bf16(kf[6],qr[3],C0,0,0,0),   P1[10],P1[11],P1[12],P1[13], pw3[0]=PKW(P1,8), pw3[1]=PKW(P1,10), pw3); \
    VRD(7); SBAR(); GAPA(C1=__builtin_amdgcn_mfma_f32_32x32x16_bf16(kf[7],qr[3],C1,0,0,0),   P1[14],P1[15],0.f,0.f,       pw3[2]=PKW(P1,12),pw3[3]=PKW(P1,14), pw3); \
    l_reg+=sacc; \
    if(GK){DMA_K((t)+3,sl_cur);} if(GV){DMA_V((t)+1,sl_next);} \
    CMASK(C0,C1,t); \
    { float a=MX3(C0[0],C0[1],C1[0]),b=MX3(C0[2],C0[3],C1[1]); a=MX3(a,C1[2],C1[3]); \
      _Pragma("unroll") for(int r=4;r<16;r+=4){a=MX3(a,C0[r],C0[r+1]);b=MX3(b,C0[r+2],C0[r+3]);a=MX3(a,C1[r],C1[r+1]);b=MX3(b,C1[r+2],C1[r+3]);} \
      float rm=__builtin_fmaxf(a,b); { auto rr=__builtin_amdgcn_permlane32_swap(__float_as_uint(rm),__float_as_uint(rm),false,false); rm=__builtin_fmaxf(__uint_as_float(rr[0]),__uint_as_float(rr[1])); } \
      resc=false; \
      if(__builtin_expect(__any(rm>(float)THRL),0)){ const float dl=__builtin_fmaxf(rm,0.f); mhat+=dl; \
        _Pragma("unroll") for(int r=0;r<16;++r){C0[r]-=dl;C1[r]-=dl;} \
        _Pragma("unroll") for(int r=0;r<16;++r)negm[r]=-mhat; asm volatile("":"+v"(negm)); \
        const float f=__builtin_amdgcn_exp2f(-dl); l_reg*=f; if(hi==0)wsf[r32]=f; resc=true; } } \
    SBAR(); \
    GAPB(o[0]=__builtin_amdgcn_mfma_f32_32x32x16_bf16(PAF(0),VFR(0),o[0],0,0,0), C0,0); \
    GAPB(o[1]=__builtin_amdgcn_mfma_f32_32x32x16_bf16(PAF(0),VFR(4),o[1],0,0,0), C0,4); \
    KRD(GL,0); GAPB(o[0]=__builtin_amdgcn_mfma_f32_32x32x16_bf16(PAF(1),VFR(1),o[0],0,0,0), C0,8); \
    KRD(GL,1); GAPB(o[1]=__builtin_amdgcn_mfma_f32_32x32x16_bf16(PAF(1),VFR(5),o[1],0,0,0), C0,12); \
    KRD(GL,2); GAPB(o[0]=__builtin_amdgcn_mfma_f32_32x32x16_bf16(PAF(2),VFR(2),o[0],0,0,0), C1,0); \
    KRD(GL,3); GAPB(o[1]=__builtin_amdgcn_mfma_f32_32x32x16_bf16(PAF(2),VFR(6),o[1],0,0,0), C1,4); \
    GAPB(o[0]=__builtin_amdgcn_mfma_f32_32x32x16_bf16(PAF(3),VFR(3),o[0],0,0,0), C1,8); \
    GAPB(o[1]=__builtin_amdgcn_mfma_f32_32x32x16_bf16(PAF(3),VFR(7),o[1],0,0,0), C1,12); \
    }while(0)
  int t=1;
  #undef CMASK
  #define CMASK(P0,P1,t) do{}while(0)
  for(;t+5<NT;t+=2){
    STEP(pB0,pB1,pA0,pA1,t,true,true,true);     WAIT_BAR(2); RESC(); ROT();
    STEP(pA0,pA1,pB0,pB1,t+1,true,true,true);   WAIT_BAR(2); RESC(); ROT();
  }
  #undef CMASK
  #define CMASK(P0,P1,t) do{int jb_=(t)-(NT-4); if(jb_>=0)cmask(P0,P1,jb_,qrel,hi);}while(0)
  #define ENDW(tt) do{ if((tt)+3<NT){WAIT_BAR(2);} else if((tt)+2<NT){WAIT_BAR(1);} else {WAIT_BAR(0);} }while(0)
  for(;t+1<NT;t+=2){
    STEP(pB0,pB1,pA0,pA1,t,(t+3<NT),(t+1<NT),(t+1<NT));       ENDW(t);   RESC(); ROT();
    STEP(pA0,pA1,pB0,pB1,t+1,(t+4<NT),(t+2<NT),(t+2<NT));     ENDW(t+1); RESC(); ROT();
  }
  STEP(pB0,pB1,pA0,pA1,NT-1,false,false,false); RESC();
  { float sacc=pB0[0]+pB0[1]; _Pragma("unroll") for(int r=2;r<16;++r)sacc+=pB0[r]; _Pragma("unroll") for(int r=0;r<16;++r)sacc+=pB1[r]; l_reg+=sacc;
    pw0=(u32x4){PKW(pB0,0),PKW(pB0,2),PKW(pB0,4),PKW(pB0,6)};pw1=(u32x4){PKW(pB0,8),PKW(pB0,10),PKW(pB0,12),PKW(pB0,14)};pw2=(u32x4){PKW(pB1,0),PKW(pB1,2),PKW(pB1,4),PKW(pB1,6)};pw3=(u32x4){PKW(pB1,8),PKW(pB1,10),PKW(pB1,12),PKW(pB1,14)};
    SBAR(); pv(o,vb0+sl_cur,PAF(0),PAF(1),PAF(2),PAF(3)); }
  #undef PKW
  #undef PAF
  #undef VFR
  #undef PIN
  #undef MX3
  #undef GAPA
  #undef GAPB
  #undef EX
  #undef VRD
  #undef KRD
  #undef STEP
  #undef ENDW
  {auto rr=__builtin_amdgcn_permlane32_swap(__float_as_uint(l_reg),__float_as_uint(l_reg),false,false);l_reg=__uint_as_float(rr[0])+__uint_as_float(rr[1]);}
  if(hi==0)wsf[32+r32]=l_reg;asm volatile("s_waitcnt lgkmcnt(0)":::"memory");
  float rli[16];
  #pragma unroll
  for(int r=0;r<16;++r)rli[r]=__builtin_amdgcn_rcpf(wsf[32+crow(r,hi)]);
  bf16*Ow=O+(rowbase+q0+wid*QBLK)*DM+h*D;
  { bf16*stg=(bf16*)(shm+LDS_OST)+wid*2048;
    #pragma unroll
    for(int r=0;r<16;++r){const int orow=crow(r,hi);
      #pragma unroll
      for(int d0=0;d0<2;++d0)stg[orow*64+d0*32+r32]=__float2bfloat16(o[d0][r]*rli[r]);}
    asm volatile("s_waitcnt lgkmcnt(0)":::"memory");
    #pragma unroll
    for(int i=0;i<4;++i){const int row=i*8+(lane>>3),ch=lane&7; const u32x4 v=*(const u32x4*)(stg+row*64+ch*8); ATTN_STORE16(Ow+(long)row*DM+ch*8,v);} }
  asm volatile("s_waitcnt lgkmcnt(0)\n\ts_barrier":::"memory");
  #undef DMA_K
  #undef DMA_V
  #undef CMASK
  #undef START
  #undef RESC
  #undef ROT
}
constexpr int V2SLOT=16384;
constexpr int L2_K=0, L2_V=NSLOT*SLOTB, L2_WS=L2_V+NSLOT*V2SLOT, L2_OST=L2_WS+NW*64*4, L2_BYTES=L2_OST+NW*4096;
__device__ __forceinline__ void pv4(f32x16*o,int vb,bf16x8 pa0,bf16x8 pa1,bf16x8 pa2,bf16x8 pa3){
  #pragma unroll
  for(int d0=0;d0<4;++d0){s16x4 lo[4],hi[4];
    #pragma unroll
    for(int ks=0;ks<4;++ks){
      asm volatile("ds_read_b64_tr_b16 %0,%1 offset:%c2":"=&v"(lo[ks]):"v"(vb),"i"(d0*4096+ks*1024):"memory");
      asm volatile("ds_read_b64_tr_b16 %0,%1 offset:%c2":"=&v"(hi[ks]):"v"(vb),"i"(d0*4096+ks*1024+512):"memory");}
    asm volatile("s_waitcnt lgkmcnt(0)":::"memory");SBAR();
    #define PK(k) (bf16x8){lo[k][0],lo[k][1],lo[k][2],lo[k][3],hi[k][0],hi[k][1],hi[k][2],hi[k][3]}
    o[d0]=__builtin_amdgcn_mfma_f32_32x32x16_bf16(pa0,PK(0),o[d0],0,0,0);
    o[d0]=__builtin_amdgcn_mfma_f32_32x32x16_bf16(pa1,PK(1),o[d0],0,0,0);
    o[d0]=__builtin_amdgcn_mfma_f32_32x32x16_bf16(pa2,PK(2),o[d0],0,0,0);
    o[d0]=__builtin_amdgcn_mfma_f32_32x32x16_bf16(pa3,PK(3),o[d0],0,0,0);
    #undef PK
  }
}
template<int THRL> __device__ __forceinline__ void attn_unit2(int b,int qb,const bf16*Q,const bf16*__restrict__ K,const bf16*__restrict__ V,bf16*O,char*shm){
  int tid_=threadIdx.x; asm volatile("":"+v"(tid_)); const int tid=tid_,lane=tid&63,r32=lane&31,hi=lane>>5; const int wid=__builtin_amdgcn_readfirstlane(tid>>6);
  const long rowbase=(long)b*SEQ; const int q0=qb*QB;
  if(wid>=4)__builtin_amdgcn_s_setprio(1);
  const bf16*Qw=Q+(rowbase+q0+wid*QBLK)*DM;
  const bf16*Kh=K+rowbase*DM,*Vh=V+rowbase*DM;
  const unsigned lds0=(unsigned)(uintptr_t)shm;
  float*wsf=(float*)(shm+L2_WS)+wid*64;
  const bf16*ksrc=Kh+(long)lane*DM+wid*8;
  const bf16*vsrc=Vh+(long)(16*(wid&3)+(lane>>2))*DM+(wid>>2)*32+(lane&3)*8;
  const unsigned kdst=lds0+L2_K+wid*1024, vdst=lds0+L2_V+wid*1024;
  #define DMA_K(t,slot) glds16(ksrc+(long)(t)*KVBLK*DM,(unsigned)__builtin_amdgcn_readfirstlane(kdst+(slot)))
  #define DMA_V(t,slot) do{ glds16(vsrc+(long)(t)*KVBLK*DM,(unsigned)__builtin_amdgcn_readfirstlane(vdst+2*(slot))); glds16(vsrc+64+(long)(t)*KVBLK*DM,(unsigned)__builtin_amdgcn_readfirstlane(vdst+2*(slot)+8192)); }while(0)
  const int vb0=(int)(lds0+L2_V)+((lane>>4)&1)*32+(lane&3)*8+(4*hi+((lane&15)>>2))*64;
  const char*Kbase=shm+L2_K; bf16x8 kf[8];
  const lds_cptr shm3=(lds_cptr)shm; const lds_cptr kp0=shm3+L2_K+hi*1024+r32*16; const lds_cptr vp0=shm3+L2_V+((lane>>4)&1)*32+(lane&3)*8+(4*hi+((lane&15)>>2))*64;
  const int NT=(q0+QB)/KVBLK;
  DMA_K(0,0);DMA_V(0,0);DMA_K(1,SLOTB);
  bf16x8 qr[4];
  #pragma unroll
  for(int d0=0;d0<4;++d0)qr[d0]=*reinterpret_cast<const bf16x8*>(&Qw[(long)r32*DM+d0*16+hi*8]);
  float mhat=0.f,l_reg=0.f;f32x16 o[4];o[0]=f32x16{};o[1]=f32x16{};o[2]=f32x16{};o[3]=f32x16{};f32x16 negm=f32x16{};asm volatile("":"+v"(negm));
  const int qrel=wid*QBLK+r32;
  #define CMASK(P0,P1,t) do{int jb_=(t)-(NT-4); if(jb_>=0)cmask(P0,P1,jb_,qrel,hi);}while(0)
  bool resc=false;
  #define START(P0,P1) do{ const float rm=rowmax(P0,P1); resc=false; \
    { const float dl=rm; mhat=fadd_s(mhat,dl); \
      _Pragma("unroll") for(int r=0;r<16;++r){P0[r]=fsub_s(P0[r],dl);P1[r]=fsub_s(P1[r],dl);} \
      _Pragma("unroll") for(int r=0;r<16;++r)negm[r]=-mhat; asm volatile("":"+v"(negm)); } \
    _Pragma("unroll") for(int r=0;r<16;++r)P0[r]=__builtin_amdgcn_exp2f(P0[r]); }while(0)
  #define RESC() do{ if(resc){ asm volatile("s_waitcnt lgkmcnt(0)":::"memory"); \
      _Pragma("unroll") for(int d_=0;d_<4;++d_) _Pragma("unroll") for(int r=0;r<16;++r)o[d_][r]*=wsf[crow(r,hi)]; } }while(0)
  f32x16 pA0,pA1,pB0,pB1;
  int sl_prev=0,sl_cur=0,sl_next=SLOTB;
  #define ROT() do{sl_prev=sl_cur;sl_cur=sl_next;sl_next=(sl_next==(NSLOT-1)*SLOTB)?0:sl_next+SLOTB;}while(0)
  DMA_K(2,2*SLOTB);
  WAIT_BAR(4);
  qkt(pA0,pA1,Kbase,qr,negm,r32,hi);asm volatile("s_nop 15\n\ts_nop 7":"+v"(pA0),"+v"(pA1));CMASK(pA0,pA1,0);
  START(pA0,pA1);
  _Pragma("unroll") for(int r=0;r<16;++r)pA1[r]=__builtin_amdgcn_exp2f(pA1[r]);
  WAIT_BAR(0);
  DMA_K(3,0);DMA_V(1,SLOTB);
  ROT();
  kload8(kf,kp0+sl_cur);
  WAIT_BAR(3);
  s16x4 vlo[8],vhi[8]; u32x4 pw0,pw1,pw2,pw3;
  #define VRD2(rg,i) do{ vlo[rg]=vtr(vp_+(((i)>>2)*4096+((i)&3)*1024)); vhi[rg]=vtr(vp_+(((i)>>2)*4096+((i)&3)*1024+512)); }while(0)
  #define GAPB2(MF,X,B) do{ MF; X[B]=EX(X[B]); X[B+1]=EX(X[B+1]); PIN(X); SBAR(); }while(0)
  #define PKW(P,B) cvtpk_s(P[B],P[B+1])
  #define PAF(k) __builtin_bit_cast(bf16x8,pw##k)
  #define VFR(i) (bf16x8){vlo[i][0],vlo[i][1],vlo[i][2],vlo[i][3],vhi[i][0],vhi[i][1],vhi[i][2],vhi[i][3]}
  #define PIN(x) asm volatile("":"+v"(x))
  #define MX3(a,b,c) __builtin_fmaxf(__builtin_fmaxf((a),(b)),(c))
  #define GAPA(MF,A0,A1,A2,A3,W0,W1,PW) do{ MF; sacc+=A0; sacc+=A1; sacc+=A2; sacc+=A3; PIN(sacc); W0; W1; PIN(PW); SBAR(); }while(0)
  #define EX(v) __builtin_amdgcn_exp2f(v)
  #define GAPB(MF,X,B) do{ MF; X[B]=EX(X[B]); X[B+1]=EX(X[B+1]); X[B+2]=EX(X[B+2]); X[B+3]=EX(X[B+3]); PIN(X); SBAR(); }while(0)
  #define VRD(i) do{ vlo[i]=vtr(vp_+(((i)>>2)*4096+((i)&3)*1024)); vhi[i]=vtr(vp_+(((i)>>2)*4096+((i)&3)*1024+512)); }while(0)
  #define KRD(G,j) do{ if(G){ kload2(kf,kp0+sl_next,j); SBAR(); } }while(0)
  #define STEP(C0,C1,P0,P1,t,GK,GV,GL) do{ SBAR(); \
    const lds_cptr vp_=vp0+2*sl_prev; \
    VRD2(0,0); SBAR(); float sacc=(P0[0]+P0[1]); \
    GAPA(C0=__builtin_amdgcn_mfma_f32_32x32x16_bf16(kf[0],qr[0],negm,0,0,0), P0[2],P0[3],P0[4],P0[5],     pw0[0]=PKW(P0,0), pw0[1]=PKW(P0,2), pw0); \
    VRD2(1,4); SBAR(); GAPA(C1=__builtin_amdgcn_mfma_f32_32x32x16_bf16(kf[1],qr[0],negm,0,0,0), P0[6],P0[7],P0[8],P0[9],     pw0[2]=PKW(P0,4), pw0[3]=PKW(P0,6), pw0); \
    VRD2(2,8); SBAR(); GAPA(C0=__builtin_amdgcn_mfma_f32_32x32x16_bf16(kf[2],qr[1],C0,0,0,0),   P0[10],P0[11],P0[12],P0[13], pw1[0]=PKW(P0,8), pw1[1]=PKW(P0,10), pw1); \
    VRD2(3,12); SBAR(); GAPA(C1=__builtin_amdgcn_mfma_f32_32x32x16_bf16(kf[3],qr[1],C1,0,0,0),   P0[14],P0[15],P1[0],P1[1],   pw1[2]=PKW(P0,12),pw1[3]=PKW(P0,14), pw1); \
    VRD2(4,1); SBAR(); GAPA(C0=__builtin_amdgcn_mfma_f32_32x32x16_bf16(kf[4],qr[2],C0,0,0,0),   P1[2],P1[3],P1[4],P1[5],     pw2[0]=PKW(P1,0), pw2[1]=PKW(P1,2), pw2); \
    VRD2(5,5); SBAR(); GAPA(C1=__builtin_amdgcn_mfma_f32_32x32x16_bf16(kf[5],qr[2],C1,0,0,0),   P1[6],P1[7],P1[8],P1[9],     pw2[2]=PKW(P1,4), pw2[3]=PKW(P1,6), pw2); \
    VRD2(6,9); SBAR(); GAPA(C0=__builtin_amdgcn_mfma_f32_32x32x16_bf16(kf[6],qr[3],C0,0,0,0),   P1[10],P1[11],P1[12],P1[13], pw3[0]=PKW(P1,8), pw3[1]=PKW(P1,10), pw3); \
    VRD2(7,13); SBAR(); GAPA(C1=__builtin_amdgcn_mfma_f32_32x32x16_bf16(kf[7],qr[3],C1,0,0,0),   P1[14],P1[15],0.f,0.f,       pw3[2]=PKW(P1,12),pw3[3]=PKW(P1,14), pw3); \
    l_reg+=sacc; \
    if(GK){DMA_K((t)+3,sl_cur);} if(GV){DMA_V((t)+1,sl_next);} \
    CMASK(C0,C1,t); \
    { float a=MX3(C0[0],C0[1],C1[0]),b=MX3(C0[2],C0[3],C1[1]); a=MX3(a,C1[2],C1[3]); \
      _Pragma("unroll") for(int r=4;r<16;r+=4){a=MX3(a,C0[r],C0[r+1]);b=MX3(b,C0[r+2],C0[r+3]);a=MX3(a,C1[r],C1[r+1]);b=MX3(b,C1[r+2],C1[r+3]);} \
      float rm=__builtin_fmaxf(a,b); { auto rr=__builtin_amdgcn_permlane32_swap(__float_as_uint(rm),__float_as_uint(rm),false,false); rm=__builtin_fmaxf(__uint_as_float(rr[0]),__uint_as_float(rr[1])); } \
      resc=false; \
      if(__builtin_expect(__any(rm>(float)THRL),0)){ const float dl=__builtin_fmaxf(rm,0.f); mhat+=dl; \
        _Pragma("unroll") for(int r=0;r<16;++r){C0[r]-=dl;C1[r]-=dl;} \
        _Pragma("unroll") for(int r=0;r<16;++r)negm[r]=-mhat; asm volatile("":"+v"(negm)); \
        const float f=__builtin_amdgcn_exp2f(-dl); l_reg*=f; if(hi==0)wsf[r32]=f; resc=true; } } \
    SBAR(); \
    GAPB2(o[0]=__builtin_amdgcn_mfma_f32_32x32x16_bf16(PAF(0),VFR(0),o[0],0,0,0), C0,0); VRD2(0,2); SBAR(); \
    GAPB2(o[1]=__builtin_amdgcn_mfma_f32_32x32x16_bf16(PAF(0),VFR(1),o[1],0,0,0), C0,2); VRD2(1,6); SBAR(); \
    GAPB2(o[2]=__builtin_amdgcn_mfma_f32_32x32x16_bf16(PAF(0),VFR(2),o[2],0,0,0), C0,4); VRD2(2,10); SBAR(); \
    GAPB2(o[3]=__builtin_amdgcn_mfma_f32_32x32x16_bf16(PAF(0),VFR(3),o[3],0,0,0), C0,6); VRD2(3,14); SBAR(); \
    GAPB2(o[0]=__builtin_amdgcn_mfma_f32_32x32x16_bf16(PAF(1),VFR(4),o[0],0,0,0), C0,8); VRD2(4,3); SBAR(); \
    GAPB2(o[1]=__builtin_amdgcn_mfma_f32_32x32x16_bf16(PAF(1),VFR(5),o[1],0,0,0), C0,10); VRD2(5,7); SBAR(); \
    GAPB2(o[2]=__builtin_amdgcn_mfma_f32_32x32x16_bf16(PAF(1),VFR(6),o[2],0,0,0), C0,12); VRD2(6,11); SBAR(); \
    GAPB2(o[3]=__builtin_amdgcn_mfma_f32_32x32x16_bf16(PAF(1),VFR(7),o[3],0,0,0), C0,14); VRD2(7,15); SBAR(); \
    KRD(GL,0); GAPB2(o[0]=__builtin_amdgcn_mfma_f32_32x32x16_bf16(PAF(2),VFR(0),o[0],0,0,0), C1,0); \
    KRD(GL,1); GAPB2(o[1]=__builtin_amdgcn_mfma_f32_32x32x16_bf16(PAF(2),VFR(1),o[1],0,0,0), C1,2); \
    KRD(GL,2); GAPB2(o[2]=__builtin_amdgcn_mfma_f32_32x32x16_bf16(PAF(2),VFR(2),o[2],0,0,0), C1,4); \
    KRD(GL,3); GAPB2(o[3]=__builtin_amdgcn_mfma_f32_32x32x16_bf16(PAF(2),VFR(3),o[3],0,0,0), C1,6); \
    GAPB2(o[0]=__builtin_amdgcn_mfma_f32_32x32x16_bf16(PAF(3),VFR(4),o[0],0,0,0), C1,8); \
    GAPB2(o[1]=__builtin_amdgcn_mfma_f32_32x32x16_bf16(PAF(3),VFR(5),o[1],0,0,0), C1,10); \
    GAPB2(o[2]=__builtin_amdgcn_mfma_f32_32x32x16_bf16(PAF(3),VFR(6),o[2],0,0,0), C1,12); \
    GAPB2(o[3]=__builtin_amdgcn_mfma_f32_32x32x16_bf16(PAF(3),VFR(7),o[3],0,0,0), C1,14); \
    }while(0)
  int t=1;
  #undef CMASK
  #define CMASK(P0,P1,t) do{}while(0)
  for(;t+5<NT;t+=2){
    STEP(pB0,pB1,pA0,pA1,t,true,true,true);     WAIT_BAR(3); RESC(); ROT();
    STEP(pA0,pA1,pB0,pB1,t+1,true,true,true);   WAIT_BAR(3); RESC(); ROT();
  }
  #undef CMASK
  #define CMASK(P0,P1,t) do{int jb_=(t)-(NT-4); if(jb_>=0)cmask(P0,P1,jb_,qrel,hi);}while(0)
  #define ENDW(tt) do{ if((tt)+3<NT){WAIT_BAR(3);} else if((tt)+2<NT){WAIT_BAR(2);} else {WAIT_BAR(0);} }while(0)
  for(;t+1<NT;t+=2){
    STEP(pB0,pB1,pA0,pA1,t,(t+3<NT),(t+1<NT),(t+1<NT));       ENDW(t);   RESC(); ROT();
    STEP(pA0,pA1,pB0,pB1,t+1,(t+4<NT),(t+2<NT),(t+2<NT));     ENDW(t+1); RESC(); ROT();
  }
  STEP(pB0,pB1,pA0,pA1,NT-1,false,false,false); RESC();
  { float sacc=pB0[0]+pB0[1]; _Pragma("unroll") for(int r=2;r<16;++r)sacc+=pB0[r]; _Pragma("unroll") for(int r=0;r<16;++r)sacc+=pB1[r]; l_reg+=sacc;
    pw0=(u32x4){PKW(pB0,0),PKW(pB0,2),PKW(pB0,4),PKW(pB0,6)};pw1=(u32x4){PKW(pB0,8),PKW(pB0,10),PKW(pB0,12),PKW(pB0,14)};pw2=(u32x4){PKW(pB1,0),PKW(pB1,2),PKW(pB1,4),PKW(pB1,6)};pw3=(u32x4){PKW(pB1,8),PKW(pB1,10),PKW(pB1,12),PKW(pB1,14)};
    SBAR(); pv4(o,vb0+2*sl_cur,PAF(0),PAF(1),PAF(2),PAF(3)); }
  #undef PKW
  #undef PAF
  #undef VFR
  #undef PIN
  #undef MX3
  #undef GAPA
  #undef GAPB
  #undef EX
  #undef VRD
  #undef VRD2
  #undef GAPB2
  #undef KRD
  #undef STEP
  #undef ENDW
  {auto rr=__builtin_amdgcn_permlane32_swap(__float_as_uint(l_reg),__float_as_uint(l_reg),false,false);l_reg=__uint_as_float(rr[0])+__uint_as_float(rr[1]);}
  if(hi==0)wsf[32+r32]=l_reg;asm volatile("s_waitcnt lgkmcnt(0)":::"memory");
  float rli[16];
  #pragma unroll
  for(int r=0;r<16;++r)rli[r]=__builtin_amdgcn_rcpf(wsf[32+crow(r,hi)]);
  bf16*Ow=O+(rowbase+q0+wid*QBLK)*DM;
  { bf16*stg=(bf16*)(shm+L2_OST)+wid*2048;
    #pragma unroll
    for(int hf=0;hf<2;++hf){
      #pragma unroll
      for(int r=0;r<16;++r){const int orow=crow(r,hi);
        #pragma unroll
        for(int d0=0;d0<2;++d0)stg[orow*64+d0*32+r32]=__float2bfloat16(o[2*hf+d0][r]*rli[r]);}
      asm volatile("s_waitcnt lgkmcnt(0)":::"memory");
      #pragma unroll
      for(int i=0;i<4;++i){const int row=i*8+(lane>>3),ch=lane&7; const u32x4 v=*(const u32x4*)(stg+row*64+ch*8); ATTN_STORE16(Ow+(long)row*DM+hf*64+ch*8,v);}
      asm volatile("s_waitcnt lgkmcnt(0)":::"memory"); } }
  asm volatile("s_waitcnt lgkmcnt(0)\n\ts_barrier":::"memory");
  __builtin_amdgcn_s_setprio(0);
  #undef DMA_K
  #undef DMA_V
  #undef CMASK
  #undef START
  #undef RESC
  #undef ROT
}

__device__ __forceinline__ void wmask(f32x16&p0,f32x16&p1,int thr,int hi){
  const float NEG=-INFINITY; const int kb=4*hi;
  #pragma unroll
  for(int r=0;r<16;++r){const int kv=kb+(r&3)+8*(r>>2); if(kv<thr)p0[r]=NEG; if(kv+32<thr)p1[r]=NEG;}
}
__device__ __forceinline__ void cmask2(f32x16&p0,f32x16&p1,int nb,int lim,int hi){
  const float NEG=-INFINITY; const int kb=nb+4*hi;
  #pragma unroll
  for(int r=0;r<16;++r){const int kv=kb+(r&3)+8*(r>>2); if(kv>lim)p0[r]=NEG; if(kv+32>lim)p1[r]=NEG;}
}
template<int THRL,int MODE,int PQ,int PKV,int PO> __device__ __forceinline__ void attn_unitN(int q0,int NT,const bf16*Qw0,const bf16*__restrict__ Kh,const bf16*__restrict__ Vh,bf16*Ow0,char*shm){
  int tid_=threadIdx.x; asm volatile("":"+v"(tid_)); const int tid=tid_,lane=tid&63,r32=lane&31,hi=lane>>5; const int wid=__builtin_amdgcn_readfirstlane(tid>>6);
  const bf16*Qw=Qw0+(long)(wid*QBLK)*PQ;
  const unsigned lds0=(unsigned)(uintptr_t)shm;
  float*wsf=(float*)(shm+LDS_WS)+wid*64;
  const bf16*ksrc=Kh+(long)lane*PKV+wid*8;
  const bf16*vsrc=Vh+(long)(16*(wid&3)+(lane>>2))*PKV+(wid>>2)*32+(lane&3)*8;
  const unsigned kdst=lds0+LDS_K+wid*1024, vdst=lds0+LDS_V+wid*1024;
  #define DMA_K(t,slot) glds16(ksrc+(long)(t)*KVBLK*PKV,(unsigned)__builtin_amdgcn_readfirstlane(kdst+(slot)))
  #define DMA_V(t,slot) glds16(vsrc+(long)(t)*KVBLK*PKV,(unsigned)__builtin_amdgcn_readfirstlane(vdst+(slot)))
  const int vb0=(int)(lds0+LDS_V)+((lane>>4)&1)*32+(lane&3)*8+(4*hi+((lane&15)>>2))*64;
  const char*Kbase=shm+LDS_K; bf16x8 kf[8];
  const lds_cptr shm3=(lds_cptr)shm; const lds_cptr kp0=shm3+LDS_K+hi*1024+r32*16; const lds_cptr vp0=shm3+LDS_V+((lane>>4)&1)*32+(lane&3)*8+(4*hi+((lane&15)>>2))*64;
  DMA_K(0,0);DMA_V(0,0);DMA_K(1,SLOTB);
  bf16x8 qr[4];
  #pragma unroll
  for(int d0=0;d0<4;++d0)qr[d0]=*reinterpret_cast<const bf16x8*>(&Qw[(long)r32*PQ+d0*16+hi*8]);
  float mhat=0.f,l_reg=0.f;f32x16 o[2];o[0]=f32x16{};o[1]=f32x16{};const f32x16 negm=f32x16{};
  const int qrel=wid*QBLK+r32; const int clim=(q0+qrel-31)>>4; (void)clim;
  #define CMASK(P0,P1,t) do{int jb_=(t)-(NT-4); if(jb_>=0){ if(MODE==2)cmask2(P0,P1,64*(t),clim,hi); else cmask(P0,P1,jb_,qrel,hi);} else if(MODE==1&&(t)<NT-8)wmask(P0,P1,qrel-511-64*jb_,hi);}while(0)
  bool resc=false;
  #define START(P0,P1) do{ const float rm=__builtin_fmaxf(rowmax(P0,P1),-32.f); resc=false; \
    { const float dl=rm; mhat=fadd_s(mhat,dl); \
      _Pragma("unroll") for(int r=0;r<16;++r){P0[r]=fsub_s(P0[r],dl);P1[r]=fsub_s(P1[r],dl);} \
      } \
    _Pragma("unroll") for(int r=0;r<16;++r)P0[r]=__builtin_amdgcn_exp2f(P0[r]); }while(0)
  #define RESC() do{ if(resc){ asm volatile("s_waitcnt lgkmcnt(0)":::"memory"); \
      _Pragma("unroll") for(int d_=0;d_<2;++d_) _Pragma("unroll") for(int r=0;r<16;++r)o[d_][r]*=wsf[crow(r,hi)]; } }while(0)
  f32x16 pA0,pA1,pB0,pB1;
  int sl_prev=0,sl_cur=0,sl_next=SLOTB;
  #define ROT() do{sl_prev=sl_cur;sl_cur=sl_next;sl_next=(sl_next==(NSLOT-1)*SLOTB)?0:sl_next+SLOTB;}while(0)
  DMA_K(2,2*SLOTB);
  WAIT_BAR(3);
  qkt(pA0,pA1,Kbase,qr,negm,r32,hi);asm volatile("s_nop 15\n\ts_nop 7":"+v"(pA0),"+v"(pA1));CMASK(pA0,pA1,0);
  START(pA0,pA1);
  _Pragma("unroll") for(int r=0;r<16;++r)pA1[r]=__builtin_amdgcn_exp2f(pA1[r]);
  WAIT_BAR(0);
  DMA_K(3,0);DMA_V(1,SLOTB);
  ROT();
  kload8(kf,kp0+sl_cur);
  WAIT_BAR(2);
  s16x4 vlo[8],vhi[8]; u32x4 pw0,pw1,pw2,pw3;
  #define PKW(P,B) cvtpk_s(P[B],P[B+1])
  #define PAF(k) __builtin_bit_cast(bf16x8,pw##k)
  #define VFR(i) (bf16x8){vlo[i][0],vlo[i][1],vlo[i][2],vlo[i][3],vhi[i][0],vhi[i][1],vhi[i][2],vhi[i][3]}
  #define PIN(x) asm volatile("":"+v"(x))
  #define MX3(a,b,c) __builtin_fmaxf(__builtin_fmaxf((a),(b)),(c))
  #define GAPA(MF,A0,A1,A2,A3,W0,W1,PW) do{ MF; sacc+=A0; sacc+=A1; sacc+=A2; sacc+=A3; PIN(sacc); W0; W1; PIN(PW); SBAR(); }while(0)
  #define EX(v) __builtin_amdgcn_exp2f(v)
  #define GAPB(MF,X,B) do{ MF; X[B]=EX(X[B]); X[B+1]=EX(X[B+1]); X[B+2]=EX(X[B+2]); X[B+3]=EX(X[B+3]); PIN(X); SBAR(); }while(0)
  #define VRD(i) do{ vlo[i]=vtr(vp_+(((i)>>2)*4096+((i)&3)*1024)); vhi[i]=vtr(vp_+(((i)>>2)*4096+((i)&3)*1024+512)); }while(0)
  #define KRD(G,j) do{ if(G){ kload2(kf,kp0+sl_next,j); SBAR(); } }while(0)
  #define STEP(C0,C1,P0,P1,t,GK,GV,GL) do{ SBAR(); \
    const lds_cptr vp_=vp0+sl_prev; \
    VRD(0); SBAR(); float sacc=(P0[0]+P0[1]); \
    GAPA(C0=__builtin_amdgcn_mfma_f32_32x32x16_bf16(kf[0],qr[0],negm,0,0,0), P0[2],P0[3],P0[4],P0[5],     pw0[0]=PKW(P0,0), pw0[1]=PKW(P0,2), pw0); \
    VRD(4); SBAR(); GAPA(C1=__builtin_amdgcn_mfma_f32_32x32x16_bf16(kf[1],qr[0],negm,0,0,0), P0[6],P0[7],P0[8],P0[9],     pw0[2]=PKW(P0,4), pw0[3]=PKW(P0,6), pw0); \
    VRD(1); SBAR(); GAPA(C0=__builtin_amdgcn_mfma_f32_32x32x16_bf16(kf[2],qr[1],C0,0,0,0),   P0[10],P0[11],P0[12],P0[13], pw1[0]=PKW(P0,8), pw1[1]=PKW(P0,10), pw1); \
    VRD(5); SBAR(); GAPA(C1=__builtin_amdgcn_mfma_f32_32x32x16_bf16(kf[3],qr[1],C1,0,0,0),   P0[14],P0[15],P1[0],P1[1],   pw1[2]=PKW(P0,12),pw1[3]=PKW(P0,14), pw1); \
    VRD(2); SBAR(); GAPA(C0=__builtin_amdgcn_mfma_f32_32x32x16_bf16(kf[4],qr[2],C0,0,0,0),   P1[2],P1[3],P1[4],P1[5],     pw2[0]=PKW(P1,0), pw2[1]=PKW(P1,2), pw2); \
    VRD(6); SBAR(); GAPA(C1=__builtin_amdgcn_mfma_f32_32x32x16_bf16(kf[5],qr[2],C1,0,0,0),   P1[6],P1[7],P1[8],P1[9],     pw2[2]=PKW(P1,4), pw2[3]=PKW(P1,6), pw2); \
    VRD(3); SBAR(); GAPA(C0=__builtin_amdgcn_mfma_f32_32x32x16_bf16(kf[6],qr[3],C0,0,0,0),   P1[10],P1[11],P1[12],P1[13], pw3[0]=PKW(P1,8), pw3[1]=PKW(P1,10), pw3); \
    VRD(7); SBAR(); GAPA(C1=__builtin_amdgcn_mfma_f32_32x32x16_bf16(kf[7],qr[3],C1,0,0,0),   P1[14],P1[15],0.f,0.f,       pw3[2]=PKW(P1,12),pw3[3]=PKW(P1,14), pw3); \
    l_reg+=sacc; \
    if(GK){DMA_K((t)+3,sl_cur);} if(GV){DMA_V((t)+1,sl_next);} \
    C0=C0-mhat; C1=C1-mhat; \
    CMASK(C0,C1,t); \
    { float a=MX3(C0[0],C0[1],C1[0]),b=MX3(C0[2],C0[3],C1[1]); a=MX3(a,C1[2],C1[3]); \
      _Pragma("unroll") for(int r=4;r<16;r+=4){a=MX3(a,C0[r],C0[r+1]);b=MX3(b,C0[r+2],C0[r+3]);a=MX3(a,C1[r],C1[r+1]);b=MX3(b,C1[r+2],C1[r+3]);} \
      float rm=__builtin_fmaxf(a,b); { auto rr=__builtin_amdgcn_permlane32_swap(__float_as_uint(rm),__float_as_uint(rm),false,false); rm=__builtin_fmaxf(__uint_as_float(rr[0]),__uint_as_float(rr[1])); } \
      resc=false; \
      if(__builtin_expect(__any(rm>(float)THRL),0)){ const float dl=__builtin_fmaxf(rm,0.f); mhat+=dl; \
        _Pragma("unroll") for(int r=0;r<16;++r){C0[r]-=dl;C1[r]-=dl;} \
        const float f=__builtin_amdgcn_exp2f(-dl); l_reg*=f; if(hi==0)wsf[r32]=f; resc=true; } } \
    SBAR(); \
    GAPB(o[0]=__builtin_amdgcn_mfma_f32_32x32x16_bf16(PAF(0),VFR(0),o[0],0,0,0), C0,0); \
    GAPB(o[1]=__builtin_amdgcn_mfma_f32_32x32x16_bf16(PAF(0),VFR(4),o[1],0,0,0), C0,4); \
    KRD(GL,0); GAPB(o[0]=__builtin_amdgcn_mfma_f32_32x32x16_bf16(PAF(1),VFR(1),o[0],0,0,0), C0,8); \
    KRD(GL,1); GAPB(o[1]=__builtin_amdgcn_mfma_f32_32x32x16_bf16(PAF(1),VFR(5),o[1],0,0,0), C0,12); \
    KRD(GL,2); GAPB(o[0]=__builtin_amdgcn_mfma_f32_32x32x16_bf16(PAF(2),VFR(2),o[0],0,0,0), C1,0); \
    KRD(GL,3); GAPB(o[1]=__builtin_amdgcn_mfma_f32_32x32x16_bf16(PAF(2),VFR(6),o[1],0,0,0), C1,4); \
    GAPB(o[0]=__builtin_amdgcn_mfma_f32_32x32x16_bf16(PAF(3),VFR(3),o[0],0,0,0), C1,8); \
    GAPB(o[1]=__builtin_amdgcn_mfma_f32_32x32x16_bf16(PAF(3),VFR(7),o[1],0,0,0), C1,12); \
    }while(0)
  int t=1;
  #undef CMASK
  #define CMASK(P0,P1,t) do{ if(MODE==1&&(t)<NT-8)wmask(P0,P1,qrel-511-64*((t)-(NT-4)),hi); }while(0)
  for(;t+5<NT;t+=2){
    STEP(pB0,pB1,pA0,pA1,t,true,true,true);     WAIT_BAR(2); RESC(); ROT();
    STEP(pA0,pA1,pB0,pB1,t+1,true,true,true);   WAIT_BAR(2); RESC(); ROT();
  }
  #undef CMASK
  #define CMASK(P0,P1,t) do{int jb_=(t)-(NT-4); if(jb_>=0){ if(MODE==2)cmask2(P0,P1,64*(t),clim,hi); else cmask(P0,P1,jb_,qrel,hi);} else if(MODE==1&&(t)<NT-8)wmask(P0,P1,qrel-511-64*jb_,hi);}while(0)
  #define ENDW(tt) do{ if((tt)+3<NT){WAIT_BAR(2);} else if((tt)+2<NT){WAIT_BAR(1);} else {WAIT_BAR(0);} }while(0)
  for(;t+1<NT;t+=2){
    STEP(pB0,pB1,pA0,pA1,t,(t+3<NT),(t+1<NT),(t+1<NT));       ENDW(t);   RESC(); ROT();
    STEP(pA0,pA1,pB0,pB1,t+1,(t+4<NT),(t+2<NT),(t+2<NT));     ENDW(t+1); RESC(); ROT();
  }
  STEP(pB0,pB1,pA0,pA1,NT-1,false,false,false); RESC();
  { float sacc=pB0[0]+pB0[1]; _Pragma("unroll") for(int r=2;r<16;++r)sacc+=pB0[r]; _Pragma("unroll") for(int r=0;r<16;++r)sacc+=pB1[r]; l_reg+=sacc;
    pw0=(u32x4){PKW(pB0,0),PKW(pB0,2),PKW(pB0,4),PKW(pB0,6)};pw1=(u32x4){PKW(pB0,8),PKW(pB0,10),PKW(pB0,12),PKW(pB0,14)};pw2=(u32x4){PKW(pB1,0),PKW(pB1,2),PKW(pB1,4),PKW(pB1,6)};pw3=(u32x4){PKW(pB1,8),PKW(pB1,10),PKW(pB1,12),PKW(pB1,14)};
    SBAR(); pv(o,vb0+sl_cur,PAF(0),PAF(1),PAF(2),PAF(3)); }
  #undef PKW
  #undef PAF
  #undef VFR
  #undef PIN
  #undef MX3
  #undef GAPA
  #undef GAPB
  #undef EX
  #undef VRD
  #undef KRD
  #undef STEP
  #undef ENDW
  {auto rr=__builtin_amdgcn_permlane32_swap(__float_as_uint(l_reg),__float_as_uint(l_reg),false,false);l_reg=__uint_as_float(rr[0])+__uint_as_float(rr[1]);}
  if(hi==0)wsf[32+r32]=l_reg;asm volatile("s_waitcnt lgkmcnt(0)":::"memory");
  float rli[16];
  #pragma unroll
  for(int r=0;r<16;++r){const float lv=wsf[32+crow(r,hi)]; rli[r]=lv>0.f?__builtin_amdgcn_rcpf(lv):0.f;}
  bf16*Ow=Ow0+(long)(wid*QBLK)*PO;
  { bf16*stg=(bf16*)(shm+LDS_OST)+wid*2048;
    #pragma unroll
    for(int r=0;r<16;++r){const int orow=crow(r,hi);
      #pragma unroll
      for(int d0=0;d0<2;++d0)stg[orow*64+d0*32+r32]=__float2bfloat16(o[d0][r]*rli[r]);}
    asm volatile("s_waitcnt lgkmcnt(0)":::"memory");
    #pragma unroll
    for(int i=0;i<4;++i){const int row=i*8+(lane>>3),ch=lane&7; const u32x4 v=*(const u32x4*)(stg+row*64+ch*8); ATTN_STORE16(Ow+(long)row*PO+ch*8,v);} }
  asm volatile("s_waitcnt lgkmcnt(0)\n\ts_barrier":::"memory");
  #undef DMA_K
  #undef DMA_V
  #undef CMASK
  #undef START
  #undef RESC
  #undef ROT
}

__device__ __forceinline__ void nsa_window_phase(char*lds,const bf16*P,bf16*OW,unsigned*qc,volatile __attribute__((address_space(3))) unsigned*qw){
  for(;;){
    if(threadIdx.x==0) qw[0]=__hip_atomic_fetch_add(qc,1u,__ATOMIC_RELAXED,__HIP_MEMORY_SCOPE_AGENT);
    __syncthreads();
    const int u=__builtin_amdgcn_readfirstlane((int)qw[0]);
    __syncthreads();
    if(u>=2048)break;
    const int qb=63-(u&63),bh=u>>6,b=bh>>4,hd=bh&15,g=hd>>3; const int q0=qb*256; const int nt0=q0>=512?q0/64-8:0; const int NT=q0/64+4-nt0;
    const long rowbase=(long)b*SEQ;
    attn_unitN<8,1,2048,2048,1024>(q0,NT,P+(rowbase+q0)*2048+hd*64,P+(rowbase+64*nt0)*2048+1536+g*64,P+(rowbase+64*nt0)*2048+1664+g*64,OW+(rowbase+q0)*1024+hd*64,lds);
  }
}
constexpr int ATTN_LDS_BYTES=LDS_BYTES;
template<int THRL=8> __device__ __forceinline__ void diff_attn_phase(char*lds,const bf16*Q,const bf16*K,const bf16*V,bf16*O0,bf16*O1,int vcu,int G){
  for(int i=0;;++i){
    const int L=__builtin_amdgcn_readfirstlane(vcu+(i>>1)*G); if(L>=2048)break;
    const int combo=L>>5,x=L&31; const int b=combo>>5,hh=(combo>>1)&15,vh=combo&1; const int h=hh>>1,c=hh&1;
    const int qb=(i&1)?63-x:x;
    attn_unit<THRL>(b,0,qb,Q+hh*64,K+hh*64,V+(2*h+vh)*64,(c?O1:O0)+(2*h+vh)*64,lds);
  }
}
template<int THRL=8> __device__ __forceinline__ void diff_attn_phase2(char*lds,const bf16*Q,const bf16*K,const bf16*V,bf16*O0,bf16*O1,int vcu,int G){
  for(int i=0;;++i){
    const int L=__builtin_amdgcn_readfirstlane(vcu+(i>>1)*G); if(L>=1024)break;
    const int combo=L>>5,x=L&31; const int b=combo>>4,hh=combo&15; const int h=hh>>1,c=hh&1;
    const int qb=(i&1)?63-x:x;
    attn_unit2<THRL>(b,qb,Q+hh*64,K+hh*64,V+h*128,(c?O1:O0)+h*128,lds);
  }
}
#undef SBAR
#undef WAIT_BAR
}

namespace nsa {
typedef short bf16x8 __attribute__((ext_vector_type(8)));
typedef float f32x4 __attribute__((ext_vector_type(4)));
typedef unsigned short bf16_t;
constexpr int S = 16384, PITCH = 2048;
constexpr int COL_KS = 1280, COL_VS = 1408, COL_KW = 1536, COL_VW = 1664, COL_G = 1792;
constexpr float NEG = -1e30f;
__device__ __forceinline__ unsigned pk2(float lo, float hi) { typedef float f2 __attribute__((ext_vector_type(2))); typedef __bf16 b2 __attribute__((ext_vector_type(2))); f2 v = {lo, hi}; b2 b = __builtin_convertvector(v, b2); return __builtin_bit_cast(unsigned, b); }
__device__ __forceinline__ float bf2f(bf16_t x) { return __uint_as_float((unsigned)x << 16); }

__device__ __forceinline__ void qk_group(float (&s)[8], const bf16_t* krow0, int kpitch, const bf16x8 (&qf)[2], int n, int q) {
    const bf16_t* kp = krow0 + (size_t)(8 * (n >> 2) + (n & 3)) * kpitch + q * 8;
    const bf16x8 a00 = *(const bf16x8*)(kp), a01 = *(const bf16x8*)(kp + 32);
    const bf16x8 a10 = *(const bf16x8*)(kp + (size_t)4 * kpitch), a11 = *(const bf16x8*)(kp + (size_t)4 * kpitch + 32);
    f32x4 t0 = {0.f, 0.f, 0.f, 0.f}, t1 = {0.f, 0.f, 0.f, 0.f};
    t0 = __builtin_amdgcn_mfma_f32_16x16x32_bf16(a00, qf[0], t0, 0, 0, 0); t0 = __builtin_amdgcn_mfma_f32_16x16x32_bf16(a01, qf[1], t0, 0, 0, 0);
    t1 = __builtin_amdgcn_mfma_f32_16x16x32_bf16(a10, qf[0], t1, 0, 0, 0); t1 = __builtin_amdgcn_mfma_f32_16x16x32_bf16(a11, qf[1], t1, 0, 0, 0);
#pragma unroll
    for (int i = 0; i < 4; ++i) { s[i] = t0[i]; s[4 + i] = t1[i]; }
}
__device__ __forceinline__ void pv_group(f32x4 (&o)[4], const float (&p)[8], const bf16_t* vt, int n, int q) {
    typedef unsigned u32x4 __attribute__((ext_vector_type(4)));
    u32x4 w; w.x = pk2(p[0], p[1]); w.y = pk2(p[2], p[3]); w.z = pk2(p[4], p[5]); w.w = pk2(p[6], p[7]);
    const bf16x8 pf = __builtin_bit_cast(bf16x8, w);
#pragma unroll
    for (int dt = 0; dt < 4; ++dt) { const bf16x8 vf = *(const bf16x8*)(vt + (16 * dt + n) * 32 + q * 8); o[dt] = __builtin_amdgcn_mfma_f32_16x16x32_bf16(vf, pf, o[dt], 0, 0, 0); }
}
struct Run { f32x4 o[4]; float m, l; };
__device__ __forceinline__ void run_init(Run& r) {
#pragma unroll
    for (int dt = 0; dt < 4; ++dt) r.o[dt] = (f32x4){0.f, 0.f, 0.f, 0.f};
    r.m = NEG; r.l = 0.f;
}
struct Frag { bf16x8 k[4]; bf16x8 v[4]; };
__device__ __forceinline__ void load_kt(Frag& f, const bf16_t* kt, int lane) {
#pragma unroll
    for (int i = 0; i < 4; ++i) f.k[i] = *(const bf16x8*)(kt + i * 512 + lane * 8);
}
__device__ __forceinline__ void load_k(Frag& f, const bf16_t* krow0, int kpitch, int n, int q) {
    const bf16_t* kp = krow0 + (size_t)(8 * (n >> 2) + (n & 3)) * kpitch + q * 8;
    f.k[0] = *(const bf16x8*)(kp); f.k[1] = *(const bf16x8*)(kp + 32); f.k[2] = *(const bf16x8*)(kp + (size_t)4 * kpitch); f.k[3] = *(const bf16x8*)(kp + (size_t)4 * kpitch + 32);
}
__device__ __forceinline__ void load_v(Frag& f, const bf16_t* vt, int n, int q) {
#pragma unroll
    for (int dt = 0; dt < 4; ++dt) f.v[dt] = *(const bf16x8*)(vt + (16 * dt + n) * 32 + q * 8);
}
__device__ __forceinline__ void qk_frag(float (&s)[8], const Frag& f, const bf16x8 (&qf)[2]) {
    f32x4 t0 = {0.f, 0.f, 0.f, 0.f}, t1 = {0.f, 0.f, 0.f, 0.f};
    t0 = __builtin_amdgcn_mfma_f32_16x16x32_bf16(f.k[0], qf[0], t0, 0, 0, 0); t0 = __builtin_amdgcn_mfma_f32_16x16x32_bf16(f.k[1], qf[1], t0, 0, 0, 0);
    t1 = __builtin_amdgcn_mfma_f32_16x16x32_bf16(f.k[2], qf[0], t1, 0, 0, 0); t1 = __builtin_amdgcn_mfma_f32_16x16x32_bf16(f.k[3], qf[1], t1, 0, 0, 0);
#pragma unroll
    for (int i = 0; i < 4; ++i) { s[i] = t0[i]; s[4 + i] = t1[i]; }
}
__device__ __forceinline__ void pv_frag(f32x4 (&o)[4], const float (&p)[8], const Frag& f) {
    typedef unsigned u32x4 __attribute__((ext_vector_type(4)));
    u32x4 w; w.x = pk2(p[0], p[1]); w.y = pk2(p[2], p[3]); w.z = pk2(p[4], p[5]); w.w = pk2(p[6], p[7]);
    const bf16x8 pf = __builtin_bit_cast(bf16x8, w);
#pragma unroll
    for (int dt = 0; dt < 4; ++dt) o[dt] = __builtin_amdgcn_mfma_f32_16x16x32_bf16(f.v[dt], pf, o[dt], 0, 0, 0);
}
template<int CTRL> __device__ __forceinline__ float dppf(float v) { return __int_as_float(__builtin_amdgcn_update_dpp(0, __float_as_int(v), CTRL, 0xF, 0xF, false)); }
template<int CTRL> __device__ __forceinline__ int dppi(int v) { return __builtin_amdgcn_update_dpp(0, v, CTRL, 0xF, 0xF, false); }
__device__ __forceinline__ float xmax_q(float v) {
    auto a = __builtin_amdgcn_permlane16_swap(__float_as_uint(v), __float_as_uint(v), false, false); v = fmaxf(__uint_as_float(a[0]), __uint_as_float(a[1]));
    auto b = __builtin_amdgcn_permlane32_swap(__float_as_uint(v), __float_as_uint(v), false, false); return fmaxf(__uint_as_float(b[0]), __uint_as_float(b[1]));
}
__device__ __forceinline__ float xsum_q(float v) {
    auto a = __builtin_amdgcn_permlane16_swap(__float_as_uint(v), __float_as_uint(v), false, false); v = __uint_as_float(a[0]) + __uint_as_float(a[1]);
    auto b = __builtin_amdgcn_permlane32_swap(__float_as_uint(v), __float_as_uint(v), false, false); return __uint_as_float(b[0]) + __uint_as_float(b[1]);
}
__device__ __forceinline__ float sum8(float v) { v += dppf<0x141>(v); v += dppf<0xB1>(v); v += dppf<0x4E>(v); return v; }
template<bool FULL> __device__ __forceinline__ void flash_step(Run& r, const Frag& f, const bf16x8 (&qf)[2], int lo, int hi, bool act, int q) {
    float s[8]; qk_frag(s, f, qf);
    float gm = NEG;
    if (FULL) {
#pragma unroll
        for (int j = 0; j < 8; ++j) { const int kk = 8 * q + j; const bool ok = (kk >= lo) && (kk <= hi); s[j] = ok ? s[j] : NEG; gm = fmaxf(gm, s[j]); }
    } else {
#pragma unroll
        for (int j = 0; j < 8; ++j) gm = fmaxf(gm, s[j]);
        gm = act ? gm : NEG;
    }
    gm = xmax_q(gm);
    const float mn = fmaxf(r.m, gm), sc = __builtin_amdgcn_exp2f(r.m - mn); r.m = mn;
    float p[8], ps = 0.f;
    if (FULL) {
#pragma unroll
        for (int j = 0; j < 8; ++j) { const int kk = 8 * q + j; const bool ok = (kk >= lo) && (kk <= hi); p[j] = ok ? __builtin_amdgcn_exp2f(s[j] - mn) : 0.f; ps += p[j]; }
    } else {
#pragma unroll
        for (int j = 0; j < 8; ++j) { p[j] = __builtin_amdgcn_exp2f(s[j] - mn); ps += p[j]; }
        ps = act ? ps : 0.f;
    }
    r.l = r.l * sc + ps;
    if (__builtin_amdgcn_ballot_w64(sc != 1.0f) != 0ull) {
#pragma unroll
        for (int dt = 0; dt < 4; ++dt) r.o[dt] = r.o[dt] * sc; }
    typedef unsigned u32x4 __attribute__((ext_vector_type(4)));
    u32x4 w; w.x = pk2(p[0], p[1]); w.y = pk2(p[2], p[3]); w.z = pk2(p[4], p[5]); w.w = pk2(p[6], p[7]);
    if (!FULL) { w.x = act ? w.x : 0u; w.y = act ? w.y : 0u; w.z = act ? w.z : 0u; w.w = act ? w.w : 0u; }
    const bf16x8 pf = __builtin_bit_cast(bf16x8, w);
#pragma unroll
    for (int dt = 0; dt < 4; ++dt) r.o[dt] = __builtin_amdgcn_mfma_f32_16x16x32_bf16(f.v[dt], pf, r.o[dt], 0, 0, 0);
}

typedef unsigned u32x4n __attribute__((ext_vector_type(4)));
__device__ __forceinline__ unsigned fp8x4(float a, float b, float c, float d) { int w = __builtin_amdgcn_cvt_pk_fp8_f32(a, b, 0, false); w = __builtin_amdgcn_cvt_pk_fp8_f32(c, d, w, true); return (unsigned)w; }
__device__ __forceinline__ long mk64(unsigned lo, unsigned hi) { return (long)(((unsigned long long)hi << 32) | (unsigned long long)lo); }
struct Frag8 { u32x4n k[2]; u32x4n v[2]; };
__device__ __forceinline__ void load8(Frag8& f, const unsigned char* kb, const unsigned char* vb, int G, int lane) {
    const unsigned char* kp = kb + (size_t)G * 2048 + lane * 16; const unsigned char* vp = vb + (size_t)G * 2048 + lane * 16;
    f.k[0] = *(const u32x4n*)kp; f.k[1] = *(const u32x4n*)(kp + 1024); f.v[0] = *(const u32x4n*)vp; f.v[1] = *(const u32x4n*)(vp + 1024);
}
__device__ __forceinline__ long q_to_fp8(const bf16x8& v) {
    float x[8];
#pragma unroll
    for (int j = 0; j < 8; ++j) x[j] = __uint_as_float((unsigned)(unsigned short)v[j] << 16);
    return mk64(fp8x4(x[0], x[1], x[2], x[3]), fp8x4(x[4], x[5], x[6], x[7]));
}
template<bool FULL> __device__ __forceinline__ void flash_step8(Run& r, const Frag8& f, const long (&q8)[2], int lo, int hi, bool act, int q) {
    f32x4 t0 = {0.f, 0.f, 0.f, 0.f}, t1 = {0.f, 0.f, 0.f, 0.f};
    t0 = __builtin_amdgcn_mfma_f32_16x16x32_fp8_fp8(mk64(f.k[0].x, f.k[0].y), q8[0], t0, 0, 0, 0); t0 = __builtin_amdgcn_mfma_f32_16x16x32_fp8_fp8(mk64(f.k[0].z, f.k[0].w), q8[1], t0, 0, 0, 0);
    t1 = __builtin_amdgcn_mfma_f32_16x16x32_fp8_fp8(mk64(f.k[1].x, f.k[1].y), q8[0], t1, 0, 0, 0); t1 = __builtin_amdgcn_mfma_f32_16x16x32_fp8_fp8(mk64(f.k[1].z, f.k[1].w), q8[1], t1, 0, 0, 0);
    float s[8];
#pragma unroll
    for (int i = 0; i < 4; ++i) { s[i] = t0[i]; s[4 + i] = t1[i]; }
    float gm = NEG;
    if (FULL) {
#pragma unroll
        for (int j = 0; j < 8; ++j) { const int kk = 8 * q + j; const bool ok = (kk >= lo) && (kk <= hi); s[j] = ok ? s[j] : NEG; gm = fmaxf(gm, s[j]); }
    } else {
#pragma unroll
        for (int j = 0; j < 8; ++j) gm = fmaxf(gm, s[j]);
        gm = act ? gm : NEG;
    }
    gm = xmax_q(gm);
    const float mn = fmaxf(r.m, gm), sc = __builtin_amdgcn_exp2f(r.m - mn); r.m = mn;
    float p[8], ps = 0.f; const float mn8 = mn - 8.0f;
    if (FULL) {
#pragma unroll
        for (int j = 0; j < 8; ++j) { const int kk = 8 * q + j; const bool ok = (kk >= lo) && (kk <= hi); p[j] = ok ? __builtin_amdgcn_exp2f(s[j] - mn8) : 0.f; ps += p[j]; }
    } else {
#pragma unroll
        for (int j = 0; j < 8; ++j) { p[j] = __builtin_amdgcn_exp2f(s[j] - mn8); ps += p[j]; }
        ps = act ? ps : 0.f;
    }
    r.l = r.l * sc + ps;
    if (__builtin_amdgcn_ballot_w64(sc != 1.0f) != 0ull) {
#pragma unroll
        for (int dt = 0; dt < 4; ++dt) r.o[dt] = r.o[dt] * sc; }
    unsigned w0 = fp8x4(p[0], p[1], p[2], p[3]), w1 = fp8x4(p[4], p[5], p[6], p[7]);
    if (!FULL) { w0 = act ? w0 : 0u; w1 = act ? w1 : 0u; }
    const long pf = mk64(w0, w1);
    r.o[0] = __builtin_amdgcn_mfma_f32_16x16x32_fp8_fp8(mk64(f.v[0].x, f.v[0].y), pf, r.o[0], 0, 0, 0); r.o[1] = __builtin_amdgcn_mfma_f32_16x16x32_fp8_fp8(mk64(f.v[0].z, f.v[0].w), pf, r.o[1], 0, 0, 0);
    r.o[2] = __builtin_amdgcn_mfma_f32_16x16x32_fp8_fp8(mk64(f.v[1].x, f.v[1].y), pf, r.o[2], 0, 0, 0); r.o[3] = __builtin_amdgcn_mfma_f32_16x16x32_fp8_fp8(mk64(f.v[1].z, f.v[1].w), pf, r.o[3], 0, 0, 0);
}

__device__ __forceinline__ void qk8(float (&s)[8], const Frag8& f, const long (&q8)[2]) {
    f32x4 t0 = {0.f, 0.f, 0.f, 0.f}, t1 = {0.f, 0.f, 0.f, 0.f};
    t0 = __builtin_amdgcn_mfma_f32_16x16x32_fp8_fp8(mk64(f.k[0].x, f.k[0].y), q8[0], t0, 0, 0, 0); t0 = __builtin_amdgcn_mfma_f32_16x16x32_fp8_fp8(mk64(f.k[0].z, f.k[0].w), q8[1], t0, 0, 0, 0);
    t1 = __builtin_amdgcn_mfma_f32_16x16x32_fp8_fp8(mk64(f.k[1].x, f.k[1].y), q8[0], t1, 0, 0, 0); t1 = __builtin_amdgcn_mfma_f32_16x16x32_fp8_fp8(mk64(f.k[1].z, f.k[1].w), q8[1], t1, 0, 0, 0);
#pragma unroll
    for (int i = 0; i < 4; ++i) { s[i] = t0[i]; s[4 + i] = t1[i]; }
}
__device__ __forceinline__ void pv8(f32x4 (&o)[4], const float (&p)[8], const Frag8& f) {
    const long pf = mk64(fp8x4(p[0] * 256.f, p[1] * 256.f, p[2] * 256.f, p[3] * 256.f), fp8x4(p[4] * 256.f, p[5] * 256.f, p[6] * 256.f, p[7] * 256.f));
    o[0] = __builtin_amdgcn_mfma_f32_16x16x32_fp8_fp8(mk64(f.v[0].x, f.v[0].y), pf, o[0], 0, 0, 0); o[1] = __builtin_amdgcn_mfma_f32_16x16x32_fp8_fp8(mk64(f.v[0].z, f.v[0].w), pf, o[1], 0, 0, 0);
    o[2] = __builtin_amdgcn_mfma_f32_16x16x32_fp8_fp8(mk64(f.v[1].x, f.v[1].y), pf, o[2], 0, 0, 0); o[3] = __builtin_amdgcn_mfma_f32_16x16x32_fp8_fp8(mk64(f.v[1].z, f.v[1].w), pf, o[3], 0, 0, 0);
}
__device__ __forceinline__ void pv8s(f32x4 (&o)[4], const float (&p)[8], const Frag8& f) {
    const long pf = mk64(fp8x4(p[0], p[1], p[2], p[3]), fp8x4(p[4], p[5], p[6], p[7]));
    o[0] = __builtin_amdgcn_mfma_f32_16x16x32_fp8_fp8(mk64(f.v[0].x, f.v[0].y), pf, o[0], 0, 0, 0); o[1] = __builtin_amdgcn_mfma_f32_16x16x32_fp8_fp8(mk64(f.v[0].z, f.v[0].w), pf, o[1], 0, 0, 0);
    o[2] = __builtin_amdgcn_mfma_f32_16x16x32_fp8_fp8(mk64(f.v[1].x, f.v[1].y), pf, o[2], 0, 0, 0); o[3] = __builtin_amdgcn_mfma_f32_16x16x32_fp8_fp8(mk64(f.v[1].z, f.v[1].w), pf, o[3], 0, 0, 0);
}
__device__ __forceinline__ void loadk8(Frag8& f, const unsigned char* kb, int G, int lane) { const unsigned char* kp = kb + (size_t)G * 2048 + lane * 16; f.k[0] = *(const u32x4n*)kp; f.k[1] = *(const u32x4n*)(kp + 1024); }
struct Tensors {
    const bf16_t* P;
    const unsigned char* KC8;
    const unsigned char* K8;
    const unsigned char* VC8;
    const unsigned char* V8;
    const bf16_t* OW;
    bf16_t* O;
};
__device__ __forceinline__ float wmax64(float v) { v = fmaxf(v, dppf<0x128>(v)); v = fmaxf(v, dppf<0x124>(v)); v = fmaxf(v, dppf<0x122>(v)); v = fmaxf(v, dppf<0x121>(v)); return xmax_q(v); }
__device__ __forceinline__ int wmin64(int v) { v = min(v, dppi<0x128>(v)); v = min(v, dppi<0x124>(v)); v = min(v, dppi<0x122>(v)); v = min(v, dppi<0x121>(v));
    auto a = __builtin_amdgcn_permlane16_swap((unsigned)v, (unsigned)v, false, false); v = min((int)a[0], (int)a[1]);
    auto b = __builtin_amdgcn_permlane32_swap((unsigned)v, (unsigned)v, false, false); return min((int)b[0], (int)b[1]); }
__device__ __forceinline__ int select_blocks(const __attribute__((address_space(3))) float* impA, const __attribute__((address_space(3))) float* impB, __attribute__((address_space(3))) int* list, int qblk, int lane) {
    if (qblk <= 15) { if (lane < 16) list[lane] = lane; return qblk + 1; }
    unsigned key[4];
#pragma unroll
    for (int i = 0; i < 4; ++i) { const int j = lane + 64 * i; key[i] = (j >= 1 && j <= qblk - 2) ? (__float_as_uint(impA[j] + impB[j]) + 1u) : 0u; }
    if (lane == 0) { list[0] = 0; list[1] = qblk - 1; list[2] = qblk; }
    unsigned T = 0u;
#pragma unroll 1
    for (int b = 30; b >= 0; --b) { const unsigned c = T | (1u << b);
        const int cnt = __builtin_popcountll(__builtin_amdgcn_ballot_w64(key[0] >= c)) + __builtin_popcountll(__builtin_amdgcn_ballot_w64(key[1] >= c))
                      + __builtin_popcountll(__builtin_amdgcn_ballot_w64(key[2] >= c)) + __builtin_popcountll(__builtin_amdgcn_ballot_w64(key[3] >= c));
        if (cnt >= 13) T = c; }
    int need = 13, base = 0;
#pragma unroll
    for (int i = 0; i < 4; ++i) need -= __builtin_popcountll(__builtin_amdgcn_ballot_w64(key[i] > T));
#pragma unroll
    for (int i = 0; i < 4; ++i) {
        const unsigned long long ge = __builtin_amdgcn_ballot_w64(key[i] > T), eq = __builtin_amdgcn_ballot_w64(key[i] == T);
        const int ce = __builtin_popcountll(eq), take = ce < need ? ce : need; need -= take;
        const int eqrank = (int)__builtin_amdgcn_mbcnt_hi((unsigned)(eq >> 32), __builtin_amdgcn_mbcnt_lo((unsigned)eq, 0u));
        const bool sel = (key[i] > T) || ((key[i] == T) && eqrank < take);
        const unsigned long long sm = __builtin_amdgcn_ballot_w64(sel);
        const int pos = base + (int)__builtin_amdgcn_mbcnt_hi((unsigned)(sm >> 32), __builtin_amdgcn_mbcnt_lo((unsigned)sm, 0u));
        if (sel) list[3 + pos] = lane + 64 * i;
        base += __builtin_popcountll(sm); (void)ge; }
    return 16;
}
__device__ __forceinline__ int select_blocks4(const __attribute__((address_space(3))) float* imp  , __attribute__((address_space(3))) int* lists  , int qblk, int lane) {
    if (qblk <= 15) { if (lane < 16) { lists[lane] = lane; lists[16 + lane] = lane; lists[32 + lane] = lane; lists[48 + lane] = lane; } return qblk + 1; }
    unsigned key[4][4];
#pragma unroll
    for (int k = 0; k < 4; ++k)
#pragma unroll
        for (int i = 0; i < 4; ++i) { const int j = lane + 64 * i; key[k][i] = (j >= 1 && j <= qblk - 2) ? (__float_as_uint(imp[k * 544 + j] + imp[k * 544 + 272 + j]) + 1u) : 0u; }
    if (lane < 4) { lists[16 * lane] = 0; lists[16 * lane + 1] = qblk - 1; lists[16 * lane + 2] = qblk; }
    unsigned T[4] = {0u, 0u, 0u, 0u};
#pragma unroll 1
    for (int b = 30; b >= 0; --b) {
#pragma unroll
        for (int k = 0; k < 4; ++k) { const unsigned c = T[k] | (1u << b);
            const int cnt = __builtin_popcountll(__builtin_amdgcn_ballot_w64(key[k][0] >= c)) + __builtin_popcountll(__builtin_amdgcn_ballot_w64(key[k][1] >= c))
                          + __builtin_popcountll(__builtin_amdgcn_ballot_w64(key[k][2] >= c)) + __builtin_popcountll(__builtin_amdgcn_ballot_w64(key[k][3] >= c));
            if (cnt >= 13) T[k] = c; } }
#pragma unroll
    for (int k = 0; k < 4; ++k) {
        int need = 13, base = 0;
#pragma unroll
        for (int i = 0; i < 4; ++i) need -= __builtin_popcountll(__builtin_amdgcn_ballot_w64(key[k][i] > T[k]));
#pragma unroll
        for (int i = 0; i < 4; ++i) {
            const unsigned long long eq = __builtin_amdgcn_ballot_w64(key[k][i] == T[k]);
            const int ce = __builtin_popcountll(eq), take = ce < need ? ce : need; need -= take;
            const int eqrank = (int)__builtin_amdgcn_mbcnt_hi((unsigned)(eq >> 32), __builtin_amdgcn_mbcnt_lo((unsigned)eq, 0u));
            const bool sel = (key[k][i] > T[k]) || ((key[k][i] == T[k]) && eqrank < take);
            const unsigned long long sm = __builtin_amdgcn_ballot_w64(sel);
            const int pos = base + (int)__builtin_amdgcn_mbcnt_hi((unsigned)(sm >> 32), __builtin_amdgcn_mbcnt_lo((unsigned)sm, 0u));
            if (sel) lists[16 * k + 3 + pos] = lane + 64 * i;
            base += __builtin_popcountll(sm); } }
    return 16;
}
#define NSA_LD(F_, G_) load8(F_, kb, vb, (G_), lane)
__device__ __forceinline__ void sel_joint(const Tensors& T, Run& rsa, Run& rsb, Frag8& fa, Frag8& fb, const long (&qfa)[2], const long (&qfb)[2], const __attribute__((address_space(3))) int* list,
                                          int njoint, int qblk, int bg, int tqa, int tqb, int n, int q, int lane) {
    const unsigned char* kb = T.K8 + (size_t)bg * 512 * 2048; const unsigned char* vb = T.V8 + (size_t)bg * 512 * 2048;
#define NSA_ST2(F_, G_) do { if (jb == qblk) { flash_step8<true>(rsa, F_, qfa, 0, tqa - 32 * (G_), true, q); flash_step8<true>(rsb, F_, qfb, 0, tqb - 32 * (G_), true, q); } \
                             else { flash_step8<false>(rsa, F_, qfa, 0, 31, true, q); flash_step8<false>(rsb, F_, qfb, 0, 31, true, q); } } while (0)
    int jb = __builtin_amdgcn_readfirstlane(list[0]);
    NSA_LD(fa, 2 * jb);
    for (int e = 0; e < njoint; ++e) {
        NSA_LD(fb, 2 * jb + 1);
        NSA_ST2(fa, 2 * jb);
        int jn = 0;
        if (e + 1 < njoint) { jn = __builtin_amdgcn_readfirstlane(list[e + 1]); NSA_LD(fa, 2 * jn); }
        NSA_ST2(fb, 2 * jb + 1);
        jb = jn; }
#undef NSA_ST2
}
__device__ __forceinline__ void flash_dual8(Run& r, const Frag8& fA, const Frag8& fB, const long (&q8)[2], int tok, int q) {
    float sa[8], sb[8], s[8]; qk8(sa, fA, q8); qk8(sb, fB, q8);
    float gm = NEG;
#pragma unroll
    for (int j = 0; j < 8; ++j) { s[j] = tok ? sb[j] : sa[j]; gm = fmaxf(gm, s[j]); }
    gm = xmax_q(gm);
    const float mn = fmaxf(r.m, gm), sc = __builtin_amdgcn_exp2f(r.m - mn); r.m = mn;
    float p[8], ps = 0.f;
    const float mn8 = mn - 8.0f;
#pragma unroll
    for (int j = 0; j < 8; ++j) { p[j] = __builtin_amdgcn_exp2f(s[j] - mn8); ps += p[j]; }
    r.l = r.l * sc + ps;
    if (__builtin_amdgcn_ballot_w64(sc != 1.0f) != 0ull) {
#pragma unroll
        for (int dt = 0; dt < 4; ++dt) r.o[dt] = r.o[dt] * sc; }
    const unsigned w0 = fp8x4(p[0], p[1], p[2], p[3]), w1 = fp8x4(p[4], p[5], p[6], p[7]);
    const long pa = mk64(tok ? 0u : w0, tok ? 0u : w1), pb = mk64(tok ? w0 : 0u, tok ? w1 : 0u);
    r.o[0] = __builtin_amdgcn_mfma_f32_16x16x32_fp8_fp8(mk64(fA.v[0].x, fA.v[0].y), pa, r.o[0], 0, 0, 0); r.o[1] = __builtin_amdgcn_mfma_f32_16x16x32_fp8_fp8(mk64(fA.v[0].z, fA.v[0].w), pa, r.o[1], 0, 0, 0);
    r.o[2] = __builtin_amdgcn_mfma_f32_16x16x32_fp8_fp8(mk64(fA.v[1].x, fA.v[1].y), pa, r.o[2], 0, 0, 0); r.o[3] = __builtin_amdgcn_mfma_f32_16x16x32_fp8_fp8(mk64(fA.v[1].z, fA.v[1].w), pa, r.o[3], 0, 0, 0);
    r.o[0] = __builtin_amdgcn_mfma_f32_16x16x32_fp8_fp8(mk64(fB.v[0].x, fB.v[0].y), pb, r.o[0], 0, 0, 0); r.o[1] = __builtin_amdgcn_mfma_f32_16x16x32_fp8_fp8(mk64(fB.v[0].z, fB.v[0].w), pb, r.o[1], 0, 0, 0);
    r.o[2] = __builtin_amdgcn_mfma_f32_16x16x32_fp8_fp8(mk64(fB.v[1].x, fB.v[1].y), pb, r.o[2], 0, 0, 0); r.o[3] = __builtin_amdgcn_mfma_f32_16x16x32_fp8_fp8(mk64(fB.v[1].z, fB.v[1].w), pb, r.o[3], 0, 0, 0);
}
__device__ __forceinline__ void sel_solo(const Tensors& T, Run& rs, Frag8& fa, Frag8& fb, const long (&qf)[2], const __attribute__((address_space(3))) int* list0, const __attribute__((address_space(3))) int* list1,
                                         int bg, int tok, int n, int q, int lane) {
    const unsigned char* kb = T.K8 + (size_t)bg * 512 * 2048; const unsigned char* vb = T.V8 + (size_t)bg * 512 * 2048;
    Frag8 fc, fd;
    int ja = __builtin_amdgcn_readfirstlane(list0[3]), jb = __builtin_amdgcn_readfirstlane(list1[3]);
    NSA_LD(fa, 2 * ja); NSA_LD(fb, 2 * jb);
    for (int e = 0; e < 13; ++e) {
        NSA_LD(fc, 2 * ja + 1); NSA_LD(fd, 2 * jb + 1);
        flash_dual8(rs, fa, fb, qf, tok, q);
        int na = 0, nb = 0;
        if (e + 1 < 13) { na = __builtin_amdgcn_readfirstlane(list0[4 + e]); nb = __builtin_amdgcn_readfirstlane(list1[4 + e]); NSA_LD(fa, 2 * na); NSA_LD(fb, 2 * nb); }
        flash_dual8(rs, fc, fd, qf, tok, q);
        ja = na; jb = nb; }
}
#undef NSA_LD
__device__ __forceinline__ void out_pair(const Tensors& T, const __attribute__((address_space(3))) unsigned* st, int lane, const Run& rs, size_t rowt, int g, int head, int q) {
    const float ls = xsum_q(rs.l);
    const bf16_t* gp = T.P + rowt * PITCH + COL_G + g * 24 + head * 3;
    const float gc = 1.0f / (1.0f + __expf(-bf2f(gp[0]))), gs = 1.0f / (1.0f + __expf(-bf2f(gp[1]))), gw = 1.0f / (1.0f + __expf(-bf2f(gp[2])));
    const float fs = gs / fmaxf(ls, 1e-30f);
    const bf16_t* wp = T.OW + rowt * 1024 + (g * 8 + head) * 64 + 4 * q;
    bf16_t* op = T.O + rowt * 1024 + (g * 8 + head) * 64 + 4 * q;
#pragma unroll
    for (int dt = 0; dt < 4; ++dt) { float v[4]; typedef unsigned u32x2w __attribute__((ext_vector_type(2))); const u32x2w wv = *(const u32x2w*)(wp + 16 * dt);
        const float ow[4] = {__uint_as_float(wv.x << 16), __uint_as_float(wv.x & 0xffff0000u), __uint_as_float(wv.y << 16), __uint_as_float(wv.y & 0xffff0000u)};
        const unsigned c0 = st[(4 * dt) * 64 + lane], c1 = st[(4 * dt + 1) * 64 + lane]; const float oc[4] = {__uint_as_float(c0 << 16), __uint_as_float(c0 & 0xffff0000u), __uint_as_float(c1 << 16), __uint_as_float(c1 & 0xffff0000u)};
#pragma unroll
        for (int i = 0; i < 4; ++i) v[i] = gc * oc[i] + fs * rs.o[dt][i] + gw * ow[i];
        u32x2w w; w.x = pk2(v[0], v[1]); w.y = pk2(v[2], v[3]);
        *(u32x2w*)(op + 16 * dt) = w; }
}
__device__ __forceinline__ void quad_item(const Tensors& T, int item, __attribute__((address_space(3))) float* wl, int lane) {
    typedef __attribute__((address_space(3))) float lf; typedef __attribute__((address_space(3))) int li;
    const int n = lane & 15, q = lane >> 4, tok = n >> 3, head = n & 7;
    const int bg = item >> 12, t0 = (item & (S / 4 - 1)) * 4, b = bg >> 1, g = bg & 1;
    const int tqa = t0 + tok, tqb = t0 + 2 + tok;
    const size_t row0 = (size_t)b * S + t0;
    lf* impa = wl + tok * 544; lf* impb = wl + (2 + tok) * 544; li* lists = (li*)(wl + 2176);
    bf16x8 qfa[2], qfb[2];
    { const bf16_t* qp = T.P + (row0 + tok) * PITCH + (g * 8 + head) * 64 + q * 8; qfa[0] = *(const bf16x8*)qp; qfa[1] = *(const bf16x8*)(qp + 32);
      qfb[0] = *(const bf16x8*)(qp + 2 * PITCH); qfb[1] = *(const bf16x8*)(qp + 2 * PITCH + 32); }
    for (int i = lane; i < 2176; i += 64) wl[i] = 0.f;
    Frag8 ga, gb;
    const long qa8[2] = {q_to_fp8(qfa[0]), q_to_fp8(qfa[1])}, qb8[2] = {q_to_fp8(qfb[0]), q_to_fp8(qfb[1])};
    const int nva = tqa >= 31 ? ((tqa - 31) >> 4) + 1 : 0, nvb = tqb >= 31 ? ((tqb - 31) >> 4) + 1 : 0;
    const int nv0 = t0 >= 31 ? ((t0 - 31) >> 4) + 1 : 0, nv3 = (t0 + 3) >= 31 ? ((t0 + 3 - 31) >> 4) + 1 : 0;
    f32x4 oca[4], ocb[4];
#pragma unroll
    for (int dt = 0; dt < 4; ++dt) { oca[dt] = (f32x4){0.f, 0.f, 0.f, 0.f}; ocb[dt] = (f32x4){0.f, 0.f, 0.f, 0.f}; }
    if (nv3 > 0) {
        const unsigned char* kb = T.KC8 + (size_t)bg * 32 * 2048; const unsigned char* vb = T.VC8 + (size_t)bg * 32 * 2048; const int ng = (nv3 + 31) >> 5;
        float mca = NEG, lca = 0.f, mcb = NEG, lcb = 0.f;
#define NSA_P1(F_, G_, QF_, NV_, MC_, LC_) do { float s[8]; qk8(s, F_, QF_); const int hi = (NV_) - 1 - 32 * (G_); float gm = NEG; \
            if (32 * (G_) + 32 > nv0) { _Pragma("unroll") for (int j = 0; j < 8; ++j) { const bool ok = (8 * q + j) <= hi; s[j] = ok ? s[j] : NEG; gm = fmaxf(gm, s[j]); } } \
            else { _Pragma("unroll") for (int j = 0; j < 8; ++j) gm = fmaxf(gm, s[j]); } \
            gm = xmax_q(gm); const float mn = fmaxf(MC_, gm); float ps = 0.f; \
            _Pragma("unroll") for (int j = 0; j < 8; ++j) ps += __builtin_amdgcn_exp2f(s[j] - mn); \
            LC_ = LC_ * __builtin_amdgcn_exp2f(MC_ - mn) + ps; MC_ = mn; } while (0)
        loadk8(ga, kb, 0, lane);
        for (int G = 0; G < ng; G += 2) {
            if (G + 1 < ng) loadk8(gb, kb, G + 1, lane);
            NSA_P1(ga, G, qa8, nva, mca, lca); NSA_P1(ga, G, qb8, nvb, mcb, lcb);
            if (G + 1 < ng) { if (G + 2 < ng) loadk8(ga, kb, G + 2, lane); NSA_P1(gb, G + 1, qa8, nva, mca, lca); NSA_P1(gb, G + 1, qb8, nvb, mcb, lcb); }
        }
#undef NSA_P1
        lca = xsum_q(lca); lcb = xsum_q(lcb);
        asm volatile("s_waitcnt lgkmcnt(0)" ::: "memory");
#define NSA_P2(F_, G_, QF_, NV_, C2_, OC_, IMP_) do { float s[8]; qk8(s, F_, QF_); const int hi = (NV_) - 1 - 32 * (G_); float p[8]; \
            if (32 * (G_) + 32 > nv0) { _Pragma("unroll") for (int j = 0; j < 8; ++j) { const bool ok = (8 * q + j) <= hi; p[j] = ok ? __builtin_amdgcn_exp2f(s[j] - C2_) : 0.f; } } \
            else { _Pragma("unroll") for (int j = 0; j < 8; ++j) p[j] = __builtin_amdgcn_exp2f(s[j] - C2_); } \
            pv8s(OC_, p, F_); \
            const float a0 = sum8((p[0] + p[1]) + (p[2] + p[3])), a1 = sum8((p[4] + p[5]) + (p[6] + p[7])), b0 = sum8(p[3]), b1 = sum8(p[7]);     \
            if (head == 0) { const int j0 = 8 * (G_) + 2 * q; IMP_[j0] = a0; IMP_[j0 + 1] = a1; IMP_[272 + j0 + 1] = b0; IMP_[272 + j0 + 2] = b1; } } while (0)
        const float c2a = mca - 8.0f + __builtin_amdgcn_logf(fmaxf(lca, 1e-30f)), c2b = mcb - 8.0f + __builtin_amdgcn_logf(fmaxf(lcb, 1e-30f));
        load8(ga, kb, vb, 0, lane);
        for (int G = 0; G < ng; G += 2) {
            if (G + 1 < ng) load8(gb, kb, vb, G + 1, lane);
            NSA_P2(ga, G, qa8, nva, c2a, oca, impa); NSA_P2(ga, G, qb8, nvb, c2b, ocb, impb);
            if (G + 1 < ng) { if (G + 2 < ng) load8(ga, kb, vb, G + 2, lane);
                NSA_P2(gb, G + 1, qa8, nva, c2a, oca, impa); NSA_P2(gb, G + 1, qb8, nvb, c2b, ocb, impb); }
        }
#undef NSA_P2
#pragma unroll
        for (int dt = 0; dt < 4; ++dt) { oca[dt] = oca[dt] * (1.0f / 256.0f); ocb[dt] = ocb[dt] * (1.0f / 256.0f); }
    }
    { __attribute__((address_space(3))) unsigned* st = (__attribute__((address_space(3))) unsigned*)(wl + 2240);
#pragma unroll
      for (int dt = 0; dt < 4; ++dt) { st[(4 * dt + 0) * 64 + lane] = pk2(oca[dt][0], oca[dt][1]); st[(4 * dt + 1) * 64 + lane] = pk2(oca[dt][2], oca[dt][3]); st[(4 * dt + 2) * 64 + lane] = pk2(ocb[dt][0], ocb[dt][1]); st[(4 * dt + 3) * 64 + lane] = pk2(ocb[dt][2], ocb[dt][3]); } }
    asm volatile("s_waitcnt lgkmcnt(0)" ::: "memory"); __builtin_amdgcn_wave_barrier();
    const int qblk = t0 >> 6;
    const int nsel = select_blocks4(wl, lists, qblk, lane);
    asm volatile("s_waitcnt lgkmcnt(0)" ::: "memory"); __builtin_amdgcn_wave_barrier();
    { Run rsa, rsb; run_init(rsa); run_init(rsb);
      sel_joint(T, rsa, rsb, ga, gb, qa8, qb8, lists, qblk <= 15 ? nsel : 3, qblk, bg, tqa, tqb, n, q, lane);
      if (qblk > 15) sel_solo(T, rsa, ga, gb, qa8, lists, lists + 16, bg, tok, n, q, lane);
      out_pair(T, (const __attribute__((address_space(3))) unsigned*)(wl + 2240), lane, rsa, row0 + tok, g, head, q);
      if (qblk > 15) sel_solo(T, rsb, ga, gb, qb8, lists + 32, lists + 48, bg, tok, n, q, lane);
      out_pair(T, (const __attribute__((address_space(3))) unsigned*)(wl + 2240) + 128, lane, rsb, row0 + 2 + tok, g, head, q); }
    asm volatile("s_waitcnt lgkmcnt(0)" ::: "memory"); __builtin_amdgcn_wave_barrier();
}
}

constexpr int NWAVES = 8;
#ifndef MK_SINGLE
#define MK_SINGLE 1
#endif
constexpr int kB = 2, kS = 16384, kD = 1024, kM = kB * kS;
constexpr float kEps = 1e-6f;
constexpr float kC2 = 0.125f * 1.4426950408889634f;
constexpr int kMpad = 65536 + 32 * 256;
constexpr size_t MiB = 1u << 20;
constexpr size_t WS_CTL = 0, CTL_ZERO_BYTES = 1 * MiB;
constexpr size_t WS_ADAP = 1 * MiB;
constexpr size_t WS_MOD = 2 * MiB + 512 * 1024;
constexpr size_t WS_CBP = WS_MOD + 128 * 1024;
constexpr size_t WS_CBF = WS_CBP + 64 * 1024;
constexpr size_t WS_ROPE = 3 * MiB;
constexpr size_t WS_ROUTE = 5 * MiB;
constexpr size_t WS_ROWTOK = 6 * MiB;
constexpr size_t WS_ROWWT = 6 * MiB + 512 * 1024;
constexpr size_t WS_DUMP = 7 * MiB;
constexpr size_t WS_WR = 7 * MiB + 64 * 1024;
constexpr size_t WS_WC = 7 * MiB + 896 * 1024;
constexpr size_t WS_WQKV = 8 * MiB, WS_WO0 = 14 * MiB, WS_WNSA = 16 * MiB, WS_WO1 = 20 * MiB, WS_W1C = 22 * MiB, WS_W2C = 24 * MiB;
constexpr size_t WS_MOE0 = 26 * MiB, MOE_L = 48 * MiB, MOE_WD = 32 * MiB;
constexpr size_t WS_RA = 122 * MiB, WS_RB = 186 * MiB, WS_RC = 250 * MiB, WS_RD = 314 * MiB, WS_RE = 378 * MiB, WS_RF = 442 * MiB, WS_END = 506 * MiB;
constexpr size_t NS_KC = WS_RF  , NS_HID = WS_RF + 17 * MiB, NS_KCMP = WS_RF + 21 * MiB, NS_VCT = WS_RF + 21 * MiB + 512 * 1024, NS_VTS = WS_RF + 22 * MiB, NS_VTW = WS_RF + 30 * MiB;
constexpr int CW_BAR = 4096;
constexpr int CW_CNT = 16384;
constexpr int CW_QCTR = 16384 + 1024;
constexpr int RING_OFF = 0, RING_BYTES = 131072, LDSCTL_OFF = RING_BYTES, MISC_OFF = LDSCTL_OFF + 320, TPRE_OFF = LDSCTL_OFF + 1024;
constexpr int GTAB_OFF = LDSCTL_OFF + 2048, GTAB_UNITS = 6;
constexpr int LDS_BYTES = 147456;

#define GAS __attribute__((address_space(1)))
#define LAS __attribute__((address_space(3)))
typedef unsigned short bf16;
typedef unsigned v4u __attribute__((ext_vector_type(4)));
typedef unsigned v2u __attribute__((ext_vector_type(2)));
typedef float f32x4 __attribute__((ext_vector_type(4)));
typedef GAS unsigned gu32;
#define RLX_AGENT __ATOMIC_RELAXED, __HIP_MEMORY_SCOPE_AGENT
#define LDS_WAIT() asm volatile("s_waitcnt lgkmcnt(0)" ::: "memory")
__device__ __forceinline__ unsigned pk2(float lo, float hi) { return nsa::pk2(lo, hi); }
__device__ __forceinline__ float bf2f(unsigned short x) { return __uint_as_float((unsigned)x << 16); }
__device__ __forceinline__ float wave_sum(float v) {
#pragma unroll
    for (int o = 1; o < 64; o <<= 1) v += __shfl_xor(v, o);
    return v;
}

#define XB_TMO      128
#define XB_XCNT(j)  (256  + 64 * (j))
#define XB_XSUB(j)  (1280 + 64 * (j))
#define XB_XGEN(j)  (2304 + 64 * (j))
#define XB_TOP      3328
#define XB_TOPGEN   3392
#define XCD_BAR_WORDS 3456
#define XB_SPIN_CAP (1u << 18)

__device__ __forceinline__ unsigned xb_ld(unsigned* p)              { return __hip_atomic_load(p, __ATOMIC_RELAXED, __HIP_MEMORY_SCOPE_AGENT); }
__device__ __forceinline__ unsigned xb_add(unsigned* p, unsigned v) { return __hip_atomic_fetch_add(p, v, __ATOMIC_RELAXED, __HIP_MEMORY_SCOPE_AGENT); }
__device__ __forceinline__ unsigned xb_xcc_id() { return (unsigned)__builtin_amdgcn_s_getreg((3 << 11) | 20) & 0xFu; }
#define XB_SPIN(cond, bar) do { unsigned _sp = 0; while (cond) { __builtin_amdgcn_s_sleep(1); \
    if ((++_sp & 255u) == 0u) { if (xb_ld(&(bar)[XB_TMO])) break; if (_sp > XB_SPIN_CAP) { atomicAdd(&(bar)[XB_TMO], 1u); break; } } } } while (0)

struct XcdBarrier {
    unsigned* bar; unsigned x;
    volatile LAS unsigned* st;
};

__device__ __forceinline__ XcdBarrier xcd_barrier_post(unsigned* bar, volatile LAS unsigned* st) {
    XcdBarrier b; b.bar = bar; b.x = xb_xcc_id(); b.st = st;
    if (threadIdx.x == 0) (void)xb_add(&bar[XB_XCNT(b.x)], 1u);
    return b;
}
__device__ __forceinline__ void xcd_barrier_complete(unsigned* bar, unsigned x, unsigned& nloc, unsigned& nx) {
    const unsigned G = gridDim.x * gridDim.y * gridDim.z;
    unsigned sum, cnt, mine, sp = 0u;
    for (;;) {
        sum = 0u; cnt = 0u; mine = 0u;
#pragma unroll
        for (unsigned j = 0; j < 16; ++j) { const unsigned c = xb_ld(&bar[XB_XCNT(j)]); sum += c; cnt += (c > 0u) ? 1u : 0u; mine = (j == x) ? c : mine; }
        if (sum == G) break;
        __builtin_amdgcn_s_sleep(1);
        if ((++sp & 255u) == 0u) { if (xb_ld(&bar[XB_TMO])) break; if (sp > XB_SPIN_CAP) { atomicAdd(&bar[XB_TMO], 1u); break; } }
    }
    nloc = mine > 0u ? mine : 1u; nx = cnt > 0u ? cnt : 1u;
}

__device__ __forceinline__ void xcd_barrier(const XcdBarrier& b) {
    asm volatile("s_waitcnt vmcnt(0)" ::: "memory");
    __syncthreads();
    if (threadIdx.x == 0) {
        unsigned* bar = b.bar;
        __builtin_amdgcn_s_waitcnt(0);
        unsigned nloc = b.st[0], nx = b.st[1];
        if (nloc == 0u) { xcd_barrier_complete(bar, b.x, nloc, nx); b.st[0] = nloc; b.st[1] = nx; }
        const unsigned old = xb_add(&bar[XB_XSUB(b.x)], 1u);
        const unsigned gen = old / nloc;
        if (old + 1u == (gen + 1u) * nloc) {
            __builtin_amdgcn_fence(__ATOMIC_RELEASE, "agent");
            asm volatile("s_waitcnt vmcnt(0)" ::: "memory");
            const unsigned og = xb_add(&bar[XB_TOP], 1u);
            const unsigned tg = og / nx;
            if (og + 1u == (tg + 1u) * nx) xb_add(&bar[XB_TOPGEN], 1u);
            else XB_SPIN(xb_ld(&bar[XB_TOPGEN]) == tg, bar);
            __builtin_amdgcn_fence(__ATOMIC_ACQUIRE, "agent");
            xb_add(&bar[XB_XGEN(b.x)], 1u);
            asm volatile("s_waitcnt vmcnt(0)" ::: "memory");
        } else {
            XB_SPIN(xb_ld(&bar[XB_XGEN(b.x)]) == gen, bar);
            __builtin_amdgcn_fence(__ATOMIC_ACQUIRE, "agent");
            asm volatile("s_waitcnt vmcnt(0)" ::: "memory");
        }
    }
    __syncthreads();
}


__device__ __forceinline__ void transpose_item(const float* W, int K, int N, bf16* WT, int drow0, int kb, int nb, LAS float* scr, int lane) {
    const int k0 = 64 * kb, n0 = 32 * nb; const int nn = n0 + (lane & 7) * 4; const bool okn = nn < N;
#pragma unroll
    for (int i = 0; i < 8; ++i) { const int kk = 8 * i + (lane >> 3); const f32x4 v = okn ? *(const f32x4*)(W + (size_t)(k0 + kk) * N + nn) : (f32x4){0.f, 0.f, 0.f, 0.f};
        LAS float* d = scr + kk * 33 + (lane & 7) * 4; d[0] = v[0]; d[1] = v[1]; d[2] = v[2]; d[3] = v[3]; }
    LDS_WAIT(); asm volatile("" ::: "memory");
    const int c = lane & 7;
#pragma unroll
    for (int j = 0; j < 4; ++j) { const int n = (lane >> 3) + 8 * j; const LAS float* s = scr + (8 * c) * 33 + n;
        v4u o; o.x = pk2(s[0 * 33], s[1 * 33]); o.y = pk2(s[2 * 33], s[3 * 33]); o.z = pk2(s[4 * 33], s[5 * 33]); o.w = pk2(s[6 * 33], s[7 * 33]);
        *(v4u*)(WT + (size_t)(drow0 + n) * K + k0 + 8 * c) = o; }
    LDS_WAIT(); asm volatile("" ::: "memory");
}
__device__ __forceinline__ void sincos_acc(float ang, float& sn, float& cs) {
    const double a = (double)ang; const double kq = rint(a * 0.63661977236758134308);
    const double r = fma(-kq, 1.57079632679489661923, a) - kq * 6.123233995736766e-17;
    const int qd = (int)((long long)kq & 3);
    const float x = (float)r, x2 = x * x;
    const float sp = x * (1.0f + x2 * (-1.6666667e-1f + x2 * (8.3333338e-3f + x2 * (-1.9841270e-4f + x2 * 2.7557319e-6f))));
    const float cp = 1.0f + x2 * (-0.5f + x2 * (4.1666668e-2f + x2 * (-1.3888889e-3f + x2 * (2.4801587e-5f + x2 * -2.7557319e-7f))));
    const float s1 = (qd & 1) ? cp : sp, c1 = (qd & 1) ? sp : cp;
    sn = (qd & 2) ? -s1 : s1; cs = ((qd + 1) & 2) ? -c1 : c1;
}

struct Ptrs {
    const float* x; const float* c; const int* pos; const float* ada_w; const float* ada_b; const float* norm_g; const float* final_g;
    const float* diff_w_in; const float* diff_w_out; const float* diff_lambda; const float* diff_subln_g;
    const float* nsa_w_in; const float* nsa_w_out; const float* nsa_cmp_pos; const float* nsa_cmp_w1; const float* nsa_cmp_b1; const float* nsa_cmp_w2;
    const float* moe_w_group; const float* moe_b_group; const float* moe_w_expert; const float* moe_b_expert; const float* moe_w_gate; const float* moe_w_up; const float* moe_w_down;
    float* out; unsigned char* ws;
};

__device__ __forceinline__ void ph_prologue(const Ptrs& p, LAS unsigned char* lds, int gw, int NGW, int wave, int lane, int gtid, int NT) {
    LAS float* scr = (LAS float*)(lds + RING_OFF + wave * 16384);
    unsigned char* ws = p.ws;
    constexpr int I_QKV = 16 * 96, I_WO = 16 * 32, I_NSA = 16 * 64, I_W1C = 32 * 8, I_W2C = 4 * 8, I_EXP = 128;
    constexpr int T0 = I_QKV, T1 = T0 + I_WO, T2 = T1 + I_NSA, T3 = T2 + I_WO, T4 = T3 + 2 * I_W1C, T5 = T4 + 2 * I_W2C, T6 = T5 + 64 * 3 * I_EXP;
    struct TrDesc { const float* W; bf16* WT; int K, N, drow0, kb, nb; float sc = 1.0f; };
    auto decode = [&](int it, TrDesc& d) {
        if (it < T0) { const int r = it; d = TrDesc{p.diff_w_in, (bf16*)(ws + WS_WQKV), 1024, 3072, 32 * (r % 96), r / 96, r % 96, (r % 96) < 32 ? kC2 : 1.0f}; }
        else if (it < T1) { const int r = it - T0; d = TrDesc{p.diff_w_out, (bf16*)(ws + WS_WO0), 1024, 1024, 32 * (r % 32), r / 32, r % 32}; }
        else if (it < T2) { const int r = it - T1; d = TrDesc{p.nsa_w_in, (bf16*)(ws + WS_WNSA), 1024, 1840, 32 * (r % 64), r / 64, r % 64, (r % 64) < 32 ? kC2 : 1.0f}; }
        else if (it < T3) { const int r = it - T2; d = TrDesc{p.nsa_w_out, (bf16*)(ws + WS_WO1), 1024, 1024, 32 * (r % 32), r / 32, r % 32}; }
        else if (it < T4) { const int r = it - T3, kv = r / I_W1C, rr = r % I_W1C; d = TrDesc{p.nsa_cmp_w1 + (size_t)kv * 2048 * 256, (bf16*)(ws + WS_W1C) + (size_t)kv * 256 * 2048, 2048, 256, 32 * (rr % 8), rr / 8, rr % 8}; }
        else if (it < T5) { const int r = it - T4, kv = r / I_W2C, rr = r % I_W2C; d = TrDesc{p.nsa_cmp_w2 + (size_t)kv * 256 * 64, (bf16*)(ws + WS_W2C) + (size_t)kv * 256 * 256, 256, 64, 32 * (rr % 8), rr / 8, rr % 8}; }
        else { const int r = it - T5, le = r / (3 * I_EXP), rr = r % (3 * I_EXP), which = rr / I_EXP, ri = rr % I_EXP; const int l = le >> 5, e = le & 31;
            unsigned char* mb = ws + WS_MOE0 + (size_t)l * MOE_L;
            if (which < 2) { const int kb = ri / 8, nb = ri % 8, n0 = 32 * nb;
                d = TrDesc{(which ? p.moe_w_up : p.moe_w_gate) + (size_t)le * 1024 * 256, (bf16*)mb + (size_t)e * 512 * 1024, 1024, 256, (n0 >> 7) * 256 + which * 128 + (n0 & 127), kb, nb}; }
            else { d = TrDesc{p.moe_w_down + (size_t)le * 256 * 1024, (bf16*)(mb + MOE_WD) + (size_t)e * 1024 * 256, 256, 1024, 32 * (ri % 32), ri / 32, ri % 32}; } }
    };
    auto tr_load = [&](const TrDesc& d, f32x4 (&v)[8]) {
        const int k0 = 64 * d.kb, nn = 32 * d.nb + (lane & 7) * 4; const bool okn = nn < d.N;
#pragma unroll
        for (int i = 0; i < 8; ++i) { const int kk = 8 * i + (lane >> 3); v[i] = okn ? *(const f32x4*)(d.W + (size_t)(k0 + kk) * d.N + nn) * d.sc : (f32x4){0.f, 0.f, 0.f, 0.f}; }
    };
    auto tr_finish = [&](const TrDesc& d, const f32x4 (&v)[8]) {
#pragma unroll
        for (int i = 0; i < 8; ++i) { const int kk = 8 * i + (lane >> 3); LAS float* q = scr + kk * 33 + (lane & 7) * 4; q[0] = v[i][0]; q[1] = v[i][1]; q[2] = v[i][2]; q[3] = v[i][3]; }
        LDS_WAIT(); asm volatile("" ::: "memory");
        const int c = lane & 7, k0 = 64 * d.kb;
#pragma unroll
        for (int j = 0; j < 4; ++j) { const int n = (lane >> 3) + 8 * j; const LAS float* s_ = scr + (8 * c) * 33 + n;
            v4u o; o.x = pk2(s_[0 * 33], s_[1 * 33]); o.y = pk2(s_[2 * 33], s_[3 * 33]); o.z = pk2(s_[4 * 33], s_[5 * 33]); o.w = pk2(s_[6 * 33], s_[7 * 33]);
            *(v4u*)(d.WT + (size_t)(d.drow0 + n) * d.K + k0 + 8 * c) = o; }
        LDS_WAIT(); asm volatile("" ::: "memory");
    };
    if (gw < T6) { TrDesc dc; f32x4 vc[8]; decode(gw, dc); tr_load(dc, vc);
        for (int it = gw; it < T6; it += NGW) { TrDesc dn = dc; f32x4 vn[8];
            const bool more = it + NGW < T6;
            if (more) { decode(it + NGW, dn); tr_load(dn, vn); }
            tr_finish(dc, vc);
            if (more) { dc = dn;
#pragma unroll
                for (int i = 0; i < 8; ++i) vc[i] = vn[i]; } } }
    for (int it = gw; it < 2 * 16 * 24; it += NGW) { const int l = it / 384, kc = (it % 384) / 24, cg = it % 24;
        const float* W = p.ada_w + ((size_t)l * 1024 + kc * 64) * 6144 + cg * 256 + lane * 4;
        f32x4 a0 = {0.f, 0.f, 0.f, 0.f}, a1 = {0.f, 0.f, 0.f, 0.f};
#pragma unroll 8
        for (int r = 0; r < 64; ++r) { const f32x4 w = *(const f32x4*)(W + (size_t)r * 6144); const float c0 = p.c[kc * 64 + r], c1 = p.c[1024 + kc * 64 + r];
            const float s0 = c0 / (1.0f + __expf(-c0)), s1 = c1 / (1.0f + __expf(-c1)); a0 = a0 + w * s0; a1 = a1 + w * s1; }
        float* dst = (float*)(ws + WS_ADAP) + ((size_t)(l * 16 + kc) * 2) * 6144 + cg * 256 + lane * 4;
        *(f32x4*)dst = a0; *(f32x4*)(dst + 6144) = a1; }
    for (int i = gtid; i < kM * 8; i += NT) { const int m = i >> 3, j = i & 7;
        const float invf = exp2f(-(float)j * 0.125f * 18.931568569324174f);
        const float ang = (float)p.pos[m] * invf; float sn, cs; sincos_acc(ang, sn, cs);
        float* rp = (float*)(ws + WS_ROPE) + (size_t)m * 16; rp[j] = cs; rp[8 + j] = sn; }
    for (int it = gw; it < 2 * 4 * 32; it += NGW) { const int kv = it >> 7, cg = (it >> 5) & 3, kc = it & 31;
        const float* W = p.nsa_cmp_w1 + ((size_t)kv * 2048 + kc * 64) * 256 + cg * 64 + lane; const float* pe = p.nsa_cmp_pos + kv * 2048 + kc * 64; float a = 0.f;
#pragma unroll 8
        for (int r = 0; r < 64; ++r) a += pe[r] * W[(size_t)r * 256];
        ((float*)(ws + WS_CBP))[kc * 512 + kv * 256 + cg * 64 + lane] = a; }
}
__device__ __forceinline__ void ph_finalize(const Ptrs& p, int gtid, int NT) {
    unsigned char* ws = p.ws;
    for (int i = gtid; i < 2 * 2 * 6144 + 512; i += NT) {
        if (i < 24576) { const int l = i / 12288, b = (i / 6144) & 1, n = i % 6144; float a = p.ada_b[l * 6144 + n];
            const float* pp = (const float*)(ws + WS_ADAP) + ((size_t)(l * 16) * 2 + b) * 6144 + n;
            for (int kc = 0; kc < 16; ++kc) a += pp[(size_t)kc * 2 * 6144];
            ((float*)(ws + WS_MOD))[i] = a; }
        else { const int j = i - 24576; float a = p.nsa_cmp_b1[j]; const float* pp = (const float*)(ws + WS_CBP) + j;
            for (int kc = 0; kc < 32; ++kc) a += pp[kc * 512];
            ((float*)(ws + WS_CBF))[j] = a; }
    }
}
template <bool COMBINE, bool FINAL, bool XBF  >
__device__ __forceinline__ void ph_rows(const Ptrs& p, const float* xin, float* xout, const bf16* Y, const float* modl  , int ch_sh, int ch_g2,
                                        const float* ng, bf16* XN, int layer, int gw, int NGW, int lane, int gtid, int NT) {
    unsigned char* ws = p.ws;
    f32x4 gv[4];
#pragma unroll
    for (int j = 0; j < 4; ++j) gv[j] = *(const f32x4*)(ng + 4 * lane + 256 * j);
    for (int m = gw; m < kM; m += NGW) {
        const int b = m >= kS ? 1 : 0; const float* mb = modl + b * 6144;
        f32x4 v[4];
#pragma unroll
        for (int j = 0; j < 4; ++j) { if (XBF) { const v2u xb = *(const v2u*)((const bf16*)xin + (size_t)m * 1024 + 4 * lane + 256 * j);
                v[j][0] = __uint_as_float(xb.x << 16); v[j][1] = __uint_as_float(xb.x & 0xffff0000u); v[j][2] = __uint_as_float(xb.y << 16); v[j][3] = __uint_as_float(xb.y & 0xffff0000u); }
            else v[j] = *(const f32x4*)(xin + (size_t)m * 1024 + 4 * lane + 256 * j); }
        if (COMBINE) {
#pragma unroll
            for (int j = 0; j < 4; ++j) { const int col = 4 * lane + 256 * j; const f32x4 g2 = *(const f32x4*)(mb + ch_g2 * 1024 + col);
                const v2u y0 = *(const v2u*)(Y + (size_t)m * 1024 + col), y1 = *(const v2u*)(Y + ((size_t)kM + m) * 1024 + col);
                f32x4 ys; ys[0] = __uint_as_float(y0.x << 16) + __uint_as_float(y1.x << 16); ys[1] = __uint_as_float(y0.x & 0xffff0000u) + __uint_as_float(y1.x & 0xffff0000u);
                ys[2] = __uint_as_float(y0.y << 16) + __uint_as_float(y1.y << 16); ys[3] = __uint_as_float(y0.y & 0xffff0000u) + __uint_as_float(y1.y & 0xffff0000u);
                v[j] = v[j] + g2 * ys;
                if (!FINAL) { if (XBF) { v2u xo; xo.x = pk2(v[j][0], v[j][1]); xo.y = pk2(v[j][2], v[j][3]); *(v2u*)((bf16*)xout + (size_t)m * 1024 + col) = xo; } else *(f32x4*)(xout + (size_t)m * 1024 + col) = v[j]; } }
        }
        float ss = 0.f;
#pragma unroll
        for (int j = 0; j < 4; ++j) ss += (v[j][0] * v[j][0] + v[j][1] * v[j][1]) + (v[j][2] * v[j][2] + v[j][3] * v[j][3]);
        const float rs = 1.0f / sqrtf(wave_sum(ss) * (1.0f / 1024.0f) + kEps);
        if (FINAL) {
#pragma unroll
            for (int j = 0; j < 4; ++j) *(f32x4*)(xout + (size_t)m * 1024 + 4 * lane + 256 * j) = v[j] * rs * gv[j];
        } else {
            f32x4 h[4];
#pragma unroll
            for (int j = 0; j < 4; ++j) { const int col = 4 * lane + 256 * j; const f32x4 sh = *(const f32x4*)(mb + ch_sh * 1024 + col), sc = *(const f32x4*)(mb + (ch_sh + 1) * 1024 + col);
                h[j] = (v[j] * rs * gv[j]) * (sc + 1.0f) + sh;
                v2u o; o.x = pk2(h[j][0], h[j][1]); o.y = pk2(h[j][2], h[j][3]); *(v2u*)(XN + (size_t)m * 1024 + col) = o; }
        }
    }
}
__device__ __forceinline__ float router_w(const Ptrs& p, int l, int k, int o) { return o < 4 ? p.moe_w_group[((size_t)l * 1024 + k) * 4 + o] : p.moe_w_expert[(((size_t)l * 4 + ((o - 4) >> 3)) * 1024 + k) * 8 + ((o - 4) & 7)]; }
__device__ __forceinline__ void ph_router_prep(const Ptrs& p, const float* MOD, int gw, int NGW, int lane, int gtid, int NT) {
    bf16* WTH = (bf16*)(p.ws + WS_WR); bf16* WTL = WTH + 4 * 48 * 1024; float* WC = (float*)(p.ws + WS_WC);
    for (int i = gtid; i < 4 * 48 * 1024; i += NT) { const int lb = i / 49152, r = i % 49152, n = r >> 10, k = r & 1023, l = lb >> 1;
        const float* mb = MOD + lb * 6144; const float w = n < 36 ? p.norm_g[(l * 2 + 1) * 1024 + k] * (1.0f + mb[4 * 1024 + k]) * router_w(p, l, k, n) : 0.f;
        const unsigned h = pk2(w, 0.f) & 0xffffu; const float wl = w - __uint_as_float(h << 16);
        WTH[i] = (bf16)h; WTL[i] = (bf16)(pk2(wl, 0.f) & 0xffffu); }
    for (int it = gw; it < 4 * 36; it += NGW) { const int lb = it / 36, o = it % 36, l = lb >> 1; const float* mb = MOD + lb * 6144; float a = 0.f;
        for (int j = 0; j < 16; ++j) { const int k = lane + 64 * j; a += mb[3 * 1024 + k] * router_w(p, l, k, o); }
        a = wave_sum(a);
        if (lane == 0) WC[lb * 48 + o] = a + (o < 4 ? p.moe_b_group[l * 4 + o] : p.moe_b_expert[l * 32 + (o - 4)]); }
}
__device__ __forceinline__ void ph_router(const Ptrs& p, const float* X, int layer, LAS unsigned char* lds, int vcu, int G, int wave, int lane, int gtid, int NT, bool dummy) {
    typedef short bf16x8r __attribute__((ext_vector_type(8)));
    unsigned char* ws = p.ws;
    const int n = lane & 15, q = lane >> 4;
    LAS unsigned* lcnt = (LAS unsigned*)(lds + RING_OFF);
    for (int it0 = vcu * NWAVES; it0 < kM / 16; it0 += G * NWAVES) { const bool valid = it0 + wave < kM / 16; const int it = valid ? it0 + wave : 0;
        if (wave == 0) lcnt[lane] = 0u;
        __syncthreads();
        const int m = it * 16 + n; const int lb = layer * 2 + ((it * 16) >= kS ? 1 : 0);
        const bf16* wth = (const bf16*)(ws + WS_WR) + ((size_t)lb * 48 + n) * 1024 + 8 * q; const bf16* wtl = wth + 4 * 48 * 1024;
        const bf16* xr = (const bf16*)X + (size_t)m * 1024 + 8 * q;
        f32x4 acc[3]; float ssq = 0.f;
#pragma unroll
        for (int t = 0; t < 3; ++t) acc[t] = (f32x4){0.f, 0.f, 0.f, 0.f};
#pragma unroll 2
        for (int i = 0; i < 32; ++i) {
            const v4u hw = *(const v4u*)(xr + 32 * i);
            { const float a0 = __uint_as_float(hw.x << 16), a1 = __uint_as_float(hw.x & 0xffff0000u), a2 = __uint_as_float(hw.y << 16), a3 = __uint_as_float(hw.y & 0xffff0000u),
                          a4 = __uint_as_float(hw.z << 16), a5 = __uint_as_float(hw.z & 0xffff0000u), a6 = __uint_as_float(hw.w << 16), a7 = __uint_as_float(hw.w & 0xffff0000u);
              ssq += ((a0 * a0 + a1 * a1) + (a2 * a2 + a3 * a3)) + ((a4 * a4 + a5 * a5) + (a6 * a6 + a7 * a7)); }
            const bf16x8r xh = __builtin_bit_cast(bf16x8r, hw);
#pragma unroll
            for (int t = 0; t < 3; ++t) { const bf16x8r wh = *(const bf16x8r*)(wth + (size_t)t * 16 * 1024 + 32 * i), wl = *(const bf16x8r*)(wtl + (size_t)t * 16 * 1024 + 32 * i);
                acc[t] = __builtin_amdgcn_mfma_f32_16x16x32_bf16(wh, xh, acc[t], 0, 0, 0); acc[t] = __builtin_amdgcn_mfma_f32_16x16x32_bf16(wl, xh, acc[t], 0, 0, 0); }
        }
        ssq = nsa::xsum_q(ssq);
        const float rs = 1.0f / sqrtf(ssq * (1.0f / 1024.0f) + kEps);
        const float* wc = (const float*)(ws + WS_WC) + lb * 48;
        float t[48];
#pragma unroll
        for (int tt = 0; tt < 3; ++tt)
#pragma unroll
            for (int r = 0; r < 4; ++r) { const float v = acc[tt][r] * rs + wc[16 * tt + 4 * q + r];
                auto a = __builtin_amdgcn_permlane16_swap(__float_as_uint(v), __float_as_uint(v), false, false);
                auto e = __builtin_amdgcn_permlane32_swap(a[0], a[0], false, false); auto o = __builtin_amdgcn_permlane32_swap(a[1], a[1], false, false);
                t[16 * tt + r] = __uint_as_float(e[0]); t[16 * tt + 4 + r] = __uint_as_float(o[0]); t[16 * tt + 8 + r] = __uint_as_float(e[1]); t[16 * tt + 12 + r] = __uint_as_float(o[1]); }
        int ea = 0, eb = 0, s0 = 0, s1 = 0; float w0 = 0.f, w1 = 0.f;
        if (q == 0 && valid) {
            int grp = 0; float lmax = t[0];
#pragma unroll
            for (int i = 1; i < 4; ++i) if (t[i] > lmax) { lmax = t[i]; grp = i; }
            float den = 0.f;
#pragma unroll
            for (int i = 0; i < 4; ++i) den += __expf(t[i] - lmax);
            const float ptop = 1.0f / den;
            float le[8];
#pragma unroll
            for (int e = 0; e < 8; ++e) le[e] = grp == 0 ? t[4 + e] : grp == 1 ? t[12 + e] : grp == 2 ? t[20 + e] : t[28 + e];
            int i0 = 0; float v0 = le[0];
#pragma unroll
            for (int i = 1; i < 8; ++i) if (le[i] > v0) { v0 = le[i]; i0 = i; }
            int i1 = -1; float v1 = -3.0e38f;
#pragma unroll
            for (int i = 0; i < 8; ++i) if (i != i0 && le[i] > v1) { v1 = le[i]; i1 = i; }
            const float ex = __expf(v1 - v0); w0 = ptop / (1.0f + ex); w1 = ptop * ex / (1.0f + ex);
            ea = grp * 8 + i0; eb = grp * 8 + i1;
            s0 = (int)__hip_atomic_fetch_add(lcnt + ea, 1u, __ATOMIC_RELAXED, __HIP_MEMORY_SCOPE_WORKGROUP); s1 = (int)__hip_atomic_fetch_add(lcnt + eb, 1u, __ATOMIC_RELAXED, __HIP_MEMORY_SCOPE_WORKGROUP);
        }
        __syncthreads();
        if (wave == 0 && lane < 32) { const unsigned c = lcnt[lane]; unsigned* cnt = (unsigned*)(ws + WS_CTL) + CW_CNT + layer * 32 + (dummy ? 64 : 0);
            lcnt[32 + lane] = c ? __hip_atomic_fetch_add(cnt + lane, c, RLX_AGENT) : 0u; }
        __syncthreads();
        if (q == 0 && valid) { s0 += (int)lcnt[32 + ea]; s1 += (int)lcnt[32 + eb];
            int* RT = (int*)(ws + (dummy ? WS_RE : WS_RC)); float* RW = (float*)(RT + 32 * 32768);
            RT[ea * 32768 + s0] = m * 2; RW[ea * 32768 + s0] = w0; RT[eb * 32768 + s1] = m * 2 + 1; RW[eb * 32768 + s1] = w1; }
        __syncthreads();
    }
}
__device__ __forceinline__ void ph_diffcombine(const Ptrs& p, const bf16* O0, const bf16* O1, bf16* AO, int gw, int NGW, int lane) {
    const float* lam = p.diff_lambda;
    const float s1 = wave_sum(lam[lane] * lam[64 + lane]), s2 = wave_sum(lam[128 + lane] * lam[192 + lane]);
    const float lam_full = __expf(s1) - __expf(s2) + 0.2f;
    float sg[8];
#pragma unroll
    for (int i = 0; i < 8; ++i) sg[i] = p.diff_subln_g[(8 * lane + i) & 127] * 0.8f;
    for (int m = gw; m < kM; m += NGW) {
#pragma unroll
        for (int j = 0; j < 2; ++j) { const size_t off = (size_t)m * 1024 + 512 * j + 8 * lane;
            const v4u a = *(const v4u*)(O0 + off), c = *(const v4u*)(O1 + off); float v[8];
#pragma unroll
            for (int i = 0; i < 4; ++i) { v[2 * i] = __uint_as_float(a[i] << 16) - lam_full * __uint_as_float(c[i] << 16); v[2 * i + 1] = __uint_as_float(a[i] & 0xffff0000u) - lam_full * __uint_as_float(c[i] & 0xffff0000u); }
            float ss = 0.f;
#pragma unroll
            for (int i = 0; i < 8; ++i) ss += v[i] * v[i];
            ss += __shfl_xor(ss, 1); ss += __shfl_xor(ss, 2); ss += __shfl_xor(ss, 4); ss += __shfl_xor(ss, 8);
            const float rs = 1.0f / sqrtf(ss * (1.0f / 128.0f) + kEps);
            v4u o; o.x = pk2(v[0] * rs * sg[0], v[1] * rs * sg[1]); o.y = pk2(v[2] * rs * sg[2], v[3] * rs * sg[3]); o.z = pk2(v[4] * rs * sg[4], v[5] * rs * sg[5]); o.w = pk2(v[6] * rs * sg[6], v[7] * rs * sg[7]);
            *(v4u*)(AO + off) = o; }
    }
}
__device__ __forceinline__ void moe_tpre(const Ptrs& p, int layer, LAS int* tpre, int tid) {
    if (tid < 32) { const unsigned* cnt = (const unsigned*)(p.ws + WS_CTL) + CW_CNT + layer * 32; tpre[40 + tid] = (int)__hip_atomic_load(cnt + tid, RLX_AGENT); }
    __syncthreads();
    if (tid < 32) { int acc = 0, nt_me = 0;
#pragma unroll 8
        for (int j = 0; j < 32; ++j) { const int nt = (int)(((unsigned)tpre[40 + j] + 255u) >> 8); if (j < tid) acc += nt; if (j == tid) nt_me = nt; }
        tpre[tid] = acc; if (tid == 31) tpre[32] = acc + nt_me; }
    __syncthreads();
}
__device__ __forceinline__ void ph_gather(const Ptrs& p, const bf16* XN, bf16* Xg, const LAS int* tpre, int gw, int NGW, int lane) {
    unsigned char* ws = p.ws; int* rowtok = (int*)(ws + WS_ROWTOK); float* rowwt = (float*)(ws + WS_ROWWT);
    for (int it = gw; it < 2 * kM; it += NGW) { const int m = it >> 1, k = it & 1; const int* ro = (const int*)(ws + WS_ROUTE) + (size_t)m * 6;
        const int e = ro[k], slot = ro[2 + k]; const float w = ((const float*)ro)[4 + k]; const int row = tpre[e & 31] * 256 + slot;
        const v4u* src = (const v4u*)(XN + (size_t)m * 1024); v4u* dst = (v4u*)(Xg + (size_t)row * 1024);
        dst[lane] = src[lane]; dst[64 + lane] = src[64 + lane];
        if (lane == 0) { rowtok[row] = it; rowwt[row] = w; } }
}
__device__ __forceinline__ void ph_vtrans(const Ptrs& p, const bf16* P, bf16* VTS, bf16* KTS, LAS unsigned char* lds, int gw, int NGW, int wave, int lane) {
    LAS bf16* scr = (LAS bf16*)(lds + RING_OFF + wave * 16384);
    unsigned char* V8 = (unsigned char*)VTS; unsigned char* K8 = (unsigned char*)KTS;
    const int n = lane & 15, q = lane >> 4;
    for (int it = gw; it < 4 * 512; it += NGW) { const int bg = (it >> 9) & 3, G = it & 511, b = bg >> 1, g = bg & 1;
        const bf16* src = P + ((size_t)b * kS + 32 * G) * 2048 + nsa::COL_VS + g * 64;
        { const int kk = lane >> 1, hf = lane & 1; const v4u* sp = (const v4u*)(src + (size_t)kk * 2048 + hf * 32);
#pragma unroll
          for (int c = 0; c < 4; ++c) { const v4u v = sp[c]; LAS unsigned* d = (LAS unsigned*)(scr + kk * 66 + hf * 32 + c * 8); d[0] = v.x; d[1] = v.y; d[2] = v.z; d[3] = v.w; } }
        LDS_WAIT(); asm volatile("" ::: "memory");
#pragma unroll
        for (int h = 0; h < 2; ++h) { unsigned w[4];
#pragma unroll
            for (int e = 0; e < 2; ++e) { const int d = 16 * (2 * h + e) + n; float x[8];
#pragma unroll
                for (int j = 0; j < 8; ++j) x[j] = bf2f(scr[(8 * q + j) * 66 + d]);
                w[2 * e] = nsa::fp8x4(x[0], x[1], x[2], x[3]); w[2 * e + 1] = nsa::fp8x4(x[4], x[5], x[6], x[7]); }
            v4u o; o.x = w[0]; o.y = w[1]; o.z = w[2]; o.w = w[3]; *(v4u*)(V8 + ((size_t)(bg * 512 + G) * 2 + h) * 1024 + lane * 16) = o; }
        LDS_WAIT(); asm volatile("" ::: "memory");
        { const bf16* ks = P + ((size_t)b * kS + 32 * G) * 2048 + nsa::COL_KS + g * 64;
          { const int kk = lane >> 1, hf = lane & 1; const v4u* sp = (const v4u*)(ks + (size_t)kk * 2048 + hf * 32);
#pragma unroll
            for (int c = 0; c < 4; ++c) { const v4u v = sp[c]; LAS unsigned* d = (LAS unsigned*)(scr + kk * 66 + hf * 32 + c * 8); d[0] = v.x; d[1] = v.y; d[2] = v.z; d[3] = v.w; } }
          LDS_WAIT(); asm volatile("" ::: "memory");
#pragma unroll
          for (int T = 0; T < 2; ++T) { const int key = 8 * (n >> 2) + 4 * T + (n & 3); unsigned w[4];
#pragma unroll
              for (int dh = 0; dh < 2; ++dh) { float x[8];
#pragma unroll
                  for (int j = 0; j < 8; ++j) x[j] = bf2f(scr[key * 66 + 32 * dh + 8 * q + j]);
                  w[2 * dh] = nsa::fp8x4(x[0], x[1], x[2], x[3]); w[2 * dh + 1] = nsa::fp8x4(x[4], x[5], x[6], x[7]); }
              v4u o; o.x = w[0]; o.y = w[1]; o.z = w[2]; o.w = w[3]; *(v4u*)(K8 + ((size_t)(bg * 512 + G) * 2 + T) * 1024 + lane * 16) = o; }
          LDS_WAIT(); asm volatile("" ::: "memory"); } }
}

constexpr int N_PHASES = 23;
struct Args { Ptrs p; int ph_lo, ph_hi; };
typedef const unsigned long long __attribute__((address_space(4))) kq_t;
template <class T> __device__ __forceinline__ T* as_global(T* q) { return (T*)(GAS T*)q; }
__global__ void __launch_bounds__(NWAVES * 64, 2) mega_fwd(Args args_unused) {
    extern __shared__ __attribute__((aligned(16))) unsigned char lds_raw[];
    LAS unsigned char* lds = (LAS unsigned char*)lds_raw;
    for (int u = threadIdx.x; u < (LDS_BYTES - LDSCTL_OFF) / 4; u += NWAVES * 64) ((LAS unsigned*)(lds + LDSCTL_OFF))[u] = 0u;
    __syncthreads();
    volatile LAS unsigned* MISC = (volatile LAS unsigned*)(lds + MISC_OFF);
    LAS int* tpre = (LAS int*)(lds + TPRE_OFF);
    int lo, hi;
    { kq_t* kq = (kq_t*)__builtin_amdgcn_kernarg_segment_ptr(); const unsigned long long w = kq[26]; lo = (int)(unsigned)w; hi = (int)(unsigned)(w >> 32); }
#if MK_SINGLE
    XcdBarrier bar;
    { kq_t* kq = (kq_t*)__builtin_amdgcn_kernarg_segment_ptr(); bar = xcd_barrier_post((unsigned*)((unsigned char*)kq[25] + WS_CTL) + CW_BAR, MISC + 8); }
#define GRID_BAR() xcd_barrier(bar)
#else
#define GRID_BAR() do {} while (0)
#endif
#ifndef PH_MASK
#define PH_MASK 0xffffffffu
#endif
#define IN(k) ((((PH_MASK) >> (k)) & 1u) && lo <= (k) && (k) < hi)
#ifndef REP_MASK
#define REP_MASK 0u
#endif
#define PH_REPS(k) (1 + (int)(((REP_MASK) >> (k)) & 1u))
#define SEAM(k) do { if (IN(k) && IN((k) + 1)) GRID_BAR(); } while (0)
#define PH_BEGIN \
    kq_t* kq_ = (kq_t*)__builtin_amdgcn_kernarg_segment_ptr(); asm volatile("" : "+s"(kq_)); \
    Ptrs p; p.x = (const float*)(GAS const float*)(unsigned long long)kq_[0]; p.c = (const float*)(GAS const float*)(unsigned long long)kq_[1]; p.pos = (const int*)(GAS const int*)(unsigned long long)kq_[2]; p.ada_w = (const float*)(GAS const float*)(unsigned long long)kq_[3]; p.ada_b = (const float*)(GAS const float*)(unsigned long long)kq_[4]; p.norm_g = (const float*)(GAS const float*)(unsigned long long)kq_[5]; p.final_g = (const float*)(GAS const float*)(unsigned long long)kq_[6]; p.diff_w_in = (const float*)(GAS const float*)(unsigned long long)kq_[7]; p.diff_w_out = (const float*)(GAS const float*)(unsigned long long)kq_[8]; p.diff_lambda = (const float*)(GAS const float*)(unsigned long long)kq_[9]; p.diff_subln_g = (const float*)(GAS const float*)(unsigned long long)kq_[10]; p.nsa_w_in = (const float*)(GAS const float*)(unsigned long long)kq_[11]; p.nsa_w_out = (const float*)(GAS const float*)(unsigned long long)kq_[12]; p.nsa_cmp_pos = (const float*)(GAS const float*)(unsigned long long)kq_[13]; p.nsa_cmp_w1 = (const float*)(GAS const float*)(unsigned long long)kq_[14]; p.nsa_cmp_b1 = (const float*)(GAS const float*)(unsigned long long)kq_[15]; p.nsa_cmp_w2 = (const float*)(GAS const float*)(unsigned long long)kq_[16]; p.moe_w_group = (const float*)(GAS const float*)(unsigned long long)kq_[17]; p.moe_b_group = (const float*)(GAS const float*)(unsigned long long)kq_[18]; p.moe_w_expert = (const float*)(GAS const float*)(unsigned long long)kq_[19]; p.moe_b_expert = (const float*)(GAS const float*)(unsigned long long)kq_[20]; p.moe_w_gate = (const float*)(GAS const float*)(unsigned long long)kq_[21]; p.moe_w_up = (const float*)(GAS const float*)(unsigned long long)kq_[22]; p.moe_w_down = (const float*)(GAS const float*)(unsigned long long)kq_[23]; p.out = (float*)(GAS float*)(unsigned long long)kq_[24]; p.ws = (unsigned char*)(GAS unsigned char*)(unsigned long long)kq_[25]; \
    unsigned char* ws = p.ws; int G = gridDim.x, bx = blockIdx.x; asm volatile("" : "+s"(G), "+s"(bx)); \
    const int tid = threadIdx.x, lane = tid & 63, wave = __builtin_amdgcn_readfirstlane(tid >> 6); (void)lane; \
    const int vcu = (G % 8 == 0) ? (bx % 8) * (G / 8) + bx / 8 : bx; \
    const int gw = vcu * NWAVES + wave, NGW = G * NWAVES, gtid = bx * (NWAVES * 64) + tid, NT = G * NWAVES * 64; \
    bf16* const RA = (bf16*)(ws + WS_RA); bf16* const RB = (bf16*)(ws + WS_RB); bf16* const RC = (bf16*)(ws + WS_RC); bf16* const RD = (bf16*)(ws + WS_RD); bf16* const RE = (bf16*)(ws + WS_RE); bf16* const RF = (bf16*)(ws + WS_RF); \
    const float* MOD = (const float*)(ws + WS_MOD); const float* ROPE = (const float*)(ws + WS_ROPE); \
    int* rowtok = (int*)(ws + WS_ROWTOK); float* rowwt = (float*)(ws + WS_ROWWT); \
    (void)vcu; (void)gw; (void)NGW; (void)gtid; (void)NT; (void)RA; (void)RB; (void)RC; (void)RD; (void)RE; (void)RF; (void)MOD; (void)ROPE; (void)rowtok; (void)rowwt;

    if (IN(0)) for (int rep_ = 0; rep_ < PH_REPS(0); ++rep_) { const bool dummy_ = rep_ + 1 < PH_REPS(0); if (rep_) __syncthreads(); PH_BEGIN ph_prologue(p, lds, gw, NGW, wave, lane, gtid, NT); } SEAM(0);
    if (IN(1)) for (int rep_ = 0; rep_ < PH_REPS(1); ++rep_) { const bool dummy_ = rep_ + 1 < PH_REPS(1); if (rep_) __syncthreads(); PH_BEGIN ph_finalize(p, gtid, NT); } SEAM(1);
    if (IN(2)) for (int rep_ = 0; rep_ < PH_REPS(2); ++rep_) { const bool dummy_ = rep_ + 1 < PH_REPS(2); if (rep_) __syncthreads(); PH_BEGIN ph_rows<false, false, false>(p, p.x, nullptr, nullptr, MOD, 0, 0, p.norm_g, RA, 0, gw, NGW, lane, gtid, NT); ph_router_prep(p, MOD, gw, NGW, lane, gtid, NT); } SEAM(2);
    if (IN(3)) for (int rep_ = 0; rep_ < PH_REPS(3); ++rep_) { const bool dummy_ = rep_ + 1 < PH_REPS(3); if (rep_) __syncthreads(); PH_BEGIN pg8::Gemm g{RA, (const bf16*)(ws + WS_WQKV), kM, 3072, 1024, 1024}; pg8::StaticOrder S; S.init(kM, 3072, G, bx);
        pg8::EpiQKV E{RB, (size_t)(WS_RC - WS_RB) / 2, pg8::RopeCtx{ROPE, 0xffffu}};
        pg8::gemm_phase<pg8::EpiQKV, pg8::StaticOrder, true, true>(lds + RING_OFF, g, S, E); } SEAM(3);
    if (IN(4)) for (int rep_ = 0; rep_ < PH_REPS(4); ++rep_) { const bool dummy_ = rep_ + 1 < PH_REPS(4); if (rep_) __syncthreads(); PH_BEGIN attn_body::diff_attn_phase2<8>((char*)lds_raw + RING_OFF, (const attn_body::bf16*)RB, (const attn_body::bf16*)RC, (const attn_body::bf16*)RD, (attn_body::bf16*)RE, (attn_body::bf16*)RF, vcu, G); } SEAM(4);
    if (IN(5)) for (int rep_ = 0; rep_ < PH_REPS(5); ++rep_) { const bool dummy_ = rep_ + 1 < PH_REPS(5); if (rep_) __syncthreads(); PH_BEGIN ph_diffcombine(p, RE, RF, RA, gw, NGW, lane); } SEAM(5);
    if (IN(6)) for (int rep_ = 0; rep_ < PH_REPS(6); ++rep_) { const bool dummy_ = rep_ + 1 < PH_REPS(6); if (rep_) __syncthreads(); PH_BEGIN pg8::Gemm g{RA, (const bf16*)(ws + WS_WO0), kM, 1024, 1024, 1024}; pg8::StaticOrder S; S.init(kM, 1024, G, bx);
        pg8::EpiResidB E{p.x, nullptr, RD, MOD + 2 * 1024};
        pg8::gemm_phase<pg8::EpiResidB, pg8::StaticOrder, true, true>(lds + RING_OFF, g, S, E); } SEAM(6);
    if (IN(7)) for (int rep_ = 0; rep_ < PH_REPS(7); ++rep_) { const bool dummy_ = rep_ + 1 < PH_REPS(7); if (rep_) __syncthreads(); PH_BEGIN ph_rows<false, false, true>(p, (const float*)RD, nullptr, nullptr, MOD, 3, 0, p.norm_g + 1024, RB, 0, gw, NGW, lane, gtid, NT); ph_router(p, (const float*)RD, 0, lds, vcu, G, wave, lane, gtid, NT, dummy_); } SEAM(7);
    if (IN(9)) for (int rep_ = 0; rep_ < PH_REPS(9); ++rep_) { const bool dummy_ = rep_ + 1 < PH_REPS(9); (void)dummy_; if (rep_) __syncthreads(); PH_BEGIN
        moe_tpre(p, 0, tpre, tid); pg8::Gemm g{RB, (const bf16*)(ws + WS_MOE0), kMpad, 32 * 512, 1024, 1024}; pg8::MoeOrder S{tpre, 2, G, vcu};
        const int* RT = (const int*)(ws + WS_RC); const float* RW = (const float*)(RT + 32 * 32768);
        LAS unsigned* gtab = (LAS unsigned*)(lds + GTAB_OFF);
        for (int i = 0; i < GTAB_UNITS; ++i) { pg8::Unit u; if (!S.next(i, u)) break;
            if (tid < 256) { const int idx = u.ti * 256 + tid; const int tok = idx < u.cnt ? (RT[u.e * 32768 + idx] >> 1) : 0; gtab[i * 256 + tid] = (unsigned)tok * 2048u; } }
        __syncthreads();
        pg8::EpiGateUp E{RF, RW}; pg8::gemm_phase_g<pg8::EpiGateUp, pg8::MoeOrder, true>(lds + RING_OFF, g, S, E, gtab); } SEAM(9);
    if (IN(10)) for (int rep_ = 0; rep_ < PH_REPS(10); ++rep_) { const bool dummy_ = rep_ + 1 < PH_REPS(10); if (rep_) __syncthreads(); PH_BEGIN moe_tpre(p, 0, tpre, tid); pg8::Gemm g{RF, (const bf16*)(ws + WS_MOE0 + MOE_WD), kMpad, 32 * 1024, 256, 256}; pg8::MoeOrder S{tpre, 4, G, vcu};
        pg8::EpiScatter E{ws, (unsigned)WS_RA, (unsigned)WS_DUMP, (const int*)(ws + WS_RC)}; pg8::gemm_phase<pg8::EpiScatter, pg8::MoeOrder, true, true>(lds + RING_OFF, g, S, E); } SEAM(10);
    if (IN(11)) for (int rep_ = 0; rep_ < PH_REPS(11); ++rep_) { const bool dummy_ = rep_ + 1 < PH_REPS(11); if (rep_) __syncthreads(); PH_BEGIN ph_rows<true, false, true>(p, (const float*)RD, dummy_ ? (float*)RE : p.out, RA, MOD, 12, 5, p.norm_g + 2048, RC, 1, gw, NGW, lane, gtid, NT); }         SEAM(11);
    if (IN(12)) for (int rep_ = 0; rep_ < PH_REPS(12); ++rep_) { const bool dummy_ = rep_ + 1 < PH_REPS(12); if (rep_) __syncthreads(); PH_BEGIN pg8::Gemm g{RC, (const bf16*)(ws + WS_WNSA), kM, 2048, 1024, 1024}; pg8::StaticOrder S; S.init(kM, 2048, G, bx);
        pg8::EpiNsaProj E{RD, (bf16*)(ws + NS_KC), pg8::RopeCtx{ROPE, 0x3cffu}};
        pg8::gemm_phase<pg8::EpiNsaProj, pg8::StaticOrder, true, true>(lds + RING_OFF, g, S, E); } SEAM(12);
    if (IN(13)) for (int rep_ = 0; rep_ < PH_REPS(13); ++rep_) { const bool dummy_ = rep_ + 1 < PH_REPS(13); (void)dummy_; if (rep_) __syncthreads();
        { PH_BEGIN pg8::Gemm g{(const bf16*)(ws + NS_KC), (const bf16*)(ws + WS_W1C), 8192, 512, 2048, 1024}; pg8::CmpOrder S{G, bx};
          pg8::EpiCmp1 E{(bf16*)(ws + NS_HID), (const float*)(ws + WS_CBF)};
          pg8::gemm_phase<pg8::EpiCmp1, pg8::CmpOrder, true, true>(lds + RING_OFF, g, S, E); }
        asm volatile("s_waitcnt vmcnt(0)" ::: "memory"); __builtin_amdgcn_fence(__ATOMIC_RELEASE, "workgroup"); __syncthreads(); __builtin_amdgcn_fence(__ATOMIC_ACQUIRE, "workgroup");
        { PH_BEGIN pg8::Gemm g{(const bf16*)(ws + NS_HID), (const bf16*)(ws + WS_W2C), 8192, 512, 256, 256}; pg8::CmpOrder S{G, bx};
          pg8::EpiCmp2 E{(unsigned char*)(ws + NS_KCMP), (unsigned char*)(ws + NS_VCT)};
          pg8::gemm_phase<pg8::EpiCmp2, pg8::CmpOrder, true, true>(lds + RING_OFF, g, S, E); }
        __syncthreads();
        { PH_BEGIN ph_vtrans(p, RD, (bf16*)(ws + NS_VTS), (bf16*)(ws + NS_VTW), lds, gw, NGW, wave, lane); }
        __syncthreads();
        { PH_BEGIN attn_body::nsa_window_phase((char*)lds_raw + RING_OFF, (const attn_body::bf16*)RD, (attn_body::bf16*)RB, (unsigned*)(ws + WS_CTL) + CW_QCTR + 128 + rep_ * 64, MISC + 16); }
    } SEAM(13);
    if (IN(16)) for (int rep_ = 0; rep_ < PH_REPS(16); ++rep_) { const bool dummy_ = rep_ + 1 < PH_REPS(16); if (rep_) __syncthreads(); PH_BEGIN const nsa::Tensors T{RD, (const unsigned char*)(ws + NS_KCMP), (const unsigned char*)(ws + NS_VTW), (const unsigned char*)(ws + NS_VCT), (const unsigned char*)(ws + NS_VTS), RB, RA};
        LAS float* wl = (LAS float*)(lds + RING_OFF + wave * 16384);
        unsigned* qbase = (unsigned*)(ws + WS_CTL) + CW_QCTR + 1024 + rep_ * 512;
        const unsigned xcc = xb_xcc_id() & 7u;
        for (unsigned qi = 0; qi < 8u; ++qi) { const unsigned qq = (xcc + qi) & 7u; unsigned* qc = qbase + qq * 64;
            for (;;) { unsigned it = 0; if (lane == 0) it = __hip_atomic_fetch_add(qc, 1u, RLX_AGENT); it = (unsigned)__builtin_amdgcn_readfirstlane((int)it);
                if (it >= 2048u) break;
                nsa::quad_item(T, (int)(((qq >> 1) << 12) | ((qq & 1u) * 2048u + 2047u - it)), wl, lane); } } } SEAM(16);
    if (IN(17)) for (int rep_ = 0; rep_ < PH_REPS(17); ++rep_) { const bool dummy_ = rep_ + 1 < PH_REPS(17); if (rep_) __syncthreads(); PH_BEGIN pg8::Gemm g{RA, (const bf16*)(ws + WS_WO1), kM, 1024, 1024, 1024}; pg8::StaticOrder S; S.init(kM, 1024, G, bx);
        pg8::EpiResidB E{nullptr, (const bf16*)p.out, dummy_ ? RE : RD, MOD + 12288 + 2 * 1024};
        pg8::gemm_phase<pg8::EpiResidB, pg8::StaticOrder, true, true>(lds + RING_OFF, g, S, E); } SEAM(17);
    if (IN(18)) for (int rep_ = 0; rep_ < PH_REPS(18); ++rep_) { const bool dummy_ = rep_ + 1 < PH_REPS(18); if (rep_) __syncthreads(); PH_BEGIN ph_rows<false, false, true>(p, (const float*)RD, nullptr, nullptr, MOD + 12288, 3, 0, p.norm_g + 3072, RB, 1, gw, NGW, lane, gtid, NT); ph_router(p, (const float*)RD, 1, lds, vcu, G, wave, lane, gtid, NT, dummy_); } SEAM(18);
    if (IN(20)) for (int rep_ = 0; rep_ < PH_REPS(20); ++rep_) { const bool dummy_ = rep_ + 1 < PH_REPS(20); (void)dummy_; if (rep_) __syncthreads(); PH_BEGIN
        moe_tpre(p, 1, tpre, tid); pg8::Gemm g{RB, (const bf16*)(ws + WS_MOE0 + MOE_L), kMpad, 32 * 512, 1024, 1024}; pg8::MoeOrder S{tpre, 2, G, vcu};
        const int* RT = (const int*)(ws + WS_RC); const float* RW = (const float*)(RT + 32 * 32768);
        LAS unsigned* gtab = (LAS unsigned*)(lds + GTAB_OFF);
        for (int i = 0; i < GTAB_UNITS; ++i) { pg8::Unit u; if (!S.next(i, u)) break;
            if (tid < 256) { const int idx = u.ti * 256 + tid; const int tok = idx < u.cnt ? (RT[u.e * 32768 + idx] >> 1) : 0; gtab[i * 256 + tid] = (unsigned)tok * 2048u; } }
        __syncthreads();
        pg8::EpiGateUp E{RF, RW}; pg8::gemm_phase_g<pg8::EpiGateUp, pg8::MoeOrder, true>(lds + RING_OFF, g, S, E, gtab); } SEAM(20);
    if (IN(21)) for (int rep_ = 0; rep_ < PH_REPS(21); ++rep_) { const bool dummy_ = rep_ + 1 < PH_REPS(21); if (rep_) __syncthreads(); PH_BEGIN moe_tpre(p, 1, tpre, tid); pg8::Gemm g{RF, (const bf16*)(ws + WS_MOE0 + MOE_L + MOE_WD), kMpad, 32 * 1024, 256, 256}; pg8::MoeOrder S{tpre, 4, G, vcu};
        pg8::EpiScatter E{ws, (unsigned)WS_RA, (unsigned)WS_DUMP, (const int*)(ws + WS_RC)}; pg8::gemm_phase<pg8::EpiScatter, pg8::MoeOrder, true, true>(lds + RING_OFF, g, S, E); } SEAM(21);
    if (IN(22)) for (int rep_ = 0; rep_ < PH_REPS(22); ++rep_) { const bool dummy_ = rep_ + 1 < PH_REPS(22); if (rep_) __syncthreads(); PH_BEGIN ph_rows<true, true, true>(p, (const float*)RD, dummy_ ? (float*)RE : p.out, RA, MOD + 12288, 0, 5, p.final_g, nullptr, 1, gw, NGW, lane, gtid, NT); }
#undef IN
#undef SEAM
}

extern "C" void kernel_launch(void* const* d_in, const int* in_sizes, int n_in, void* d_out, int out_size, void* d_ws, size_t ws_size, hipStream_t stream) {
    static int grid = 0;
    if (grid == 0) {
        if (n_in != 24 || in_sizes[0] != kM * kD || out_size != kM * kD || ws_size < WS_END) { fprintf(stderr, "kernel_launch: unexpected shapes (n_in %d, in0 %d, out %d, ws %zu)\n", n_in, n_in > 0 ? in_sizes[0] : -1, out_size, ws_size); grid = -1; return; }
        int dev = 0, cus = 0, per_cu = 0;
        if (hipGetDevice(&dev) != hipSuccess || hipDeviceGetAttribute(&cus, hipDeviceAttributeMultiprocessorCount, dev) != hipSuccess) { grid = -1; return; }
        if (hipFuncSetAttribute((const void*)mega_fwd, hipFuncAttributeMaxDynamicSharedMemorySize, LDS_BYTES) != hipSuccess) { fprintf(stderr, "kernel_launch: hipFuncSetAttribute failed\n"); grid = -1; return; }
        if (hipOccupancyMaxActiveBlocksPerMultiprocessor(&per_cu, (const void*)mega_fwd, NWAVES * 64, LDS_BYTES) != hipSuccess || per_cu < 1) { fprintf(stderr, "kernel_launch: occupancy query says %d\n", per_cu); }
        (void)hipGetLastError();
        grid = cus;
    }
    if (grid < 0) return;
    if (hipMemsetAsync((char*)d_ws + WS_CTL, 0, CTL_ZERO_BYTES, stream) != hipSuccess) return;
    Args a{};
    const void** pp = (const void**)&a.p;
    for (int i = 0; i < 24; ++i) pp[i] = d_in[i];
    a.p.out = (float*)d_out; a.p.ws = (unsigned char*)d_ws;
#if MK_SINGLE
    a.ph_lo = 0; a.ph_hi = N_PHASES;
    hipLaunchKernelGGL(mega_fwd, dim3(grid), dim3(NWAVES * 64), LDS_BYTES, stream, a);
#else
    for (int ph = 0; ph < N_PHASES; ++ph) { a.ph_lo = ph; a.ph_hi = ph + 1; hipLaunchKernelGGL(mega_fwd, dim3(grid), dim3(NWAVES * 64), LDS_BYTES, stream, a); }
#endif
}
```

```cpp
#include <hip/hip_runtime.h>
#include <cstdio>
#include <cstdint>
namespace pg8 {
#define PG8_LAS __attribute__((address_space(3)))
typedef unsigned short bf16_t;
typedef short bf16x8 __attribute__((ext_vector_type(8)));
typedef float f32x4 __attribute__((ext_vector_type(4)));
typedef unsigned u32x4 __attribute__((ext_vector_type(4)));
constexpr int BM = 256, BK = 64, HALF = 128, HTB = HALF * BK * 2  , STAGE_BYTES = 8 * HTB, NXCD = 8, WGM = 8;

__host__ __device__ __forceinline__ int lds_byte(int r, int c) { const int st = (r >> 4) * 2 + (c >> 5), rr = r & 15, cc = c & 31, ob = rr * 64 + cc * 2; return st * 1024 + (ob ^ (((ob >> 9) & 1) << 5)); }
__host__ __device__ __forceinline__ void stage_rc(int b, int& R, int& C) { const int st = b / 1024, sb = b % 1024, swz = sb ^ (((sb >> 9) & 1) << 5); R = (st >> 1) * 16 + swz / 64; C = (st & 1) * 32 + (swz % 64) / 2; }
__host__ __device__ __forceinline__ int perm32(int rho) { const int n = rho >> 4, i = rho & 15; return 8 * (i >> 2) + 4 * n + (i & 3); }

struct Unit { int pm, pn, e, ti, cnt; };
struct Gemm { const bf16_t* A; const bf16_t* Bt; int M, N, K, lda; };

struct StaticOrder {
    int nM, nN, nwg, G, c;
    __host__ __device__ void init(int M, int N, int G_, int c_) { nM = M / BM; nN = N / BM; nwg = nM * nN; G = G_; c = c_; }
    __host__ __device__ bool next(int i, Unit& u) const {
        const long L = (long)i * G + c; if (L >= nwg) return false;
        int wgid = (int)L; { const int q = nwg / NXCD, r = nwg % NXCD, xcd = wgid % NXCD, off = wgid / NXCD; wgid = (xcd < r ? xcd * (q + 1) : r * (q + 1) + (xcd - r) * q) + off; }
        const int nig = WGM * nN, gid = wgid / nig, fm = gid * WGM, gsz = (nM - fm) < WGM ? (nM - fm) : WGM;
        u.pm = fm + ((wgid % nig) % gsz); u.pn = (wgid % nig) / gsz; return true;
    }
    __device__ __forceinline__ void a_ready(const Unit&) const {}
    __device__ __forceinline__ void done(const Unit&) const {}
};

__device__ __forceinline__ unsigned cvt_pk_bf16(float lo, float hi) { unsigned r; asm volatile("v_cvt_pk_bf16_f32 %0, %1, %2" : "=v"(r) : "v"(lo), "v"(hi)); return r; }
typedef float f32x2 __attribute__((ext_vector_type(2)));

constexpr int kSeq = 16384, kTok = 32768;
struct RopeCtx { const float* rope; unsigned ropemask; };
__device__ __forceinline__ void rope8p(f32x4& v0, f32x4& v1, const RopeCtx& R, int ch, int wc, int fq, int bp, const f32x4 (&t)[4]) {
    if (((R.ropemask >> ch) & 1u) && ((wc & 1) == 0)) {
        f32x4 o0, o1;
#pragma unroll
        for (int i = 0; i < 4; ++i) { o0[i] = __int_as_float(__builtin_amdgcn_ds_bpermute(bp, __float_as_int(v0[i]))); o1[i] = __int_as_float(__builtin_amdgcn_ds_bpermute(bp, __float_as_int(v1[i]))); }
        if (fq < 2) { v0 = v0 * t[0] + o0 * t[2]; v1 = v1 * t[1] + o1 * t[3]; }
    }
}
__device__ __forceinline__ u32x4 pack8(const f32x4& v0, const f32x4& v1) { u32x4 w; w.x = cvt_pk_bf16(v0[0], v0[1]); w.y = cvt_pk_bf16(v0[2], v0[3]); w.z = cvt_pk_bf16(v1[0], v1[1]); w.w = cvt_pk_bf16(v1[2], v1[3]); return w; }

struct EpiQKV {
    static constexpr bool PERM = true, AFTER_DRAIN = false;
    bf16_t* O; size_t tstride; RopeCtx R;
    __device__ __forceinline__ void operator()(const f32x4 (&acc)[2][2][4][2], const Unit& u, int wr, int wc, int fr, int fq) const {
        const int row0 = u.pm * BM + wr * 64 + fr, bp = (((fq ^ 1) & 3) * 16 + fr) * 4;
#pragma unroll
        for (int ai = 0; ai < 2; ++ai)
        { f32x4 rt[4][4];
            if (((R.ropemask >> (2 * u.pn)) & 3u) && ((wc & 1) == 0) && fq < 2) { const float sg = (fq == 0) ? -1.f : 1.f;
#pragma unroll
                for (int m = 0; m < 4; ++m) { const f32x4* rp = (const f32x4*)(R.rope + (size_t)(row0 + ai * HALF + m * 16) * 16); rt[m][0] = rp[0]; rt[m][1] = rp[1]; rt[m][2] = rp[2] * sg; rt[m][3] = rp[3] * sg; } }
#pragma unroll
            for (int m = 0; m < 4; ++m) { const int row = row0 + ai * HALF + m * 16;
#pragma unroll
                for (int bj = 0; bj < 2; ++bj) { const int ch = 2 * u.pn + bj, t = ch >> 3, col = (ch & 7) * 128 + wc * 32 + 8 * fq;
                    f32x4 v0 = acc[ai][bj][m][0], v1 = acc[ai][bj][m][1]; rope8p(v0, v1, R, ch, wc, fq, bp, rt[m]);
                    *(u32x4*)(O + (size_t)t * tstride + (size_t)row * 1024 + col) = pack8(v0, v1); } } }
    }
};
struct EpiV8 {
    static constexpr bool PERM = false, AFTER_DRAIN = false;
    unsigned char* V8;
    __device__ __forceinline__ void operator()(const f32x4 (&acc)[2][2][4][2], const Unit& u, int wr, int wc, int fr, int fq) const {
#pragma unroll
        for (int ai = 0; ai < 2; ++ai) { const int row0 = u.pm * BM + ai * HALF + wr * 64, b = row0 >> 14, kt = (row0 & 16383) >> 6;
#pragma unroll
            for (int bj = 0; bj < 2; ++bj)
#pragma unroll
                for (int n = 0; n < 2; ++n) { const int c = u.pn * BM + bj * HALF + wc * 32 + n * 16 + fr, h = c >> 7, db = (c >> 5) & 3, r32 = c & 31;
                    u32x4 w;
#pragma unroll
                    for (int m = 0; m < 4; ++m) { const f32x4 a = acc[ai][bj][m][n]; int x = __builtin_amdgcn_cvt_pk_fp8_f32(a[0], a[1], 0, false); x = __builtin_amdgcn_cvt_pk_fp8_f32(a[2], a[3], x, true); w[m] = (unsigned)x; }
                    *(u32x4*)(V8 + ((size_t)((b * 8 + h) * 256 + kt)) * 8192 + db * 2048 + (fq >> 1) * 1024 + ((fq & 1) * 32 + r32) * 16) = w; } }
    }
};
struct EpiNsaProj {
    static constexpr bool PERM = true, AFTER_DRAIN = false;
    bf16_t* P; bf16_t* KC; RopeCtx R;
    __device__ __forceinline__ void operator()(const f32x4 (&acc)[2][2][4][2], const Unit& u, int wr, int wc, int fr, int fq) const {
        const int row0 = u.pm * BM + wr * 64 + fr, bp = (((fq ^ 1) & 3) * 16 + fr) * 4;
#pragma unroll
        for (int ai = 0; ai < 2; ++ai) { f32x4 rt[4][4];
            if (((R.ropemask >> (2 * u.pn)) & 3u) && ((wc & 1) == 0) && fq < 2) { const float sg = (fq == 0) ? -1.f : 1.f;
#pragma unroll
                for (int m = 0; m < 4; ++m) { const f32x4* rp = (const f32x4*)(R.rope + (size_t)(row0 + ai * HALF + m * 16) * 16); rt[m][0] = rp[0]; rt[m][1] = rp[1]; rt[m][2] = rp[2] * sg; rt[m][3] = rp[3] * sg; } }
#pragma unroll
            for (int m = 0; m < 4; ++m) { const int row = row0 + ai * HALF + m * 16;
#pragma unroll
                for (int bj = 0; bj < 2; ++bj) { const int ch = 2 * u.pn + bj;
                    f32x4 v0 = acc[ai][bj][m][0], v1 = acc[ai][bj][m][1]; rope8p(v0, v1, R, ch, wc, fq, bp, rt[m]);
                    bf16_t* dst;
                    if (ch == 8 || ch == 9) { const int kv = ch - 8, b = row >= kSeq ? 1 : 0, t = row - b * kSeq, gi = wc >> 1;
                        dst = KC + ((size_t)((kv * 2 + b) * 2 + gi) * kSeq + t) * 64 + (wc & 1) * 32 + 8 * fq; }
                    else dst = P + (size_t)row * 2048 + ch * 128 + wc * 32 + 8 * fq;
                    *(u32x4*)dst = pack8(v0, v1); } } }
    }
};
struct EpiResid {
    static constexpr bool PERM = false, AFTER_DRAIN = false;
    const float* base; float* out; const float* gate;
    __device__ __forceinline__ void operator()(const f32x4 (&acc)[2][2][4][2], const Unit& u, int wr, int wc, int fr, int fq) const {
        const int row0 = u.pm * BM + wr * 64 + fr, col0 = u.pn * BM + wc * 32 + 4 * fq;
        const float* gp = gate + ((u.pm * BM) >= kSeq ? 6144 : 0);
        f32x4 gv[2][2];
#pragma unroll
        for (int bj = 0; bj < 2; ++bj)
#pragma unroll
            for (int n = 0; n < 2; ++n) gv[bj][n] = *(const f32x4*)(gp + col0 + bj * HALF + n * 16);
#pragma unroll
        for (int ai = 0; ai < 2; ++ai)
#pragma unroll
            for (int m = 0; m < 4; ++m) { const size_t off = (size_t)(row0 + ai * HALF + m * 16) * 1024 + col0;
#pragma unroll
                for (int bj = 0; bj < 2; ++bj)
#pragma unroll
                    for (int n = 0; n < 2; ++n) { const f32x4 bs = *(const f32x4*)(base + off + bj * HALF + n * 16);
                        *(f32x4*)(out + off + bj * HALF + n * 16) = bs + gv[bj][n] * acc[ai][bj][m][n]; } }
    }
};
struct EpiResidB {
    static constexpr bool PERM = true, AFTER_DRAIN = false;
    const float* basef; const bf16_t* baseh; bf16_t* out; const float* gate;
    __device__ __forceinline__ void operator()(const f32x4 (&acc)[2][2][4][2], const Unit& u, int wr, int wc, int fr, int fq) const {
        const int row0 = u.pm * BM + wr * 64 + fr, col0 = u.pn * BM + wc * 32 + 8 * fq;
        const float* gp = gate + ((u.pm * BM) >= kSeq ? 6144 : 0);
        f32x4 gv[2][2];
#pragma unroll
        for (int bj = 0; bj < 2; ++bj) { gv[bj][0] = *(const f32x4*)(gp + col0 + bj * HALF); gv[bj][1] = *(const f32x4*)(gp + col0 + bj * HALF + 4); }
        if (basef) {
#pragma unroll
            for (int am = 0; am < 4; ++am) { const int ai = am >> 1, m0 = (am & 1) * 2; f32x4 bb[2][2][2];
#pragma unroll
                for (int m = 0; m < 2; ++m) { const size_t off = (size_t)(row0 + ai * HALF + (m0 + m) * 16) * 1024 + col0;
#pragma unroll
                    for (int bj = 0; bj < 2; ++bj) { bb[m][bj][0] = *(const f32x4*)(basef + off + bj * HALF); bb[m][bj][1] = *(const f32x4*)(basef + off + bj * HALF + 4); } }
#pragma unroll
                for (int m = 0; m < 2; ++m) { const size_t off = (size_t)(row0 + ai * HALF + (m0 + m) * 16) * 1024 + col0;
#pragma unroll
                    for (int bj = 0; bj < 2; ++bj) *(u32x4*)(out + off + bj * HALF) = pack8(bb[m][bj][0] + gv[bj][0] * acc[ai][bj][m0 + m][0], bb[m][bj][1] + gv[bj][1] * acc[ai][bj][m0 + m][1]); } }
        } else {
            u32x4 hb[2][4][2];
#pragma unroll
            for (int ai = 0; ai < 2; ++ai)
#pragma unroll
                for (int m = 0; m < 4; ++m) { const size_t off = (size_t)(row0 + ai * HALF + m * 16) * 1024 + col0;
#pragma unroll
                    for (int bj = 0; bj < 2; ++bj) hb[ai][m][bj] = *(const u32x4*)(baseh + off + bj * HALF); }
#pragma unroll
            for (int ai = 0; ai < 2; ++ai)
#pragma unroll
                for (int m = 0; m < 4; ++m) { const size_t off = (size_t)(row0 + ai * HALF + m * 16) * 1024 + col0;
#pragma unroll
                    for (int bj = 0; bj < 2; ++bj) { const u32x4 h = hb[ai][m][bj];
                        const f32x4 b0 = (f32x4){__uint_as_float(h.x << 16), __uint_as_float(h.x & 0xffff0000u), __uint_as_float(h.y << 16), __uint_as_float(h.y & 0xffff0000u)};
                        const f32x4 b1 = (f32x4){__uint_as_float(h.z << 16), __uint_as_float(h.z & 0xffff0000u), __uint_as_float(h.w << 16), __uint_as_float(h.w & 0xffff0000u)};
                        *(u32x4*)(out + off + bj * HALF) = pack8(b0 + gv[bj][0] * acc[ai][bj][m][0], b1 + gv[bj][1] * acc[ai][bj][m][1]); } }
        }
    }
};
struct EpiGateUp {
    static constexpr bool PERM = true, AFTER_DRAIN = false;
    bf16_t* ACT; const float* RW;
    __device__ __forceinline__ void operator()(const f32x4 (&acc)[2][2][4][2], const Unit& u, int wr, int wc, int fr, int fq) const {
        const int rl0 = wr * 64 + fr, col = (u.pn & 1) * 128 + wc * 32 + 8 * fq; const float* rwp = RW + u.e * 32768 + u.ti * 256; const int lim = u.cnt - u.ti * 256;
        float wtw[2];
#pragma unroll
        for (int ai = 0; ai < 2; ++ai) { const int rl = wr * 64 + ai * HALF + fq * 16 + fr; const float wv = rwp[rl < lim ? rl : 0]; wtw[ai] = rl < lim ? wv : 0.f; }
#pragma unroll
        for (int ai = 0; ai < 2; ++ai)
#pragma unroll
            for (int m = 0; m < 4; ++m) { const int rl = rl0 + ai * HALF + m * 16; const float wt = __int_as_float(__builtin_amdgcn_ds_bpermute((m * 16 + fr) * 4, __float_as_int(wtw[ai])));
                f32x4 a[2];
#pragma unroll
                for (int n = 0; n < 2; ++n)
#pragma unroll
                    for (int i = 0; i < 4; ++i) { const float g = acc[ai][0][m][n][i], up = acc[ai][1][m][n][i];
                        const float sg = g * __builtin_amdgcn_rcpf(1.0f + __builtin_amdgcn_exp2f(-1.4426950408889634f * g)); a[n][i] = sg * up * wt; }
                *(u32x4*)(ACT + (size_t)(u.pm * BM + rl) * 256 + col) = pack8(a[0], a[1]); }
    }
};
struct EpiScatter {
    static constexpr bool PERM = true, AFTER_DRAIN = false;
    unsigned char* B; unsigned yoff, doff; const int* RT;
    __device__ __forceinline__ void operator()(const f32x4 (&acc)[2][2][4][2], const Unit& u, int wr, int wc, int fr, int fq) const {
        asm volatile("" : "+v"(fr), "+v"(fq));
        const int rl0 = wr * 64 + fr, col0 = (u.pn & 3) * BM + wc * 32 + 8 * fq; const int* rtp = RT + u.e * 32768 + u.ti * 256; const int lim = u.cnt - u.ti * 256;
        int tkw[2];
#pragma unroll
        for (int ai = 0; ai < 2; ++ai) { const int rl = wr * 64 + ai * HALF + fq * 16 + fr; const int tv = rtp[rl < lim ? rl : 0]; tkw[ai] = rl < lim ? tv : -1; }
#pragma unroll
        for (int ai = 0; ai < 2; ++ai)
#pragma unroll
            for (int m = 0; m < 4; ++m) { const int tk = __builtin_amdgcn_ds_bpermute((m * 16 + fr) * 4, tkw[ai]);
                const unsigned yo = (tk >= 0 ? yoff + ((unsigned)(tk & 1) * (unsigned)kTok + (unsigned)(tk >> 1)) * 2048u : doff) + (unsigned)col0 * 2u;
#pragma unroll
                for (int bj = 0; bj < 2; ++bj) *(u32x4*)(B + (size_t)(yo + (unsigned)(bj * HALF * 2))) = pack8(acc[ai][bj][m][0], acc[ai][bj][m][1]);
                asm volatile("" ::: "memory"); }
    }
};
__device__ __forceinline__ float gelu_tanh(float x) {
    const float z = 0.7978845608028654f * (x + 0.044715f * x * x * x);
    return x * __builtin_amdgcn_rcpf(1.0f + __builtin_amdgcn_exp2f(-2.0f * 1.4426950408889634f * z));
}
struct EpiCmp1 {
    static constexpr bool PERM = true, AFTER_DRAIN = false;
    bf16_t* HID; const float* biasF;
    __device__ __forceinline__ void operator()(const f32x4 (&acc)[2][2][4][2], const Unit& u, int wr, int wc, int fr, int fq) const {
        const int row0 = u.pm * BM + wr * 64 + fr;
#pragma unroll
        for (int bj = 0; bj < 2; ++bj) { const int col = bj * HALF + wc * 32 + 8 * fq;
            const f32x4 b0 = *(const f32x4*)(biasF + u.pn * 256 + col), b1 = *(const f32x4*)(biasF + u.pn * 256 + col + 4);
#pragma unroll
            for (int ai = 0; ai < 2; ++ai)
#pragma unroll
                for (int m = 0; m < 4; ++m) { const int row = row0 + ai * HALF + m * 16; f32x4 v0 = acc[ai][bj][m][0] + b0, v1 = acc[ai][bj][m][1] + b1;
#pragma unroll
                    for (int i = 0; i < 4; ++i) { v0[i] = gelu_tanh(v0[i]); v1[i] = gelu_tanh(v1[i]); }
                    *(u32x4*)(HID + (size_t)row * 256 + col) = pack8(v0, v1); } }
    }
};
struct EpiCmp2 {
    static constexpr bool PERM = true, AFTER_DRAIN = false;
    unsigned char* KC8; unsigned char* VC8;
    __device__ __forceinline__ void operator()(const f32x4 (&acc)[2][2][4][2], const Unit& u, int wr, int wc, int fr, int fq) const {
        if (wc >= 2) return;
        const int row0 = u.pm * BM + wr * 64 + fr, kv = u.pn;
#pragma unroll
        for (int ai = 0; ai < 2; ++ai)
#pragma unroll
            for (int m = 0; m < 4; ++m) { const int row = row0 + ai * HALF + m * 16, r2 = row - kv * 4096, bg = r2 >> 10, n = r2 & 1023, G = n >> 5, k32 = n & 31;
                const f32x4 a0 = acc[ai][0][m][0], a1 = acc[ai][0][m][1];
                int w0 = __builtin_amdgcn_cvt_pk_fp8_f32(a0[0], a0[1], 0, false); w0 = __builtin_amdgcn_cvt_pk_fp8_f32(a0[2], a0[3], w0, true);
                int w1 = __builtin_amdgcn_cvt_pk_fp8_f32(a1[0], a1[1], 0, false); w1 = __builtin_amdgcn_cvt_pk_fp8_f32(a1[2], a1[3], w1, true);
                if (kv == 0) { const int T = (k32 >> 2) & 1, mrow = ((k32 >> 3) << 2) | (k32 & 3);
                    typedef unsigned u32x2 __attribute__((ext_vector_type(2))); u32x2 w; w.x = (unsigned)w0; w.y = (unsigned)w1;
                    *(u32x2*)(KC8 + ((size_t)(bg * 32 + G) * 2 + T) * 1024 + (fq * 16 + mrow) * 16 + wc * 8) = w; }
                else { const int qq = k32 >> 3, j = k32 & 7;
                    unsigned char* vp = VC8 + ((size_t)(bg * 32 + G) * 2 + wc) * 1024 + (qq * 16 + 8 * (fq & 1)) * 16 + (fq >> 1) * 8 + j;
#pragma unroll
                    for (int i = 0; i < 8; ++i) { const unsigned x = (i < 4) ? (unsigned)w0 : (unsigned)w1; vp[i * 16] = (unsigned char)((x >> (8 * (i & 3))) & 0xffu); } } }
    }
};
struct CmpOrder {
    int G, c;
    __device__ __forceinline__ bool next(int i, Unit& u) const { const int L = i * G + c; if (L >= 32) return false; u.pm = L; u.pn = L >> 4; return true; }
    __device__ __forceinline__ void a_ready(const Unit&) const {}
    __device__ __forceinline__ void done(const Unit&) const {}
};
struct MoeOrder {
    const PG8_LAS int* tpre; int npn, G, c;
    __device__ __forceinline__ bool next(int i, Unit& u) const {
        const int L = i * G + c, total = __builtin_amdgcn_readfirstlane(tpre[32]) * npn; if (L >= total) return false;
        const int rt = L / npn, pl = L - rt * npn; int e = 0;
#pragma unroll
        for (int st = 16; st >= 1; st >>= 1) { const int v = __builtin_amdgcn_readfirstlane(tpre[e + st]); e += (rt >= v) ? st : 0; }
        u.pm = __builtin_amdgcn_readfirstlane(rt); u.pn = __builtin_amdgcn_readfirstlane(e * npn + pl); u.e = e; u.ti = __builtin_amdgcn_readfirstlane(rt - tpre[e]); u.cnt = __builtin_amdgcn_readfirstlane(tpre[40 + e]); return true;
    }
    __device__ __forceinline__ void a_ready(const Unit&) const {}
    __device__ __forceinline__ void done(const Unit&) const {}
};

template <class Epi, class Sched, bool ALIGN_EPI = false, bool SP2 = false, bool SWAP = false>
__device__ __forceinline__ void gemm_phase(PG8_LAS unsigned char* lds, const Gemm g, const Sched& S, const Epi& E) {
    const int tid = threadIdx.x, wid = __builtin_amdgcn_readfirstlane(tid >> 6), lane = tid & 63, wr = wid >> 2, wc = wid & 3, fr = lane & 15, fq = lane >> 4;
    const int K = g.K, nt = K / BK;
    unsigned voffA[2], voffB[2];
#pragma unroll
    for (int i = 0; i < 2; ++i) { int R, C; stage_rc(tid * 16 + i * 8192, R, C); const int Rb = Epi::PERM ? ((R & ~31) + perm32(R & 31)) : R;
        voffA[i] = (unsigned)(R * g.lda + C) * 2u; voffB[i] = (unsigned)(Rb * K + C) * 2u; }
    const size_t kstep = (size_t)(BK * 2);
    const size_t hstep = (size_t)HALF * K * 2;
    const size_t tstep = 2 * hstep; const size_t hstepA = (size_t)HALF * g.lda * 2, tstepA = 2 * hstepA;
    const unsigned ldsw = (unsigned)wid * 1024u;
    const int aoff = lds_byte(wr * 64 + fr, fq * 8), boff = lds_byte(wc * 32 + fr, fq * 8);
#define PG8_SA(b, h) (((b) * 2 + (h)) * HTB)
#define PG8_SB(b, h) ((4 + (b) * 2 + (h)) * HTB)
#define PG8_STAGE(bufoff, gbase, voff) do { _Pragma("unroll") for (int _i = 0; _i < 2; ++_i) \
        __builtin_amdgcn_global_load_lds((const unsigned*)((const char*)(gbase) + (voff)[_i]), (PG8_LAS unsigned*)(lds + (bufoff) + ldsw + _i * 8192), 16, 0, 0); } while (0)
#define PG8_LDA(dst, b, h) do { _Pragma("unroll") for (int m = 0; m < 4; ++m) _Pragma("unroll") for (int k = 0; k < 2; ++k) dst[m][k] = *(const PG8_LAS bf16x8*)(lds + PG8_SA(b, h) + aoff + m * 2048 + k * 1024); } while (0)
#define PG8_LDB(dst, b, h) do { _Pragma("unroll") for (int n = 0; n < 2; ++n) _Pragma("unroll") for (int k = 0; k < 2; ++k) dst[n][k] = *(const PG8_LAS bf16x8*)(lds + PG8_SB(b, h) + boff + n * 2048 + k * 1024); } while (0)
#define PG8_MMA(ai, bj, At, Bt) do { __builtin_amdgcn_s_setprio(1); _Pragma("unroll") for (int m = 0; m < 4; ++m) _Pragma("unroll") for (int n = 0; n < 2; ++n) _Pragma("unroll") for (int k = 0; k < 2; ++k) \
        acc[ai][bj][m][n] = SWAP ? __builtin_amdgcn_mfma_f32_16x16x32_bf16(At[m][k], Bt[n][k], acc[ai][bj][m][n], 0, 0, 0) : __builtin_amdgcn_mfma_f32_16x16x32_bf16(Bt[n][k], At[m][k], acc[ai][bj][m][n], 0, 0, 0); __builtin_amdgcn_s_setprio(0); } while (0)
#define PG8_WAIT_V(n) asm volatile("s_waitcnt vmcnt(" #n ")" ::: "memory")
#define PG8_WAIT_L(n) asm volatile("s_waitcnt lgkmcnt(" #n ")" ::: "memory")
#define PG8_BAR __builtin_amdgcn_s_barrier()
#define PG8_SCHED __builtin_amdgcn_sched_barrier(0)
    Unit cur, nxt; int ui = 0;
    if (!S.next(0, cur)) return;
    f32x4 acc[2][2][4][2];
#pragma unroll
    for (int a = 0; a < 2; ++a)
#pragma unroll
        for (int b = 0; b < 2; ++b)
#pragma unroll
            for (int m = 0; m < 4; ++m)
#pragma unroll
                for (int n = 0; n < 2; ++n) acc[a][b][m][n] = (f32x4){0.f, 0.f, 0.f, 0.f};
    bf16x8 At[4][2], B0[2][2], B1[2][2];
    const char* cA = (const char*)g.A + (size_t)cur.pm * tstepA; const char* cB = (const char*)g.Bt + (size_t)cur.pn * tstep;
    S.a_ready(cur);
    if constexpr (SP2) {
        PG8_STAGE(PG8_SB(0, 0), cB, voffB); PG8_STAGE(PG8_SB(0, 1), cB + hstep, voffB); PG8_STAGE(PG8_SA(0, 0), cA, voffA); PG8_STAGE(PG8_SA(0, 1), cA + hstepA, voffA);
        if (wr == 1) PG8_BAR;
        PG8_WAIT_V(2); PG8_BAR;
        PG8_STAGE(PG8_SB(1, 0), cB + kstep, voffB); PG8_STAGE(PG8_SA(1, 0), cA + kstep, voffA); PG8_STAGE(PG8_SB(1, 1), cB + hstep + kstep, voffB);
        PG8_WAIT_V(6); PG8_BAR;
    } else {
        PG8_STAGE(PG8_SB(0, 0), cB, voffB); PG8_STAGE(PG8_SA(0, 0), cA, voffA); PG8_STAGE(PG8_SB(0, 1), cB + hstep, voffB); PG8_STAGE(PG8_SA(0, 1), cA + hstepA, voffA);
        if (wr == 1) PG8_BAR;
        PG8_WAIT_V(4); PG8_BAR;
        PG8_STAGE(PG8_SB(1, 0), cB + kstep, voffB); PG8_STAGE(PG8_SA(1, 0), cA + kstep, voffA); PG8_STAGE(PG8_SB(1, 1), cB + hstep + kstep, voffB);
        PG8_WAIT_V(6); PG8_BAR;
    }
    for (;;) {
        const bool has_next = S.next(ui + 1, nxt);
        const char* nA = has_next ? (const char*)g.A + (size_t)nxt.pm * tstepA : cA; const char* nB = has_next ? (const char*)g.Bt + (size_t)nxt.pn * tstep : cB;
        for (int t = 0; t < nt; t += 2) {
            const bool last = (t == nt - 2);
            const char* a1 = cA + (size_t)(t + 1) * kstep;
            const char* a2 = last ? nA : cA + (size_t)(t + 2) * kstep; const char* b2 = last ? nB : cB + (size_t)(t + 2) * kstep;
            const char* a3 = a2 + kstep; const char* b3 = b2 + kstep;
            if (last && has_next) S.a_ready(nxt);
            if constexpr (SP2) {
            PG8_LDB(B0, 0, 0); PG8_LDB(B1, 0, 1); PG8_SCHED; PG8_LDA(At, 0, 0); PG8_STAGE(PG8_SA(1, 1), a1 + hstepA, voffA);
            PG8_WAIT_V(8); PG8_WAIT_L(0); PG8_BAR; PG8_MMA(0, 0, At, B0); PG8_MMA(0, 1, At, B1); PG8_BAR; PG8_SCHED;
            PG8_LDA(At, 0, 1); PG8_STAGE(PG8_SB(0, 0), b2, voffB); PG8_STAGE(PG8_SB(0, 1), b2 + hstep, voffB); PG8_STAGE(PG8_SA(0, 0), a2, voffA);
            PG8_WAIT_V(8); PG8_WAIT_L(0); PG8_BAR; PG8_MMA(1, 0, At, B0); PG8_MMA(1, 1, At, B1); PG8_BAR; PG8_SCHED;
            PG8_LDB(B0, 1, 0); PG8_LDB(B1, 1, 1); PG8_SCHED; PG8_LDA(At, 1, 0); PG8_STAGE(PG8_SA(0, 1), a2 + hstepA, voffA);
            PG8_WAIT_V(8); PG8_WAIT_L(0); PG8_BAR; PG8_MMA(0, 0, At, B0); PG8_MMA(0, 1, At, B1); PG8_BAR; PG8_SCHED;
            PG8_LDA(At, 1, 1); PG8_STAGE(PG8_SB(1, 0), b3, voffB); PG8_STAGE(PG8_SB(1, 1), b3 + hstep, voffB); PG8_STAGE(PG8_SA(1, 0), a3, voffA);
            PG8_WAIT_V(8); PG8_WAIT_L(0); PG8_BAR; PG8_MMA(1, 0, At, B0); PG8_MMA(1, 1, At, B1); PG8_BAR; PG8_SCHED;
            } else {
            PG8_LDB(B0, 0, 0); PG8_SCHED; PG8_LDA(At, 0, 0); PG8_STAGE(PG8_SA(1, 1), a1 + hstepA, voffA);
            PG8_WAIT_L(8); PG8_BAR; PG8_WAIT_L(0); PG8_MMA(0, 0, At, B0); PG8_BAR; PG8_SCHED;
            PG8_LDB(B1, 0, 1); PG8_STAGE(PG8_SB(0, 0), b2, voffB);
            PG8_BAR; PG8_WAIT_L(0); PG8_MMA(0, 1, At, B1); PG8_BAR;
            PG8_LDA(At, 0, 1); PG8_STAGE(PG8_SA(0, 0), a2, voffA);
            PG8_BAR; PG8_WAIT_L(0); PG8_MMA(1, 0, At, B0); PG8_BAR; PG8_SCHED;
            PG8_STAGE(PG8_SB(0, 1), b2 + hstep, voffB);
            PG8_WAIT_V(6); PG8_BAR; PG8_MMA(1, 1, At, B1); PG8_BAR;
            PG8_LDB(B0, 1, 0); PG8_SCHED; PG8_LDA(At, 1, 0); PG8_STAGE(PG8_SA(0, 1), a2 + hstepA, voffA);
            PG8_WAIT_L(8); PG8_BAR; PG8_WAIT_L(0); PG8_MMA(0, 0, At, B0); PG8_BAR; PG8_SCHED;
            PG8_LDB(B1, 1, 1); PG8_STAGE(PG8_SB(1, 0), b3, voffB);
            PG8_BAR; PG8_WAIT_L(0); PG8_MMA(0, 1, At, B1); PG8_BAR;
            PG8_LDA(At, 1, 1); PG8_STAGE(PG8_SA(1, 0), a3, voffA);
            PG8_BAR; PG8_WAIT_L(0); PG8_MMA(1, 0, At, B0); PG8_BAR; PG8_SCHED;
            PG8_STAGE(PG8_SB(1, 1), b3 + hstep, voffB);
            PG8_WAIT_V(6); PG8_BAR; PG8_MMA(1, 1, At, B1); PG8_BAR;
            }
        }
        if constexpr (ALIGN_EPI) { if (wr == 0) PG8_BAR; }
        if constexpr (!Epi::AFTER_DRAIN) { E(acc, cur, wr, wc, fr, fq); S.done(cur); }
        if (!has_next) break;
#pragma unroll
        for (int a = 0; a < 2; ++a)
#pragma unroll
            for (int b = 0; b < 2; ++b)
#pragma unroll
                for (int m = 0; m < 4; ++m)
#pragma unroll
                    for (int n = 0; n < 2; ++n) acc[a][b][m][n] = (f32x4){0.f, 0.f, 0.f, 0.f};
        cur = nxt; cA = nA; cB = nB; ++ui;
        if constexpr (ALIGN_EPI) { if (wr == 1) PG8_BAR; }
    }
    PG8_WAIT_V(0);
    if constexpr (!ALIGN_EPI) { if (wr == 0) PG8_BAR; }
    PG8_BAR;
    if constexpr (Epi::AFTER_DRAIN) { E.fused(acc, cur, wr, wc, fr, fq, lds, wid, lane); S.done(cur); }
#undef PG8_SA
#undef PG8_SB
#undef PG8_STAGE
#undef PG8_LDA
#undef PG8_LDB
#undef PG8_MMA
#undef PG8_WAIT_V
#undef PG8_WAIT_L
#undef PG8_BAR
#undef PG8_SCHED
}
template <class Epi, class Sched, bool ALIGN_EPI = false>
__device__ __forceinline__ void gemm_phase_g(PG8_LAS unsigned char* lds, const Gemm g, const Sched& S, const Epi& E, const PG8_LAS unsigned* gtab) {
    constexpr bool SP2 = true;
    const int tid = threadIdx.x, wid = __builtin_amdgcn_readfirstlane(tid >> 6), lane = tid & 63, wr = wid >> 2, wc = wid & 3, fr = lane & 15, fq = lane >> 4;
    const int K = g.K, nt = K / BK;
    unsigned voffB[2], cofsA[2]; int rowA[2];
#pragma unroll
    for (int i = 0; i < 2; ++i) { int R, C; stage_rc(tid * 16 + i * 8192, R, C); const int Rb = Epi::PERM ? ((R & ~31) + perm32(R & 31)) : R;
        rowA[i] = R; cofsA[i] = (unsigned)C * 2u; voffB[i] = (unsigned)(Rb * K + C) * 2u; }
    unsigned vC0[2], vC1[2], vN0[2], vN1[2];
#define PG8_GV(dst0, dst1, u_) do { _Pragma("unroll") for (int _i = 0; _i < 2; ++_i) { dst0[_i] = gtab[(u_) * 256 + rowA[_i]] + cofsA[_i]; dst1[_i] = gtab[(u_) * 256 + 128 + rowA[_i]] + cofsA[_i]; } } while (0)
    const size_t kstep = (size_t)(BK * 2);
    const size_t hstep = (size_t)HALF * K * 2;
    const size_t tstep = 2 * hstep; const size_t hstepA = (size_t)HALF * g.lda * 2, tstepA = 2 * hstepA;
    const unsigned ldsw = (unsigned)wid * 1024u;
    const int aoff = lds_byte(wr * 64 + fr, fq * 8), boff = lds_byte(wc * 32 + fr, fq * 8);
#define PG8_SA(b, h) (((b) * 2 + (h)) * HTB)
#define PG8_SB(b, h) ((4 + (b) * 2 + (h)) * HTB)
#define PG8_STAGE(bufoff, gbase, voff) do { _Pragma("unroll") for (int _i = 0; _i < 2; ++_i) \
        __builtin_amdgcn_global_load_lds((const unsigned*)((const char*)(gbase) + (voff)[_i]), (PG8_LAS unsigned*)(lds + (bufoff) + ldsw + _i * 8192), 16, 0, 0); } while (0)
#define PG8_LDA(dst, b, h) do { _Pragma("unroll") for (int m = 0; m < 4; ++m) _Pragma("unroll") for (int k = 0; k < 2; ++k) dst[m][k] = *(const PG8_LAS bf16x8*)(lds + PG8_SA(b, h) + aoff + m * 2048 + k * 1024); } while (0)
#define PG8_LDB(dst, b, h) do { _Pragma("unroll") for (int n = 0; n < 2; ++n) _Pragma("unroll") for (int k = 0; k < 2; ++k) dst[n][k] = *(const PG8_LAS bf16x8*)(lds + PG8_SB(b, h) + boff + n * 2048 + k * 1024); } while (0)
#define PG8_MMA(ai, bj, At, Bt) do { __builtin_amdgcn_s_setprio(1); _Pragma("unroll") for (int m = 0; m < 4; ++m) _Pragma("unroll") for (int n = 0; n < 2; ++n) _Pragma("unroll") for (int k = 0; k < 2; ++k) \
        acc[ai][bj][m][n] = __builtin_amdgcn_mfma_f32_16x16x32_bf16(Bt[n][k], At[m][k], acc[ai][bj][m][n], 0, 0, 0); __builtin_amdgcn_s_setprio(0); } while (0)
#define PG8_WAIT_V(n) asm volatile("s_waitcnt vmcnt(" #n ")" ::: "memory")
#define PG8_WAIT_L(n) asm volatile("s_waitcnt lgkmcnt(" #n ")" ::: "memory")
#define PG8_BAR __builtin_amdgcn_s_barrier()
#define PG8_SCHED __builtin_amdgcn_sched_barrier(0)
    Unit cur, nxt; int ui = 0;
    if (!S.next(0, cur)) return;
    f32x4 acc[2][2][4][2];
#pragma unroll
    for (int a = 0; a < 2; ++a)
#pragma unroll
        for (int b = 0; b < 2; ++b)
#pragma unroll
            for (int m = 0; m < 4; ++m)
#pragma unroll
                for (int n = 0; n < 2; ++n) acc[a][b][m][n] = (f32x4){0.f, 0.f, 0.f, 0.f};
    bf16x8 At[4][2], B0[2][2], B1[2][2];
    const char* cA = (const char*)g.A; const char* cB = (const char*)g.Bt + (size_t)cur.pn * tstep;
    PG8_GV(vC0, vC1, 0);
    S.a_ready(cur);
    if constexpr (SP2) {
        PG8_STAGE(PG8_SB(0, 0), cB, voffB); PG8_STAGE(PG8_SB(0, 1), cB + hstep, voffB); PG8_STAGE(PG8_SA(0, 0), cA, vC0); PG8_STAGE(PG8_SA(0, 1), cA, vC1);
        if (wr == 1) PG8_BAR;
        PG8_WAIT_V(2); PG8_BAR;
        PG8_STAGE(PG8_SB(1, 0), cB + kstep, voffB); PG8_STAGE(PG8_SA(1, 0), cA + kstep, vC0); PG8_STAGE(PG8_SB(1, 1), cB + hstep + kstep, voffB);
        PG8_WAIT_V(6); PG8_BAR;
    } else {
        PG8_STAGE(PG8_SB(0, 0), cB, voffB); PG8_STAGE(PG8_SA(0, 0), cA, vC0); PG8_STAGE(PG8_SB(0, 1), cB + hstep, voffB); PG8_STAGE(PG8_SA(0, 1), cA, vC1);
        if (wr == 1) PG8_BAR;
        PG8_WAIT_V(4); PG8_BAR;
        PG8_STAGE(PG8_SB(1, 0), cB + kstep, voffB); PG8_STAGE(PG8_SA(1, 0), cA + kstep, vC0); PG8_STAGE(PG8_SB(1, 1), cB + hstep + kstep, voffB);
        PG8_WAIT_V(6); PG8_BAR;
    }
    for (;;) {
        const bool has_next = S.next(ui + 1, nxt);
        const char* nA = cA; const char* nB = has_next ? (const char*)g.Bt + (size_t)nxt.pn * tstep : cB;
        if (has_next) PG8_GV(vN0, vN1, ui + 1); else { _Pragma("unroll") for (int _i = 0; _i < 2; ++_i) { vN0[_i] = vC0[_i]; vN1[_i] = vC1[_i]; } }
        for (int t = 0; t < nt; t += 2) {
            const bool last = (t == nt - 2);
            const char* a1 = cA + (size_t)(t + 1) * kstep;
            const unsigned va0[2] = {last ? vN0[0] : vC0[0], last ? vN0[1] : vC0[1]}, va1[2] = {last ? vN1[0] : vC1[0], last ? vN1[1] : vC1[1]};
            const char* a2 = last ? nA : cA + (size_t)(t + 2) * kstep; const char* b2 = last ? nB : cB + (size_t)(t + 2) * kstep;
            const char* a3 = a2 + kstep; const char* b3 = b2 + kstep;
            if (last && has_next) S.a_ready(nxt);
            if constexpr (SP2) {
            PG8_LDB(B0, 0, 0); PG8_LDB(B1, 0, 1); PG8_SCHED; PG8_LDA(At, 0, 0); PG8_STAGE(PG8_SA(1, 1), a1, vC1);
            PG8_WAIT_V(8); PG8_WAIT_L(0); PG8_BAR; PG8_MMA(0, 0, At, B0); PG8_MMA(0, 1, At, B1); PG8_BAR; PG8_SCHED;
            PG8_LDA(At, 0, 1); PG8_STAGE(PG8_SB(0, 0), b2, voffB); PG8_STAGE(PG8_SB(0, 1), b2 + hstep, voffB); PG8_STAGE(PG8_SA(0, 0), a2, va0);
            PG8_WAIT_V(8); PG8_WAIT_L(0); PG8_BAR; PG8_MMA(1, 0, At, B0); PG8_MMA(1, 1, At, B1); PG8_BAR; PG8_SCHED;
            PG8_LDB(B0, 1, 0); PG8_LDB(B1, 1, 1); PG8_SCHED; PG8_LDA(At, 1, 0); PG8_STAGE(PG8_SA(0, 1), a2, va1);
            PG8_WAIT_V(8); PG8_WAIT_L(0); PG8_BAR; PG8_MMA(0, 0, At, B0); PG8_MMA(0, 1, At, B1); PG8_BAR; PG8_SCHED;
            PG8_LDA(At, 1, 1); PG8_STAGE(PG8_SB(1, 0), b3, voffB); PG8_STAGE(PG8_SB(1, 1), b3 + hstep, voffB); PG8_STAGE(PG8_SA(1, 0), a3, va0);
            PG8_WAIT_V(8); PG8_WAIT_L(0); PG8_BAR; PG8_MMA(1, 0, At, B0); PG8_MMA(1, 1, At, B1); PG8_BAR; PG8_SCHED;
            } else {
            PG8_LDB(B0, 0, 0); PG8_SCHED; PG8_LDA(At, 0, 0); PG8_STAGE(PG8_SA(1, 1), a1, vC1);
            PG8_WAIT_L(8); PG8_BAR; PG8_WAIT_L(0); PG8_MMA(0, 0, At, B0); PG8_BAR; PG8_SCHED;
            PG8_LDB(B1, 0, 1); PG8_STAGE(PG8_SB(0, 0), b2, voffB);
            PG8_BAR; PG8_WAIT_L(0); PG8_MMA(0, 1, At, B1); PG8_BAR;
            PG8_LDA(At, 0, 1); PG8_STAGE(PG8_SA(0, 0), a2, va0);
            PG8_BAR; PG8_WAIT_L(0); PG8_MMA(1, 0, At, B0); PG8_BAR; PG8_SCHED;
            PG8_STAGE(PG8_SB(0, 1), b2 + hstep, voffB);
            PG8_WAIT_V(6); PG8_BAR; PG8_MMA(1, 1, At, B1); PG8_BAR;
            PG8_LDB(B0, 1, 0); PG8_SCHED; PG8_LDA(At, 1, 0); PG8_STAGE(PG8_SA(0, 1), a2, va1);
            PG8_WAIT_L(8); PG8_BAR; PG8_WAIT_L(0); PG8_MMA(0, 0, At, B0); PG8_BAR; PG8_SCHED;
            PG8_LDB(B1, 1, 1); PG8_STAGE(PG8_SB(1, 0), b3, voffB);
            PG8_BAR; PG8_WAIT_L(0); PG8_MMA(0, 1, At, B1); PG8_BAR;
            PG8_LDA(At, 1, 1); PG8_STAGE(PG8_SA(1, 0), a3, va0);
            PG8_BAR; PG8_WAIT_L(0); PG8_MMA(1, 0, At, B0); PG8_BAR; PG8_SCHED;
            PG8_STAGE(PG8_SB(1, 1), b3 + hstep, voffB);
            PG8_WAIT_V(6); PG8_BAR; PG8_MMA(1, 1, At, B1); PG8_BAR;
            }
        }
        if constexpr (ALIGN_EPI) { if (wr == 0) PG8_BAR; }
        if constexpr (!Epi::AFTER_DRAIN) { E(acc, cur, wr, wc, fr, fq); S.done(cur); }
        if (!has_next) break;
#pragma unroll
        for (int a = 0; a < 2; ++a)
#pragma unroll
            for (int b = 0; b < 2; ++b)
#pragma unroll
                for (int m = 0; m < 4; ++m)
#pragma unroll
                    for (int n = 0; n < 2; ++n) acc[a][b][m][n] = (f32x4){0.f, 0.f, 0.f, 0.f};
        cur = nxt; cA = nA; cB = nB; ++ui;
        { _Pragma("unroll") for (int _i = 0; _i < 2; ++_i) { vC0[_i] = vN0[_i]; vC1[_i] = vN1[_i]; } }
        if constexpr (ALIGN_EPI) { if (wr == 1) PG8_BAR; }
    }
    PG8_WAIT_V(0);
    if constexpr (!ALIGN_EPI) { if (wr == 0) PG8_BAR; }
    PG8_BAR;
    if constexpr (Epi::AFTER_DRAIN) { E.fused(acc, cur, wr, wc, fr, fq, lds, wid, lane); S.done(cur); }
#undef PG8_SA
#undef PG8_SB
#undef PG8_STAGE
#undef PG8_LDA
#undef PG8_LDB
#undef PG8_MMA
#undef PG8_WAIT_V
#undef PG8_WAIT_L
#undef PG8_BAR
#undef PG8_SCHED
#undef PG8_GV
}

}

#include <hip/hip_bf16.h>
#include <cmath>
namespace attn_body {
using bf16=__hip_bfloat16;
using bf16x8=__attribute__((ext_vector_type(8)))short;
using s16x4=__attribute__((ext_vector_type(4)))short;
using f32x16=__attribute__((ext_vector_type(16)))float;
using u32x4=__attribute__((ext_vector_type(4)))unsigned;
constexpr int BATCH=2,NHEAD=16,SEQ=16384,D=64,DM=NHEAD*D;
constexpr int NW=8,QBLK=32,QB=QBLK*NW,KVBLK=64,NQB=SEQ/QB;
constexpr int ATTN_PITCH=DM, ATTN_UNIT_ROWS=QB;
__device__ __forceinline__ int crow(int r,int hi){return (r&3)+8*(r>>2)+4*hi;}
#define SBAR() __builtin_amdgcn_sched_barrier(0)
__device__ __forceinline__ void cmask(f32x16&p0,f32x16&p1,int jb,int qrel,int hi){
  const float NEG=-INFINITY; int kb=64*jb+4*hi;
  #pragma unroll
  for(int r=0;r<16;++r){int kv=kb+(r&3)+8*(r>>2); if(kv>qrel)p0[r]=NEG; if(kv+32>qrel)p1[r]=NEG;}
}

constexpr int NSLOT=3, SLOTB=8192;
constexpr int LDS_K=0, LDS_V=NSLOT*SLOTB, LDS_WS=2*NSLOT*SLOTB, LDS_OST=LDS_WS+NW*64*4, LDS_BYTES=LDS_OST+NW*4096;
constexpr float C2=0.125f*1.4426950408889634f;
__device__ __forceinline__ void glds16(const void*gsrc,unsigned lds_dst){unsigned keep;
  asm volatile("s_mov_b32 %0, m0\n\ts_mov_b32 m0, %2\n\ts_nop 0\n\tglobal_load_lds_dwordx4 %1, off\n\ts_mov_b32 m0, %0":"=&s"(keep):"v"(gsrc),"s"(lds_dst):"memory");}
__device__ __forceinline__ float max3f(float a,float b,float c){float r;asm("v_max3_f32 %0, %1, %2, %3":"=v"(r):"v"(a),"v"(b),"v"(c));return r;}
__device__ __forceinline__ float max2f(float a,float b){float r;asm("v_max_f32_e32 %0, %1, %2":"=v"(r):"v"(a),"v"(b));return r;}
__device__ __forceinline__ float fadd_s(float a,float b){float r;asm("v_add_f32_e32 %0, %1, %2":"=v"(r):"v"(a),"v"(b));return r;}
__device__ __forceinline__ float fsub_s(float a,float b){float r;asm("v_sub_f32_e32 %0, %1, %2":"=v"(r):"v"(a),"v"(b));return r;}
typedef float f32x2_t __attribute__((ext_vector_type(2))); typedef __bf16 bf16x2_t __attribute__((ext_vector_type(2)));
__device__ __forceinline__ unsigned cvtpk_s(float lo,float hi){f32x2_t v={lo,hi};bf16x2_t b=__builtin_convertvector(v,bf16x2_t);return __builtin_bit_cast(unsigned,b);}
#define WAIT_BAR(N) asm volatile("s_waitcnt vmcnt(" #N ") lgkmcnt(0)\n\ts_barrier":::"memory")

__device__ __forceinline__ void qkt(f32x16&p0,f32x16&p1,const char*Kslot,const bf16x8*qr,const f32x16&negm,int r32,int hi){
  const char*kb=Kslot+hi*1024+r32*16;
  #pragma unroll
  for(int d0=0;d0<4;++d0){
    const bf16x8 b0=*reinterpret_cast<const bf16x8*>(kb+d0*2048);
    const bf16x8 b1=*reinterpret_cast<const bf16x8*>(kb+d0*2048+512);
    if(d0==0){p0=__builtin_amdgcn_mfma_f32_32x32x16_bf16(b0,qr[0],negm,0,0,0);p1=__builtin_amdgcn_mfma_f32_32x32x16_bf16(b1,qr[0],negm,0,0,0);}
    else{p0=__builtin_amdgcn_mfma_f32_32x32x16_bf16(b0,qr[d0],p0,0,0,0);p1=__builtin_amdgcn_mfma_f32_32x32x16_bf16(b1,qr[d0],p1,0,0,0);}}
}
typedef __attribute__((address_space(3))) const char* lds_cptr;
typedef short v4i16_t __attribute__((ext_vector_type(4)));
__device__ __forceinline__ void kload8(bf16x8*kf,lds_cptr kp){
  kf[0]=*(const __attribute__((address_space(3))) bf16x8*)(kp);      kf[1]=*(const __attribute__((address_space(3))) bf16x8*)(kp+512);
  kf[2]=*(const __attribute__((address_space(3))) bf16x8*)(kp+2048); kf[3]=*(const __attribute__((address_space(3))) bf16x8*)(kp+2560);
  kf[4]=*(const __attribute__((address_space(3))) bf16x8*)(kp+4096); kf[5]=*(const __attribute__((address_space(3))) bf16x8*)(kp+4608);
  kf[6]=*(const __attribute__((address_space(3))) bf16x8*)(kp+6144); kf[7]=*(const __attribute__((address_space(3))) bf16x8*)(kp+6656);
}
__device__ __forceinline__ void kload2(bf16x8*kf,lds_cptr kp,int j){ kf[2*j]=*(const __attribute__((address_space(3))) bf16x8*)(kp+j*2048); kf[2*j+1]=*(const __attribute__((address_space(3))) bf16x8*)(kp+j*2048+512); }
__device__ __forceinline__ s16x4 vtr(lds_cptr p){ return __builtin_bit_cast(s16x4,__builtin_amdgcn_ds_read_tr16_b64_v4i16((__attribute__((address_space(3))) v4i16_t*)p)); }
__device__ __forceinline__ float rowmax(const f32x16&p0,const f32x16&p1){
  float a=max3f(p0[0],p0[1],p1[0]),b=max3f(p0[2],p0[3],p1[1]);a=max3f(a,p1[2],p1[3]);
  #pragma unroll
  for(int r=4;r<16;r+=4){a=max3f(a,p0[r],p0[r+1]);b=max3f(b,p0[r+2],p0[r+3]);a=max3f(a,p1[r],p1[r+1]);b=max3f(b,p1[r+2],p1[r+3]);}
  const float m=max2f(a,b);
  auto rr=__builtin_amdgcn_permlane32_swap(__float_as_uint(m),__float_as_uint(m),false,false);
  return max2f(__uint_as_float(rr[0]),__uint_as_float(rr[1]));
}
__device__ __forceinline__ void pv(f32x16*o,int vb,bf16x8 pa0,bf16x8 pa1,bf16x8 pa2,bf16x8 pa3){
  #pragma unroll
  for(int d0=0;d0<2;++d0){s16x4 lo[4],hi[4];
    #pragma unroll
    for(int ks=0;ks<4;++ks){
      asm volatile("ds_read_b64_tr_b16 %0,%1 offset:%c2":"=&v"(lo[ks]):"v"(vb),"i"(d0*4096+ks*1024):"memory");
      asm volatile("ds_read_b64_tr_b16 %0,%1 offset:%c2":"=&v"(hi[ks]):"v"(vb),"i"(d0*4096+ks*1024+512):"memory");}
    asm volatile("s_waitcnt lgkmcnt(0)":::"memory");SBAR();
    #define PK(k) (bf16x8){lo[k][0],lo[k][1],lo[k][2],lo[k][3],hi[k][0],hi[k][1],hi[k][2],hi[k][3]}
    o[d0]=__builtin_amdgcn_mfma_f32_32x32x16_bf16(pa0,PK(0),o[d0],0,0,0);
    o[d0]=__builtin_amdgcn_mfma_f32_32x32x16_bf16(pa1,PK(1),o[d0],0,0,0);
    o[d0]=__builtin_amdgcn_mfma_f32_32x32x16_bf16(pa2,PK(2),o[d0],0,0,0);
    o[d0]=__builtin_amdgcn_mfma_f32_32x32x16_bf16(pa3,PK(3),o[d0],0,0,0);
    #undef PK
  }
}

#ifndef ATTN_STORE16
#define ATTN_STORE16(p,v) (*(u32x4*)(p)=(v))
#endif
template<int THRL> __device__ __forceinline__ void attn_unit(int b,int h,int qb,const bf16*Q,const bf16*__restrict__ K,const bf16*__restrict__ V,bf16*O,char*shm){
  int tid_=threadIdx.x; asm volatile("":"+v"(tid_)); const int tid=tid_,lane=tid&63,r32=lane&31,hi=lane>>5; const int wid=__builtin_amdgcn_readfirstlane(tid>>6);
  const long rowbase=(long)b*SEQ; const int q0=qb*QB;
  const bf16*Qw=Q+(rowbase+q0+wid*QBLK)*DM+h*D;
  const bf16*Kh=K+rowbase*DM+h*D,*Vh=V+rowbase*DM+h*D;
  const unsigned lds0=(unsigned)(uintptr_t)shm;
  float*wsf=(float*)(shm+LDS_WS)+wid*64;
  const bf16*ksrc=Kh+(long)lane*DM+wid*8;
  const bf16*vsrc=Vh+(long)(16*(wid&3)+(lane>>2))*DM+(wid>>2)*32+(lane&3)*8;
  const unsigned kdst=lds0+LDS_K+wid*1024, vdst=lds0+LDS_V+wid*1024;
  #define DMA_K(t,slot) glds16(ksrc+(long)(t)*KVBLK*DM,(unsigned)__builtin_amdgcn_readfirstlane(kdst+(slot)))
  #define DMA_V(t,slot) glds16(vsrc+(long)(t)*KVBLK*DM,(unsigned)__builtin_amdgcn_readfirstlane(vdst+(slot)))
  const int vb0=(int)(lds0+LDS_V)+((lane>>4)&1)*32+(lane&3)*8+(4*hi+((lane&15)>>2))*64;
  const char*Kbase=shm+LDS_K; bf16x8 kf[8];
  const lds_cptr shm3=(lds_cptr)shm; const lds_cptr kp0=shm3+LDS_K+hi*1024+r32*16; const lds_cptr vp0=shm3+LDS_V+((lane>>4)&1)*32+(lane&3)*8+(4*hi+((lane&15)>>2))*64;
  const int NT=(q0+QB)/KVBLK;
  DMA_K(0,0);DMA_V(0,0);DMA_K(1,SLOTB);
  bf16x8 qr[4];
  #pragma unroll
  for(int d0=0;d0<4;++d0)qr[d0]=*reinterpret_cast<const bf16x8*>(&Qw[(long)r32*DM+d0*16+hi*8]);
  float mhat=0.f,l_reg=0.f;f32x16 o[2];o[0]=f32x16{};o[1]=f32x16{};f32x16 negm=f32x16{};asm volatile("":"+v"(negm));
  const int qrel=wid*QBLK+r32;
  #define CMASK(P0,P1,t) do{int jb_=(t)-(NT-4); if(jb_>=0)cmask(P0,P1,jb_,qrel,hi);}while(0)
  bool resc=false;
  #define START(P0,P1) do{ const float rm=rowmax(P0,P1); resc=false; \
    { const float dl=rm; mhat=fadd_s(mhat,dl); \
      _Pragma("unroll") for(int r=0;r<16;++r){P0[r]=fsub_s(P0[r],dl);P1[r]=fsub_s(P1[r],dl);} \
      _Pragma("unroll") for(int r=0;r<16;++r)negm[r]=-mhat; asm volatile("":"+v"(negm)); } \
    _Pragma("unroll") for(int r=0;r<16;++r)P0[r]=__builtin_amdgcn_exp2f(P0[r]); }while(0)
  #define RESC() do{ if(resc){ asm volatile("s_waitcnt lgkmcnt(0)":::"memory"); \
      _Pragma("unroll") for(int d_=0;d_<2;++d_) _Pragma("unroll") for(int r=0;r<16;++r)o[d_][r]*=wsf[crow(r,hi)]; } }while(0)
  f32x16 pA0,pA1,pB0,pB1;
  int sl_prev=0,sl_cur=0,sl_next=SLOTB;
  #define ROT() do{sl_prev=sl_cur;sl_cur=sl_next;sl_next=(sl_next==(NSLOT-1)*SLOTB)?0:sl_next+SLOTB;}while(0)
  DMA_K(2,2*SLOTB);
  WAIT_BAR(3);
  qkt(pA0,pA1,Kbase,qr,negm,r32,hi);asm volatile("s_nop 15\n\ts_nop 7":"+v"(pA0),"+v"(pA1));CMASK(pA0,pA1,0);
  START(pA0,pA1);
  _Pragma("unroll") for(int r=0;r<16;++r)pA1[r]=__builtin_amdgcn_exp2f(pA1[r]);
  WAIT_BAR(0);
  DMA_K(3,0);DMA_V(1,SLOTB);
  ROT();
  kload8(kf,kp0+sl_cur);
  WAIT_BAR(2);
  s16x4 vlo[8],vhi[8]; u32x4 pw0,pw1,pw2,pw3;
  #define PKW(P,B) cvtpk_s(P[B],P[B+1])
  #define PAF(k) __builtin_bit_cast(bf16x8,pw##k)
  #define VFR(i) (bf16x8){vlo[i][0],vlo[i][1],vlo[i][2],vlo[i][3],vhi[i][0],vhi[i][1],vhi[i][2],vhi[i][3]}
  #define PIN(x) asm volatile("":"+v"(x))
  #define MX3(a,b,c) __builtin_fmaxf(__builtin_fmaxf((a),(b)),(c))
  #define GAPA(MF,A0,A1,A2,A3,W0,W1,PW) do{ MF; sacc+=A0; sacc+=A1; sacc+=A2; sacc+=A3; PIN(sacc); W0; W1; PIN(PW); SBAR(); }while(0)
  #define EX(v) __builtin_amdgcn_exp2f(v)
  #define GAPB(MF,X,B) do{ MF; X[B]=EX(X[B]); X[B+1]=EX(X[B+1]); X[B+2]=EX(X[B+2]); X[B+3]=EX(X[B+3]); PIN(X); SBAR(); }while(0)
  #define VRD(i) do{ vlo[i]=vtr(vp_+(((i)>>2)*4096+((i)&3)*1024)); vhi[i]=vtr(vp_+(((i)>>2)*4096+((i)&3)*1024+512)); }while(0)
  #define KRD(G,j) do{ if(G){ kload2(kf,kp0+sl_next,j); SBAR(); } }while(0)
  #define STEP(C0,C1,P0,P1,t,GK,GV,GL) do{ SBAR(); \
    const lds_cptr vp_=vp0+sl_prev; \
    VRD(0); SBAR(); float sacc=(P0[0]+P0[1]); \
    GAPA(C0=__builtin_amdgcn_mfma_f32_32x32x16_bf16(kf[0],qr[0],negm,0,0,0), P0[2],P0[3],P0[4],P0[5],     pw0[0]=PKW(P0,0), pw0[1]=PKW(P0,2), pw0); \
    VRD(4); SBAR(); GAPA(C1=__builtin_amdgcn_mfma_f32_32x32x16_bf16(kf[1],qr[0],negm,0,0,0), P0[6],P0[7],P0[8],P0[9],     pw0[2]=PKW(P0,4), pw0[3]=PKW(P0,6), pw0); \
    VRD(1); SBAR(); GAPA(C0=__builtin_amdgcn_mfma_f32_32x32x16_bf16(kf[2],qr[1],C0,0,0,0),   P0[10],P0[11],P0[12],P0[13], pw1[0]=PKW(P0,8), pw1[1]=PKW(P0,10), pw1); \
    VRD(5); SBAR(); GAPA(C1=__builtin_amdgcn_mfma_f32_32x32x16_bf16(kf[3],qr[1],C1,0,0,0),   P0[14],P0[15],P1[0],P1[1],   pw1[2]=PKW(P0,12),pw1[3]=PKW(P0,14), pw1); \
    VRD(2); SBAR(); GAPA(C0=__builtin_amdgcn_mfma_f32_32x32x16_bf16(kf[4],qr[2],C0,0,0,0),   P1[2],P1[3],P1[4],P1[5],     pw2[0]=PKW(P1,0), pw2[1]=PKW(P1,2), pw2); \
    VRD(6); SBAR(); GAPA(C1=__builtin_amdgcn_mfma_f32_32x32x16_bf16(kf[5],qr[2],C1,0,0,0),   P1[6],P1[7],P1[8],P1[9],     pw2[2]=PKW(P1,4), pw2[3]=PKW(P1,6), pw2); \
    VRD(3); SBAR(); GAPA(C0=__builtin_amdgcn_mfma_f32_32x32x16_bf16(kf[6],qr[3],C0,0,0,0),   P1[10],P1[11],P1[12],P1[13], pw3[0]=PKW(P1,8), pw3[1]=PKW(P1,10), pw3); \
    VRD(7); SBAR(); GAPA(C1=__builtin_amdgcn_mfma_f32_32x32x16_bf16(kf[7],qr[3],C1,0,0,0),   P1[14],P1[15],0.f,0.f,       pw3[2]=PKW(P1,12),pw3[3]=PKW(P1,14), pw3); \
    l_reg+=sacc; \
    if(GK){DMA_K((t)+3,sl_cur);} if(GV){DMA_V((t)+1,sl_next);} \
    CMASK(C0,C1,t); \
    { float a=MX3(C0[0],C0[1],C1[0]),b=MX3(C0[2],C0[3],C1[1]); a=MX3(a,C1[2],C1[3]); \
      _Pragma("unroll") for(int r=4;r<16;r+=4){a=MX3(a,C0[r],C0[r+1]);b=MX3(b,C0[r+2],C0[r+3]);a=MX3(a,C1[r],C1[r+1]);b=MX3(b,C1[r+2],C1[r+3]);} \
      float rm=__builtin_fmaxf(a,b); { auto rr=__builtin_amdgcn_permlane32_swap(__float_as_uint(rm),__float_as_uint(rm),false,false); rm=__builtin_fmaxf(__uint_as_float(rr[0]),__uint_as_float(rr[1])); } \
      resc=false; \
      if(__builtin_expect(__any(rm>(float)THRL),0)){ const float dl=__builtin_fmaxf(rm,0.f); mhat+=dl; \
        _Pragma("unroll") for(int r=0;r<16;++r){C0[r]-=dl;C1[r]-=dl;} \
        _Pragma("unroll") for(int r=0;r<16;++r)negm[r]=-mhat; asm volatile("":"+v"(negm)); \
        const float f=__builtin_amdgcn_exp2f(-dl); l_reg*=f; if(hi==0)wsf[r32]=f; resc=true; } } \
    SBAR(); \
    GAPB(o[0]=__builtin_amdgcn_mfma_f32_32x32x16_bf16(PAF(0),VFR(0),o[0],0,0,0), C0,0); \
    GAPB(o[1]=__builtin_amdgcn_mfma_f32_32x32x16_bf16(PAF(0),VFR(4),o[1],0,0,0), C0,4); \
    KRD(GL,0); GAPB(o[0]=__builtin_amdgcn_mfma_f32_32x32x16_bf16(PAF(1),VFR(1),o[0],0,0,0), C0,8); \
    KRD(GL,1); GAPB(o[1]=__builtin_amdgcn_mfma_f32_32x32x16_bf16(PAF(1),VFR(5),o[1],0,0,0), C0,12); \
    KRD(GL,2); GAPB(o[0]=__builtin_amdgcn_mfma_f32_32x32x16_bf16(PAF(2),VFR(2),o[0],0,0,0), C1,0); \
    KRD(GL,3); GAPB(o[1]=__builtin_amdgcn_mfma_f32_32x32x16_bf16(PAF(2),VFR(6),o[1],0,0,0), C1,4); \
    GAPB(o[0]=__builtin_amdgcn_mfma_f32_32x32x16_bf16(PAF(3),VFR(3),o[0],0,0,0), C1,8); \
    GAPB(o[1]=__builtin_amdgcn_mfma_f32_32x32x16_bf16(PAF(3),VFR(7),o[1],0,0,0), C1,12); \
    }while(0)
  int t=1;
  #undef CMASK
  #define CMASK(P0,P1,t) do{}while(0)
  for(;t+5<NT;t+=2){
    STEP(pB0,pB1,pA0,pA1,t,true,true,true);     WAIT_BAR(2); RESC(); ROT();
    STEP(pA0,pA1,pB0,pB1,t+1,true,true,true);   WAIT_BAR(2); RESC(); ROT();
  }
  #undef CMASK
  #define CMASK(P0,P1,t) do{int jb_=(t)-(NT-4); if(jb_>=0)cmask(P0,P1,jb_,qrel,hi);}while(0)
  #define ENDW(tt) do{ if((tt)+3<NT){WAIT_BAR(2);} else if((tt)+2<NT){WAIT_BAR(1);} else {WAIT_BAR(0);} }while(0)
  for(;t+1<NT;t+=2){
    STEP(pB0,pB1,pA0,pA1,t,(t+3<NT),(t+1<NT),(t+1<NT));       ENDW(t);   RESC(); ROT();
    STEP(pA0,pA1,pB0,pB1,t+1,(t+4<NT),(t+2<NT),(t+2<NT));     ENDW(t+1); RESC(); ROT();
  }
  STEP(pB0,pB1,pA0,pA1,NT-1,false,false,false); RESC();
  { float sacc=pB0[0]+pB0[1]; _Pragma("unroll") for(int r=2;r<16;++r)sacc+=pB0[r]; _Pragma("unroll") for(int r=0;r<16;++r)sacc+=pB1[r]; l_reg+=sacc;
    pw0=(u32x4){PKW(pB0,0),PKW(pB0,2),PKW(pB0,4),PKW(pB0,6)};pw1=(u32x4){PKW(pB0,8),PKW(pB0,10),PKW(pB0,12),PKW(pB0,14)};pw2=(u32x4){PKW(pB1,0),PKW(pB1,2),PKW(pB1,4),PKW(pB1,6)};pw3=(u32x4){PKW(pB1,8),PKW(pB1,10),PKW(pB1,12),PKW(pB1,14)};
    SBAR(); pv(o,vb0+sl_cur,PAF(0),PAF(1),PAF(2),PAF(3)); }
  #undef PKW
  #undef PAF
  #undef VFR
  #undef PIN
  #undef MX3
  #undef GAPA
  #undef GAPB
  #undef EX
  #undef VRD
  #undef KRD
  #undef STEP
  #undef ENDW
  {auto rr=__builtin_amdgcn_permlane32_swap(__float_as_uint(l_reg),__float_as_uint(l_reg),false,false);l_reg=__uint_as_float(rr[0])+__uint_as_float(rr[1]);}
  if(hi==0)wsf[32+r32]=l_reg;asm volatile("s_waitcnt lgkmcnt(0)":::"memory");
  float rli[16];
  #pragma unroll
  for(int r=0;r<16;++r)rli[r]=__builtin_amdgcn_rcpf(wsf[32+crow(r,hi)]);
  bf16*Ow=O+(rowbase+q0+wid*QBLK)*DM+h*D;
  { bf16*stg=(bf16*)(shm+LDS_OST)+wid*2048;
    #pragma unroll
    for(int r=0;r<16;++r){const int orow=crow(r,hi);
      #pragma unroll
      for(int d0=0;d0<2;++d0)stg[orow*64+d0*32+r32]=__float2bfloat16(o[d0][r]*rli[r]);}
    asm volatile("s_waitcnt lgkmcnt(0)":::"memory");
    #pragma unroll
    for(int i=0;i<4;++i){const int row=i*8+(lane>>3),ch=lane&7; const u32x4 v=*(const u32x4*)(stg+row*64+ch*8); ATTN_STORE16(Ow+(long)row*DM+ch*8,v);} }
  asm volatile("s_waitcnt lgkmcnt(0)\n\ts_barrier":::"memory");
  #undef DMA_K
  #undef DMA_V
  #undef CMASK
  #undef START
  #undef RESC
  #undef ROT
}
constexpr int V2SLOT=16384;
constexpr int L2_K=0, L2_V=NSLOT*SLOTB, L2_WS=L2_V+NSLOT*V2SLOT, L2_OST=L2_WS+NW*64*4, L2_BYTES=L2_OST+NW*4096;
__device__ __forceinline__ void pv4(f32x16*o,int vb,bf16x8 pa0,bf16x8 pa1,bf16x8 pa2,bf16x8 pa3){
  #pragma unroll
  for(int d0=0;d0<4;++d0){s16x4 lo[4],hi[4];
    #pragma unroll
    for(int ks=0;ks<4;++ks){
      asm volatile("ds_read_b64_tr_b16 %0,%1 offset:%c2":"=&v"(lo[ks]):"v"(vb),"i"(d0*4096+ks*1024):"memory");
      asm volatile("ds_read_b64_tr_b16 %0,%1 offset:%c2":"=&v"(hi[ks]):"v"(vb),"i"(d0*4096+ks*1024+512):"memory");}
    asm volatile("s_waitcnt lgkmcnt(0)":::"memory");SBAR();
    #define PK(k) (bf16x8){lo[k][0],lo[k][1],lo[k][2],lo[k][3],hi[k][0],hi[k][1],hi[k][2],hi[k][3]}
    o[d0]=__builtin_amdgcn_mfma_f32_32x32x16_bf16(pa0,PK(0),o[d0],0,0,0);
    o[d0]=__builtin_amdgcn_mfma_f32_32x32x16_bf16(pa1,PK(1),o[d0],0,0,0);
    o[d0]=__builtin_amdgcn_mfma_f32_32x32x16_bf16(pa2,PK(2),o[d0],0,0,0);
    o[d0]=__builtin_amdgcn_mfma_f32_32x32x16_bf16(pa3,PK(3),o[d0],0,0,0);
    #undef PK
  }
}
template<int THRL> __device__ __forceinline__ void attn_unit2(int b,int qb,const bf16*Q,const bf16*__restrict__ K,const bf16*__restrict__ V,bf16*O,char*shm){
  int tid_=threadIdx.x; asm volatile("":"+v"(tid_)); const int tid=tid_,lane=tid&63,r32=lane&31,hi=lane>>5; const int wid=__builtin_amdgcn_readfirstlane(tid>>6);
  const long rowbase=(long)b*SEQ; const int q0=qb*QB;
  if(wid>=4)__builtin_amdgcn_s_setprio(1);
  const bf16*Qw=Q+(rowbase+q0+wid*QBLK)*DM;
  const bf16*Kh=K+rowbase*DM,*Vh=V+rowbase*DM;
  const unsigned lds0=(unsigned)(uintptr_t)shm;
  float*wsf=(float*)(shm+L2_WS)+wid*64;
  const bf16*ksrc=Kh+(long)lane*DM+wid*8;
  const bf16*vsrc=Vh+(long)(16*(wid&3)+(lane>>2))*DM+(wid>>2)*32+(lane&3)*8;
  const unsigned kdst=lds0+L2_K+wid*1024, vdst=lds0+L2_V+wid*1024;
  #define DMA_K(t,slot) glds16(ksrc+(long)(t)*KVBLK*DM,(unsigned)__builtin_amdgcn_readfirstlane(kdst+(slot)))
  #define DMA_V(t,slot) do{ glds16(vsrc+(long)(t)*KVBLK*DM,(unsigned)__builtin_amdgcn_readfirstlane(vdst+2*(slot))); glds16(vsrc+64+(long)(t)*KVBLK*DM,(unsigned)__builtin_amdgcn_readfirstlane(vdst+2*(slot)+8192)); }while(0)
  const int vb0=(int)(lds0+L2_V)+((lane>>4)&1)*32+(lane&3)*8+(4*hi+((lane&15)>>2))*64;
  const char*Kbase=shm+L2_K; bf16x8 kf[8];
  const lds_cptr shm3=(lds_cptr)shm; const lds_cptr kp0=shm3+L2_K+hi*1024+r32*16; const lds_cptr vp0=shm3+L2_V+((lane>>4)&1)*32+(lane&3)*8+(4*hi+((lane&15)>>2))*64;
  const int NT=(q0+QB)/KVBLK;
  DMA_K(0,0);DMA_V(0,0);DMA_K(1,SLOTB);
  bf16x8 qr[4];
  #pragma unroll
  for(int d0=0;d0<4;++d0)qr[d0]=*reinterpret_cast<const bf16x8*>(&Qw[(long)r32*DM+d0*16+hi*8]);
  float mhat=0.f,l_reg=0.f;f32x16 o[4];o[0]=f32x16{};o[1]=f32x16{};o[2]=f32x16{};o[3]=f32x16{};f32x16 negm=f32x16{};asm volatile("":"+v"(negm));
  const int qrel=wid*QBLK+r32;
  #define CMASK(P0,P1,t) do{int jb_=(t)-(NT-4); if(jb_>=0)cmask(P0,P1,jb_,qrel,hi);}while(0)
  bool resc=false;
  #define START(P0,P1) do{ const float rm=rowmax(P0,P1); resc=false; \
    { const float dl=rm; mhat=fadd_s(mhat,dl); \
      _Pragma("unroll") for(int r=0;r<16;++r){P0[r]=fsub_s(P0[r],dl);P1[r]=fsub_s(P1[r],dl);} \
      _Pragma("unroll") for(int r=0;r<16;++r)negm[r]=-mhat; asm volatile("":"+v"(negm)); } \
    _Pragma("unroll") for(int r=0;r<16;++r)P0[r]=__builtin_amdgcn_exp2f(P0[r]); }while(0)
  #define RESC() do{ if(resc){ asm volatile("s_waitcnt lgkmcnt(0)":::"memory"); \
      _Pragma("unroll") for(int d_=0;d_<4;++d_) _Pragma("unroll") for(int r=0;r<16;++r)o[d_][r]*=wsf[crow(r,hi)]; } }while(0)
  f32x16 pA0,pA1,pB0,pB1;
  int sl_prev=0,sl_cur=0,sl_next=SLOTB;
  #define ROT() do{sl_prev=sl_cur;sl_cur=sl_next;sl_next=(sl_next==(NSLOT-1)*SLOTB)?0:sl_next+SLOTB;}while(0)
  DMA_K(2,2*SLOTB);
  WAIT_BAR(4);
  qkt(pA0,pA1,Kbase,qr,negm,r32,hi);asm volatile("s_nop 15\n\ts_nop 7":"+v"(pA0),"+v"(pA1));CMASK(pA0,pA1,0);
  START(pA0,pA1);
  _Pragma("unroll") for(int r=0;r<16;++r)pA1[r]=__builtin_amdgcn_exp2f(pA1[r]);
  WAIT_BAR(0);
  DMA_K(3,0);DMA_V(1,SLOTB);
  ROT();
  kload8(kf,kp0+sl_cur);
  WAIT_BAR(3);
  s16x4 vlo[8],vhi[8]; u32x4 pw0,pw1,pw2,pw3;
  #define VRD2(rg,i) do{ vlo[rg]=vtr(vp_+(((i)>>2)*4096+((i)&3)*1024)); vhi[rg]=vtr(vp_+(((i)>>2)*4096+((i)&3)*1024+512)); }while(0)
  #define GAPB2(MF,X,B) do{ MF; X[B]=EX(X[B]); X[B+1]=EX(X[B+1]); PIN(X); SBAR(); }while(0)
  #define PKW(P,B) cvtpk_s(P[B],P[B+1])
  #define PAF(k) __builtin_bit_cast(bf16x8,pw##k)
  #define VFR(i) (bf16x8){vlo[i][0],vlo[i][1],vlo[i][2],vlo[i][3],vhi[i][0],vhi[i][1],vhi[i][2],vhi[i][3]}
  #define PIN(x) asm volatile("":"+v"(x))
  #define MX3(a,b,c) __builtin_fmaxf(__builtin_fmaxf((a),(b)),(c))
  #define GAPA(MF,A0,A1,A2,A3,W0,W1,PW) do{ MF; sacc+=A0; sacc+=A1; sacc+=A2; sacc+=A3; PIN(sacc); W0; W1; PIN(PW); SBAR(); }while(0)
  #define EX(v) __builtin_amdgcn_exp2f(v)
  #define GAPB(MF,X,B) do{ MF; X[B]=EX(X[B]); X[B+1]=EX(X[B+1]); X[B+2]=EX(X[B+2]); X[B+3]=EX(X[B+3]); PIN(X); SBAR(); }while(0)
  #define VRD(i) do{ vlo[i]=vtr(vp_+(((i)>>2)*4096+((i)&3)*1024)); vhi[i]=vtr(vp_+(((i)>>2)*4096+((i)&3)*1024+512)); }while(0)
  #define KRD(G,j) do{ if(G){ kload2(kf,kp0+sl_next,j); SBAR(); } }while(0)
  #define STEP(C0,C1,P0,P1,t,GK,GV,GL) do{ SBAR(); \
    const lds_cptr vp_=vp0+2*sl_prev; \
    VRD2(0,0); SBAR(); float sacc=(P0[0]+P0[1]); \
    GAPA(C0=__builtin_amdgcn_mfma_f32_32x32x16_bf16(kf[0],qr[0],negm,0,0,0), P0[2],P0[3],P0[4],P0[5],     pw0[0]=PKW(P0,0), pw0[1]=PKW(P0,2), pw0); \
    VRD2(1,4); SBAR(); GAPA(C1=__builtin_amdgcn_mfma_f32_32x32x16_bf16(kf[1],qr[0],negm,0,0,0), P0[6],P0[7],P0[8],P0[9],     pw0[2]=PKW(P0,4), pw0[3]=PKW(P0,6), pw0); \
    VRD2(2,8); SBAR(); GAPA(C0=__builtin_amdgcn_mfma_f32_32x32x16_bf16(kf[2],qr[1],C0,0,0,0),   P0[10],P0[11],P0[12],P0[13], pw1[0]=PKW(P0,8), pw1[1]=PKW(P0,10), pw1); \
    VRD2(3,12); SBAR(); GAPA(C1=__builtin_amdgcn_mfma_f32_32x32x16_bf16(kf[3],qr[1],C1,0,0,0),   P0[14],P0[15],P1[0],P1[1],   pw1[2]=PKW(P0,12),pw1[3]=PKW(P0,14), pw1); \
    VRD2(4,1); SBAR(); GAPA(C0=__builtin_amdgcn_mfma_f32_32x32x16_bf16(kf[4],qr[2],C0,0,0,0),   P1[2],P1[3],P1[4],P1[5],     pw2[0]=PKW(P1,0), pw2[1]=PKW(P1,2), pw2); \
    VRD2(5,5); SBAR(); GAPA(C1=__builtin_amdgcn_mfma_f32_32x32x16_bf16(kf[5],qr[2],C1,0,0,0),   P1[6],P1[7],P1[8],P1[9],     pw2[2]=PKW(P1,4), pw2[3]=PKW(P1,6), pw2); \
    VRD2(6,9); SBAR(); GAPA(C0=__builtin_amdgcn_mfma_f32_32x32x16_bf16(kf[6],qr[3],C0,0,0,0),   P1[10],P1[11],P1[12],P1[13], pw3[0]=PKW(P1,8), pw3[1]=PKW(P1,10), pw3); \
    VRD2(7,13); SBAR(); GAPA(C1=__builtin_amdgcn_mfma_f32_32x32x16_bf16(kf[7],qr[3],C1,0,0,0),   P1[14],P1[15],0.f,0.f,       pw3[2]=PKW(P1,12),pw3[3]=PKW(P1,14), pw3); \
    l_reg+=sacc; \
    if(GK){DMA_K((t)+3,sl_cur);} if(GV){DMA_V((t)+1,sl_next);} \
    CMASK(C0,C1,t); \
    { float a=MX3(C0[0],C0[1],C1[0]),b=MX3(C0[2],C0[3],C1[1]); a=MX3(a,C1[2],C1[3]); \
      _Pragma("unroll") for(int r=4;r<16;r+=4){a=MX3(a,C0[r],C0[r+1]);b=MX3(b,C0[r+2],C0[r+3]);a=MX3(a,C1[r],C1[r+1]);b=MX3(b,C1[r+2],C1[r+3]);} \
      float rm=__builtin_fmaxf(a,b); { auto rr=__builtin_amdgcn_permlane32_swap(__float_as_uint(rm),__float_as_uint(rm),false,false); rm=__builtin_fmaxf(__uint_as_float(rr[0]),__uint_as_float(rr[1])); } \
      resc=false; \
      if(__builtin_expect(__any(rm>(float)THRL),0)){ const float dl=__builtin_fmaxf(rm,0.f); mhat+=dl; \
        _Pragma("unroll") for(int r=0;r<16;++r){C0[r]-=dl;C1[r]-=dl;} \
        _Pragma("unroll") for(int r=0;r<16;++r)negm[r]=-mhat; asm volatile("":"+v"(negm)); \
        const float f=__builtin_amdgcn_exp2f(-dl); l_reg*=f; if(hi==0)wsf[r32]=f; resc=true; } } \
    SBAR(); \
    GAPB2(o[0]=__builtin_amdgcn_mfma_f32_32x32x16_bf16(PAF(0),VFR(0),o[0],0,0,0), C0,0); VRD2(0,2); SBAR(); \
    GAPB2(o[1]=__builtin_amdgcn_mfma_f32_32x32x16_bf16(PAF(0),VFR(1),o[1],0,0,0), C0,2); VRD2(1,6); SBAR(); \
    GAPB2(o[2]=__builtin_amdgcn_mfma_f32_32x32x16_bf16(PAF(0),VFR(2),o[2],0,0,0), C0,4); VRD2(2,10); SBAR(); \
    GAPB2(o[3]=__builtin_amdgcn_mfma_f32_32x32x16_bf16(PAF(0),VFR(3),o[3],0,0,0), C0,6); VRD2(3,14); SBAR(); \
    GAPB2(o[0]=__builtin_amdgcn_mfma_f32_32x32x16_bf16(PAF(1),VFR(4),o[0],0,0,0), C0,8); VRD2(4,3); SBAR(); \
    GAPB2(o[1]=__builtin_amdgcn_mfma_f32_32x32x16_bf16(PAF(1),VFR(5),o[1],0,0,0), C0,10); VRD2(5,7); SBAR(); \
    GAPB2(o[2]=__builtin_amdgcn_mfma_f32_32x32x16_bf16(PAF(1),VFR(6),o[2],0,0,0), C0,12); VRD2(6,11); SBAR(); \
    GAPB2(o[3]=__builtin_amdgcn_mfma_f32_32x32x16_bf16(PAF(1),VFR(7),o[3],0,0,0), C0,14); VRD2(7,15); SBAR(); \
    KRD(GL,0); GAPB2(o[0]=__builtin_amdgcn_mfma_f32_32x32x16_bf16(PAF(2),VFR(0),o[0],0,0,0), C1,0); \
    KRD(GL,1); GAPB2(o[1]=__builtin_amdgcn_mfma_f32_32x32x16_bf16(PAF(2),VFR(1),o[1],0,0,0), C1,2); \
    KRD(GL,2); GAPB2(o[2]=__builtin_amdgcn_mfma_f32_32x32x16_bf16(PAF(2),VFR(2),o[2],0,0,0), C1,4); \
    KRD(GL,3); GAPB2(o[3]=__builtin_amdgcn_mfma_f32_32x32x16_bf16(PAF(2),VFR(3),o[3],0,0,0), C1,6); \
    GAPB2(o[0]=__builtin_amdgcn_mfma_f32_32x32x16_bf16(PAF(3),VFR(4),o[0],0,0,0), C1,8); \
    GAPB2(o[1]=__builtin_amdgcn_mfma_f32_32x32x16_bf16(PAF(3),VFR(5),o[1],0,0,0), C1,10); \
    GAPB2(o[2]=__builtin_amdgcn_mfma_f32_32x32x16_bf16(PAF(3),VFR(6),o[2],0,0,0), C1,12); \
    GAPB2(o[3]=__builtin_amdgcn_mfma_f32_32x32x16_bf16(PAF(3),VFR(7),o[3],0,0,0), C1,14); \
    }while(0)
  int t=1;
  #undef CMASK
  #define CMASK(P0,P1,t) do{}while(0)
  for(;t+5<NT;t+=2){
    STEP(pB0,pB1,pA0,pA1,t,true,true,true);     WAIT_BAR(3); RESC(); ROT();
    STEP(pA0,pA1,pB0,pB1,t+1,true,true,true);   WAIT_BAR(3); RESC(); ROT();
  }
  #undef CMASK
  #define CMASK(P0,P1,t) do{int jb_=(t)-(NT-4); if(jb_>=0)cmask(P0,P1,jb_,qrel,hi);}while(0)
  #define ENDW(tt) do{ if((tt)+3<NT){WAIT_BAR(3);} else if((tt)+2<NT){WAIT_BAR(2);} else {WAIT_BAR(0);} }while(0)
  for(;t+1<NT;t+=2){
    STEP(pB0,pB1,pA0,pA1,t,(t+3<NT),(t+1<NT),(t+1<NT));       ENDW(t);   RESC(); ROT();
    STEP(pA0,pA1,pB0,pB1,t+1,(t+4<NT),(t+2<NT),(t+2<NT));     ENDW(t+1); RESC(); ROT();
  }
  STEP(pB0,pB1,pA0,pA1,NT-1,false,false,false); RESC();
  { float sacc=pB0[0]+pB0[1]; _Pragma("unroll") for(int r=2;r<16;++r)sacc+=pB0[r]; _Pragma("unroll") for(int r=0;r<16;++r)sacc+=pB1[r]; l_reg+=sacc;
    pw0=(u32x4){PKW(pB0,0),PKW(pB0,2),PKW(pB0,4),PKW(pB0,6)};pw1=(u32x4){PKW(pB0,8),PKW(pB0,10),PKW(pB0,12),PKW(pB0,14)};pw2=(u32x4){PKW(pB1,0),PKW(pB1,2),PKW(pB1,4),PKW(pB1,6)};pw3=(u32x4){PKW(pB1,8),PKW(pB1,10),PKW(pB1,12),PKW(pB1,14)};
    SBAR(); pv4(o,vb0+2*sl_cur,PAF(0),PAF(1),PAF(2),PAF(3)); }
  #undef PKW
  #undef PAF
  #undef VFR
  #undef PIN
  #undef MX3
  #undef GAPA
  #undef GAPB
  #undef EX
  #undef VRD
  #undef VRD2
  #undef GAPB2
  #undef KRD
  #undef STEP
  #undef ENDW
  {auto rr=__builtin_amdgcn_permlane32_swap(__float_as_uint(l_reg),__float_as_uint(l_reg),false,false);l_reg=__uint_as_float(rr[0])+__uint_as_float(rr[1]);}
  if(hi==0)wsf[32+r32]=l_reg;asm volatile("s_waitcnt lgkmcnt(0)":::"memory");
  float rli[16];
  #pragma unroll
  for(int r=0;r<16;++r)rli[r]=__builtin_amdgcn_rcpf(wsf[32+crow(r,hi)]);
  bf16*Ow=O+(rowbase+q0+wid*QBLK)*DM;
  { bf16*stg=(bf16*)(shm+L2_OST)+wid*2048;
    #pragma unroll
    for(int hf=0;hf<2;++hf){
      #pragma unroll
      for(int r=0;r<16;++r){const int orow=crow(r,hi);
        #pragma unroll
        for(int d0=0;d0<2;++d0)stg[orow*64+d0*32+r32]=__float2bfloat16(o[2*hf+d0][r]*rli[r]);}
      asm volatile("s_waitcnt lgkmcnt(0)":::"memory");
      #pragma unroll
      for(int i=0;i<4;++i){const int row=i*8+(lane>>3),ch=lane&7; const u32x4 v=*(const u32x4*)(stg+row*64+ch*8); ATTN_STORE16(Ow+(long)row*DM+hf*64+ch*8,v);}
      asm volatile("s_waitcnt lgkmcnt(0)":::"memory"); } }
  asm volatile("s_waitcnt lgkmcnt(0)\n\ts_barrier":::"memory");
  __builtin_amdgcn_s_setprio(0);
  #undef DMA_K
  #undef DMA_V
  #undef CMASK
  #undef START
  #undef RESC
  #undef ROT
}

constexpr int L3_K=0, L3_V=NSLOT*SLOTB, L3_WS=L3_V+NSLOT*8192, L3_OST=L3_WS+NW*64*4, L3_BYTES=L3_OST+NW*4096;
template<int THRL> __device__ __forceinline__ void attn_unit3(int b,int qb,const bf16*Q,const bf16*__restrict__ K,const unsigned char*__restrict__ V8,bf16*O,char*shm){
  int tid_=threadIdx.x; asm volatile("":"+v"(tid_)); const int tid=tid_,lane=tid&63,r32=lane&31,hi=lane>>5; const int wid=__builtin_amdgcn_readfirstlane(tid>>6);
  const long rowbase=(long)b*SEQ; const int q0=qb*QB;
  if(wid>=4)__builtin_amdgcn_s_setprio(1);
  const bf16*Qw=Q+(rowbase+q0+wid*QBLK)*DM;
  const bf16*Kh=K+rowbase*DM;
  const unsigned lds0=(unsigned)(uintptr_t)shm;
  float*wsf=(float*)(shm+L3_WS)+wid*64;
  const bf16*ksrc=Kh+(long)lane*DM+wid*8;
  const unsigned char*vsrc=V8+wid*1024+lane*16;
  const unsigned kdst=lds0+L3_K+wid*1024, vdst=lds0+L3_V+wid*1024;
  #define DMA_K(t,slot) glds16(ksrc+(long)(t)*KVBLK*DM,(unsigned)__builtin_amdgcn_readfirstlane(kdst+(slot)))
  #define DMA_V(t,slot) glds16(vsrc+(long)(t)*8192,(unsigned)__builtin_amdgcn_readfirstlane(vdst+(slot)))
  const char*Kbase=shm+L3_K; bf16x8 kf[8];
  const lds_cptr shm3=(lds_cptr)shm; const lds_cptr kp0=shm3+L3_K+hi*1024+r32*16; const lds_cptr vp0=shm3+L3_V+lane*16;
  const int NT=(q0+QB)/KVBLK;
  DMA_K(0,0);DMA_V(0,0);DMA_K(1,SLOTB);
  bf16x8 qr[4];
  #pragma unroll
  for(int d0=0;d0<4;++d0)qr[d0]=*reinterpret_cast<const bf16x8*>(&Qw[(long)r32*DM+d0*16+hi*8]);
  float mhat=0.f,l_reg=0.f;f32x16 o[4];o[0]=f32x16{};o[1]=f32x16{};o[2]=f32x16{};o[3]=f32x16{};f32x16 negm=f32x16{};asm volatile("":"+v"(negm));
  const int qrel=wid*QBLK+r32;
  #define CMASK(P0,P1,t) do{int jb_=(t)-(NT-4); if(jb_>=0)cmask(P0,P1,jb_,qrel,hi);}while(0)
  bool resc=false;
  #define START(P0,P1) do{ const float rm=rowmax(P0,P1); resc=false; \
    { const float dl=rm; mhat=fadd_s(mhat,dl); \
      _Pragma("unroll") for(int r=0;r<16;++r){P0[r]=fsub_s(P0[r],dl);P1[r]=fsub_s(P1[r],dl);} \
      _Pragma("unroll") for(int r=0;r<16;++r)negm[r]=-mhat; asm volatile("":"+v"(negm)); } \
    _Pragma("unroll") for(int r=0;r<16;++r)P0[r]=__builtin_amdgcn_exp2f(P0[r]); }while(0)
  #define RESC() do{ if(resc){ asm volatile("s_waitcnt lgkmcnt(0)":::"memory"); \
      _Pragma("unroll") for(int d_=0;d_<4;++d_) _Pragma("unroll") for(int r=0;r<16;++r)o[d_][r]*=wsf[crow(r,hi)]; } }while(0)
  f32x16 pA0,pA1,pB0,pB1;
  int sl_prev=0,sl_cur=0,sl_next=SLOTB;
  #define ROT() do{sl_prev=sl_cur;sl_cur=sl_next;sl_next=(sl_next==(NSLOT-1)*SLOTB)?0:sl_next+SLOTB;}while(0)
  DMA_K(2,2*SLOTB);
  WAIT_BAR(4);
  qkt(pA0,pA1,Kbase,qr,negm,r32,hi);asm volatile("s_nop 15\n\ts_nop 7":"+v"(pA0),"+v"(pA1));CMASK(pA0,pA1,0);
  START(pA0,pA1);
  _Pragma("unroll") for(int r=0;r<16;++r)pA1[r]=__builtin_amdgcn_exp2f(pA1[r]);
  WAIT_BAR(0);
  DMA_K(3,0);DMA_V(1,SLOTB);
  ROT();
  kload8(kf,kp0+sl_cur);
  WAIT_BAR(2);
  typedef int v8i_t __attribute__((ext_vector_type(8)));
  u32x4 vq[8]; v8i_t pq;
  #define VQ(i) vq[i]=*(const __attribute__((address_space(3))) u32x4*)(vp_+(((i)>>1)*2048+((i)&1)*1024))
  #define PQW(k,P,B) do{ const int w_=__builtin_amdgcn_cvt_pk_fp8_f32(P[B],P[(B)+1],0,false); pq[k]=__builtin_amdgcn_cvt_pk_fp8_f32(P[(B)+2],P[(B)+3],w_,true); }while(0)
  #define VF8(d) (v8i_t){(int)vq[2*(d)].x,(int)vq[2*(d)].y,(int)vq[2*(d)].z,(int)vq[2*(d)].w,(int)vq[2*(d)+1].x,(int)vq[2*(d)+1].y,(int)vq[2*(d)+1].z,(int)vq[2*(d)+1].w}
  #define MF8(d) o[d]=__builtin_amdgcn_mfma_scale_f32_32x32x64_f8f6f4(pq,VF8(d),o[d],0,0,0,0,0,0)
  #define PIN(x) asm volatile("":"+v"(x))
  #define MX3(a,b,c) __builtin_fmaxf(__builtin_fmaxf((a),(b)),(c))
  #define GAPA(MF,A0,A1,A2,A3,W) do{ MF; sacc+=A0; sacc+=A1; sacc+=A2; sacc+=A3; PIN(sacc); W; PIN(pq); SBAR(); }while(0)
  #define EX(v) __builtin_amdgcn_exp2f(v)
  #define GAPB8(MF,X,B) do{ MF; X[B]=EX(X[B]); X[B+1]=EX(X[B+1]); X[B+2]=EX(X[B+2]); X[B+3]=EX(X[B+3]); X[B+4]=EX(X[B+4]); X[B+5]=EX(X[B+5]); X[B+6]=EX(X[B+6]); X[B+7]=EX(X[B+7]); PIN(X); SBAR(); }while(0)
  #define KRD(G,j) do{ if(G){ kload2(kf,kp0+sl_next,j); SBAR(); } }while(0)
  #define STEP(C0,C1,P0,P1,t,GK,GV,GL) do{ SBAR(); \
    const lds_cptr vp_=vp0+sl_prev; \
    VQ(0); SBAR(); float sacc=(P0[0]+P0[1]); \
    GAPA(C0=__builtin_amdgcn_mfma_f32_32x32x16_bf16(kf[0],qr[0],negm,0,0,0), P0[2],P0[3],P0[4],P0[5],     PQW(0,P0,0)); \
    VQ(1); SBAR(); GAPA(C1=__builtin_amdgcn_mfma_f32_32x32x16_bf16(kf[1],qr[0],negm,0,0,0), P0[6],P0[7],P0[8],P0[9],     PQW(1,P0,8)); \
    VQ(2); SBAR(); GAPA(C0=__builtin_amdgcn_mfma_f32_32x32x16_bf16(kf[2],qr[1],C0,0,0,0),   P0[10],P0[11],P0[12],P0[13], PQW(2,P1,0)); \
    VQ(3); SBAR(); GAPA(C1=__builtin_amdgcn_mfma_f32_32x32x16_bf16(kf[3],qr[1],C1,0,0,0),   P0[14],P0[15],P1[0],P1[1],   PQW(3,P1,8)); \
    VQ(4); SBAR(); GAPA(C0=__builtin_amdgcn_mfma_f32_32x32x16_bf16(kf[4],qr[2],C0,0,0,0),   P1[2],P1[3],P1[4],P1[5],     PQW(4,P0,4)); \
    VQ(5); SBAR(); GAPA(C1=__builtin_amdgcn_mfma_f32_32x32x16_bf16(kf[5],qr[2],C1,0,0,0),   P1[6],P1[7],P1[8],P1[9],     PQW(5,P0,12)); \
    VQ(6); SBAR(); GAPA(C0=__builtin_amdgcn_mfma_f32_32x32x16_bf16(kf[6],qr[3],C0,0,0,0),   P1[10],P1[11],P1[12],P1[13], PQW(6,P1,4)); \
    VQ(7); SBAR(); GAPA(C1=__builtin_amdgcn_mfma_f32_32x32x16_bf16(kf[7],qr[3],C1,0,0,0),   P1[14],P1[15],0.f,0.f,       PQW(7,P1,12)); \
    l_reg+=sacc; \
    if(GK){DMA_K((t)+3,sl_cur);} if(GV){DMA_V((t)+1,sl_next);} \
    CMASK(C0,C1,t); \
    { float a=MX3(C0[0],C0[1],C1[0]),b=MX3(C0[2],C0[3],C1[1]); a=MX3(a,C1[2],C1[3]); \
      _Pragma("unroll") for(int r=4;r<16;r+=4){a=MX3(a,C0[r],C0[r+1]);b=MX3(b,C0[r+2],C0[r+3]);a=MX3(a,C1[r],C1[r+1]);b=MX3(b,C1[r+2],C1[r+3]);} \
      float rm=__builtin_fmaxf(a,b); { auto rr=__builtin_amdgcn_permlane32_swap(__float_as_uint(rm),__float_as_uint(rm),false,false); rm=__builtin_fmaxf(__uint_as_float(rr[0]),__uint_as_float(rr[1])); } \
      resc=false; \
      if(__builtin_expect(__any(rm>(float)THRL),0)){ const float dl=__builtin_fmaxf(rm,0.f); mhat+=dl; \
        _Pragma("unroll") for(int r=0;r<16;++r){C0[r]-=dl;C1[r]-=dl;} \
        _Pragma("unroll") for(int r=0;r<16;++r)negm[r]=-mhat; asm volatile("":"+v"(negm)); \
        const float f=__builtin_amdgcn_exp2f(-dl); l_reg*=f; if(hi==0)wsf[r32]=f; resc=true; } } \
    SBAR(); \
    KRD(GL,0); GAPB8(MF8(0), C0,0); \
    KRD(GL,1); GAPB8(MF8(1), C0,8); \
    KRD(GL,2); GAPB8(MF8(2), C1,0); \
    KRD(GL,3); GAPB8(MF8(3), C1,8); \
    }while(0)
  int t=1;
  #undef CMASK
  #define CMASK(P0,P1,t) do{}while(0)
  for(;t+5<NT;t+=2){
    STEP(pB0,pB1,pA0,pA1,t,true,true,true);     WAIT_BAR(2); RESC(); ROT();
    STEP(pA0,pA1,pB0,pB1,t+1,true,true,true);   WAIT_BAR(2); RESC(); ROT();
  }
  #undef CMASK
  #define CMASK(P0,P1,t) do{int jb_=(t)-(NT-4); if(jb_>=0)cmask(P0,P1,jb_,qrel,hi);}while(0)
  #define ENDW(tt) do{ if((tt)+3<NT){WAIT_BAR(2);} else if((tt)+2<NT){WAIT_BAR(1);} else {WAIT_BAR(0);} }while(0)
  for(;t+1<NT;t+=2){
    STEP(pB0,pB1,pA0,pA1,t,(t+3<NT),(t+1<NT),(t+1<NT));       ENDW(t);   RESC(); ROT();
    STEP(pA0,pA1,pB0,pB1,t+1,(t+4<NT),(t+2<NT),(t+2<NT));     ENDW(t+1); RESC(); ROT();
  }
  STEP(pB0,pB1,pA0,pA1,NT-1,false,false,false); RESC();
  { float sacc=pB0[0]+pB0[1]; _Pragma("unroll") for(int r=2;r<16;++r)sacc+=pB0[r]; _Pragma("unroll") for(int r=0;r<16;++r)sacc+=pB1[r]; l_reg+=sacc;
    PQW(0,pB0,0); PQW(1,pB0,8); PQW(2,pB1,0); PQW(3,pB1,8); PQW(4,pB0,4); PQW(5,pB0,12); PQW(6,pB1,4); PQW(7,pB1,12);
    SBAR(); const lds_cptr vp_=vp0+sl_cur; VQ(0); VQ(1); VQ(2); VQ(3); VQ(4); VQ(5); VQ(6); VQ(7); MF8(0); MF8(1); MF8(2); MF8(3); }
  #undef PQW
  #undef VQ
  #undef VF8
  #undef MF8
  #undef PIN
  #undef MX3
  #undef GAPA
  #undef GAPB8
  #undef EX
  #undef KRD
  #undef STEP
  #undef ENDW
  {auto rr=__builtin_amdgcn_permlane32_swap(__float_as_uint(l_reg),__float_as_uint(l_reg),false,false);l_reg=__uint_as_float(rr[0])+__uint_as_float(rr[1]);}
  if(hi==0)wsf[32+r32]=l_reg;asm volatile("s_waitcnt lgkmcnt(0)":::"memory");
  float rli[16];
  #pragma unroll
  for(int r=0;r<16;++r)rli[r]=__builtin_amdgcn_rcpf(wsf[32+crow(r,hi)]);
  bf16*Ow=O+(rowbase+q0+wid*QBLK)*DM;
  { bf16*stg=(bf16*)(shm+L3_OST)+wid*2048;
    #pragma unroll
    for(int hf=0;hf<2;++hf){
      #pragma unroll
      for(int r=0;r<16;++r){const int orow=crow(r,hi);
        #pragma unroll
        for(int d0=0;d0<2;++d0)stg[orow*64+d0*32+r32]=__float2bfloat16(o[2*hf+d0][r]*rli[r]);}
      asm volatile("s_waitcnt lgkmcnt(0)":::"memory");
      #pragma unroll
      for(int i=0;i<4;++i){const int row=i*8+(lane>>3),ch=lane&7; const u32x4 v=*(const u32x4*)(stg+row*64+ch*8); ATTN_STORE16(Ow+(long)row*DM+hf*64+ch*8,v);}
      asm volatile("s_waitcnt lgkmcnt(0)":::"memory"); } }
  asm volatile("s_waitcnt lgkmcnt(0)\n\ts_barrier":::"memory");
  __builtin_amdgcn_s_setprio(0);
  #undef DMA_K
  #undef DMA_V
  #undef CMASK
  #undef START
  #undef RESC
  #undef ROT
}

__device__ __forceinline__ void wmask(f32x16&p0,f32x16&p1,int thr,int hi){
  const float NEG=-INFINITY; const int kb=4*hi;
  #pragma unroll
  for(int r=0;r<16;++r){const int kv=kb+(r&3)+8*(r>>2); if(kv<thr)p0[r]=NEG; if(kv+32<thr)p1[r]=NEG;}
}
__device__ __forceinline__ void cmask2(f32x16&p0,f32x16&p1,int nb,int lim,int hi){
  const float NEG=-INFINITY; const int kb=nb+4*hi;
  #pragma unroll
  for(int r=0;r<16;++r){const int kv=kb+(r&3)+8*(r>>2); if(kv>lim)p0[r]=NEG; if(kv+32>lim)p1[r]=NEG;}
}
template<int THRL,int MODE,int PQ,int PKV,int PO> __device__ __forceinline__ void attn_unitN(int q0,int NT,const bf16*Qw0,const bf16*__restrict__ Kh,const bf16*__restrict__ Vh,bf16*Ow0,char*shm){
  int tid_=threadIdx.x; asm volatile("":"+v"(tid_)); const int tid=tid_,lane=tid&63,r32=lane&31,hi=lane>>5; const int wid=__builtin_amdgcn_readfirstlane(tid>>6);
  const bf16*Qw=Qw0+(long)(wid*QBLK)*PQ;
  const unsigned lds0=(unsigned)(uintptr_t)shm;
  float*wsf=(float*)(shm+LDS_WS)+wid*64;
  const bf16*ksrc=Kh+(long)lane*PKV+wid*8;
  const bf16*vsrc=Vh+(long)(16*(wid&3)+(lane>>2))*PKV+(wid>>2)*32+(lane&3)*8;
  const unsigned kdst=lds0+LDS_K+wid*1024, vdst=lds0+LDS_V+wid*1024;
  #define DMA_K(t,slot) glds16(ksrc+(long)(t)*KVBLK*PKV,(unsigned)__builtin_amdgcn_readfirstlane(kdst+(slot)))
  #define DMA_V(t,slot) glds16(vsrc+(long)(t)*KVBLK*PKV,(unsigned)__builtin_amdgcn_readfirstlane(vdst+(slot)))
  const int vb0=(int)(lds0+LDS_V)+((lane>>4)&1)*32+(lane&3)*8+(4*hi+((lane&15)>>2))*64;
  const char*Kbase=shm+LDS_K; bf16x8 kf[8];
  const lds_cptr shm3=(lds_cptr)shm; const lds_cptr kp0=shm3+LDS_K+hi*1024+r32*16; const lds_cptr vp0=shm3+LDS_V+((lane>>4)&1)*32+(lane&3)*8+(4*hi+((lane&15)>>2))*64;
  DMA_K(0,0);DMA_V(0,0);DMA_K(1,SLOTB);
  bf16x8 qr[4];
  #pragma unroll
  for(int d0=0;d0<4;++d0)qr[d0]=*reinterpret_cast<const bf16x8*>(&Qw[(long)r32*PQ+d0*16+hi*8]);
  float mhat=0.f,l_reg=0.f;f32x16 o[2];o[0]=f32x16{};o[1]=f32x16{};const f32x16 negm=f32x16{};
  const int qrel=wid*QBLK+r32; const int clim=(q0+qrel-31)>>4; (void)clim;
  #define CMASK(P0,P1,t) do{int jb_=(t)-(NT-4); if(jb_>=0){ if(MODE==2)cmask2(P0,P1,64*(t),clim,hi); else cmask(P0,P1,jb_,qrel,hi);} else if(MODE==1&&(t)<NT-8)wmask(P0,P1,qrel-511-64*jb_,hi);}while(0)
  bool resc=false;
  #define START(P0,P1) do{ const float rm=__builtin_fmaxf(rowmax(P0,P1),-32.f); resc=false; \
    { const float dl=rm; mhat=fadd_s(mhat,dl); \
      _Pragma("unroll") for(int r=0;r<16;++r){P0[r]=fsub_s(P0[r],dl);P1[r]=fsub_s(P1[r],dl);} \
      } \
    _Pragma("unroll") for(int r=0;r<16;++r)P0[r]=__builtin_amdgcn_exp2f(P0[r]); }while(0)
  #define RESC() do{ if(resc){ asm volatile("s_waitcnt lgkmcnt(0)":::"memory"); \
      _Pragma("unroll") for(int d_=0;d_<2;++d_) _Pragma("unroll") for(int r=0;r<16;++r)o[d_][r]*=wsf[crow(r,hi)]; } }while(0)
  f32x16 pA0,pA1,pB0,pB1;
  int sl_prev=0,sl_cur=0,sl_next=SLOTB;
  #define ROT() do{sl_prev=sl_cur;sl_cur=sl_next;sl_next=(sl_next==(NSLOT-1)*SLOTB)?0:sl_next+SLOTB;}while(0)
  DMA_K(2,2*SLOTB);
  WAIT_BAR(3);
  qkt(pA0,pA1,Kbase,qr,negm,r32,hi);asm volatile("s_nop 15\n\ts_nop 7":"+v"(pA0),"+v"(pA1));CMASK(pA0,pA1,0);
  START(pA0,pA1);
  _Pragma("unroll") for(int r=0;r<16;++r)pA1[r]=__builtin_amdgcn_exp2f(pA1[r]);
  WAIT_BAR(0);
  DMA_K(3,0);DMA_V(1,SLOTB);
  ROT();
  kload8(kf,kp0+sl_cur);
  WAIT_BAR(2);
  s16x4 vlo[8],vhi[8]; u32x4 pw0,pw1,pw2,pw3;
  #define PKW(P,B) cvtpk_s(P[B],P[B+1])
  #define PAF(k) __builtin_bit_cast(bf16x8,pw##k)
  #define VFR(i) (bf16x8){vlo[i][0],vlo[i][1],vlo[i][2],vlo[i][3],vhi[i][0],vhi[i][1],vhi[i][2],vhi[i][3]}
  #define PIN(x) asm volatile("":"+v"(x))
  #define MX3(a,b,c) __builtin_fmaxf(__builtin_fmaxf((a),(b)),(c))
  #define GAPA(MF,A0,A1,A2,A3,W0,W1,PW) do{ MF; sacc+=A0; sacc+=A1; sacc+=A2; sacc+=A3; PIN(sacc); W0; W1; PIN(PW); SBAR(); }while(0)
  #define EX(v) __builtin_amdgcn_exp2f(v)
  #define GAPB(MF,X,B) do{ MF; X[B]=EX(X[B]); X[B+1]=EX(X[B+1]); X[B+2]=EX(X[B+2]); X[B+3]=EX(X[B+3]); PIN(X); SBAR(); }while(0)
  #define VRD(i) do{ vlo[i]=vtr(vp_+(((i)>>2)*4096+((i)&3)*1024)); vhi[i]=vtr(vp_+(((i)>>2)*4096+((i)&3)*1024+512)); }while(0)
  #define KRD(G,j) do{ if(G){ kload2(kf,kp0+sl_next,j); SBAR(); } }while(0)
  #define STEP(C0,C1,P0,P1,t,GK,GV,GL) do{ SBAR(); \
    const lds_cptr vp_=vp0+sl_prev; \
    VRD(0); SBAR(); float sacc=(P0[0]+P0[1]); \
    GAPA(C0=__builtin_amdgcn_mfma_f32_32x32x16_bf16(kf[0],qr[0],negm,0,0,0), P0[2],P0[3],P0[4],P0[5],     pw0[0]=PKW(P0,0), pw0[1]=PKW(P0,2), pw0); \
    VRD(4); SBAR(); GAPA(C1=__builtin_amdgcn_mfma_f32_32x32x16_bf16(kf[1],qr[0],negm,0,0,0), P0[6],P0[7],P0[8],P0[9],     pw0[2]=PKW(P0,4), pw0[3]=PKW(P0,6), pw0); \
    VRD(1); SBAR(); GAPA(C0=__builtin_amdgcn_mfma_f32_32x32x16_bf16(kf[2],qr[1],C0,0,0,0),   P0[10],P0[11],P0[12],P0[13], pw1[0]=PKW(P0,8), pw1[1]=PKW(P0,10), pw1); \
    VRD(5); SBAR(); GAPA(C1=__builtin_amdgcn_mfma_f32_32x32x16_bf16(kf[3],qr[1],C1,0,0,0),   P0[14],P0[15],P1[0],P1[1],   pw1[2]=PKW(P0,12),pw1[3]=PKW(P0,14), pw1); \
    VRD(2); SBAR(); GAPA(C0=__builtin_amdgcn_mfma_f32_32x32x16_bf16(kf[4],qr[2],C0,0,0,0),   P1[2],P1[3],P1[4],P1[5],     pw2[0]=PKW(P1,0), pw2[1]=PKW(P1,2), pw2); \
    VRD(6); SBAR(); GAPA(C1=__builtin_amdgcn_mfma_f32_32x32x16_bf16(kf[5],qr[2],C1,0,0,0),   P1[6],P1[7],P1[8],P1[9],     pw2[2]=PKW(P1,4), pw2[3]=PKW(P1,6), pw2); \
    VRD(3); SBAR(); GAPA(C0=__builtin_amdgcn_mfma_f32_32x32x16_bf16(kf[6],qr[3],C0,0,0,0),   P1[10],P1[11],P1[12],P1[13], pw3[0]=PKW(P1,8), pw3[1]=PKW(P1,10), pw3); \
    VRD(7); SBAR(); GAPA(C1=__builtin_amdgcn_mfma_f32_32x32x16_bf16(kf[7],qr[3],C1,0,0,0),   P1[14],P1[15],0.f,0.f,       pw3[2]=PKW(P1,12),pw3[3]=PKW(P1,14), pw3); \
    l_reg+=sacc; \
    if(GK){DMA_K((t)+3,sl_cur);} if(GV){DMA_V((t)+1,sl_next);} \
    C0=C0-mhat; C1=C1-mhat; \
    CMASK(C0,C1,t); \
    { float a=MX3(C0[0],C0[1],C1[0]),b=MX3(C0[2],C0[3],C1[1]); a=MX3(a,C1[2],C1[3]); \
      _Pragma("unroll") for(int r=4;r<16;r+=4){a=MX3(a,C0[r],C0[r+1]);b=MX3(b,C0[r+2],C0[r+3]);a=MX3(a,C1[r],C1[r+1]);b=MX3(b,C1[r+2],C1[r+3]);} \
      float rm=__builtin_fmaxf(a,b); { auto rr=__builtin_amdgcn_permlane32_swap(__float_as_uint(rm),__float_as_uint(rm),false,false); rm=__builtin_fmaxf(__uint_as_float(rr[0]),__uint_as_float(rr[1])); } \
      resc=false; \
      if(__builtin_expect(__any(rm>(float)THRL),0)){ const float dl=__builtin_fmaxf(rm,0.f); mhat+=dl; \
        _Pragma("unroll") for(int r=0;r<16;++r){C0[r]-=dl;C1[r]-=dl;} \
        const float f=__builtin_amdgcn_exp2f(-dl); l_reg*=f; if(hi==0)wsf[r32]=f; resc=true; } } \
    SBAR(); \
    GAPB(o[0]=__builtin_amdgcn_mfma_f32_32x32x16_bf16(PAF(0),VFR(0),o[0],0,0,0), C0,0); \
    GAPB(o[1]=__builtin_amdgcn_mfma_f32_32x32x16_bf16(PAF(0),VFR(4),o[1],0,0,0), C0,4); \
    KRD(GL,0); GAPB(o[0]=__builtin_amdgcn_mfma_f32_32x32x16_bf16(PAF(1),VFR(1),o[0],0,0,0), C0,8); \
    KRD(GL,1); GAPB(o[1]=__builtin_amdgcn_mfma_f32_32x32x16_bf16(PAF(1),VFR(5),o[1],0,0,0), C0,12); \
    KRD(GL,2); GAPB(o[0]=__builtin_amdgcn_mfma_f32_32x32x16_bf16(PAF(2),VFR(2),o[0],0,0,0), C1,0); \
    KRD(GL,3); GAPB(o[1]=__builtin_amdgcn_mfma_f32_32x32x16_bf16(PAF(2),VFR(6),o[1],0,0,0), C1,4); \
    GAPB(o[0]=__builtin_amdgcn_mfma_f32_32x32x16_bf16(PAF(3),VFR(3),o[0],0,0,0), C1,8); \
    GAPB(o[1]=__builtin_amdgcn_mfma_f32_32x32x16_bf16(PAF(3),VFR(7),o[1],0,0,0), C1,12); \
    }while(0)
  int t=1;
  #undef CMASK
  #define CMASK(P0,P1,t) do{ if(MODE==1&&(t)<NT-8)wmask(P0,P1,qrel-511-64*((t)-(NT-4)),hi); }while(0)
  for(;t+5<NT;t+=2){
    STEP(pB0,pB1,pA0,pA1,t,true,true,true);     WAIT_BAR(2); RESC(); ROT();
    STEP(pA0,pA1,pB0,pB1,t+1,true,true,true);   WAIT_BAR(2); RESC(); ROT();
  }
  #undef CMASK
  #define CMASK(P0,P1,t) do{int jb_=(t)-(NT-4); if(jb_>=0){ if(MODE==2)cmask2(P0,P1,64*(t),clim,hi); else cmask(P0,P1,jb_,qrel,hi);} else if(MODE==1&&(t)<NT-8)wmask(P0,P1,qrel-511-64*jb_,hi);}while(0)
  #define ENDW(tt) do{ if((tt)+3<NT){WAIT_BAR(2);} else if((tt)+2<NT){WAIT_BAR(1);} else {WAIT_BAR(0);} }while(0)
  for(;t+1<NT;t+=2){
    STEP(pB0,pB1,pA0,pA1,t,(t+3<NT),(t+1<NT),(t+1<NT));       ENDW(t);   RESC(); ROT();
    STEP(pA0,pA1,pB0,pB1,t+1,(t+4<NT),(t+2<NT),(t+2<NT));     ENDW(t+1); RESC(); ROT();
  }
  STEP(pB0,pB1,pA0,pA1,NT-1,false,false,false); RESC();
  { float sacc=pB0[0]+pB0[1]; _Pragma("unroll") for(int r=2;r<16;++r)sacc+=pB0[r]; _Pragma("unroll") for(int r=0;r<16;++r)sacc+=pB1[r]; l_reg+=sacc;
    pw0=(u32x4){PKW(pB0,0),PKW(pB0,2),PKW(pB0,4),PKW(pB0,6)};pw1=(u32x4){PKW(pB0,8),PKW(pB0,10),PKW(pB0,12),PKW(pB0,14)};pw2=(u32x4){PKW(pB1,0),PKW(pB1,2),PKW(pB1,4),PKW(pB1,6)};pw3=(u32x4){PKW(pB1,8),PKW(pB1,10),PKW(pB1,12),PKW(pB1,14)};
    SBAR(); pv(o,vb0+sl_cur,PAF(0),PAF(1),PAF(2),PAF(3)); }
  #undef PKW
  #undef PAF
  #undef VFR
  #undef PIN
  #undef MX3
  #undef GAPA
  #undef GAPB
  #undef EX
  #undef VRD
  #undef KRD
  #undef STEP
  #undef ENDW
  {auto rr=__builtin_amdgcn_permlane32_swap(__float_as_uint(l_reg),__float_as_uint(l_reg),false,false);l_reg=__uint_as_float(rr[0])+__uint_as_float(rr[1]);}
  if(hi==0)wsf[32+r32]=l_reg;asm volatile("s_waitcnt lgkmcnt(0)":::"memory");
  float rli[16];
  #pragma unroll
  for(int r=0;r<16;++r){const float lv=wsf[32+crow(r,hi)]; rli[r]=lv>0.f?__builtin_amdgcn_rcpf(lv):0.f;}
  bf16*Ow=Ow0+(long)(wid*QBLK)*PO;
  { bf16*stg=(bf16*)(shm+LDS_OST)+wid*2048;
    #pragma unroll
    for(int r=0;r<16;++r){const int orow=crow(r,hi);
      #pragma unroll
      for(int d0=0;d0<2;++d0)stg[orow*64+d0*32+r32]=__float2bfloat16(o[d0][r]*rli[r]);}
    asm volatile("s_waitcnt lgkmcnt(0)":::"memory");
    #pragma unroll
    for(int i=0;i<4;++i){const int row=i*8+(lane>>3),ch=lane&7; const u32x4 v=*(const u32x4*)(stg+row*64+ch*8); ATTN_STORE16(Ow+(long)row*PO+ch*8,v);} }
  asm volatile("s_waitcnt lgkmcnt(0)\n\ts_barrier":::"memory");
  #undef DMA_K
  #undef DMA_V
  #undef CMASK
  #undef START
  #undef RESC
  #undef ROT
}

__device__ __forceinline__ void nsa_window_phase(char*lds,const bf16*P,bf16*OW,unsigned*qc,volatile __attribute__((address_space(3))) unsigned*qw){
  for(;;){
    if(threadIdx.x==0) qw[0]=__hip_atomic_fetch_add(qc,1u,__ATOMIC_RELAXED,__HIP_MEMORY_SCOPE_AGENT);
    __syncthreads();
    const int u=__builtin_amdgcn_readfirstlane((int)qw[0]);
    __syncthreads();
    if(u>=2048)break;
    const int qb=63-(u&63),bh=u>>6,b=bh>>4,hd=bh&15,g=hd>>3; const int q0=qb*256; const int nt0=q0>=512?q0/64-8:0; const int NT=q0/64+4-nt0;
    const long rowbase=(long)b*SEQ;
    attn_unitN<8,1,2048,2048,1024>(q0,NT,P+(rowbase+q0)*2048+hd*64,P+(rowbase+64*nt0)*2048+1536+g*64,P+(rowbase+64*nt0)*2048+1664+g*64,OW+(rowbase+q0)*1024+hd*64,lds);
  }
}
constexpr int ATTN_LDS_BYTES=LDS_BYTES;
template<int THRL=8> __device__ __forceinline__ void diff_attn_phase(char*lds,const bf16*Q,const bf16*K,const bf16*V,bf16*O0,bf16*O1,int vcu,int G){
  for(int i=0;;++i){
    const int L=__builtin_amdgcn_readfirstlane(vcu+(i>>1)*G); if(L>=2048)break;
    const int combo=L>>5,x=L&31; const int b=combo>>5,hh=(combo>>1)&15,vh=combo&1; const int h=hh>>1,c=hh&1;
    const int qb=(i&1)?63-x:x;
    attn_unit<THRL>(b,0,qb,Q+hh*64,K+hh*64,V+(2*h+vh)*64,(c?O1:O0)+(2*h+vh)*64,lds);
  }
}
template<int THRL=8> __device__ __forceinline__ void diff_attn_phase3(char*lds,const bf16*Q,const bf16*K,const unsigned char*V8,bf16*O0,bf16*O1,int vcu,int G){
  for(int i=0;;++i){
    const int L=__builtin_amdgcn_readfirstlane(vcu+(i>>1)*G); if(L>=1024)break;
    const int combo=L>>5,x=L&31; const int b=combo>>4,hh=combo&15; const int h=hh>>1,c=hh&1;
    const int qb=(i&1)?63-x:x;
    attn_unit3<THRL>(b,qb,Q+hh*64,K+hh*64,V8+(size_t)((b*8+h)*256)*8192,(c?O1:O0)+h*128,lds);
  }
}
template<int THRL=8> __device__ __forceinline__ void diff_attn_phase2(char*lds,const bf16*Q,const bf16*K,const bf16*V,bf16*O0,bf16*O1,int vcu,int G){
  for(int i=0;;++i){
    const int L=__builtin_amdgcn_readfirstlane(vcu+(i>>1)*G); if(L>=1024)break;
    const int combo=L>>5,x=L&31; const int b=combo>>4,hh=combo&15; const int h=hh>>1,c=hh&1;
    const int qb=(i&1)?63-x:x;
    attn_unit2<THRL>(b,qb,Q+hh*64,K+hh*64,V+h*128,(c?O1:O0)+h*128,lds);
  }
}
#undef SBAR
#undef WAIT_BAR
}

namespace nsa {
typedef short bf16x8 __attribute__((ext_vector_type(8)));
typedef float f32x4 __attribute__((ext_vector_type(4)));
typedef unsigned short bf16_t;
constexpr int S = 16384, PITCH = 2048;
constexpr int COL_KS = 1280, COL_VS = 1408, COL_KW = 1536, COL_VW = 1664, COL_G = 1792;
constexpr float NEG = -1e30f;
__device__ __forceinline__ unsigned pk2(float lo, float hi) { typedef float f2 __attribute__((ext_vector_type(2))); typedef __bf16 b2 __attribute__((ext_vector_type(2))); f2 v = {lo, hi}; b2 b = __builtin_convertvector(v, b2); return __builtin_bit_cast(unsigned, b); }
__device__ __forceinline__ float bf2f(bf16_t x) { return __uint_as_float((unsigned)x << 16); }

__device__ __forceinline__ void qk_group(float (&s)[8], const bf16_t* krow0, int kpitch, const bf16x8 (&qf)[2], int n, int q) {
    const bf16_t* kp = krow0 + (size_t)(8 * (n >> 2) + (n & 3)) * kpitch + q * 8;
    const bf16x8 a00 = *(const bf16x8*)(kp), a01 = *(const bf16x8*)(kp + 32);
    const bf16x8 a10 = *(const bf16x8*)(kp + (size_t)4 * kpitch), a11 = *(const bf16x8*)(kp + (size_t)4 * kpitch + 32);
    f32x4 t0 = {0.f, 0.f, 0.f, 0.f}, t1 = {0.f, 0.f, 0.f, 0.f};
    t0 = __builtin_amdgcn_mfma_f32_16x16x32_bf16(a00, qf[0], t0, 0, 0, 0); t0 = __builtin_amdgcn_mfma_f32_16x16x32_bf16(a01, qf[1], t0, 0, 0, 0);
    t1 = __builtin_amdgcn_mfma_f32_16x16x32_bf16(a10, qf[0], t1, 0, 0, 0); t1 = __builtin_amdgcn_mfma_f32_16x16x32_bf16(a11, qf[1], t1, 0, 0, 0);
#pragma unroll
    for (int i = 0; i < 4; ++i) { s[i] = t0[i]; s[4 + i] = t1[i]; }
}
__device__ __forceinline__ void pv_group(f32x4 (&o)[4], const float (&p)[8], const bf16_t* vt, int n, int q) {
    typedef unsigned u32x4 __attribute__((ext_vector_type(4)));
    u32x4 w; w.x = pk2(p[0], p[1]); w.y = pk2(p[2], p[3]); w.z = pk2(p[4], p[5]); w.w = pk2(p[6], p[7]);
    const bf16x8 pf = __builtin_bit_cast(bf16x8, w);
#pragma unroll
    for (int dt = 0; dt < 4; ++dt) { const bf16x8 vf = *(const bf16x8*)(vt + (16 * dt + n) * 32 + q * 8); o[dt] = __builtin_amdgcn_mfma_f32_16x16x32_bf16(vf, pf, o[dt], 0, 0, 0); }
}
struct Run { f32x4 o[4]; float m, l; };
__device__ __forceinline__ void run_init(Run& r) {
#pragma unroll
    for (int dt = 0; dt < 4; ++dt) r.o[dt] = (f32x4){0.f, 0.f, 0.f, 0.f};
    r.m = NEG; r.l = 0.f;
}
struct Frag { bf16x8 k[4]; bf16x8 v[4]; };
__device__ __forceinline__ void load_kt(Frag& f, const bf16_t* kt, int lane) {
#pragma unroll
    for (int i = 0; i < 4; ++i) f.k[i] = *(const bf16x8*)(kt + i * 512 + lane * 8);
}
__device__ __forceinline__ void load_k(Frag& f, const bf16_t* krow0, int kpitch, int n, int q) {
    const bf16_t* kp = krow0 + (size_t)(8 * (n >> 2) + (n & 3)) * kpitch + q * 8;
    f.k[0] = *(const bf16x8*)(kp); f.k[1] = *(const bf16x8*)(kp + 32); f.k[2] = *(const bf16x8*)(kp + (size_t)4 * kpitch); f.k[3] = *(const bf16x8*)(kp + (size_t)4 * kpitch + 32);
}
__device__ __forceinline__ void load_v(Frag& f, const bf16_t* vt, int n, int q) {
#pragma unroll
    for (int dt = 0; dt < 4; ++dt) f.v[dt] = *(const bf16x8*)(vt + (16 * dt + n) * 32 + q * 8);
}
__device__ __forceinline__ void qk_frag(float (&s)[8], const Frag& f, const bf16x8 (&qf)[2]) {
    f32x4 t0 = {0.f, 0.f, 0.f, 0.f}, t1 = {0.f, 0.f, 0.f, 0.f};
    t0 = __builtin_amdgcn_mfma_f32_16x16x32_bf16(f.k[0], qf[0], t0, 0, 0, 0); t0 = __builtin_amdgcn_mfma_f32_16x16x32_bf16(f.k[1], qf[1], t0, 0, 0, 0);
    t1 = __builtin_amdgcn_mfma_f32_16x16x32_bf16(f.k[2], qf[0], t1, 0, 0, 0); t1 = __builtin_amdgcn_mfma_f32_16x16x32_bf16(f.k[3], qf[1], t1, 0, 0, 0);
#pragma unroll
    for (int i = 0; i < 4; ++i) { s[i] = t0[i]; s[4 + i] = t1[i]; }
}
__device__ __forceinline__ void pv_frag(f32x4 (&o)[4], const float (&p)[8], const Frag& f) {
    typedef unsigned u32x4 __attribute__((ext_vector_type(4)));
    u32x4 w; w.x = pk2(p[0], p[1]); w.y = pk2(p[2], p[3]); w.z = pk2(p[4], p[5]); w.w = pk2(p[6], p[7]);
    const bf16x8 pf = __builtin_bit_cast(bf16x8, w);
#pragma unroll
    for (int dt = 0; dt < 4; ++dt) o[dt] = __builtin_amdgcn_mfma_f32_16x16x32_bf16(f.v[dt], pf, o[dt], 0, 0, 0);
}
template<int CTRL> __device__ __forceinline__ float dppf(float v) { return __int_as_float(__builtin_amdgcn_update_dpp(0, __float_as_int(v), CTRL, 0xF, 0xF, false)); }
template<int CTRL> __device__ __forceinline__ int dppi(int v) { return __builtin_amdgcn_update_dpp(0, v, CTRL, 0xF, 0xF, false); }
__device__ __forceinline__ float xmax_q(float v) {
    auto a = __builtin_amdgcn_permlane16_swap(__float_as_uint(v), __float_as_uint(v), false, false); v = fmaxf(__uint_as_float(a[0]), __uint_as_float(a[1]));
    auto b = __builtin_amdgcn_permlane32_swap(__float_as_uint(v), __float_as_uint(v), false, false); return fmaxf(__uint_as_float(b[0]), __uint_as_float(b[1]));
}
__device__ __forceinline__ float xsum_q(float v) {
    auto a = __builtin_amdgcn_permlane16_swap(__float_as_uint(v), __float_as_uint(v), false, false); v = __uint_as_float(a[0]) + __uint_as_float(a[1]);
    auto b = __builtin_amdgcn_permlane32_swap(__float_as_uint(v), __float_as_uint(v), false, false); return __uint_as_float(b[0]) + __uint_as_float(b[1]);
}
__device__ __forceinline__ float sum8(float v) { v += dppf<0x141>(v); v += dppf<0xB1>(v); v += dppf<0x4E>(v); return v; }
template<bool FULL> __device__ __forceinline__ void flash_step(Run& r, const Frag& f, const bf16x8 (&qf)[2], int lo, int hi, bool act, int q) {
    float s[8]; qk_frag(s, f, qf);
    float gm = NEG;
    if (FULL) {
#pragma unroll
        for (int j = 0; j < 8; ++j) { const int kk = 8 * q + j; const bool ok = (kk >= lo) && (kk <= hi); s[j] = ok ? s[j] : NEG; gm = fmaxf(gm, s[j]); }
    } else {
#pragma unroll
        for (int j = 0; j < 8; ++j) gm = fmaxf(gm, s[j]);
        gm = act ? gm : NEG;
    }
    gm = xmax_q(gm);
    const float mn = fmaxf(r.m, gm), sc = __builtin_amdgcn_exp2f(r.m - mn); r.m = mn;
    float p[8], ps = 0.f;
    if (FULL) {
#pragma unroll
        for (int j = 0; j < 8; ++j) { const int kk = 8 * q + j; const bool ok = (kk >= lo) && (kk <= hi); p[j] = ok ? __builtin_amdgcn_exp2f(s[j] - mn) : 0.f; ps += p[j]; }
    } else {
#pragma unroll
        for (int j = 0; j < 8; ++j) { p[j] = __builtin_amdgcn_exp2f(s[j] - mn); ps += p[j]; }
        ps = act ? ps : 0.f;
    }
    r.l = r.l * sc + ps;
    if (__builtin_amdgcn_ballot_w64(sc != 1.0f) != 0ull) {
#pragma unroll
        for (int dt = 0; dt < 4; ++dt) r.o[dt] = r.o[dt] * sc; }
    typedef unsigned u32x4 __attribute__((ext_vector_type(4)));
    u32x4 w; w.x = pk2(p[0], p[1]); w.y = pk2(p[2], p[3]); w.z = pk2(p[4], p[5]); w.w = pk2(p[6], p[7]);
    if (!FULL) { w.x = act ? w.x : 0u; w.y = act ? w.y : 0u; w.z = act ? w.z : 0u; w.w = act ? w.w : 0u; }
    const bf16x8 pf = __builtin_bit_cast(bf16x8, w);
#pragma unroll
    for (int dt = 0; dt < 4; ++dt) r.o[dt] = __builtin_amdgcn_mfma_f32_16x16x32_bf16(f.v[dt], pf, r.o[dt], 0, 0, 0);
}

typedef unsigned u32x4n __attribute__((ext_vector_type(4)));
__device__ __forceinline__ unsigned fp8x4(float a, float b, float c, float d) { int w = __builtin_amdgcn_cvt_pk_fp8_f32(a, b, 0, false); w = __builtin_amdgcn_cvt_pk_fp8_f32(c, d, w, true); return (unsigned)w; }
__device__ __forceinline__ long mk64(unsigned lo, unsigned hi) { return (long)(((unsigned long long)hi << 32) | (unsigned long long)lo); }
struct Frag8 { u32x4n k[2]; u32x4n v[2]; };
__device__ __forceinline__ void load8(Frag8& f, const unsigned char* kb, const unsigned char* vb, int G, int lane) {
    const unsigned char* kp = kb + (size_t)G * 2048 + lane * 16; const unsigned char* vp = vb + (size_t)G * 2048 + lane * 16;
    f.k[0] = *(const u32x4n*)kp; f.k[1] = *(const u32x4n*)(kp + 1024); f.v[0] = *(const u32x4n*)vp; f.v[1] = *(const u32x4n*)(vp + 1024);
}
__device__ __forceinline__ long q_to_fp8(const bf16x8& v) {
    float x[8];
#pragma unroll
    for (int j = 0; j < 8; ++j) x[j] = __uint_as_float((unsigned)(unsigned short)v[j] << 16);
    return mk64(fp8x4(x[0], x[1], x[2], x[3]), fp8x4(x[4], x[5], x[6], x[7]));
}
template<bool FULL> __device__ __forceinline__ void flash_step8(Run& r, const Frag8& f, const long (&q8)[2], int lo, int hi, bool act, int q) {
    f32x4 t0 = {0.f, 0.f, 0.f, 0.f}, t1 = {0.f, 0.f, 0.f, 0.f};
    t0 = __builtin_amdgcn_mfma_f32_16x16x32_fp8_fp8(mk64(f.k[0].x, f.k[0].y), q8[0], t0, 0, 0, 0); t0 = __builtin_amdgcn_mfma_f32_16x16x32_fp8_fp8(mk64(f.k[0].z, f.k[0].w), q8[1], t0, 0, 0, 0);
    t1 = __builtin_amdgcn_mfma_f32_16x16x32_fp8_fp8(mk64(f.k[1].x, f.k[1].y), q8[0], t1, 0, 0, 0); t1 = __builtin_amdgcn_mfma_f32_16x16x32_fp8_fp8(mk64(f.k[1].z, f.k[1].w), q8[1], t1, 0, 0, 0);
    float s[8];
#pragma unroll
    for (int i = 0; i < 4; ++i) { s[i] = t0[i]; s[4 + i] = t1[i]; }
    float gm = NEG;
    if (FULL) {
#pragma unroll
        for (int j = 0; j < 8; ++j) { const int kk = 8 * q + j; const bool ok = (kk >= lo) && (kk <= hi); s[j] = ok ? s[j] : NEG; gm = fmaxf(gm, s[j]); }
    } else {
#pragma unroll
        for (int j = 0; j < 8; ++j) gm = fmaxf(gm, s[j]);
        gm = act ? gm : NEG;
    }
    gm = xmax_q(gm);
    const float mn = fmaxf(r.m, gm), sc = __builtin_amdgcn_exp2f(r.m - mn); r.m = mn;
    float p[8], ps = 0.f; const float mn8 = mn - 8.0f;
    if (FULL) {
#pragma unroll
        for (int j = 0; j < 8; ++j) { const int kk = 8 * q + j; const bool ok = (kk >= lo) && (kk <= hi); p[j] = ok ? __builtin_amdgcn_exp2f(s[j] - mn8) : 0.f; ps += p[j]; }
    } else {
#pragma unroll
        for (int j = 0; j < 8; ++j) { p[j] = __builtin_amdgcn_exp2f(s[j] - mn8); ps += p[j]; }
        ps = act ? ps : 0.f;
    }
    r.l = r.l * sc + ps;
    if (__builtin_amdgcn_ballot_w64(sc != 1.0f) != 0ull) {
#pragma unroll
        for (int dt = 0; dt < 4; ++dt) r.o[dt] = r.o[dt] * sc; }
    unsigned w0 = fp8x4(p[0], p[1], p[2], p[3]), w1 = fp8x4(p[4], p[5], p[6], p[7]);
    if (!FULL) { w0 = act ? w0 : 0u; w1 = act ? w1 : 0u; }
    const long pf = mk64(w0, w1);
    r.o[0] = __builtin_amdgcn_mfma_f32_16x16x32_fp8_fp8(mk64(f.v[0].x, f.v[0].y), pf, r.o[0], 0, 0, 0); r.o[1] = __builtin_amdgcn_mfma_f32_16x16x32_fp8_fp8(mk64(f.v[0].z, f.v[0].w), pf, r.o[1], 0, 0, 0);
    r.o[2] = __builtin_amdgcn_mfma_f32_16x16x32_fp8_fp8(mk64(f.v[1].x, f.v[1].y), pf, r.o[2], 0, 0, 0); r.o[3] = __builtin_amdgcn_mfma_f32_16x16x32_fp8_fp8(mk64(f.v[1].z, f.v[1].w), pf, r.o[3], 0, 0, 0);
}

__device__ __forceinline__ void qk8(float (&s)[8], const Frag8& f, const long (&q8)[2]) {
    f32x4 t0 = {0.f, 0.f, 0.f, 0.f}, t1 = {0.f, 0.f, 0.f, 0.f};
    t0 = __builtin_amdgcn_mfma_f32_16x16x32_fp8_fp8(mk64(f.k[0].x, f.k[0].y), q8[0], t0, 0, 0, 0); t0 = __builtin_amdgcn_mfma_f32_16x16x32_fp8_fp8(mk64(f.k[0].z, f.k[0].w), q8[1], t0, 0, 0, 0);
    t1 = __builtin_amdgcn_mfma_f32_16x16x32_fp8_fp8(mk64(f.k[1].x, f.k[1].y), q8[0], t1, 0, 0, 0); t1 = __builtin_amdgcn_mfma_f32_16x16x32_fp8_fp8(mk64(f.k[1].z, f.k[1].w), q8[1], t1, 0, 0, 0);
#pragma unroll
    for (int i = 0; i < 4; ++i) { s[i] = t0[i]; s[4 + i] = t1[i]; }
}
__device__ __forceinline__ void pv8(f32x4 (&o)[4], const float (&p)[8], const Frag8& f) {
    const long pf = mk64(fp8x4(p[0] * 256.f, p[1] * 256.f, p[2] * 256.f, p[3] * 256.f), fp8x4(p[4] * 256.f, p[5] * 256.f, p[6] * 256.f, p[7] * 256.f));
    o[0] = __builtin_amdgcn_mfma_f32_16x16x32_fp8_fp8(mk64(f.v[0].x, f.v[0].y), pf, o[0], 0, 0, 0); o[1] = __builtin_amdgcn_mfma_f32_16x16x32_fp8_fp8(mk64(f.v[0].z, f.v[0].w), pf, o[1], 0, 0, 0);
    o[2] = __builtin_amdgcn_mfma_f32_16x16x32_fp8_fp8(mk64(f.v[1].x, f.v[1].y), pf, o[2], 0, 0, 0); o[3] = __builtin_amdgcn_mfma_f32_16x16x32_fp8_fp8(mk64(f.v[1].z, f.v[1].w), pf, o[3], 0, 0, 0);
}
__device__ __forceinline__ void pv8s(f32x4 (&o)[4], const float (&p)[8], const Frag8& f) {
    const long pf = mk64(fp8x4(p[0], p[1], p[2], p[3]), fp8x4(p[4], p[5], p[6], p[7]));
    o[0] = __builtin_amdgcn_mfma_f32_16x16x32_fp8_fp8(mk64(f.v[0].x, f.v[0].y), pf, o[0], 0, 0, 0); o[1] = __builtin_amdgcn_mfma_f32_16x16x32_fp8_fp8(mk64(f.v[0].z, f.v[0].w), pf, o[1], 0, 0, 0);
    o[2] = __builtin_amdgcn_mfma_f32_16x16x32_fp8_fp8(mk64(f.v[1].x, f.v[1].y), pf, o[2], 0, 0, 0); o[3] = __builtin_amdgcn_mfma_f32_16x16x32_fp8_fp8(mk64(f.v[1].z, f.v[1].w), pf, o[3], 0, 0, 0);
}
__device__ __forceinline__ void loadk8(Frag8& f, const unsigned char* kb, int G, int lane) { const unsigned char* kp = kb + (size_t)G * 2048 + lane * 16; f.k[0] = *(const u32x4n*)kp; f.k[1] = *(const u32x4n*)(kp + 1024); }
struct Tensors {
    const bf16_t* P;
    const unsigned char* KC8;
    const unsigned char* K8;
    const unsigned char* VC8;
    const unsigned char* V8;
    const bf16_t* OW;
    bf16_t* O;
};
__device__ __forceinline__ float wmax64(float v) { v = fmaxf(v, dppf<0x128>(v)); v = fmaxf(v, dppf<0x124>(v)); v = fmaxf(v, dppf<0x122>(v)); v = fmaxf(v, dppf<0x121>(v)); return xmax_q(v); }
__device__ __forceinline__ int wmin64(int v) { v = min(v, dppi<0x128>(v)); v = min(v, dppi<0x124>(v)); v = min(v, dppi<0x122>(v)); v = min(v, dppi<0x121>(v));
    auto a = __builtin_amdgcn_permlane16_swap((unsigned)v, (unsigned)v, false, false); v = min((int)a[0], (int)a[1]);
    auto b = __builtin_amdgcn_permlane32_swap((unsigned)v, (unsigned)v, false, false); return min((int)b[0], (int)b[1]); }
__device__ __forceinline__ int select_blocks(const __attribute__((address_space(3))) float* impA, const __attribute__((address_space(3))) float* impB, __attribute__((address_space(3))) int* list, int qblk, int lane) {
    if (qblk <= 15) { if (lane < 16) list[lane] = lane; return qblk + 1; }
    unsigned key[4];
#pragma unroll
    for (int i = 0; i < 4; ++i) { const int j = lane + 64 * i; key[i] = (j >= 1 && j <= qblk - 2) ? (__float_as_uint(impA[j] + impB[j]) + 1u) : 0u; }
    if (lane == 0) { list[0] = 0; list[1] = qblk - 1; list[2] = qblk; }
    unsigned T = 0u;
#pragma unroll 1
    for (int b = 30; b >= 0; --b) { const unsigned c = T | (1u << b);
        const int cnt = __builtin_popcountll(__builtin_amdgcn_ballot_w64(key[0] >= c)) + __builtin_popcountll(__builtin_amdgcn_ballot_w64(key[1] >= c))
                      + __builtin_popcountll(__builtin_amdgcn_ballot_w64(key[2] >= c)) + __builtin_popcountll(__builtin_amdgcn_ballot_w64(key[3] >= c));
        if (cnt >= 13) T = c; }
    int need = 13, base = 0;
#pragma unroll
    for (int i = 0; i < 4; ++i) need -= __builtin_popcountll(__builtin_amdgcn_ballot_w64(key[i] > T));
#pragma unroll
    for (int i = 0; i < 4; ++i) {
        const unsigned long long ge = __builtin_amdgcn_ballot_w64(key[i] > T), eq = __builtin_amdgcn_ballot_w64(key[i] == T);
        const int ce = __builtin_popcountll(eq), take = ce < need ? ce : need; need -= take;
        const int eqrank = (int)__builtin_amdgcn_mbcnt_hi((unsigned)(eq >> 32), __builtin_amdgcn_mbcnt_lo((unsigned)eq, 0u));
        const bool sel = (key[i] > T) || ((key[i] == T) && eqrank < take);
        const unsigned long long sm = __builtin_amdgcn_ballot_w64(sel);
        const int pos = base + (int)__builtin_amdgcn_mbcnt_hi((unsigned)(sm >> 32), __builtin_amdgcn_mbcnt_lo((unsigned)sm, 0u));
        if (sel) list[3 + pos] = lane + 64 * i;
        base += __builtin_popcountll(sm); (void)ge; }
    return 16;
}
__device__ __forceinline__ int select_blocks4(const __attribute__((address_space(3))) float* imp  , __attribute__((address_space(3))) int* lists  , int qblk, int lane) {
    if (qblk <= 15) { if (lane < 16) { lists[lane] = lane; lists[16 + lane] = lane; lists[32 + lane] = lane; lists[48 + lane] = lane; } return qblk + 1; }
    unsigned key[4][4];
#pragma unroll
    for (int k = 0; k < 4; ++k)
#pragma unroll
        for (int i = 0; i < 4; ++i) { const int j = lane + 64 * i; key[k][i] = (j >= 1 && j <= qblk - 2) ? (__float_as_uint(imp[k * 544 + j] + imp[k * 544 + 272 + j]) + 1u) : 0u; }
    if (lane < 4) { lists[16 * lane] = 0; lists[16 * lane + 1] = qblk - 1; lists[16 * lane + 2] = qblk; }
    unsigned T[4] = {0u, 0u, 0u, 0u};
#pragma unroll 1
    for (int b = 30; b >= 0; --b) {
#pragma unroll
        for (int k = 0; k < 4; ++k) { const unsigned c = T[k] | (1u << b);
            const int cnt = __builtin_popcountll(__builtin_amdgcn_ballot_w64(key[k][0] >= c)) + __builtin_popcountll(__builtin_amdgcn_ballot_w64(key[k][1] >= c))
                          + __builtin_popcountll(__builtin_amdgcn_ballot_w64(key[k][2] >= c)) + __builtin_popcountll(__builtin_amdgcn_ballot_w64(key[k][3] >= c));
            if (cnt >= 13) T[k] = c; } }
#pragma unroll
    for (int k = 0; k < 4; ++k) {
        int need = 13, base = 0;
#pragma unroll
        for (int i = 0; i < 4; ++i) need -= __builtin_popcountll(__builtin_amdgcn_ballot_w64(key[k][i] > T[k]));
#pragma unroll
        for (int i = 0; i < 4; ++i) {
            const unsigned long long eq = __builtin_amdgcn_ballot_w64(key[k][i] == T[k]);
            const int ce = __builtin_popcountll(eq), take = ce < need ? ce : need; need -= take;
            const int eqrank = (int)__builtin_amdgcn_mbcnt_hi((unsigned)(eq >> 32), __builtin_amdgcn_mbcnt_lo((unsigned)eq, 0u));
            const bool sel = (key[k][i] > T[k]) || ((key[k][i] == T[k]) && eqrank < take);
            const unsigned long long sm = __builtin_amdgcn_ballot_w64(sel);
            const int pos = base + (int)__builtin_amdgcn_mbcnt_hi((unsigned)(sm >> 32), __builtin_amdgcn_mbcnt_lo((unsigned)sm, 0u));
            if (sel) lists[16 * k + 3 + pos] = lane + 64 * i;
            base += __builtin_popcountll(sm); } }
    return 16;
}
#define NSA_LD(F_, G_) load8(F_, kb, vb, (G_), lane)
__device__ __forceinline__ void sel_joint(const Tensors& T, Run& rsa, Run& rsb, Frag8& fa, Frag8& fb, const long (&qfa)[2], const long (&qfb)[2], const __attribute__((address_space(3))) int* list,
                                          int njoint, int qblk, int bg, int tqa, int tqb, int n, int q, int lane) {
    const unsigned char* kb = T.K8 + (size_t)bg * 512 * 2048; const unsigned char* vb = T.V8 + (size_t)bg * 512 * 2048;
#define NSA_ST2(F_, G_) do { if (jb == qblk) { flash_step8<true>(rsa, F_, qfa, 0, tqa - 32 * (G_), true, q); flash_step8<true>(rsb, F_, qfb, 0, tqb - 32 * (G_), true, q); } \
                             else { flash_step8<false>(rsa, F_, qfa, 0, 31, true, q); flash_step8<false>(rsb, F_, qfb, 0, 31, true, q); } } while (0)
    int jb = __builtin_amdgcn_readfirstlane(list[0]);
    NSA_LD(fa, 2 * jb);
    for (int e = 0; e < njoint; ++e) {
        NSA_LD(fb, 2 * jb + 1);
        NSA_ST2(fa, 2 * jb);
        int jn = 0;
        if (e + 1 < njoint) { jn = __builtin_amdgcn_readfirstlane(list[e + 1]); NSA_LD(fa, 2 * jn); }
        NSA_ST2(fb, 2 * jb + 1);
        jb = jn; }
#undef NSA_ST2
}
__device__ __forceinline__ void flash_dual8(Run& r, const Frag8& fA, const Frag8& fB, const long (&q8)[2], int tok, int q) {
    float sa[8], sb[8], s[8]; qk8(sa, fA, q8); qk8(sb, fB, q8);
    float gm = NEG;
#pragma unroll
    for (int j = 0; j < 8; ++j) { s[j] = tok ? sb[j] : sa[j]; gm = fmaxf(gm, s[j]); }
    gm = xmax_q(gm);
    const float mn = fmaxf(r.m, gm), sc = __builtin_amdgcn_exp2f(r.m - mn); r.m = mn;
    float p[8], ps = 0.f;
    const float mn8 = mn - 8.0f;
#pragma unroll
    for (int j = 0; j < 8; ++j) { p[j] = __builtin_amdgcn_exp2f(s[j] - mn8); ps += p[j]; }
    r.l = r.l * sc + ps;
    if (__builtin_amdgcn_ballot_w64(sc != 1.0f) != 0ull) {
#pragma unroll
        for (int dt = 0; dt < 4; ++dt) r.o[dt] = r.o[dt] * sc; }
    const unsigned w0 = fp8x4(p[0], p[1], p[2], p[3]), w1 = fp8x4(p[4], p[5], p[6], p[7]);
    const long pa = mk64(tok ? 0u : w0, tok ? 0u : w1), pb = mk64(tok ? w0 : 0u, tok ? w1 : 0u);
    r.o[0] = __builtin_amdgcn_mfma_f32_16x16x32_fp8_fp8(mk64(fA.v[0].x, fA.v[0].y), pa, r.o[0], 0, 0, 0); r.o[1] = __builtin_amdgcn_mfma_f32_16x16x32_fp8_fp8(mk64(fA.v[0].z, fA.v[0].w), pa, r.o[1], 0, 0, 0);
    r.o[2] = __builtin_amdgcn_mfma_f32_16x16x32_fp8_fp8(mk64(fA.v[1].x, fA.v[1].y), pa, r.o[2], 0, 0, 0); r.o[3] = __builtin_amdgcn_mfma_f32_16x16x32_fp8_fp8(mk64(fA.v[1].z, fA.v[1].w), pa, r.o[3], 0, 0, 0);
    r.o[0] = __builtin_amdgcn_mfma_f32_16x16x32_fp8_fp8(mk64(fB.v[0].x, fB.v[0].y), pb, r.o[0], 0, 0, 0); r.o[1] = __builtin_amdgcn_mfma_f32_16x16x32_fp8_fp8(mk64(fB.v[0].z, fB.v[0].w), pb, r.o[1], 0, 0, 0);
    r.o[2] = __builtin_amdgcn_mfma_f32_16x16x32_fp8_fp8(mk64(fB.v[1].x, fB.v[1].y), pb, r.o[2], 0, 0, 0); r.o[3] = __builtin_amdgcn_mfma_f32_16x16x32_fp8_fp8(mk64(fB.v[1].z, fB.v[1].w), pb, r.o[3], 0, 0, 0);
}
__device__ __forceinline__ void sel_solo(const Tensors& T, Run& rs, Frag8& fa, Frag8& fb, const long (&qf)[2], const __attribute__((address_space(3))) int* list0, const __attribute__((address_space(3))) int* list1,
                                         int bg, int tok, int n, int q, int lane) {
    const unsigned char* kb = T.K8 + (size_t)bg * 512 * 2048; const unsigned char* vb = T.V8 + (size_t)bg * 512 * 2048;
    Frag8 fc, fd;
    int ja = __builtin_amdgcn_readfirstlane(list0[3]), jb = __builtin_amdgcn_readfirstlane(list1[3]);
    NSA_LD(fa, 2 * ja); NSA_LD(fb, 2 * jb);
    for (int e = 0; e < 13; ++e) {
        NSA_LD(fc, 2 * ja + 1); NSA_LD(fd, 2 * jb + 1);
        flash_dual8(rs, fa, fb, qf, tok, q);
        int na = 0, nb = 0;
        if (e + 1 < 13) { na = __builtin_amdgcn_readfirstlane(list0[4 + e]); nb = __builtin_amdgcn_readfirstlane(list1[4 + e]); NSA_LD(fa, 2 * na); NSA_LD(fb, 2 * nb); }
        flash_dual8(rs, fc, fd, qf, tok, q);
        ja = na; jb = nb; }
}
#undef NSA_LD
__device__ __forceinline__ void out_pair(const Tensors& T, const __attribute__((address_space(3))) unsigned* st, int lane, const Run& rs, size_t rowt, int g, int head, int q) {
    const float ls = xsum_q(rs.l);
    const bf16_t* gp = T.P + rowt * PITCH + COL_G + g * 24 + head * 3;
    const float gc = 1.0f / (1.0f + __expf(-bf2f(gp[0]))), gs = 1.0f / (1.0f + __expf(-bf2f(gp[1]))), gw = 1.0f / (1.0f + __expf(-bf2f(gp[2])));
    const float fs = gs / fmaxf(ls, 1e-30f);
    const bf16_t* wp = T.OW + rowt * 1024 + (g * 8 + head) * 64 + 4 * q;
    bf16_t* op = T.O + rowt * 1024 + (g * 8 + head) * 64 + 4 * q;
#pragma unroll
    for (int dt = 0; dt < 4; ++dt) { float v[4]; typedef unsigned u32x2w __attribute__((ext_vector_type(2))); const u32x2w wv = *(const u32x2w*)(wp + 16 * dt);
        const float ow[4] = {__uint_as_float(wv.x << 16), __uint_as_float(wv.x & 0xffff0000u), __uint_as_float(wv.y << 16), __uint_as_float(wv.y & 0xffff0000u)};
        const unsigned c0 = st[(4 * dt) * 64 + lane], c1 = st[(4 * dt + 1) * 64 + lane]; const float oc[4] = {__uint_as_float(c0 << 16), __uint_as_float(c0 & 0xffff0000u), __uint_as_float(c1 << 16), __uint_as_float(c1 & 0xffff0000u)};
#pragma unroll
        for (int i = 0; i < 4; ++i) v[i] = gc * oc[i] + fs * rs.o[dt][i] + gw * ow[i];
        u32x2w w; w.x = pk2(v[0], v[1]); w.y = pk2(v[2], v[3]);
        *(u32x2w*)(op + 16 * dt) = w; }
}
__device__ __forceinline__ void quad_item(const Tensors& T, int item, __attribute__((address_space(3))) float* wl, int lane) {
    typedef __attribute__((address_space(3))) float lf; typedef __attribute__((address_space(3))) int li;
    const int n = lane & 15, q = lane >> 4, tok = n >> 3, head = n & 7;
    const int bg = item >> 12, t0 = (item & (S / 4 - 1)) * 4, b = bg >> 1, g = bg & 1;
    const int tqa = t0 + tok, tqb = t0 + 2 + tok;
    const size_t row0 = (size_t)b * S + t0;
    lf* impa = wl + tok * 544; lf* impb = wl + (2 + tok) * 544; li* lists = (li*)(wl + 2176);
    bf16x8 qfa[2], qfb[2];
    { const bf16_t* qp = T.P + (row0 + tok) * PITCH + (g * 8 + head) * 64 + q * 8; qfa[0] = *(const bf16x8*)qp; qfa[1] = *(const bf16x8*)(qp + 32);
      qfb[0] = *(const bf16x8*)(qp + 2 * PITCH); qfb[1] = *(const bf16x8*)(qp + 2 * PITCH + 32); }
    for (int i = lane; i < 2176; i += 64) wl[i] = 0.f;
    Frag8 ga, gb;
    const long qa8[2] = {q_to_fp8(qfa[0]), q_to_fp8(qfa[1])}, qb8[2] = {q_to_fp8(qfb[0]), q_to_fp8(qfb[1])};
    const int nva = tqa >= 31 ? ((tqa - 31) >> 4) + 1 : 0, nvb = tqb >= 31 ? ((tqb - 31) >> 4) + 1 : 0;
    const int nv0 = t0 >= 31 ? ((t0 - 31) >> 4) + 1 : 0, nv3 = (t0 + 3) >= 31 ? ((t0 + 3 - 31) >> 4) + 1 : 0;
    f32x4 oca[4], ocb[4];
#pragma unroll
    for (int dt = 0; dt < 4; ++dt) { oca[dt] = (f32x4){0.f, 0.f, 0.f, 0.f}; ocb[dt] = (f32x4){0.f, 0.f, 0.f, 0.f}; }
    if (nv3 > 0) {
        const unsigned char* kb = T.KC8 + (size_t)bg * 32 * 2048; const unsigned char* vb = T.VC8 + (size_t)bg * 32 * 2048; const int ng = (nv3 + 31) >> 5;
        float mca = NEG, lca = 0.f, mcb = NEG, lcb = 0.f;
#define NSA_P1(F_, G_, QF_, NV_, MC_, LC_) do { float s[8]; qk8(s, F_, QF_); const int hi = (NV_) - 1 - 32 * (G_); float gm = NEG; \
            if (32 * (G_) + 32 > nv0) { _Pragma("unroll") for (int j = 0; j < 8; ++j) { const bool ok = (8 * q + j) <= hi; s[j] = ok ? s[j] : NEG; gm = fmaxf(gm, s[j]); } } \
            else { _Pragma("unroll") for (int j = 0; j < 8; ++j) gm = fmaxf(gm, s[j]); } \
            gm = xmax_q(gm); const float mn = fmaxf(MC_, gm); float ps = 0.f; \
            _Pragma("unroll") for (int j = 0; j < 8; ++j) ps += __builtin_amdgcn_exp2f(s[j] - mn); \
            LC_ = LC_ * __builtin_amdgcn_exp2f(MC_ - mn) + ps; MC_ = mn; } while (0)
        loadk8(ga, kb, 0, lane);
        for (int G = 0; G < ng; G += 2) {
            if (G + 1 < ng) loadk8(gb, kb, G + 1, lane);
            NSA_P1(ga, G, qa8, nva, mca, lca); NSA_P1(ga, G, qb8, nvb, mcb, lcb);
            if (G + 1 < ng) { if (G + 2 < ng) loadk8(ga, kb, G + 2, lane); NSA_P1(gb, G + 1, qa8, nva, mca, lca); NSA_P1(gb, G + 1, qb8, nvb, mcb, lcb); }
        }
#undef NSA_P1
        lca = xsum_q(lca); lcb = xsum_q(lcb);
        asm volatile("s_waitcnt lgkmcnt(0)" ::: "memory");
#define NSA_P2(F_, G_, QF_, NV_, C2_, OC_, IMP_) do { float s[8]; qk8(s, F_, QF_); const int hi = (NV_) - 1 - 32 * (G_); float p[8]; \
            if (32 * (G_) + 32 > nv0) { _Pragma("unroll") for (int j = 0; j < 8; ++j) { const bool ok = (8 * q + j) <= hi; p[j] = ok ? __builtin_amdgcn_exp2f(s[j] - C2_) : 0.f; } } \
            else { _Pragma("unroll") for (int j = 0; j < 8; ++j) p[j] = __builtin_amdgcn_exp2f(s[j] - C2_); } \
            pv8s(OC_, p, F_); \
            const float a0 = sum8((p[0] + p[1]) + (p[2] + p[3])), a1 = sum8((p[4] + p[5]) + (p[6] + p[7])), b0 = sum8(p[3]), b1 = sum8(p[7]);     \
            if (head == 0) { const int j0 = 8 * (G_) + 2 * q; IMP_[j0] = a0; IMP_[j0 + 1] = a1; IMP_[272 + j0 + 1] = b0; IMP_[272 + j0 + 2] = b1; } } while (0)
        const float c2a = mca - 8.0f + __builtin_amdgcn_logf(fmaxf(lca, 1e-30f)), c2b = mcb - 8.0f + __builtin_amdgcn_logf(fmaxf(lcb, 1e-30f));
        load8(ga, kb, vb, 0, lane);
        for (int G = 0; G < ng; G += 2) {
            if (G + 1 < ng) load8(gb, kb, vb, G + 1, lane);
            NSA_P2(ga, G, qa8, nva, c2a, oca, impa); NSA_P2(ga, G, qb8, nvb, c2b, ocb, impb);
            if (G + 1 < ng) { if (G + 2 < ng) load8(ga, kb, vb, G + 2, lane);
                NSA_P2(gb, G + 1, qa8, nva, c2a, oca, impa); NSA_P2(gb, G + 1, qb8, nvb, c2b, ocb, impb); }
        }
#undef NSA_P2
#pragma unroll
        for (int dt = 0; dt < 4; ++dt) { oca[dt] = oca[dt] * (1.0f / 256.0f); ocb[dt] = ocb[dt] * (1.0f / 256.0f); }
    }
    { __attribute__((address_space(3))) unsigned* st = (__attribute__((address_space(3))) unsigned*)(wl + 2240);
#pragma unroll
      for (int dt = 0; dt < 4; ++dt) { st[(4 * dt + 0) * 64 + lane] = pk2(oca[dt][0], oca[dt][1]); st[(4 * dt + 1) * 64 + lane] = pk2(oca[dt][2], oca[dt][3]); st[(4 * dt + 2) * 64 + lane] = pk2(ocb[dt][0], ocb[dt][1]); st[(4 * dt + 3) * 64 + lane] = pk2(ocb[dt][2], ocb[dt][3]); } }
    asm volatile("s_waitcnt lgkmcnt(0)" ::: "memory"); __builtin_amdgcn_wave_barrier();
    const int qblk = t0 >> 6;
    const int nsel = select_blocks4(wl, lists, qblk, lane);
    asm volatile("s_waitcnt lgkmcnt(0)" ::: "memory"); __builtin_amdgcn_wave_barrier();
    { Run rsa, rsb; run_init(rsa); run_init(rsb);
      sel_joint(T, rsa, rsb, ga, gb, qa8, qb8, lists, qblk <= 15 ? nsel : 3, qblk, bg, tqa, tqb, n, q, lane);
      if (qblk > 15) sel_solo(T, rsa, ga, gb, qa8, lists, lists + 16, bg, tok, n, q, lane);
      out_pair(T, (const __attribute__((address_space(3))) unsigned*)(wl + 2240), lane, rsa, row0 + tok, g, head, q);
      if (qblk > 15) sel_solo(T, rsb, ga, gb, qb8, lists + 32, lists + 48, bg, tok, n, q, lane);
      out_pair(T, (const __attribute__((address_space(3))) unsigned*)(wl + 2240) + 128, lane, rsb, row0 + 2 + tok, g, head, q); }
    asm volatile("s_waitcnt lgkmcnt(0)" ::: "memory"); __builtin_amdgcn_wave_barrier();
}
}

constexpr int NWAVES = 8;
#ifndef MK_SINGLE
#define MK_SINGLE 1
#endif
constexpr int kB = 2, kS = 16384, kD = 1024, kM = kB * kS;
constexpr float kEps = 1e-6f;
constexpr float kC2 = 0.125f * 1.4426950408889634f;
constexpr int kMpad = 65536 + 32 * 256;
constexpr size_t MiB = 1u << 20;
constexpr size_t WS_CTL = 0, CTL_ZERO_BYTES = 1 * MiB;
constexpr size_t WS_ADAP = 1 * MiB;
constexpr size_t WS_MOD = 2 * MiB + 512 * 1024;
constexpr size_t WS_CBP = WS_MOD + 128 * 1024;
constexpr size_t WS_CBF = WS_CBP + 64 * 1024;
constexpr size_t WS_ROPE = 3 * MiB;
constexpr size_t WS_ROUTE = 5 * MiB;
constexpr size_t WS_ROWTOK = 6 * MiB;
constexpr size_t WS_ROWWT = 6 * MiB + 512 * 1024;
constexpr size_t WS_DUMP = 7 * MiB;
constexpr size_t WS_WR = 7 * MiB + 64 * 1024;
constexpr size_t WS_WC = 7 * MiB + 896 * 1024;
constexpr size_t WS_WQKV = 8 * MiB, WS_WO0 = 14 * MiB, WS_WNSA = 16 * MiB, WS_WO1 = 20 * MiB, WS_W1C = 22 * MiB, WS_W2C = 24 * MiB;
constexpr size_t WS_MOE0 = 26 * MiB, MOE_L = 48 * MiB, MOE_WD = 32 * MiB;
constexpr size_t WS_RA = 122 * MiB, WS_RB = 186 * MiB, WS_RC = 250 * MiB, WS_RD = 314 * MiB, WS_RE = 378 * MiB, WS_RF = 442 * MiB, WS_END = 506 * MiB;
constexpr size_t NS_KC = WS_RF  , NS_HID = WS_RF + 17 * MiB, NS_KCMP = WS_RF + 21 * MiB, NS_VCT = WS_RF + 21 * MiB + 512 * 1024, NS_VTS = WS_RF + 22 * MiB, NS_VTW = WS_RF + 30 * MiB;
constexpr int CW_BAR = 4096;
constexpr int CW_CNT = 16384;
constexpr int CW_QCTR = 16384 + 1024;
constexpr int RING_OFF = 0, RING_BYTES = 131072, LDSCTL_OFF = RING_BYTES, MISC_OFF = LDSCTL_OFF + 320, TPRE_OFF = LDSCTL_OFF + 1024;
constexpr int GTAB_OFF = LDSCTL_OFF + 2048, GTAB_UNITS = 6;
constexpr int LDS_BYTES = 147456;

#define GAS __attribute__((address_space(1)))
#define LAS __attribute__((address_space(3)))
typedef unsigned short bf16;
typedef unsigned v4u __attribute__((ext_vector_type(4)));
typedef unsigned v2u __attribute__((ext_vector_type(2)));
typedef float f32x4 __attribute__((ext_vector_type(4)));
typedef GAS unsigned gu32;
#define RLX_AGENT __ATOMIC_RELAXED, __HIP_MEMORY_SCOPE_AGENT
#define LDS_WAIT() asm volatile("s_waitcnt lgkmcnt(0)" ::: "memory")
__device__ __forceinline__ unsigned pk2(float lo, float hi) { return nsa::pk2(lo, hi); }
__device__ __forceinline__ float bf2f(unsigned short x) { return __uint_as_float((unsigned)x << 16); }
__device__ __forceinline__ float wave_sum(float v) {
#pragma unroll
    for (int o = 1; o < 64; o <<= 1) v += __shfl_xor(v, o);
    return v;
}

#define XB_TMO      128
#define XB_XCNT(j)  (256  + 64 * (j))
#define XB_XSUB(j)  (1280 + 64 * (j))
#define XB_XGEN(j)  (2304 + 64 * (j))
#define XB_TOP      3328
#define XB_TOPGEN   3392
#define XCD_BAR_WORDS 3456
#define XB_SPIN_CAP (1u << 18)

__device__ __forceinline__ unsigned xb_ld(unsigned* p)              { return __hip_atomic_load(p, __ATOMIC_RELAXED, __HIP_MEMORY_SCOPE_AGENT); }
__device__ __forceinline__ unsigned xb_add(unsigned* p, unsigned v) { return __hip_atomic_fetch_add(p, v, __ATOMIC_RELAXED, __HIP_MEMORY_SCOPE_AGENT); }
__device__ __forceinline__ unsigned xb_xcc_id() { return (unsigned)__builtin_amdgcn_s_getreg((3 << 11) | 20) & 0xFu; }
#define XB_SPIN(cond, bar) do { unsigned _sp = 0; while (cond) { __builtin_amdgcn_s_sleep(1); \
    if ((++_sp & 255u) == 0u) { if (xb_ld(&(bar)[XB_TMO])) break; if (_sp > XB_SPIN_CAP) { atomicAdd(&(bar)[XB_TMO], 1u); break; } } } } while (0)

struct XcdBarrier {
    unsigned* bar; unsigned x;
    volatile LAS unsigned* st;
};

__device__ __forceinline__ XcdBarrier xcd_barrier_post(unsigned* bar, volatile LAS unsigned* st) {
    XcdBarrier b; b.bar = bar; b.x = xb_xcc_id(); b.st = st;
    if (threadIdx.x == 0) (void)xb_add(&bar[XB_XCNT(b.x)], 1u);
    return b;
}
__device__ __forceinline__ void xcd_barrier_complete(unsigned* bar, unsigned x, unsigned& nloc, unsigned& nx) {
    const unsigned G = gridDim.x * gridDim.y * gridDim.z;
    unsigned sum, cnt, mine, sp = 0u;
    for (;;) {
        sum = 0u; cnt = 0u; mine = 0u;
#pragma unroll
        for (unsigned j = 0; j < 16; ++j) { const unsigned c = xb_ld(&bar[XB_XCNT(j)]); sum += c; cnt += (c > 0u) ? 1u : 0u; mine = (j == x) ? c : mine; }
        if (sum == G) break;
        __builtin_amdgcn_s_sleep(1);
        if ((++sp & 255u) == 0u) { if (xb_ld(&bar[XB_TMO])) break; if (sp > XB_SPIN_CAP) { atomicAdd(&bar[XB_TMO], 1u); break; } }
    }
    nloc = mine > 0u ? mine : 1u; nx = cnt > 0u ? cnt : 1u;
}

__device__ __forceinline__ void xcd_barrier(const XcdBarrier& b) {
    asm volatile("s_waitcnt vmcnt(0)" ::: "memory");
    __syncthreads();
    if (threadIdx.x == 0) {
        unsigned* bar = b.bar;
        __builtin_amdgcn_s_waitcnt(0);
        unsigned nloc = b.st[0], nx = b.st[1];
        if (nloc == 0u) { xcd_barrier_complete(bar, b.x, nloc, nx); b.st[0] = nloc; b.st[1] = nx; }
        const unsigned old = xb_add(&bar[XB_XSUB(b.x)], 1u);
        const unsigned gen = old / nloc;
        if (old + 1u == (gen + 1u) * nloc) {
            __builtin_amdgcn_fence(__ATOMIC_RELEASE, "agent");
            asm volatile("s_waitcnt vmcnt(0)" ::: "memory");
            const unsigned og = xb_add(&bar[XB_TOP], 1u);
            const unsigned tg = og / nx;
            if (og + 1u == (tg + 1u) * nx) xb_add(&bar[XB_TOPGEN], 1u);
            else XB_SPIN(xb_ld(&bar[XB_TOPGEN]) == tg, bar);
            __builtin_amdgcn_fence(__ATOMIC_ACQUIRE, "agent");
            xb_add(&bar[XB_XGEN(b.x)], 1u);
            asm volatile("s_waitcnt vmcnt(0)" ::: "memory");
        } else {
            XB_SPIN(xb_ld(&bar[XB_XGEN(b.x)]) == gen, bar);
            __builtin_amdgcn_fence(__ATOMIC_ACQUIRE, "agent");
            asm volatile("s_waitcnt vmcnt(0)" ::: "memory");
        }
    }
    __syncthreads();
}


__device__ __forceinline__ void transpose_item(const float* W, int K, int N, bf16* WT, int drow0, int kb, int nb, LAS float* scr, int lane) {
    const int k0 = 64 * kb, n0 = 32 * nb; const int nn = n0 + (lane & 7) * 4; const bool okn = nn < N;
#pragma unroll
    for (int i = 0; i < 8; ++i) { const int kk = 8 * i + (lane >> 3); const f32x4 v = okn ? *(const f32x4*)(W + (size_t)(k0 + kk) * N + nn) : (f32x4){0.f, 0.f, 0.f, 0.f};
        LAS float* d = scr + kk * 33 + (lane & 7) * 4; d[0] = v[0]; d[1] = v[1]; d[2] = v[2]; d[3] = v[3]; }
    LDS_WAIT(); asm volatile("" ::: "memory");
    const int c = lane & 7;
#pragma unroll
    for (int j = 0; j < 4; ++j) { const int n = (lane >> 3) + 8 * j; const LAS float* s = scr + (8 * c) * 33 + n;
        v4u o; o.x = pk2(s[0 * 33], s[1 * 33]); o.y = pk2(s[2 * 33], s[3 * 33]); o.z = pk2(s[4 * 33], s[5 * 33]); o.w = pk2(s[6 * 33], s[7 * 33]);
        *(v4u*)(WT + (size_t)(drow0 + n) * K + k0 + 8 * c) = o; }
    LDS_WAIT(); asm volatile("" ::: "memory");
}
__device__ __forceinline__ void sincos_acc(float ang, float& sn, float& cs) {
    const double a = (double)ang; const double kq = rint(a * 0.63661977236758134308);
    const double r = fma(-kq, 1.57079632679489661923, a) - kq * 6.123233995736766e-17;
    const int qd = (int)((long long)kq & 3);
    const float x = (float)r, x2 = x * x;
    const float sp = x * (1.0f + x2 * (-1.6666667e-1f + x2 * (8.3333338e-3f + x2 * (-1.9841270e-4f + x2 * 2.7557319e-6f))));
    const float cp = 1.0f + x2 * (-0.5f + x2 * (4.1666668e-2f + x2 * (-1.3888889e-3f + x2 * (2.4801587e-5f + x2 * -2.7557319e-7f))));
    const float s1 = (qd & 1) ? cp : sp, c1 = (qd & 1) ? sp : cp;
    sn = (qd & 2) ? -s1 : s1; cs = ((qd + 1) & 2) ? -c1 : c1;
}

struct Ptrs {
    const float* x; const float* c; const int* pos; const float* ada_w; const float* ada_b; const float* norm_g; const float* final_g;
    const float* diff_w_in; const float* diff_w_out; const float* diff_lambda; const float* diff_subln_g;
    const float* nsa_w_in; const float* nsa_w_out; const float* nsa_cmp_pos; const float* nsa_cmp_w1; const float* nsa_cmp_b1; const float* nsa_cmp_w2;
    const float* moe_w_group; const float* moe_b_group; const float* moe_w_expert; const float* moe_b_expert; const float* moe_w_gate; const float* moe_w_up; const float* moe_w_down;
    float* out; unsigned char* ws;
};

__device__ __forceinline__ void ph_prologue(const Ptrs& p, LAS unsigned char* lds, int gw, int NGW, int wave, int lane, int gtid, int NT) {
    LAS float* scr = (LAS float*)(lds + RING_OFF + wave * 16384);
    unsigned char* ws = p.ws;
    constexpr int I_QKV = 16 * 96, I_WO = 16 * 32, I_NSA = 16 * 64, I_W1C = 32 * 8, I_W2C = 4 * 8, I_EXP = 128;
    constexpr int T0 = I_QKV, T1 = T0 + I_WO, T2 = T1 + I_NSA, T3 = T2 + I_WO, T4 = T3 + 2 * I_W1C, T5 = T4 + 2 * I_W2C, T6 = T5 + 64 * 3 * I_EXP;
    struct TrDesc { const float* W; bf16* WT; int K, N, drow0, kb, nb; float sc = 1.0f; };
    auto decode = [&](int it, TrDesc& d) {
        if (it < T0) { const int r = it; d = TrDesc{p.diff_w_in, (bf16*)(ws + WS_WQKV), 1024, 3072, 32 * (r % 96), r / 96, r % 96, (r % 96) < 32 ? kC2 : 1.0f}; }
        else if (it < T1) { const int r = it - T0; d = TrDesc{p.diff_w_out, (bf16*)(ws + WS_WO0), 1024, 1024, 32 * (r % 32), r / 32, r % 32}; }
        else if (it < T2) { const int r = it - T1; d = TrDesc{p.nsa_w_in, (bf16*)(ws + WS_WNSA), 1024, 1840, 32 * (r % 64), r / 64, r % 64, (r % 64) < 32 ? kC2 : 1.0f}; }
        else if (it < T3) { const int r = it - T2; d = TrDesc{p.nsa_w_out, (bf16*)(ws + WS_WO1), 1024, 1024, 32 * (r % 32), r / 32, r % 32}; }
        else if (it < T4) { const int r = it - T3, kv = r / I_W1C, rr = r % I_W1C; d = TrDesc{p.nsa_cmp_w1 + (size_t)kv * 2048 * 256, (bf16*)(ws + WS_W1C) + (size_t)kv * 256 * 2048, 2048, 256, 32 * (rr % 8), rr / 8, rr % 8}; }
        else if (it < T5) { const int r = it - T4, kv = r / I_W2C, rr = r % I_W2C; d = TrDesc{p.nsa_cmp_w2 + (size_t)kv * 256 * 64, (bf16*)(ws + WS_W2C) + (size_t)kv * 256 * 256, 256, 64, 32 * (rr % 8), rr / 8, rr % 8}; }
        else { const int r = it - T5, le = r / (3 * I_EXP), rr = r % (3 * I_EXP), which = rr / I_EXP, ri = rr % I_EXP; const int l = le >> 5, e = le & 31;
            unsigned char* mb = ws + WS_MOE0 + (size_t)l * MOE_L;
            if (which < 2) { const int kb = ri / 8, nb = ri % 8, n0 = 32 * nb;
                d = TrDesc{(which ? p.moe_w_up : p.moe_w_gate) + (size_t)le * 1024 * 256, (bf16*)mb + (size_t)e * 512 * 1024, 1024, 256, (n0 >> 7) * 256 + which * 128 + (n0 & 127), kb, nb}; }
            else { d = TrDesc{p.moe_w_down + (size_t)le * 256 * 1024, (bf16*)(mb + MOE_WD) + (size_t)e * 1024 * 256, 256, 1024, 32 * (ri % 32), ri / 32, ri % 32}; } }
    };
    auto tr_load = [&](const TrDesc& d, f32x4 (&v)[8]) {
        const int k0 = 64 * d.kb, nn = 32 * d.nb + (lane & 7) * 4; const bool okn = nn < d.N;
#pragma unroll
        for (int i = 0; i < 8; ++i) { const int kk = 8 * i + (lane >> 3); v[i] = okn ? *(const f32x4*)(d.W + (size_t)(k0 + kk) * d.N + nn) * d.sc : (f32x4){0.f, 0.f, 0.f, 0.f}; }
    };
    auto tr_finish = [&](const TrDesc& d, const f32x4 (&v)[8]) {
#pragma unroll
        for (int i = 0; i < 8; ++i) { const int kk = 8 * i + (lane >> 3); LAS float* q = scr + kk * 33 + (lane & 7) * 4; q[0] = v[i][0]; q[1] = v[i][1]; q[2] = v[i][2]; q[3] = v[i][3]; }
        LDS_WAIT(); asm volatile("" ::: "memory");
        const int c = lane & 7, k0 = 64 * d.kb;
#pragma unroll
        for (int j = 0; j < 4; ++j) { const int n = (lane >> 3) + 8 * j; const LAS float* s_ = scr + (8 * c) * 33 + n;
            v4u o; o.x = pk2(s_[0 * 33], s_[1 * 33]); o.y = pk2(s_[2 * 33], s_[3 * 33]); o.z = pk2(s_[4 * 33], s_[5 * 33]); o.w = pk2(s_[6 * 33], s_[7 * 33]);
            *(v4u*)(d.WT + (size_t)(d.drow0 + n) * d.K + k0 + 8 * c) = o; }
        LDS_WAIT(); asm volatile("" ::: "memory");
    };
    if (gw < T6) { TrDesc dc; f32x4 vc[8]; decode(gw, dc); tr_load(dc, vc);
        for (int it = gw; it < T6; it += NGW) { TrDesc dn = dc; f32x4 vn[8];
            const bool more = it + NGW < T6;
            if (more) { decode(it + NGW, dn); tr_load(dn, vn); }
            tr_finish(dc, vc);
            if (more) { dc = dn;
#pragma unroll
                for (int i = 0; i < 8; ++i) vc[i] = vn[i]; } } }
    for (int it = gw; it < 2 * 16 * 24; it += NGW) { const int l = it / 384, kc = (it % 384) / 24, cg = it % 24;
        const float* W = p.ada_w + ((size_t)l * 1024 + kc * 64) * 6144 + cg * 256 + lane * 4;
        f32x4 a0 = {0.f, 0.f, 0.f, 0.f}, a1 = {0.f, 0.f, 0.f, 0.f};
#pragma unroll 8
        for (int r = 0; r < 64; ++r) { const f32x4 w = *(const f32x4*)(W + (size_t)r * 6144); const float c0 = p.c[kc * 64 + r], c1 = p.c[1024 + kc * 64 + r];
            const float s0 = c0 / (1.0f + __expf(-c0)), s1 = c1 / (1.0f + __expf(-c1)); a0 = a0 + w * s0; a1 = a1 + w * s1; }
        float* dst = (float*)(ws + WS_ADAP) + ((size_t)(l * 16 + kc) * 2) * 6144 + cg * 256 + lane * 4;
        *(f32x4*)dst = a0; *(f32x4*)(dst + 6144) = a1; }
    for (int i = gtid; i < kM * 8; i += NT) { const int m = i >> 3, j = i & 7;
        const float invf = exp2f(-(float)j * 0.125f * 18.931568569324174f);
        const float ang = (float)p.pos[m] * invf; float sn, cs; sincos_acc(ang, sn, cs);
        float* rp = (float*)(ws + WS_ROPE) + (size_t)m * 16; rp[j] = cs; rp[8 + j] = sn; }
    for (int it = gw; it < 2 * 4 * 32; it += NGW) { const int kv = it >> 7, cg = (it >> 5) & 3, kc = it & 31;
        const float* W = p.nsa_cmp_w1 + ((size_t)kv * 2048 + kc * 64) * 256 + cg * 64 + lane; const float* pe = p.nsa_cmp_pos + kv * 2048 + kc * 64; float a = 0.f;
#pragma unroll 8
        for (int r = 0; r < 64; ++r) a += pe[r] * W[(size_t)r * 256];
        ((float*)(ws + WS_CBP))[kc * 512 + kv * 256 + cg * 64 + lane] = a; }
}
__device__ __forceinline__ void ph_finalize(const Ptrs& p, int gtid, int NT) {
    unsigned char* ws = p.ws;
    for (int i = gtid; i < 2 * 2 * 6144 + 512; i += NT) {
        if (i < 24576) { const int l = i / 12288, b = (i / 6144) & 1, n = i % 6144; float a = p.ada_b[l * 6144 + n];
            const float* pp = (const float*)(ws + WS_ADAP) + ((size_t)(l * 16) * 2 + b) * 6144 + n;
            for (int kc = 0; kc < 16; ++kc) a += pp[(size_t)kc * 2 * 6144];
            ((float*)(ws + WS_MOD))[i] = a; }
        else { const int j = i - 24576; float a = p.nsa_cmp_b1[j]; const float* pp = (const float*)(ws + WS_CBP) + j;
            for (int kc = 0; kc < 32; ++kc) a += pp[kc * 512];
            ((float*)(ws + WS_CBF))[j] = a; }
    }
}
template <bool COMBINE, bool FINAL, bool XBF  >
__device__ __forceinline__ void ph_rows(const Ptrs& p, const float* xin, float* xout, const bf16* Y, const float* modl  , int ch_sh, int ch_g2,
                                        const float* ng, bf16* XN, int layer, int gw, int NGW, int lane, int gtid, int NT) {
    unsigned char* ws = p.ws;
    f32x4 gv[4];
#pragma unroll
    for (int j = 0; j < 4; ++j) gv[j] = *(const f32x4*)(ng + 4 * lane + 256 * j);
    for (int m = gw; m < kM; m += NGW) {
        const int b = m >= kS ? 1 : 0; const float* mb = modl + b * 6144;
        f32x4 v[4];
#pragma unroll
        for (int j = 0; j < 4; ++j) { if (XBF) { const v2u xb = *(const v2u*)((const bf16*)xin + (size_t)m * 1024 + 4 * lane + 256 * j);
                v[j][0] = __uint_as_float(xb.x << 16); v[j][1] = __uint_as_float(xb.x & 0xffff0000u); v[j][2] = __uint_as_float(xb.y << 16); v[j][3] = __uint_as_float(xb.y & 0xffff0000u); }
            else v[j] = *(const f32x4*)(xin + (size_t)m * 1024 + 4 * lane + 256 * j); }
        if (COMBINE) {
#pragma unroll
            for (int j = 0; j < 4; ++j) { const int col = 4 * lane + 256 * j; const f32x4 g2 = *(const f32x4*)(mb + ch_g2 * 1024 + col);
                const v2u y0 = *(const v2u*)(Y + (size_t)m * 1024 + col), y1 = *(const v2u*)(Y + ((size_t)kM + m) * 1024 + col);
                f32x4 ys; ys[0] = __uint_as_float(y0.x << 16) + __uint_as_float(y1.x << 16); ys[1] = __uint_as_float(y0.x & 0xffff0000u) + __uint_as_float(y1.x & 0xffff0000u);
                ys[2] = __uint_as_float(y0.y << 16) + __uint_as_float(y1.y << 16); ys[3] = __uint_as_float(y0.y & 0xffff0000u) + __uint_as_float(y1.y & 0xffff0000u);
                v[j] = v[j] + g2 * ys;
                if (!FINAL) { if (XBF) { v2u xo; xo.x = pk2(v[j][0], v[j][1]); xo.y = pk2(v[j][2], v[j][3]); *(v2u*)((bf16*)xout + (size_t)m * 1024 + col) = xo; } else *(f32x4*)(xout + (size_t)m * 1024 + col) = v[j]; } }
        }
        float ss = 0.f;
#pragma unroll
        for (int j = 0; j < 4; ++j) ss += (v[j][0] * v[j][0] + v[j][1] * v[j][1]) + (v[j][2] * v[j][2] + v[j][3] * v[j][3]);
        const float rs = 1.0f / sqrtf(wave_sum(ss) * (1.0f / 1024.0f) + kEps);
        if (FINAL) {
#pragma unroll
            for (int j = 0; j < 4; ++j) *(f32x4*)(xout + (size_t)m * 1024 + 4 * lane + 256 * j) = v[j] * rs * gv[j];
        } else {
            f32x4 h[4];
#pragma unroll
            for (int j = 0; j < 4; ++j) { const int col = 4 * lane + 256 * j; const f32x4 sh = *(const f32x4*)(mb + ch_sh * 1024 + col), sc = *(const f32x4*)(mb + (ch_sh + 1) * 1024 + col);
                h[j] = (v[j] * rs * gv[j]) * (sc + 1.0f) + sh;
                v2u o; o.x = pk2(h[j][0], h[j][1]); o.y = pk2(h[j][2], h[j][3]); *(v2u*)(XN + (size_t)m * 1024 + col) = o; }
        }
    }
}
__device__ __forceinline__ float router_w(const Ptrs& p, int l, int k, int o) { return o < 4 ? p.moe_w_group[((size_t)l * 1024 + k) * 4 + o] : p.moe_w_expert[(((size_t)l * 4 + ((o - 4) >> 3)) * 1024 + k) * 8 + ((o - 4) & 7)]; }
__device__ __forceinline__ void ph_router_prep(const Ptrs& p, const float* MOD, int gw, int NGW, int lane, int gtid, int NT) {
    bf16* WTH = (bf16*)(p.ws + WS_WR); bf16* WTL = WTH + 4 * 48 * 1024; float* WC = (float*)(p.ws + WS_WC);
    for (int i = gtid; i < 4 * 48 * 1024; i += NT) { const int lb = i / 49152, r = i % 49152, n = r >> 10, k = r & 1023, l = lb >> 1;
        const float* mb = MOD + lb * 6144; const float w = n < 36 ? p.norm_g[(l * 2 + 1) * 1024 + k] * (1.0f + mb[4 * 1024 + k]) * router_w(p, l, k, n) : 0.f;
        const unsigned h = pk2(w, 0.f) & 0xffffu; const float wl = w - __uint_as_float(h << 16);
        WTH[i] = (bf16)h; WTL[i] = (bf16)(pk2(wl, 0.f) & 0xffffu); }
    for (int it = gw; it < 4 * 36; it += NGW) { const int lb = it / 36, o = it % 36, l = lb >> 1; const float* mb = MOD + lb * 6144; float a = 0.f;
        for (int j = 0; j < 16; ++j) { const int k = lane + 64 * j; a += mb[3 * 1024 + k] * router_w(p, l, k, o); }
        a = wave_sum(a);
        if (lane == 0) WC[lb * 48 + o] = a + (o < 4 ? p.moe_b_group[l * 4 + o] : p.moe_b_expert[l * 32 + (o - 4)]); }
}
__device__ __forceinline__ void ph_router(const Ptrs& p, const float* X, int layer, LAS unsigned char* lds, int vcu, int G, int wave, int lane, int gtid, int NT, bool dummy) {
    typedef short bf16x8r __attribute__((ext_vector_type(8)));
    unsigned char* ws = p.ws;
    const int n = lane & 15, q = lane >> 4;
    LAS unsigned* lcnt = (LAS unsigned*)(lds + RING_OFF);
    for (int it0 = vcu * NWAVES; it0 < kM / 16; it0 += G * NWAVES) { const bool valid = it0 + wave < kM / 16; const int it = valid ? it0 + wave : 0;
        if (wave == 0) lcnt[lane] = 0u;
        __syncthreads();
        const int m = it * 16 + n; const int lb = layer * 2 + ((it * 16) >= kS ? 1 : 0);
        const bf16* wth = (const bf16*)(ws + WS_WR) + ((size_t)lb * 48 + n) * 1024 + 8 * q; const bf16* wtl = wth + 4 * 48 * 1024;
        const bf16* xr = (const bf16*)X + (size_t)m * 1024 + 8 * q;
        f32x4 acc[3]; float ssq = 0.f;
#pragma unroll
        for (int t = 0; t < 3; ++t) acc[t] = (f32x4){0.f, 0.f, 0.f, 0.f};
#pragma unroll 2
        for (int i = 0; i < 32; ++i) {
            const v4u hw = *(const v4u*)(xr + 32 * i);
            { const float a0 = __uint_as_float(hw.x << 16), a1 = __uint_as_float(hw.x & 0xffff0000u), a2 = __uint_as_float(hw.y << 16), a3 = __uint_as_float(hw.y & 0xffff0000u),
                          a4 = __uint_as_float(hw.z << 16), a5 = __uint_as_float(hw.z & 0xffff0000u), a6 = __uint_as_float(hw.w << 16), a7 = __uint_as_float(hw.w & 0xffff0000u);
              ssq += ((a0 * a0 + a1 * a1) + (a2 * a2 + a3 * a3)) + ((a4 * a4 + a5 * a5) + (a6 * a6 + a7 * a7)); }
            const bf16x8r xh = __builtin_bit_cast(bf16x8r, hw);
#pragma unroll
            for (int t = 0; t < 3; ++t) { const bf16x8r wh = *(const bf16x8r*)(wth + (size_t)t * 16 * 1024 + 32 * i), wl = *(const bf16x8r*)(wtl + (size_t)t * 16 * 1024 + 32 * i);
                acc[t] = __builtin_amdgcn_mfma_f32_16x16x32_bf16(wh, xh, acc[t], 0, 0, 0); acc[t] = __builtin_amdgcn_mfma_f32_16x16x32_bf16(wl, xh, acc[t], 0, 0, 0); }
        }
        ssq = nsa::xsum_q(ssq);
        const float rs = 1.0f / sqrtf(ssq * (1.0f / 1024.0f) + kEps);
        const float* wc = (const float*)(ws + WS_WC) + lb * 48;
        float t[48];
#pragma unroll
        for (int tt = 0; tt < 3; ++tt)
#pragma unroll
            for (int r = 0; r < 4; ++r) { const float v = acc[tt][r] * rs + wc[16 * tt + 4 * q + r];
                auto a = __builtin_amdgcn_permlane16_swap(__float_as_uint(v), __float_as_uint(v), false, false);
                auto e = __builtin_amdgcn_permlane32_swap(a[0], a[0], false, false); auto o = __builtin_amdgcn_permlane32_swap(a[1], a[1], false, false);
                t[16 * tt + r] = __uint_as_float(e[0]); t[16 * tt + 4 + r] = __uint_as_float(o[0]); t[16 * tt + 8 + r] = __uint_as_float(e[1]); t[16 * tt + 12 + r] = __uint_as_float(o[1]); }
        int ea = 0, eb = 0, s0 = 0, s1 = 0; float w0 = 0.f, w1 = 0.f;
        if (q == 0 && valid) {
            int grp = 0; float lmax = t[0];
#pragma unroll
            for (int i = 1; i < 4; ++i) if (t[i] > lmax) { lmax = t[i]; grp = i; }
            float den = 0.f;
#pragma unroll
            for (int i = 0; i < 4; ++i) den += __expf(t[i] - lmax);
            const float ptop = 1.0f / den;
            float le[8];
#pragma unroll
            for (int e = 0; e < 8; ++e) le[e] = grp == 0 ? t[4 + e] : grp == 1 ? t[12 + e] : grp == 2 ? t[20 + e] : t[28 + e];
            int i0 = 0; float v0 = le[0];
#pragma unroll
            for (int i = 1; i < 8; ++i) if (le[i] > v0) { v0 = le[i]; i0 = i; }
            int i1 = -1; float v1 = -3.0e38f;
#pragma unroll
            for (int i = 0; i < 8; ++i) if (i != i0 && le[i] > v1) { v1 = le[i]; i1 = i; }
            const float ex = __expf(v1 - v0); w0 = ptop / (1.0f + ex); w1 = ptop * ex / (1.0f + ex);
            ea = grp * 8 + i0; eb = grp * 8 + i1;
            s0 = (int)__hip_atomic_fetch_add(lcnt + ea, 1u, __ATOMIC_RELAXED, __HIP_MEMORY_SCOPE_WORKGROUP); s1 = (int)__hip_atomic_fetch_add(lcnt + eb, 1u, __ATOMIC_RELAXED, __HIP_MEMORY_SCOPE_WORKGROUP);
        }
        __syncthreads();
        if (wave == 0 && lane < 32) { const unsigned c = lcnt[lane]; unsigned* cnt = (unsigned*)(ws + WS_CTL) + CW_CNT + layer * 32 + (dummy ? 64 : 0);
            lcnt[32 + lane] = c ? __hip_atomic_fetch_add(cnt + lane, c, RLX_AGENT) : 0u; }
        __syncthreads();
        if (q == 0 && valid) { s0 += (int)lcnt[32 + ea]; s1 += (int)lcnt[32 + eb];
            int* RT = (int*)(ws + (dummy ? WS_RE : WS_RC)); float* RW = (float*)(RT + 32 * 32768);
            RT[ea * 32768 + s0] = m * 2; RW[ea * 32768 + s0] = w0; RT[eb * 32768 + s1] = m * 2 + 1; RW[eb * 32768 + s1] = w1; }
        __syncthreads();
    }
}
__device__ __forceinline__ void ph_diffcombine(const Ptrs& p, const bf16* O0, const bf16* O1, bf16* AO, int gw, int NGW, int lane) {
    const float* lam = p.diff_lambda;
    const float s1 = wave_sum(lam[lane] * lam[64 + lane]), s2 = wave_sum(lam[128 + lane] * lam[192 + lane]);
    const float lam_full = __expf(s1) - __expf(s2) + 0.2f;
    float sg[8];
#pragma unroll
    for (int i = 0; i < 8; ++i) sg[i] = p.diff_subln_g[(8 * lane + i) & 127] * 0.8f;
    for (int m = gw; m < kM; m += NGW) {
#pragma unroll
        for (int j = 0; j < 2; ++j) { const size_t off = (size_t)m * 1024 + 512 * j + 8 * lane;
            const v4u a = *(const v4u*)(O0 + off), c = *(const v4u*)(O1 + off); float v[8];
#pragma unroll
            for (int i = 0; i < 4; ++i) { v[2 * i] = __uint_as_float(a[i] << 16) - lam_full * __uint_as_float(c[i] << 16); v[2 * i + 1] = __uint_as_float(a[i] & 0xffff0000u) - lam_full * __uint_as_float(c[i] & 0xffff0000u); }
            float ss = 0.f;
#pragma unroll
            for (int i = 0; i < 8; ++i) ss += v[i] * v[i];
            ss += __shfl_xor(ss, 1); ss += __shfl_xor(ss, 2); ss += __shfl_xor(ss, 4); ss += __shfl_xor(ss, 8);
            const float rs = 1.0f / sqrtf(ss * (1.0f / 128.0f) + kEps);
            v4u o; o.x = pk2(v[0] * rs * sg[0], v[1] * rs * sg[1]); o.y = pk2(v[2] * rs * sg[2], v[3] * rs * sg[3]); o.z = pk2(v[4] * rs * sg[4], v[5] * rs * sg[5]); o.w = pk2(v[6] * rs * sg[6], v[7] * rs * sg[7]);
            *(v4u*)(AO + off) = o; }
    }
}
__device__ __forceinline__ void moe_tpre(const Ptrs& p, int layer, LAS int* tpre, int tid) {
    if (tid < 32) { const unsigned* cnt = (const unsigned*)(p.ws + WS_CTL) + CW_CNT + layer * 32; tpre[40 + tid] = (int)__hip_atomic_load(cnt + tid, RLX_AGENT); }
    __syncthreads();
    if (tid < 32) { int acc = 0, nt_me = 0;
#pragma unroll 8
        for (int j = 0; j < 32; ++j) { const int nt = (int)(((unsigned)tpre[40 + j] + 255u) >> 8); if (j < tid) acc += nt; if (j == tid) nt_me = nt; }
        tpre[tid] = acc; if (tid == 31) tpre[32] = acc + nt_me; }
    __syncthreads();
}
__device__ __forceinline__ void ph_gather(const Ptrs& p, const bf16* XN, bf16* Xg, const LAS int* tpre, int gw, int NGW, int lane) {
    unsigned char* ws = p.ws; int* rowtok = (int*)(ws + WS_ROWTOK); float* rowwt = (float*)(ws + WS_ROWWT);
    for (int it = gw; it < 2 * kM; it += NGW) { const int m = it >> 1, k = it & 1; const int* ro = (const int*)(ws + WS_ROUTE) + (size_t)m * 6;
        const int e = ro[k], slot = ro[2 + k]; const float w = ((const float*)ro)[4 + k]; const int row = tpre[e & 31] * 256 + slot;
        const v4u* src = (const v4u*)(XN + (size_t)m * 1024); v4u* dst = (v4u*)(Xg + (size_t)row * 1024);
        dst[lane] = src[lane]; dst[64 + lane] = src[64 + lane];
        if (lane == 0) { rowtok[row] = it; rowwt[row] = w; } }
}
__device__ __forceinline__ void ph_vtrans(const Ptrs& p, const bf16* P, bf16* VTS, bf16* KTS, LAS unsigned char* lds, int gw, int NGW, int wave, int lane) {
    LAS bf16* scr = (LAS bf16*)(lds + RING_OFF + wave * 16384);
    unsigned char* V8 = (unsigned char*)VTS; unsigned char* K8 = (unsigned char*)KTS;
    const int n = lane & 15, q = lane >> 4;
    for (int it = gw; it < 4 * 512; it += NGW) { const int bg = (it >> 9) & 3, G = it & 511, b = bg >> 1, g = bg & 1;
        const bf16* src = P + ((size_t)b * kS + 32 * G) * 2048 + nsa::COL_VS + g * 64;
        { const int kk = lane >> 1, hf = lane & 1; const v4u* sp = (const v4u*)(src + (size_t)kk * 2048 + hf * 32);
#pragma unroll
          for (int c = 0; c < 4; ++c) { const v4u v = sp[c]; LAS unsigned* d = (LAS unsigned*)(scr + kk * 66 + hf * 32 + c * 8); d[0] = v.x; d[1] = v.y; d[2] = v.z; d[3] = v.w; } }
        LDS_WAIT(); asm volatile("" ::: "memory");
#pragma unroll
        for (int h = 0; h < 2; ++h) { unsigned w[4];
#pragma unroll
            for (int e = 0; e < 2; ++e) { const int d = 16 * (2 * h + e) + n; float x[8];
#pragma unroll
                for (int j = 0; j < 8; ++j) x[j] = bf2f(scr[(8 * q + j) * 66 + d]);
                w[2 * e] = nsa::fp8x4(x[0], x[1], x[2], x[3]); w[2 * e + 1] = nsa::fp8x4(x[4], x[5], x[6], x[7]); }
            v4u o; o.x = w[0]; o.y = w[1]; o.z = w[2]; o.w = w[3]; *(v4u*)(V8 + ((size_t)(bg * 512 + G) * 2 + h) * 1024 + lane * 16) = o; }
        LDS_WAIT(); asm volatile("" ::: "memory");
        { const bf16* ks = P + ((size_t)b * kS + 32 * G) * 2048 + nsa::COL_KS + g * 64;
          { const int kk = lane >> 1, hf = lane & 1; const v4u* sp = (const v4u*)(ks + (size_t)kk * 2048 + hf * 32);
#pragma unroll
            for (int c = 0; c < 4; ++c) { const v4u v = sp[c]; LAS unsigned* d = (LAS unsigned*)(scr + kk * 66 + hf * 32 + c * 8); d[0] = v.x; d[1] = v.y; d[2] = v.z; d[3] = v.w; } }
          LDS_WAIT(); asm volatile("" ::: "memory");
#pragma unroll
          for (int T = 0; T < 2; ++T) { const int key = 8 * (n >> 2) + 4 * T + (n & 3); unsigned w[4];
#pragma unroll
              for (int dh = 0; dh < 2; ++dh) { float x[8];
#pragma unroll
                  for (int j = 0; j < 8; ++j) x[j] = bf2f(scr[key * 66 + 32 * dh + 8 * q + j]);
                  w[2 * dh] = nsa::fp8x4(x[0], x[1], x[2], x[3]); w[2 * dh + 1] = nsa::fp8x4(x[4], x[5], x[6], x[7]); }
              v4u o; o.x = w[0]; o.y = w[1]; o.z = w[2]; o.w = w[3]; *(v4u*)(K8 + ((size_t)(bg * 512 + G) * 2 + T) * 1024 + lane * 16) = o; }
          LDS_WAIT(); asm volatile("" ::: "memory"); } }
}

constexpr int N_PHASES = 23;
struct Args { Ptrs p; int ph_lo, ph_hi; };
typedef const unsigned long long __attribute__((address_space(4))) kq_t;
template <class T> __device__ __forceinline__ T* as_global(T* q) { return (T*)(GAS T*)q; }
__global__ void __launch_bounds__(NWAVES * 64, 2) mega_fwd(Args args_unused) {
    extern __shared__ __attribute__((aligned(16))) unsigned char lds_raw[];
    LAS unsigned char* lds = (LAS unsigned char*)lds_raw;
    for (int u = threadIdx.x; u < (LDS_BYTES - LDSCTL_OFF) / 4; u += NWAVES * 64) ((LAS unsigned*)(lds + LDSCTL_OFF))[u] = 0u;
    __syncthreads();
    volatile LAS unsigned* MISC = (volatile LAS unsigned*)(lds + MISC_OFF);
    LAS int* tpre = (LAS int*)(lds + TPRE_OFF);
    int lo, hi;
    { kq_t* kq = (kq_t*)__builtin_amdgcn_kernarg_segment_ptr(); const unsigned long long w = kq[26]; lo = (int)(unsigned)w; hi = (int)(unsigned)(w >> 32); }
#if MK_SINGLE
    XcdBarrier bar;
    { kq_t* kq = (kq_t*)__builtin_amdgcn_kernarg_segment_ptr(); bar = xcd_barrier_post((unsigned*)((unsigned char*)kq[25] + WS_CTL) + CW_BAR, MISC + 8); }
#define GRID_BAR() xcd_barrier(bar)
#else
#define GRID_BAR() do {} while (0)
#endif
#ifndef PH_MASK
#define PH_MASK 0xffffffffu
#endif
#define IN(k) ((((PH_MASK) >> (k)) & 1u) && lo <= (k) && (k) < hi)
#ifndef REP_MASK
#define REP_MASK 0u
#endif
#define PH_REPS(k) (1 + (int)(((REP_MASK) >> (k)) & 1u))
#define SEAM(k) do { if (IN(k) && IN((k) + 1)) GRID_BAR(); } while (0)
#define PH_BEGIN \
    kq_t* kq_ = (kq_t*)__builtin_amdgcn_kernarg_segment_ptr(); asm volatile("" : "+s"(kq_)); \
    Ptrs p; p.x = (const float*)(GAS const float*)(unsigned long long)kq_[0]; p.c = (const float*)(GAS const float*)(unsigned long long)kq_[1]; p.pos = (const int*)(GAS const int*)(unsigned long long)kq_[2]; p.ada_w = (const float*)(GAS const float*)(unsigned long long)kq_[3]; p.ada_b = (const float*)(GAS const float*)(unsigned long long)kq_[4]; p.norm_g = (const float*)(GAS const float*)(unsigned long long)kq_[5]; p.final_g = (const float*)(GAS const float*)(unsigned long long)kq_[6]; p.diff_w_in = (const float*)(GAS const float*)(unsigned long long)kq_[7]; p.diff_w_out = (const float*)(GAS const float*)(unsigned long long)kq_[8]; p.diff_lambda = (const float*)(GAS const float*)(unsigned long long)kq_[9]; p.diff_subln_g = (const float*)(GAS const float*)(unsigned long long)kq_[10]; p.nsa_w_in = (const float*)(GAS const float*)(unsigned long long)kq_[11]; p.nsa_w_out = (const float*)(GAS const float*)(unsigned long long)kq_[12]; p.nsa_cmp_pos = (const float*)(GAS const float*)(unsigned long long)kq_[13]; p.nsa_cmp_w1 = (const float*)(GAS const float*)(unsigned long long)kq_[14]; p.nsa_cmp_b1 = (const float*)(GAS const float*)(unsigned long long)kq_[15]; p.nsa_cmp_w2 = (const float*)(GAS const float*)(unsigned long long)kq_[16]; p.moe_w_group = (const float*)(GAS const float*)(unsigned long long)kq_[17]; p.moe_b_group = (const float*)(GAS const float*)(unsigned long long)kq_[18]; p.moe_w_expert = (const float*)(GAS const float*)(unsigned long long)kq_[19]; p.moe_b_expert = (const float*)(GAS const float*)(unsigned long long)kq_[20]; p.moe_w_gate = (const float*)(GAS const float*)(unsigned long long)kq_[21]; p.moe_w_up = (const float*)(GAS const float*)(unsigned long long)kq_[22]; p.moe_w_down = (const float*)(GAS const float*)(unsigned long long)kq_[23]; p.out = (float*)(GAS float*)(unsigned long long)kq_[24]; p.ws = (unsigned char*)(GAS unsigned char*)(unsigned long long)kq_[25]; \
    unsigned char* ws = p.ws; int G = gridDim.x, bx = blockIdx.x; asm volatile("" : "+s"(G), "+s"(bx)); \
    const int tid = threadIdx.x, lane = tid & 63, wave = __builtin_amdgcn_readfirstlane(tid >> 6); (void)lane; \
    const int vcu = (G % 8 == 0) ? (bx % 8) * (G / 8) + bx / 8 : bx; \
    const int gw = vcu * NWAVES + wave, NGW = G * NWAVES, gtid = bx * (NWAVES * 64) + tid, NT = G * NWAVES * 64; \
    bf16* const RA = (bf16*)(ws + WS_RA); bf16* const RB = (bf16*)(ws + WS_RB); bf16* const RC = (bf16*)(ws + WS_RC); bf16* const RD = (bf16*)(ws + WS_RD); bf16* const RE = (bf16*)(ws + WS_RE); bf16* const RF = (bf16*)(ws + WS_RF); \
    const float* MOD = (const float*)(ws + WS_MOD); const float* ROPE = (const float*)(ws + WS_ROPE); \
    int* rowtok = (int*)(ws + WS_ROWTOK); float* rowwt = (float*)(ws + WS_ROWWT); \
    (void)vcu; (void)gw; (void)NGW; (void)gtid; (void)NT; (void)RA; (void)RB; (void)RC; (void)RD; (void)RE; (void)RF; (void)MOD; (void)ROPE; (void)rowtok; (void)rowwt;

    if (IN(0)) for (int rep_ = 0; rep_ < PH_REPS(0); ++rep_) { const bool dummy_ = rep_ + 1 < PH_REPS(0); if (rep_) __syncthreads(); PH_BEGIN ph_prologue(p, lds, gw, NGW, wave, lane, gtid, NT); } SEAM(0);
    if (IN(1)) for (int rep_ = 0; rep_ < PH_REPS(1); ++rep_) { const bool dummy_ = rep_ + 1 < PH_REPS(1); if (rep_) __syncthreads(); PH_BEGIN ph_finalize(p, gtid, NT); } SEAM(1);
    if (IN(2)) for (int rep_ = 0; rep_ < PH_REPS(2); ++rep_) { const bool dummy_ = rep_ + 1 < PH_REPS(2); if (rep_) __syncthreads(); PH_BEGIN ph_rows<false, false, false>(p, p.x, nullptr, nullptr, MOD, 0, 0, p.norm_g, RA, 0, gw, NGW, lane, gtid, NT); ph_router_prep(p, MOD, gw, NGW, lane, gtid, NT); } SEAM(2);
    if (IN(3)) for (int rep_ = 0; rep_ < PH_REPS(3); ++rep_) { const bool dummy_ = rep_ + 1 < PH_REPS(3); if (rep_) __syncthreads(); PH_BEGIN
        { pg8::Gemm g{RA, (const bf16*)(ws + WS_WQKV), kM, 2048, 1024, 1024}; pg8::StaticOrder S; S.init(kM, 2048, G, bx);
          pg8::EpiQKV E{RB, (size_t)(WS_RC - WS_RB) / 2, pg8::RopeCtx{ROPE, 0xffffu}};
          pg8::gemm_phase<pg8::EpiQKV, pg8::StaticOrder, true, true>(lds + RING_OFF, g, S, E); }
        { pg8::Gemm g{RA, (const bf16*)(ws + WS_WQKV) + (size_t)2048 * 1024, kM, 1024, 1024, 1024}; pg8::StaticOrder S; S.init(kM, 1024, G, bx);
          pg8::EpiV8 E{(unsigned char*)RD};
          pg8::gemm_phase<pg8::EpiV8, pg8::StaticOrder, true, true, true>(lds + RING_OFF, g, S, E); } } SEAM(3);
    if (IN(4)) for (int rep_ = 0; rep_ < PH_REPS(4); ++rep_) { const bool dummy_ = rep_ + 1 < PH_REPS(4); if (rep_) __syncthreads(); PH_BEGIN attn_body::diff_attn_phase3<8>((char*)lds_raw + RING_OFF, (const attn_body::bf16*)RB, (const attn_body::bf16*)RC, (const unsigned char*)RD, (attn_body::bf16*)RE, (attn_body::bf16*)RF, vcu, G); } SEAM(4);
    if (IN(5)) for (int rep_ = 0; rep_ < PH_REPS(5); ++rep_) { const bool dummy_ = rep_ + 1 < PH_REPS(5); if (rep_) __syncthreads(); PH_BEGIN ph_diffcombine(p, RE, RF, RA, gw, NGW, lane); } SEAM(5);
    if (IN(6)) for (int rep_ = 0; rep_ < PH_REPS(6); ++rep_) { const bool dummy_ = rep_ + 1 < PH_REPS(6); if (rep_) __syncthreads(); PH_BEGIN pg8::Gemm g{RA, (const bf16*)(ws + WS_WO0), kM, 1024, 1024, 1024}; pg8::StaticOrder S; S.init(kM, 1024, G, bx);
        pg8::EpiResidB E{p.x, nullptr, RD, MOD + 2 * 1024};
        pg8::gemm_phase<pg8::EpiResidB, pg8::StaticOrder, true, true>(lds + RING_OFF, g, S, E); } SEAM(6);
    if (IN(7)) for (int rep_ = 0; rep_ < PH_REPS(7); ++rep_) { const bool dummy_ = rep_ + 1 < PH_REPS(7); if (rep_) __syncthreads(); PH_BEGIN ph_rows<false, false, true>(p, (const float*)RD, nullptr, nullptr, MOD, 3, 0, p.norm_g + 1024, RB, 0, gw, NGW, lane, gtid, NT); ph_router(p, (const float*)RD, 0, lds, vcu, G, wave, lane, gtid, NT, dummy_); } SEAM(7);
    if (IN(9)) for (int rep_ = 0; rep_ < PH_REPS(9); ++rep_) { const bool dummy_ = rep_ + 1 < PH_REPS(9); (void)dummy_; if (rep_) __syncthreads(); PH_BEGIN
        moe_tpre(p, 0, tpre, tid); pg8::Gemm g{RB, (const bf16*)(ws + WS_MOE0), kMpad, 32 * 512, 1024, 1024}; pg8::MoeOrder S{tpre, 2, G, vcu};
        const int* RT = (const int*)(ws + WS_RC); const float* RW = (const float*)(RT + 32 * 32768);
        LAS unsigned* gtab = (LAS unsigned*)(lds + GTAB_OFF);
        for (int i = 0; i < GTAB_UNITS; ++i) { pg8::Unit u; if (!S.next(i, u)) break;
            if (tid < 256) { const int idx = u.ti * 256 + tid; const int tok = idx < u.cnt ? (RT[u.e * 32768 + idx] >> 1) : 0; gtab[i * 256 + tid] = (unsigned)tok * 2048u; } }
        __syncthreads();
        pg8::EpiGateUp E{RF, RW}; pg8::gemm_phase_g<pg8::EpiGateUp, pg8::MoeOrder, true>(lds + RING_OFF, g, S, E, gtab); } SEAM(9);
    if (IN(10)) for (int rep_ = 0; rep_ < PH_REPS(10); ++rep_) { const bool dummy_ = rep_ + 1 < PH_REPS(10); if (rep_) __syncthreads(); PH_BEGIN moe_tpre(p, 0, tpre, tid); pg8::Gemm g{RF, (const bf16*)(ws + WS_MOE0 + MOE_WD), kMpad, 32 * 1024, 256, 256}; pg8::MoeOrder S{tpre, 4, G, vcu};
        pg8::EpiScatter E{ws, (unsigned)WS_RA, (unsigned)WS_DUMP, (const int*)(ws + WS_RC)}; pg8::gemm_phase<pg8::EpiScatter, pg8::MoeOrder, true, true>(lds + RING_OFF, g, S, E); } SEAM(10);
    if (IN(11)) for (int rep_ = 0; rep_ < PH_REPS(11); ++rep_) { const bool dummy_ = rep_ + 1 < PH_REPS(11); if (rep_) __syncthreads(); PH_BEGIN ph_rows<true, false, true>(p, (const float*)RD, dummy_ ? (float*)RE : p.out, RA, MOD, 12, 5, p.norm_g + 2048, RC, 1, gw, NGW, lane, gtid, NT); }         SEAM(11);
    if (IN(12)) for (int rep_ = 0; rep_ < PH_REPS(12); ++rep_) { const bool dummy_ = rep_ + 1 < PH_REPS(12); if (rep_) __syncthreads(); PH_BEGIN pg8::Gemm g{RC, (const bf16*)(ws + WS_WNSA), kM, 2048, 1024, 1024}; pg8::StaticOrder S; S.init(kM, 2048, G, bx);
        pg8::EpiNsaProj E{RD, (bf16*)(ws + NS_KC), pg8::RopeCtx{ROPE, 0x3cffu}};
        pg8::gemm_phase<pg8::EpiNsaProj, pg8::StaticOrder, true, true>(lds + RING_OFF, g, S, E); } SEAM(12);
    if (IN(13)) for (int rep_ = 0; rep_ < PH_REPS(13); ++rep_) { const bool dummy_ = rep_ + 1 < PH_REPS(13); (void)dummy_; if (rep_) __syncthreads();
        { PH_BEGIN pg8::Gemm g{(const bf16*)(ws + NS_KC), (const bf16*)(ws + WS_W1C), 8192, 512, 2048, 1024}; pg8::CmpOrder S{G, bx};
          pg8::EpiCmp1 E{(bf16*)(ws + NS_HID), (const float*)(ws + WS_CBF)};
          pg8::gemm_phase<pg8::EpiCmp1, pg8::CmpOrder, true, true>(lds + RING_OFF, g, S, E); }
        asm volatile("s_waitcnt vmcnt(0)" ::: "memory"); __builtin_amdgcn_fence(__ATOMIC_RELEASE, "workgroup"); __syncthreads(); __builtin_amdgcn_fence(__ATOMIC_ACQUIRE, "workgroup");
        { PH_BEGIN pg8::Gemm g{(const bf16*)(ws + NS_HID), (const bf16*)(ws + WS_W2C), 8192, 512, 256, 256}; pg8::CmpOrder S{G, bx};
          pg8::EpiCmp2 E{(unsigned char*)(ws + NS_KCMP), (unsigned char*)(ws + NS_VCT)};
          pg8::gemm_phase<pg8::EpiCmp2, pg8::CmpOrder, true, true>(lds + RING_OFF, g, S, E); }
        __syncthreads();
        { PH_BEGIN ph_vtrans(p, RD, (bf16*)(ws + NS_VTS), (bf16*)(ws + NS_VTW), lds, gw, NGW, wave, lane); }
        __syncthreads();
        { PH_BEGIN attn_body::nsa_window_phase((char*)lds_raw + RING_OFF, (const attn_body::bf16*)RD, (attn_body::bf16*)RB, (unsigned*)(ws + WS_CTL) + CW_QCTR + 128 + rep_ * 64, MISC + 16); }
    } SEAM(13);
    if (IN(16)) for (int rep_ = 0; rep_ < PH_REPS(16); ++rep_) { const bool dummy_ = rep_ + 1 < PH_REPS(16); if (rep_) __syncthreads(); PH_BEGIN const nsa::Tensors T{RD, (const unsigned char*)(ws + NS_KCMP), (const unsigned char*)(ws + NS_VTW), (const unsigned char*)(ws + NS_VCT), (const unsigned char*)(ws + NS_VTS), RB, RA};
        LAS float* wl = (LAS float*)(lds + RING_OFF + wave * 16384);
        unsigned* qbase = (unsigned*)(ws + WS_CTL) + CW_QCTR + 1024 + rep_ * 512;
        const unsigned xcc = xb_xcc_id() & 7u;
        for (unsigned qi = 0; qi < 8u; ++qi) { const unsigned qq = (xcc + qi) & 7u; unsigned* qc = qbase + qq * 64;
            for (;;) { unsigned it = 0; if (lane == 0) it = __hip_atomic_fetch_add(qc, 1u, RLX_AGENT); it = (unsigned)__builtin_amdgcn_readfirstlane((int)it);
                if (it >= 2048u) break;
                nsa::quad_item(T, (int)(((qq >> 1) << 12) | ((qq & 1u) * 2048u + 2047u - it)), wl, lane); } } } SEAM(16);
    if (IN(17)) for (int rep_ = 0; rep_ < PH_REPS(17); ++rep_) { const bool dummy_ = rep_ + 1 < PH_REPS(17); if (rep_) __syncthreads(); PH_BEGIN pg8::Gemm g{RA, (const bf16*)(ws + WS_WO1), kM, 1024, 1024, 1024}; pg8::StaticOrder S; S.init(kM, 1024, G, bx);
        pg8::EpiResidB E{nullptr, (const bf16*)p.out, dummy_ ? RE : RD, MOD + 12288 + 2 * 1024};
        pg8::gemm_phase<pg8::EpiResidB, pg8::StaticOrder, true, true>(lds + RING_OFF, g, S, E); } SEAM(17);
    if (IN(18)) for (int rep_ = 0; rep_ < PH_REPS(18); ++rep_) { const bool dummy_ = rep_ + 1 < PH_REPS(18); if (rep_) __syncthreads(); PH_BEGIN ph_rows<false, false, true>(p, (const float*)RD, nullptr, nullptr, MOD + 12288, 3, 0, p.norm_g + 3072, RB, 1, gw, NGW, lane, gtid, NT); ph_router(p, (const float*)RD, 1, lds, vcu, G, wave, lane, gtid, NT, dummy_); } SEAM(18);
    if (IN(20)) for (int rep_ = 0; rep_ < PH_REPS(20); ++rep_) { const bool dummy_ = rep_ + 1 < PH_REPS(20); (void)dummy_; if (rep_) __syncthreads(); PH_BEGIN
        moe_tpre(p, 1, tpre, tid); pg8::Gemm g{RB, (const bf16*)(ws + WS_MOE0 + MOE_L), kMpad, 32 * 512, 1024, 1024}; pg8::MoeOrder S{tpre, 2, G, vcu};
        const int* RT = (const int*)(ws + WS_RC); const float* RW = (const float*)(RT + 32 * 32768);
        LAS unsigned* gtab = (LAS unsigned*)(lds + GTAB_OFF);
        for (int i = 0; i < GTAB_UNITS; ++i) { pg8::Unit u; if (!S.next(i, u)) break;
            if (tid < 256) { const int idx = u.ti * 256 + tid; const int tok = idx < u.cnt ? (RT[u.e * 32768 + idx] >> 1) : 0; gtab[i * 256 + tid] = (unsigned)tok * 2048u; } }
        __syncthreads();
        pg8::EpiGateUp E{RF, RW}; pg8::gemm_phase_g<pg8::EpiGateUp, pg8::MoeOrder, true>(lds + RING_OFF, g, S, E, gtab); } SEAM(20);
    if (IN(21)) for (int rep_ = 0; rep_ < PH_REPS(21); ++rep_) { const bool dummy_ = rep_ + 1 < PH_REPS(21); if (rep_) __syncthreads(); PH_BEGIN moe_tpre(p, 1, tpre, tid); pg8::Gemm g{RF, (const bf16*)(ws + WS_MOE0 + MOE_L + MOE_WD), kMpad, 32 * 1024, 256, 256}; pg8::MoeOrder S{tpre, 4, G, vcu};
        pg8::EpiScatter E{ws, (unsigned)WS_RA, (unsigned)WS_DUMP, (const int*)(ws + WS_RC)}; pg8::gemm_phase<pg8::EpiScatter, pg8::MoeOrder, true, true>(lds + RING_OFF, g, S, E); } SEAM(21);
    if (IN(22)) for (int rep_ = 0; rep_ < PH_REPS(22); ++rep_) { const bool dummy_ = rep_ + 1 < PH_REPS(22); if (rep_) __syncthreads(); PH_BEGIN ph_rows<true, true, true>(p, (const float*)RD, dummy_ ? (float*)RE : p.out, RA, MOD + 12288, 0, 5, p.final_g, nullptr, 1, gw, NGW, lane, gtid, NT); }
#undef IN
#undef SEAM
}

extern "C" void kernel_launch(void* const* d_in, const int* in_sizes, int n_in, void* d_out, int out_size, void* d_ws, size_t ws_size, hipStream_t stream) {
    static int grid = 0;
    if (grid == 0) {
        if (n_in != 24 || in_sizes[0] != kM * kD || out_size != kM * kD || ws_size < WS_END) { fprintf(stderr, "kernel_launch: unexpected shapes (n_in %d, in0 %d, out %d, ws %zu)\n", n_in, n_in > 0 ? in_sizes[0] : -1, out_size, ws_size); grid = -1; return; }
        int dev = 0, cus = 0, per_cu = 0;
        if (hipGetDevice(&dev) != hipSuccess || hipDeviceGetAttribute(&cus, hipDeviceAttributeMultiprocessorCount, dev) != hipSuccess) { grid = -1; return; }
        if (hipFuncSetAttribute((const void*)mega_fwd, hipFuncAttributeMaxDynamicSharedMemorySize, LDS_BYTES) != hipSuccess) { fprintf(stderr, "kernel_launch: hipFuncSetAttribute failed\n"); grid = -1; return; }
        if (hipOccupancyMaxActiveBlocksPerMultiprocessor(&per_cu, (const void*)mega_fwd, NWAVES * 64, LDS_BYTES) != hipSuccess || per_cu < 1) { fprintf(stderr, "kernel_launch: occupancy query says %d\n", per_cu); }
        (void)hipGetLastError();
        grid = cus;
    }
    if (grid < 0) return;
    if (hipMemsetAsync((char*)d_ws + WS_CTL, 0, CTL_ZERO_BYTES, stream) != hipSuccess) return;
    Args a{};
    const void** pp = (const void**)&a.p;
    for (int i = 0; i < 24; ++i) pp[i] = d_in[i];
    a.p.out = (float*)d_out; a.p.ws = (unsigned char*)d_ws;
#if MK_SINGLE
    a.ph_lo = 0; a.ph_hi = N_PHASES;
    hipLaunchKernelGGL(mega_fwd, dim3(grid), dim3(NWAVES * 64), LDS_BYTES, stream, a);
#else
    for (int ph = 0; ph < N_PHASES; ++ph) { a.ph_lo = ph; a.ph_hi = ph + 1; hipLaunchKernelGGL(mega_fwd, dim3(grid), dim3(NWAVES * 64), LDS_BYTES, stream, a); }
#endif
}
```
